# Optimizing an MI355X kernel written in HIP

```python
import jax, jax.numpy as jnp
from jax import lax
import numpy as np

D_MODEL = 1024
BATCH = 8
SEQ = 2048
DEPTH = 1

D_MIX = D_MODEL
D_A = D_MIX // 2
D_B = D_MIX - D_A
HEAD_CH = 64
N_HEADS_A = D_A // HEAD_CH
N_HEADS_B = D_B // HEAD_CH
CONV_A_WIDTH = 3
CONV_B_WIDTH = 31
D_IN = 3 * D_A + 2 * D_B
N_GROUPS = 4
EXPERTS_PER_GROUP = 8
N_EXPERTS = N_GROUPS * EXPERTS_PER_GROUP
TOP_K_IN_GROUP = 2
D_EXPERT = D_MODEL // 2
EPS = 1e-6

kernel_name = "hybrid_shortconv_conformer_hmoe_encoder"


def rmsnorm(x, g):
    xf = x.astype(jnp.float32)
    r = lax.rsqrt(jnp.mean(xf * xf, axis=-1, keepdims=True) + EPS)
    return (xf * r).astype(x.dtype) * g


def layernorm(x, g, b):
    xf = x.astype(jnp.float32)
    mu = jnp.mean(xf, axis=-1, keepdims=True)
    var = jnp.mean(jnp.square(xf - mu), axis=-1, keepdims=True)
    return ((xf - mu) * lax.rsqrt(var + EPS)).astype(x.dtype) * g + b


def head_rmsnorm(y, n_heads, gain):
    bsz, s, c = y.shape
    yh = y.reshape(bsz, s, n_heads, c // n_heads).astype(jnp.float32)
    yh = yh * lax.rsqrt(jnp.mean(yh * yh, axis=-1, keepdims=True) + EPS)
    return yh.reshape(bsz, s, c).astype(y.dtype) * gain


def depthwise_conv_centred(u, w):
    k = w.shape[0]
    pad = (k - 1) // 2
    return lax.conv_general_dilated(
        u, w[:, None, :].astype(u.dtype), window_strides=(1,), padding=[(pad, pad)],
        dimension_numbers=("NWC", "WIO", "NWC"), feature_group_count=u.shape[-1])


def mixer_block(h, w_in, conv_a_w, conv_b_w, conv_b_bias, ln_b_g, ln_b_b, beta_a, beta_b, w_out):
    proj = jnp.einsum("bsd,dc->bsc", h, w_in)
    a_in, a_b, a_c, b_val, b_gate = jnp.split(
        proj, [D_A, 2 * D_A, 3 * D_A, 3 * D_A + D_B], axis=-1)
    y_a = a_b * depthwise_conv_centred(a_c * a_in, conv_a_w)
    u = b_val * jax.nn.sigmoid(b_gate)
    u = depthwise_conv_centred(u, conv_b_w) + conv_b_bias
    y_b = jax.nn.silu(layernorm(u, ln_b_g, ln_b_b))
    y = jnp.concatenate([head_rmsnorm(y_a, N_HEADS_A, beta_a),
                         head_rmsnorm(y_b, N_HEADS_B, beta_b)], axis=-1)
    return jnp.einsum("bsc,cd->bsd", y, w_out)


def hierarchical_moe(h, w_route_group, b_route_group, w_route_expert, b_route_expert, w1, w3, w2):
    bsz, s, d = h.shape
    t = h.reshape(bsz * s, d)
    p_group = jax.nn.softmax((t @ w_route_group + b_route_group).astype(jnp.float32), axis=-1)
    g_idx = jnp.argmax(p_group, axis=-1)
    p_sel = jnp.take_along_axis(p_group, g_idx[:, None], axis=1)[:, 0]
    le = (t @ w_route_expert + b_route_expert).astype(jnp.float32)
    le = le.reshape(-1, N_GROUPS, EXPERTS_PER_GROUP)
    le_sel = jnp.take_along_axis(le, g_idx[:, None, None], axis=1)[:, 0]
    p_exp = jax.nn.softmax(le_sel, axis=-1)
    top_v, top_i = lax.top_k(p_exp, TOP_K_IN_GROUP)
    top_w = top_v / jnp.sum(top_v, axis=-1, keepdims=True)
    eid = g_idx[:, None] * EXPERTS_PER_GROUP + top_i
    combine = p_sel[:, None] * jnp.einsum(
        "tk,tke->te", top_w, jax.nn.one_hot(eid, N_EXPERTS, dtype=jnp.float32))
    combine = combine.astype(t.dtype)
    out = jnp.zeros_like(t)
    for e in range(N_EXPERTS):
        act = jax.nn.silu(t @ w1[e]) * (t @ w3[e])
        out = out + combine[:, e:e + 1] * (act @ w2[e])
    return out.reshape(bsz, s, d)


def setup_inputs(seed: int = 0) -> dict:
    key = jax.random.key(seed)
    ks = jax.random.split(key, 20)
    f32 = jnp.float32
    nrm = lambda k, shape, scale: jax.random.normal(k, shape, f32) * scale
    L = DEPTH
    return {
        "x": jax.random.normal(ks[0], (BATCH, SEQ, D_MODEL), f32),
        "norm_mix_g": 1.0 + nrm(ks[1], (L, D_MODEL), 0.02),
        "w_in": nrm(ks[2], (L, D_MODEL, D_IN), D_MODEL ** -0.5),
        "conv_a_w": nrm(ks[3], (L, CONV_A_WIDTH, D_A), CONV_A_WIDTH ** -0.5),
        "conv_b_w": nrm(ks[4], (L, CONV_B_WIDTH, D_B), CONV_B_WIDTH ** -0.5),
        "conv_b_bias": nrm(ks[5], (L, D_B), 0.02),
        "ln_b_g": 1.0 + nrm(ks[6], (L, D_B), 0.02),
        "ln_b_b": nrm(ks[7], (L, D_B), 0.02),
        "beta_a": 1.0 + nrm(ks[8], (L, D_A), 0.02),
        "beta_b": 1.0 + nrm(ks[9], (L, D_B), 0.02),
        "w_out": nrm(ks[10], (L, D_MIX, D_MODEL), D_MIX ** -0.5),
        "norm_ffn_g": 1.0 + nrm(ks[11], (L, D_MODEL), 0.02),
        "w_route_group": nrm(ks[12], (L, D_MODEL, N_GROUPS), D_MODEL ** -0.5),
        "b_route_group": nrm(ks[13], (L, N_GROUPS), 0.01),
        "w_route_expert": nrm(ks[14], (L, D_MODEL, N_EXPERTS), D_MODEL ** -0.5),
        "b_route_expert": nrm(ks[15], (L, N_EXPERTS), 0.01),
        "w1": nrm(ks[16], (L, N_EXPERTS, D_MODEL, D_EXPERT), D_MODEL ** -0.5),
        "w3": nrm(ks[17], (L, N_EXPERTS, D_MODEL, D_EXPERT), D_MODEL ** -0.5),
        "w2": nrm(ks[18], (L, N_EXPERTS, D_EXPERT, D_MODEL), D_EXPERT ** -0.5),
        "norm_final_g": 1.0 + nrm(ks[19], (D_MODEL,), 0.02),
    }


def reference(x, norm_mix_g, w_in, conv_a_w, conv_b_w, conv_b_bias, ln_b_g, ln_b_b,
              beta_a, beta_b, w_out, norm_ffn_g, w_route_group, b_route_group,
              w_route_expert, b_route_expert, w1, w3, w2, norm_final_g):
    for l in range(DEPTH):
        h = rmsnorm(x, norm_mix_g[l])
        x = x + mixer_block(h, w_in[l], conv_a_w[l], conv_b_w[l], conv_b_bias[l],
                            ln_b_g[l], ln_b_b[l], beta_a[l], beta_b[l], w_out[l])
        h = rmsnorm(x, norm_ffn_g[l])
        x = x + hierarchical_moe(h, w_route_group[l], b_route_group[l], w_route_expert[l],
                                 b_route_expert[l], w1[l], w3[l], w2[l])
    return rmsnorm(x, norm_final_g)
```

```cpp
#include <hip/hip_runtime.h>
#include <cstdio>
#include <cstdint>

constexpr int T = 16384, SEQ = 2048, D = 1024, DA = 512, DB = 512, DIN = 2560, NG = 4, EPG = 8, NE = 32, DE = 512;
constexpr float EPS = 1e-6f;

__device__ __forceinline__ float wave_sum(float v) {
#pragma unroll
    for (int o = 1; o < 64; o <<= 1) v += __shfl_xor(v, o);
    return v;
}
__device__ __forceinline__ float sigmoidf_(float v) { return 1.0f / (1.0f + __expf(-v)); }
__device__ __forceinline__ float siluf_(float v) { return v * sigmoidf_(v); }

__global__ void k_rowrms(const float* __restrict__ x, float* __restrict__ r) {
    const int t = blockIdx.x * 4 + (threadIdx.x >> 6), lane = threadIdx.x & 63;
    float s = 0.f;
    for (int k = lane; k < D; k += 64) { const float v = x[(size_t)t * D + k]; s += v * v; }
    s = wave_sum(s);
    if (lane == 0) r[t] = rsqrtf(s / D + EPS);
}

template <bool HAS_RS, bool HAS_KS, bool HAS_RES>
__global__ void k_gemm_naive(const float* __restrict__ A, const float* __restrict__ B, float* __restrict__ C, int N, int K,
                             const float* __restrict__ rs, const float* __restrict__ ks, const float* __restrict__ res) {
    const int n = blockIdx.x * 256 + threadIdx.x, t0 = blockIdx.y * 8;
    float acc[8];
#pragma unroll
    for (int i = 0; i < 8; ++i) acc[i] = 0.f;
    for (int k = 0; k < K; ++k) {
        float b = B[(size_t)k * N + n];
        if (HAS_KS) b *= ks[k];
#pragma unroll
        for (int i = 0; i < 8; ++i) acc[i] += A[(size_t)(t0 + i) * K + k] * b;
    }
#pragma unroll
    for (int i = 0; i < 8; ++i) {
        float v = acc[i];
        if (HAS_RS) v *= rs[t0 + i];
        if (HAS_RES) v += res[(size_t)(t0 + i) * N + n];
        C[(size_t)(t0 + i) * N + n] = v;
    }
}

__global__ void __launch_bounds__(512) k_mixer(const float* __restrict__ proj, const float* __restrict__ conv_a_w, const float* __restrict__ conv_b_w, const float* __restrict__ conv_b_bias,
                        const float* __restrict__ ln_g, const float* __restrict__ ln_b, const float* __restrict__ beta_a, const float* __restrict__ beta_b, float* __restrict__ y) {
    __shared__ float red[16];
    const int t = blockIdx.x, c = threadIdx.x, lane = c & 63, w = c >> 6;
    const int b = t / SEQ, s = t % SEQ;
    float ca = 0.f;
#pragma unroll
    for (int j = 0; j < 3; ++j) { const int ss = s + j - 1; if (ss >= 0 && ss < SEQ) { const float* p = proj + (size_t)(b * SEQ + ss) * DIN; ca += conv_a_w[j * DA + c] * (p[2 * DA + c] * p[c]); } }
    float ya = proj[(size_t)t * DIN + DA + c] * ca;
    float ub = conv_b_bias[c];
    for (int j = 0; j < 31; ++j) { const int ss = s + j - 15; if (ss >= 0 && ss < SEQ) { const float* p = proj + (size_t)(b * SEQ + ss) * DIN; ub += conv_b_w[j * DB + c] * (p[3 * DA + c] * sigmoidf_(p[3 * DA + DB + c])); } }
    float s1 = wave_sum(ub);
    if (lane == 0) red[w] = s1;
    __syncthreads();
    float mu = 0.f;
    for (int i = 0; i < 8; ++i) mu += red[i];
    mu /= DB;
    const float dv = ub - mu;
    float s2 = wave_sum(dv * dv);
    if (lane == 0) red[8 + w] = s2;
    __syncthreads();
    float var = 0.f;
    for (int i = 0; i < 8; ++i) var += red[8 + i];
    var /= DB;
    float yb = siluf_(dv * rsqrtf(var + EPS) * ln_g[c] + ln_b[c]);
    const float ra = rsqrtf(wave_sum(ya * ya) / 64.f + EPS), rb = rsqrtf(wave_sum(yb * yb) / 64.f + EPS);
    y[(size_t)t * D + c] = ya * ra * beta_a[c];
    y[(size_t)t * D + DA + c] = yb * rb * beta_b[c];
}

__global__ void __launch_bounds__(256) k_moe_final(const float* __restrict__ x1, const float* __restrict__ gf, const float* __restrict__ wrg, const float* __restrict__ brg, const float* __restrict__ wre, const float* __restrict__ bre,
                            const float* __restrict__ w1, const float* __restrict__ w3, const float* __restrict__ w2, const float* __restrict__ gfin, float* __restrict__ out) {
    __shared__ float h[D];
    __shared__ float act[DE];
    __shared__ float red[8];
    __shared__ float lg[36];
    __shared__ int s_e[2];
    __shared__ float s_c[2];
    const int t = blockIdx.x, tid = threadIdx.x, lane = tid & 63, w = tid >> 6;
    float xv[4]; float ss = 0.f;
#pragma unroll
    for (int i = 0; i < 4; ++i) { xv[i] = x1[(size_t)t * D + tid + 256 * i]; ss += xv[i] * xv[i]; }
    ss = wave_sum(ss);
    if (lane == 0) red[w] = ss;
    __syncthreads();
    const float r2 = rsqrtf((red[0] + red[1] + red[2] + red[3]) / D + EPS);
#pragma unroll
    for (int i = 0; i < 4; ++i) h[tid + 256 * i] = xv[i] * r2 * gf[tid + 256 * i];
    __syncthreads();
    for (int o = w; o < 36; o += 4) {
        float s = 0.f;
        for (int k = lane; k < D; k += 64) s += h[k] * (o < 4 ? wrg[(size_t)k * NG + o] : wre[(size_t)k * NE + (o - 4)]);
        s = wave_sum(s);
        if (lane == 0) lg[o] = s + (o < 4 ? brg[o] : bre[o - 4]);
    }
    __syncthreads();
    if (tid == 0) {
        int g = 0; float m = lg[0];
        for (int i = 1; i < 4; ++i) if (lg[i] > m) { m = lg[i]; g = i; }
        float den = 0.f;
        for (int i = 0; i < 4; ++i) den += __expf(lg[i] - m);
        const float psel = 1.0f / den;
        const float* le = lg + 4 + g * 8;
        int i0 = 0; float m0 = le[0];
        for (int i = 1; i < 8; ++i) if (le[i] > m0) { m0 = le[i]; i0 = i; }
        int i1 = -1; float m1 = -3.0e38f;
        for (int i = 0; i < 8; ++i) if (i != i0 && le[i] > m1) { m1 = le[i]; i1 = i; }
        const float e1 = __expf(m1 - m0);
        const float wa = 1.0f / (1.0f + e1), wb = e1 / (1.0f + e1);
        s_e[0] = g * 8 + i0; s_e[1] = g * 8 + i1; s_c[0] = psel * wa; s_c[1] = psel * wb;
    }
    __syncthreads();
    float o4[4] = {0.f, 0.f, 0.f, 0.f};
    for (int sidx = 0; sidx < 2; ++sidx) {
        const int e = s_e[sidx]; const float cw = s_c[sidx];
        const float* W1 = w1 + (size_t)e * D * DE; const float* W3 = w3 + (size_t)e * D * DE; const float* W2 = w2 + (size_t)e * DE * D;
        float a0 = 0.f, a1 = 0.f, b0 = 0.f, b1 = 0.f;
        for (int k = 0; k < D; ++k) { const float hv = h[k]; a0 += hv * W1[(size_t)k * DE + tid]; a1 += hv * W1[(size_t)k * DE + tid + 256]; b0 += hv * W3[(size_t)k * DE + tid]; b1 += hv * W3[(size_t)k * DE + tid + 256]; }
        __syncthreads();
        act[tid] = siluf_(a0) * b0; act[tid + 256] = siluf_(a1) * b1;
        __syncthreads();
        float q[4] = {0.f, 0.f, 0.f, 0.f};
        for (int k = 0; k < DE; ++k) { const float av = act[k];
#pragma unroll
            for (int i = 0; i < 4; ++i) q[i] += av * W2[(size_t)k * D + tid + 256 * i]; }
#pragma unroll
        for (int i = 0; i < 4; ++i) o4[i] += cw * q[i];
    }
    float s2 = 0.f;
#pragma unroll
    for (int i = 0; i < 4; ++i) { o4[i] += xv[i]; s2 += o4[i] * o4[i]; }
    s2 = wave_sum(s2);
    __syncthreads();
    if (lane == 0) red[4 + w] = s2;
    __syncthreads();
    const float r3 = rsqrtf((red[4] + red[5] + red[6] + red[7]) / D + EPS);
#pragma unroll
    for (int i = 0; i < 4; ++i) out[(size_t)t * D + tid + 256 * i] = o4[i] * r3 * gfin[tid + 256 * i];
}

extern "C" void kernel_launch(void* const* d_in, const int* in_sizes, int n_in, void* d_out, int out_size, void* d_ws, size_t ws_size, hipStream_t stream) {
    const float* x = (const float*)d_in[0]; const float* norm_mix_g = (const float*)d_in[1]; const float* w_in = (const float*)d_in[2];
    const float* conv_a_w = (const float*)d_in[3]; const float* conv_b_w = (const float*)d_in[4]; const float* conv_b_bias = (const float*)d_in[5];
    const float* ln_b_g = (const float*)d_in[6]; const float* ln_b_b = (const float*)d_in[7]; const float* beta_a = (const float*)d_in[8]; const float* beta_b = (const float*)d_in[9];
    const float* w_out = (const float*)d_in[10]; const float* norm_ffn_g = (const float*)d_in[11]; const float* wrg = (const float*)d_in[12]; const float* brg = (const float*)d_in[13];
    const float* wre = (const float*)d_in[14]; const float* bre = (const float*)d_in[15]; const float* w1 = (const float*)d_in[16]; const float* w3 = (const float*)d_in[17];
    const float* w2 = (const float*)d_in[18]; const float* gfin = (const float*)d_in[19];
    float* out = (float*)d_out;
    char* ws = (char*)d_ws;
    const size_t need = (size_t)1 << 20 | 0; (void)need;
    float* r1 = (float*)ws;
    float* proj = (float*)(ws + (1u << 20));
    float* y = (float*)(ws + (1u << 20) + (size_t)T * DIN * 4);
    float* x1 = proj;
    if (ws_size < (1u << 20) + (size_t)T * DIN * 4 + (size_t)T * D * 4) { fprintf(stderr, "kernel_launch: workspace too small (%zu)\n", ws_size); return; }
    k_rowrms<<<T / 4, 256, 0, stream>>>(x, r1);
    k_gemm_naive<true, true, false><<<dim3(DIN / 256, T / 8), 256, 0, stream>>>(x, w_in, proj, DIN, D, r1, norm_mix_g, nullptr);
    k_mixer<<<T, 512, 0, stream>>>(proj, conv_a_w, conv_b_w, conv_b_bias, ln_b_g, ln_b_b, beta_a, beta_b, y);
    k_gemm_naive<false, false, true><<<dim3(D / 256, T / 8), 256, 0, stream>>>(y, w_out, x1, D, D, nullptr, nullptr, x);
    k_moe_final<<<T, 256, 0, stream>>>(x1, norm_ffn_g, wrg, brg, wre, bre, w1, w3, w2, gfin, out);
}
```

```cpp
#include <hip/hip_runtime.h>
#include <cstdio>
#include <cstdint>

#define LAS __attribute__((address_space(3)))
#define GAS __attribute__((address_space(1)))
typedef unsigned short bf16;
typedef short bf16x8 __attribute__((ext_vector_type(8)));
typedef float f32x4 __attribute__((ext_vector_type(4)));
typedef float f32x2 __attribute__((ext_vector_type(2)));
typedef unsigned u32x4 __attribute__((ext_vector_type(4)));
typedef unsigned u32x2 __attribute__((ext_vector_type(2)));
typedef GAS unsigned gu32;

constexpr int T = 16384, SEQ = 2048, D = 1024, DA = 512, DB = 512, DIN = 2560, NE = 32, DE = 512, CAP = 16384, PW = 1536;
constexpr float EPS = 1e-6f;
constexpr int NWAVES = 8;
#ifndef MK_N_LAUNCHES
#define MK_N_LAUNCHES 1
#endif
constexpr int N_LAUNCHES = MK_N_LAUNCHES;
constexpr int NPHASES = 8;

constexpr size_t MiB = 1u << 20;
constexpr size_t WS_CTL = 0, CTL_ZERO_BYTES = 1 * MiB;
constexpr size_t WS_WIN = 1 * MiB;
constexpr size_t WS_WOUT = 6 * MiB;
constexpr size_t WS_WR = 8 * MiB;
constexpr size_t WS_SSQ = 9 * MiB;
constexpr size_t WS_LTOK = 11 * MiB;
constexpr size_t WS_LW = 13 * MiB;
constexpr size_t WS_LR2 = 15 * MiB;
constexpr size_t WS_W13 = 17 * MiB;
constexpr size_t WS_W2 = 81 * MiB;
constexpr size_t WS_X1B = 113 * MiB;
constexpr size_t WS_XB = 145 * MiB;
constexpr size_t WS_P = 177 * MiB;
constexpr size_t WS_Y = 225 * MiB;
constexpr size_t WS_H = 145 * MiB;
constexpr size_t WS_CB = 185 * MiB;
constexpr size_t WS_END = 257 * MiB;
constexpr int CW_TMO = 0, CW_CODE = 1, CW_BAR = 4096, CW_GCNT = 16384;

constexpr int RING_OFF = 0, RING_BYTES = 131072;
constexpr int LDSCTL_OFF = RING_BYTES, MISC_OFF = LDSCTL_OFF + 320;
constexpr int LDS_BYTES = 147456;

#define RLX_AGENT __ATOMIC_RELAXED, __HIP_MEMORY_SCOPE_AGENT
#define LDS_WAIT() asm volatile("s_waitcnt lgkmcnt(0)" ::: "memory")
#define VM_WAIT() asm volatile("s_waitcnt vmcnt(0)" ::: "memory")
__device__ __forceinline__ unsigned f2bf(float f) { unsigned u = __builtin_bit_cast(unsigned, f); return (u + 0x7fffu + ((u >> 16) & 1u)) >> 16; }
__device__ __forceinline__ unsigned pk2(float lo, float hi) { return f2bf(lo) | (f2bf(hi) << 16); }
__device__ __forceinline__ unsigned cvt_pk_bf16(float lo, float hi) { unsigned r; asm volatile("v_cvt_pk_bf16_f32 %0, %1, %2" : "=v"(r) : "v"(lo), "v"(hi)); return r; }
__device__ __forceinline__ float bflo(unsigned v) { return __builtin_bit_cast(float, v << 16); }
__device__ __forceinline__ float bfhi(unsigned v) { return __builtin_bit_cast(float, v & 0xffff0000u); }
__device__ __forceinline__ float fast_sigmoid(float v) { return __builtin_amdgcn_rcpf(1.0f + __expf(-v)); }
__device__ __forceinline__ float wave_sum(float v) {
#pragma unroll
    for (int o = 1; o < 64; o <<= 1) v += __shfl_xor(v, o);
    return v;
}

namespace pg8 {
constexpr int BM = 256, BK = 64, HALF = 128, HTB = HALF * BK * 2, STAGE_BYTES = 8 * HTB, NXCD = 8, WGM = 8;
__host__ __device__ __forceinline__ int lds_byte(int r, int c) { const int st = (r >> 4) * 2 + (c >> 5), rr = r & 15, cc = c & 31, ob = rr * 64 + cc * 2; return st * 1024 + (ob ^ (((ob >> 9) & 1) << 5)); }
__host__ __device__ __forceinline__ void stage_rc(int b, int& R, int& C) { const int st = b / 1024, sb = b % 1024, swz = sb ^ (((sb >> 9) & 1) << 5); R = (st >> 1) * 16 + swz / 64; C = (st & 1) * 32 + (swz % 64) / 2; }
__host__ __device__ __forceinline__ int perm32(int rho) { const int n = rho >> 4, i = rho & 15; return 8 * (i >> 2) + 4 * n + (i & 3); }

struct Unit { int pm, pn, e, rt, cnt; };

__device__ __forceinline__ bool tile_order(int i, int G, int c, int nM, int nN, int& pm, int& pn) {
    const int nwg = nM * nN; const long L = (long)i * G + c; if (L >= nwg) return false;
    int wgid = (int)L; { const int q = nwg / NXCD, r = nwg % NXCD, xcd = wgid % NXCD, off = wgid / NXCD; wgid = (xcd < r ? xcd * (q + 1) : r * (q + 1) + (xcd - r) * q) + off; }
    const int nig = WGM * nN, gid = wgid / nig, fm = gid * WGM, gsz = (nM - fm) < WGM ? (nM - fm) : WGM;
    pm = fm + ((wgid % nig) % gsz); pn = (wgid % nig) / gsz; return true;
}

struct SchedDense {
    static constexpr bool GATHER = false;
    const char* A; const char* Bt; int nM, nN, G, c; size_t tstepA, tstepB;
    __device__ __forceinline__ bool next(int i, Unit& u) const { u.e = 0; u.rt = 0; u.cnt = 0; return tile_order(i, G, c, nM, nN, u.pm, u.pn); }
    __device__ __forceinline__ const char* a_base(const Unit& u) const { return A + (size_t)u.pm * tstepA; }
    __device__ __forceinline__ const char* b_base(const Unit& u) const { return Bt + (size_t)u.pn * tstepB; }
    __device__ __forceinline__ void a_tokens(const Unit&, int, unsigned (&)[2]) const {}
};
struct SchedMoe {
    const char* A; const char* W; const unsigned* ltok; int total_rt, G, c, my_start, my_cnt; size_t a_tile_bytes, w_row_bytes;
    __device__ __forceinline__ bool next(int i, Unit& u) const {
        if (!tile_order(i, G, c, total_rt, 4, u.pm, u.pn)) return false;
        const int lane = threadIdx.x & 63;
        const unsigned long long m = __ballot(lane < 32 && my_start <= u.pm);
        const int e = __builtin_amdgcn_readfirstlane(__popcll(m) - 1);
        u.e = e; u.rt = u.pm - __builtin_amdgcn_readlane(my_start, e); u.cnt = __builtin_amdgcn_readlane(my_cnt, e); return true;
    }
    __device__ __forceinline__ const char* b_base(const Unit& u) const { return W + ((size_t)u.e * 1024 + (size_t)u.pn * 256) * w_row_bytes; }
};
struct SchedMoeA : SchedMoe {
    static constexpr bool GATHER = true;
    __device__ __forceinline__ const char* a_base(const Unit&) const { return A; }
    __device__ __forceinline__ void a_tokens(const Unit& u, int R, unsigned (&tk)[2]) const {
        asm volatile("" : "+v"(R));
#pragma unroll
        for (int h = 0; h < 2; ++h) { const int p0 = u.rt * 256 + 128 * h + R, p1 = p0 + 64; unsigned r0 = 0u, r1 = 0u;
            if (p0 < u.cnt) r0 = ltok[(size_t)u.e * CAP + p0]; if (p1 < u.cnt) r1 = ltok[(size_t)u.e * CAP + p1];
            tk[h] = (r0 & 0xffffu) | (r1 << 16); }
    }
};
struct SchedMoeB : SchedMoe {
    static constexpr bool GATHER = false;
    __device__ __forceinline__ const char* a_base(const Unit& u) const { return A + (size_t)u.pm * a_tile_bytes; }
    __device__ __forceinline__ void a_tokens(const Unit&, int, unsigned (&)[2]) const {}
};

struct EpiP1 {
    bf16* P;
    __device__ __forceinline__ void operator()(const f32x4 (&acc)[2][2][4][2], const Unit& u, int wr, int wc, int fr, int fq) const {
        const int row0 = u.pm * BM + wr * 64 + fr, cl = wc * 32 + 8 * fq;
        if (u.pn >= 4 && u.pn < 6) {
#pragma unroll
            for (int ai = 0; ai < 2; ++ai)
#pragma unroll
                for (int m = 0; m < 4; ++m) { bf16* rowp = P + (size_t)(row0 + ai * HALF + m * 16) * PW + 512 + (u.pn - 4) * 256 + cl;
#pragma unroll
                    for (int bj = 0; bj < 2; ++bj) { const f32x4 v0 = acc[ai][bj][m][0], v1 = acc[ai][bj][m][1];
                        u32x4 w; w.x = cvt_pk_bf16(v0[0], v0[1]); w.y = cvt_pk_bf16(v0[2], v0[3]); w.z = cvt_pk_bf16(v1[0], v1[1]); w.w = cvt_pk_bf16(v1[2], v1[3]);
                        *(u32x4*)(rowp + bj * HALF) = w; } }
        } else if (u.pn < 4) {
#pragma unroll
            for (int ai = 0; ai < 2; ++ai)
#pragma unroll
                for (int m = 0; m < 4; ++m) { bf16* rowp = P + (size_t)(row0 + ai * HALF + m * 16) * PW + u.pn * 128 + cl;
                    const f32x4 v0 = acc[ai][0][m][0] * acc[ai][1][m][0], v1 = acc[ai][0][m][1] * acc[ai][1][m][1];
                    u32x4 w; w.x = cvt_pk_bf16(v0[0], v0[1]); w.y = cvt_pk_bf16(v0[2], v0[3]); w.z = cvt_pk_bf16(v1[0], v1[1]); w.w = cvt_pk_bf16(v1[2], v1[3]);
                    *(u32x4*)rowp = w; }
        } else {
#pragma unroll
            for (int ai = 0; ai < 2; ++ai)
#pragma unroll
                for (int m = 0; m < 4; ++m) { bf16* rowp = P + (size_t)(row0 + ai * HALF + m * 16) * PW + 1024 + (u.pn - 6) * 128 + cl;
                    f32x4 v0, v1;
#pragma unroll
                    for (int j = 0; j < 4; ++j) { v0[j] = acc[ai][0][m][0][j] * fast_sigmoid(acc[ai][1][m][0][j]); v1[j] = acc[ai][0][m][1][j] * fast_sigmoid(acc[ai][1][m][1][j]); }
                    u32x4 w; w.x = cvt_pk_bf16(v0[0], v0[1]); w.y = cvt_pk_bf16(v0[2], v0[3]); w.z = cvt_pk_bf16(v1[0], v1[1]); w.w = cvt_pk_bf16(v1[2], v1[3]);
                    *(u32x4*)rowp = w; }
        }
    }
};
struct EpiX1 {
    const float* x; bf16* x1b; float* ssq;
    __device__ __forceinline__ void operator()(const f32x4 (&acc)[2][2][4][2], const Unit& u, int wr, int wc, int fr, int fq) const {
        const int row0 = u.pm * BM + wr * 64 + fr, col0 = u.pn * BM + wc * 32 + 8 * fq;
#pragma unroll
        for (int ai = 0; ai < 2; ++ai)
#pragma unroll
            for (int m = 0; m < 4; ++m) { const int row = row0 + ai * HALF + m * 16; const float* xr = x + (size_t)row * D + col0; bf16* orow = x1b + (size_t)row * D + col0; float s = 0.f;
#pragma unroll
                for (int bj = 0; bj < 2; ++bj) { const f32x4 a = *(const f32x4*)(xr + bj * HALF), b = *(const f32x4*)(xr + bj * HALF + 4);
                    const f32x4 v0 = acc[ai][bj][m][0] + a, v1 = acc[ai][bj][m][1] + b;
                    s += (v0[0] * v0[0] + v0[1] * v0[1]) + (v0[2] * v0[2] + v0[3] * v0[3]) + (v1[0] * v1[0] + v1[1] * v1[1]) + (v1[2] * v1[2] + v1[3] * v1[3]);
                    u32x4 w; w.x = cvt_pk_bf16(v0[0], v0[1]); w.y = cvt_pk_bf16(v0[2], v0[3]); w.z = cvt_pk_bf16(v1[0], v1[1]); w.w = cvt_pk_bf16(v1[2], v1[3]);
                    *(u32x4*)(orow + bj * HALF) = w; }
                s += __shfl_xor(s, 16); s += __shfl_xor(s, 32);
                if (fq == 0) ssq[(size_t)(u.pn * 4 + wc) * T + row] = s; }
    }
};
struct EpiH {
    bf16* H; const float* lr2;
    __device__ __forceinline__ void operator()(const f32x4 (&acc)[2][2][4][2], const Unit& u, int wr, int wc, int fr, int fq) const {
        const int cl = u.pn * 128 + wc * 32 + 8 * fq;
#pragma unroll
        for (int ai = 0; ai < 2; ++ai)
#pragma unroll
            for (int m = 0; m < 4; ++m) { const int rl = ai * HALF + wr * 64 + m * 16 + fr, pos = u.rt * 256 + rl; float rr = 0.f; if (pos < u.cnt) rr = lr2[(size_t)u.e * CAP + pos];
                f32x4 v0, v1;
#pragma unroll
                for (int j = 0; j < 4; ++j) { const float a0 = acc[ai][0][m][0][j] * rr, b0 = acc[ai][1][m][0][j] * rr, a1 = acc[ai][0][m][1][j] * rr, b1 = acc[ai][1][m][1][j] * rr;
                    v0[j] = a0 * fast_sigmoid(a0) * b0; v1[j] = a1 * fast_sigmoid(a1) * b1; }
                u32x4 w; w.x = cvt_pk_bf16(v0[0], v0[1]); w.y = cvt_pk_bf16(v0[2], v0[3]); w.z = cvt_pk_bf16(v1[0], v1[1]); w.w = cvt_pk_bf16(v1[2], v1[3]);
                *(u32x4*)(H + ((size_t)u.pm * 256 + rl) * DE + cl) = w; }
    }
};
struct EpiC {
    bf16* Cb; const unsigned* ltok; const float* lw;
    __device__ __forceinline__ void operator()(const f32x4 (&acc)[2][2][4][2], const Unit& u, int wr, int wc, int fr, int fq) const {
        const int cl = u.pn * 256 + wc * 32 + 8 * fq;
#pragma unroll
        for (int ai = 0; ai < 2; ++ai)
#pragma unroll
            for (int m = 0; m < 4; ++m) { const int rl = ai * HALF + wr * 64 + m * 16 + fr, pos = u.rt * 256 + rl;
                if (pos < u.cnt) { const unsigned rec = ltok[(size_t)u.e * CAP + pos]; const float cw = lw[(size_t)u.e * CAP + pos];
                    bf16* orow = Cb + ((size_t)(rec >> 16) * T + (rec & 0xffffu)) * D + cl;
#pragma unroll
                    for (int bj = 0; bj < 2; ++bj) { const f32x4 v0 = acc[ai][bj][m][0] * cw, v1 = acc[ai][bj][m][1] * cw;
                        u32x4 w; w.x = cvt_pk_bf16(v0[0], v0[1]); w.y = cvt_pk_bf16(v0[2], v0[3]); w.z = cvt_pk_bf16(v1[0], v1[1]); w.w = cvt_pk_bf16(v1[2], v1[3]);
                        *(u32x4*)(orow + bj * HALF) = w; } } }
    }
};

template <class Epi, class Sched>
__device__ __forceinline__ void gemm_phase(LAS unsigned char* lds, const int K, const Sched& S, const Epi& E) {
    constexpr bool GATHER = Sched::GATHER;
    const int tid = threadIdx.x, wid = __builtin_amdgcn_readfirstlane(tid >> 6), lane = tid & 63, wr = wid >> 2, wc = wid & 3, fr = lane & 15, fq = lane >> 4;
    const int nt = K / BK;
    const size_t kstep = (size_t)(BK * 2), hstep = (size_t)HALF * K * 2;
    unsigned voffA[2], voffB[2], ct[2] = {0u, 0u}, ntk[2] = {0u, 0u}; int R0; unsigned pc2;
    { int R, C; stage_rc(tid * 16, R, C); R0 = R; pc2 = (unsigned)C * 2u; }
#pragma unroll
    for (int i = 0; i < 2; ++i) { int R, C; stage_rc(tid * 16 + i * 8192, R, C); const int Rb = (R & ~31) + perm32(R & 31);
        voffA[i] = (unsigned)(R * K + C) * 2u; voffB[i] = (unsigned)(Rb * K + C) * 2u; }
    const unsigned ldsw = (unsigned)wid * 1024u;
    const int aoff = lds_byte(wr * 64 + fr, fq * 8), boff = lds_byte(wc * 32 + fr, fq * 8);
#define PG8_SA(b, h) (((b) * 2 + (h)) * HTB)
#define PG8_SB(b, h) ((4 + (b) * 2 + (h)) * HTB)
#define PG8_STAGE(bufoff, gbase, voff) do { _Pragma("unroll") for (int _i = 0; _i < 2; ++_i) \
        __builtin_amdgcn_global_load_lds((const unsigned*)((const char*)(gbase) + (voff)[_i]), (LAS unsigned*)(lds + (bufoff) + ldsw + _i * 8192), 16, 0, 0); } while (0)
#define PG8_STAGE_A(bufoff, gbase, h, TK) do { _Pragma("unroll") for (int _i = 0; _i < 2; ++_i) { \
        const unsigned _o = GATHER ? ((((TK)[h] >> (16 * _i)) & 0xffffu) * 2048u + pc2) : voffA[_i]; const char* _b = GATHER ? (const char*)(gbase) : (const char*)(gbase) + (h) * hstep; \
        __builtin_amdgcn_global_load_lds((const unsigned*)(_b + _o), (LAS unsigned*)(lds + (bufoff) + ldsw + _i * 8192), 16, 0, 0); } } while (0)
#define PG8_LDA(dst, b, h) do { _Pragma("unroll") for (int m = 0; m < 4; ++m) _Pragma("unroll") for (int k = 0; k < 2; ++k) dst[m][k] = *(const LAS bf16x8*)(lds + PG8_SA(b, h) + aoff + m * 2048 + k * 1024); } while (0)
#define PG8_LDB(dst, b, h) do { _Pragma("unroll") for (int n = 0; n < 2; ++n) _Pragma("unroll") for (int k = 0; k < 2; ++k) dst[n][k] = *(const LAS bf16x8*)(lds + PG8_SB(b, h) + boff + n * 2048 + k * 1024); } while (0)
#define PG8_MMA(ai, bj, At, Bt) do { __builtin_amdgcn_s_setprio(1); _Pragma("unroll") for (int m = 0; m < 4; ++m) _Pragma("unroll") for (int n = 0; n < 2; ++n) _Pragma("unroll") for (int k = 0; k < 2; ++k) \
        acc[ai][bj][m][n] = __builtin_amdgcn_mfma_f32_16x16x32_bf16(Bt[n][k], At[m][k], acc[ai][bj][m][n], 0, 0, 0); __builtin_amdgcn_s_setprio(0); } while (0)
#define PG8_WAIT_V(n) asm volatile("s_waitcnt vmcnt(" #n ")" ::: "memory")
#define PG8_WAIT_L(n) asm volatile("s_waitcnt lgkmcnt(" #n ")" ::: "memory")
#define PG8_BAR __builtin_amdgcn_s_barrier()
#define PG8_SCHED __builtin_amdgcn_sched_barrier(0)
    Unit cur, nxt; int ui = 0;
    if (!S.next(0, cur)) return;
    f32x4 acc[2][2][4][2];
#pragma unroll
    for (int a = 0; a < 2; ++a)
#pragma unroll
        for (int b = 0; b < 2; ++b)
#pragma unroll
            for (int m = 0; m < 4; ++m)
#pragma unroll
                for (int n = 0; n < 2; ++n) acc[a][b][m][n] = (f32x4){0.f, 0.f, 0.f, 0.f};
    bf16x8 At[4][2], B0[2][2], B1[2][2];
    const char* cA = S.a_base(cur); const char* cB = S.b_base(cur);
    if constexpr (GATHER) { S.a_tokens(cur, R0, ct); asm volatile("" : "+v"(ct[0]), "+v"(ct[1])); }
    PG8_STAGE(PG8_SB(0, 0), cB, voffB); PG8_STAGE(PG8_SB(0, 1), cB + hstep, voffB); PG8_STAGE_A(PG8_SA(0, 0), cA, 0, ct); PG8_STAGE_A(PG8_SA(0, 1), cA, 1, ct);
    if (wr == 1) PG8_BAR;
    PG8_WAIT_V(2); PG8_BAR;
    PG8_STAGE(PG8_SB(1, 0), cB + kstep, voffB); PG8_STAGE_A(PG8_SA(1, 0), cA + kstep, 0, ct); PG8_STAGE(PG8_SB(1, 1), cB + hstep + kstep, voffB);
    PG8_WAIT_V(6); PG8_BAR;
    for (;;) {
        const bool has_next = S.next(ui + 1, nxt);
        const char* nA = cA; const char* nB = cB;
        if constexpr (GATHER) { ntk[0] = ct[0]; ntk[1] = ct[1]; }
        if (has_next) { nA = S.a_base(nxt); nB = S.b_base(nxt);
            if constexpr (GATHER) { S.a_tokens(nxt, R0, ntk); asm volatile("" : "+v"(ntk[0]), "+v"(ntk[1])); } }
        for (int t = 0; t < nt; t += 2) {
            const bool last = (t == nt - 2);
            const char* a1 = cA + (size_t)(t + 1) * kstep;
            const char* a2 = last ? nA : cA + (size_t)(t + 2) * kstep; const char* b2 = last ? nB : cB + (size_t)(t + 2) * kstep;
            const char* a3 = a2 + kstep; const char* b3 = b2 + kstep;
            unsigned t2[2]; t2[0] = (GATHER && last) ? ntk[0] : ct[0]; t2[1] = (GATHER && last) ? ntk[1] : ct[1];
            PG8_LDB(B0, 0, 0); PG8_LDB(B1, 0, 1); PG8_SCHED; PG8_LDA(At, 0, 0); PG8_STAGE_A(PG8_SA(1, 1), a1, 1, ct);
            PG8_WAIT_V(8); PG8_WAIT_L(0); PG8_BAR; PG8_MMA(0, 0, At, B0); PG8_MMA(0, 1, At, B1); PG8_BAR; PG8_SCHED;
            PG8_LDA(At, 0, 1); PG8_STAGE(PG8_SB(0, 0), b2, voffB); PG8_STAGE(PG8_SB(0, 1), b2 + hstep, voffB); PG8_STAGE_A(PG8_SA(0, 0), a2, 0, t2);
            PG8_WAIT_V(8); PG8_WAIT_L(0); PG8_BAR; PG8_MMA(1, 0, At, B0); PG8_MMA(1, 1, At, B1); PG8_BAR; PG8_SCHED;
            PG8_LDB(B0, 1, 0); PG8_LDB(B1, 1, 1); PG8_SCHED; PG8_LDA(At, 1, 0); PG8_STAGE_A(PG8_SA(0, 1), a2, 1, t2);
            PG8_WAIT_V(8); PG8_WAIT_L(0); PG8_BAR; PG8_MMA(0, 0, At, B0); PG8_MMA(0, 1, At, B1); PG8_BAR; PG8_SCHED;
            PG8_LDA(At, 1, 1); PG8_STAGE(PG8_SB(1, 0), b3, voffB); PG8_STAGE(PG8_SB(1, 1), b3 + hstep, voffB); PG8_STAGE_A(PG8_SA(1, 0), a3, 0, t2);
            PG8_WAIT_V(8); PG8_WAIT_L(0); PG8_BAR; PG8_MMA(1, 0, At, B0); PG8_MMA(1, 1, At, B1); PG8_BAR; PG8_SCHED;
        }
        if (wr == 0) PG8_BAR;
        E(acc, cur, wr, wc, fr, fq);
        if (!has_next) break;
#pragma unroll
        for (int a = 0; a < 2; ++a)
#pragma unroll
            for (int b = 0; b < 2; ++b)
#pragma unroll
                for (int m = 0; m < 4; ++m)
#pragma unroll
                    for (int n = 0; n < 2; ++n) acc[a][b][m][n] = (f32x4){0.f, 0.f, 0.f, 0.f};
        cur = nxt; cA = nA; cB = nB; ++ui;
        if constexpr (GATHER) { ct[0] = ntk[0]; ct[1] = ntk[1]; }
        if (wr == 1) PG8_BAR;
    }
    PG8_WAIT_V(0);
    PG8_BAR;
#undef PG8_SA
#undef PG8_SB
#undef PG8_STAGE
#undef PG8_STAGE_A
#undef PG8_LDA
#undef PG8_LDB
#undef PG8_MMA
#undef PG8_WAIT_V
#undef PG8_WAIT_L
#undef PG8_BAR
#undef PG8_SCHED
}
}

#define XB_TMO      128
#define XB_XCNT(j)  (256  + 64 * (j))
#define XB_XSUB(j)  (1280 + 64 * (j))
#define XB_XGEN(j)  (2304 + 64 * (j))
#define XB_TOP      3328
#define XB_TOPGEN   3392
#define XCD_BAR_WORDS 3456
#define XB_SPIN_CAP (1u << 18)
__device__ __forceinline__ unsigned xb_ld(unsigned* p)              { return __hip_atomic_load(p, __ATOMIC_RELAXED, __HIP_MEMORY_SCOPE_AGENT); }
__device__ __forceinline__ unsigned xb_add(unsigned* p, unsigned v) { return __hip_atomic_fetch_add(p, v, __ATOMIC_RELAXED, __HIP_MEMORY_SCOPE_AGENT); }
__device__ __forceinline__ unsigned xb_xcc_id() { return (unsigned)__builtin_amdgcn_s_getreg((3 << 11) | 20) & 0xFu; }
#define XB_SPIN(cond, bar) do { unsigned _sp = 0; while (cond) { __builtin_amdgcn_s_sleep(1); \
    if ((++_sp & 255u) == 0u) { if (xb_ld(&(bar)[XB_TMO])) break; if (_sp > XB_SPIN_CAP) { atomicAdd(&(bar)[XB_TMO], 1u); break; } } } } while (0)
struct XcdBarrier { unsigned* bar; unsigned x; volatile LAS unsigned* st; };
__device__ __forceinline__ XcdBarrier xcd_barrier_post(unsigned* bar, volatile LAS unsigned* st) {
    XcdBarrier b; b.bar = bar; b.x = xb_xcc_id(); b.st = st;
    if (threadIdx.x == 0) (void)xb_add(&bar[XB_XCNT(b.x)], 1u);
    return b;
}
__device__ __forceinline__ void xcd_barrier_complete(unsigned* bar, unsigned x, unsigned& nloc, unsigned& nx) {
    const unsigned G = gridDim.x * gridDim.y * gridDim.z;
    unsigned sum, cnt, mine, sp = 0u;
    for (;;) {
        sum = 0u; cnt = 0u; mine = 0u;
#pragma unroll
        for (unsigned j = 0; j < 16; ++j) { const unsigned c = xb_ld(&bar[XB_XCNT(j)]); sum += c; cnt += (c > 0u) ? 1u : 0u; mine = (j == x) ? c : mine; }
        if (sum == G) break;
        __builtin_amdgcn_s_sleep(1);
        if ((++sp & 255u) == 0u) { if (xb_ld(&bar[XB_TMO])) break; if (sp > XB_SPIN_CAP) { atomicAdd(&bar[XB_TMO], 1u); break; } }
    }
    nloc = mine > 0u ? mine : 1u; nx = cnt > 0u ? cnt : 1u;
}
__device__ __forceinline__ void xcd_barrier(const XcdBarrier& b) {
    asm volatile("s_waitcnt vmcnt(0)" ::: "memory");
    __syncthreads();
    if (threadIdx.x == 0) {
        unsigned* bar = b.bar;
        __builtin_amdgcn_s_waitcnt(0);
        unsigned nloc = b.st[0], nx = b.st[1];
        if (nloc == 0u) { xcd_barrier_complete(bar, b.x, nloc, nx); b.st[0] = nloc; b.st[1] = nx; }
        const unsigned old = xb_add(&bar[XB_XSUB(b.x)], 1u);
        const unsigned gen = old / nloc;
        if (old + 1u == (gen + 1u) * nloc) {
            __builtin_amdgcn_fence(__ATOMIC_RELEASE, "agent");
            asm volatile("s_waitcnt vmcnt(0)" ::: "memory");
            const unsigned og = xb_add(&bar[XB_TOP], 1u);
            const unsigned tg = og / nx;
            if (og + 1u == (tg + 1u) * nx) xb_add(&bar[XB_TOPGEN], 1u);
            else XB_SPIN(xb_ld(&bar[XB_TOPGEN]) == tg, bar);
            __builtin_amdgcn_fence(__ATOMIC_ACQUIRE, "agent");
            xb_add(&bar[XB_XGEN(b.x)], 1u);
            asm volatile("s_waitcnt vmcnt(0)" ::: "memory");
        } else {
            XB_SPIN(xb_ld(&bar[XB_XGEN(b.x)]) == gen, bar);
            __builtin_amdgcn_fence(__ATOMIC_ACQUIRE, "agent");
            asm volatile("s_waitcnt vmcnt(0)" ::: "memory");
        }
    }
    __syncthreads();
}

struct Frame {
    LAS unsigned char* lds;
    volatile LAS unsigned* MISC;
    gu32* ctl;
    int vcu, G;
    const float *x, *norm_mix_g, *w_in, *conv_a_w, *conv_b_w, *conv_b_bias, *ln_b_g, *ln_b_b, *beta_a, *beta_b, *w_out, *norm_ffn_g, *wrg, *brg, *wre, *bre, *w1, *w3, *w2, *gfin;
    float* out;
    bf16 *Win_t, *Wout_t, *Wr_t, *W13_t, *W2_t, *XB, *P, *Y, *X1B, *H, *CB;
    float *SSQ, *LW, *LR2; unsigned* LTOK; unsigned* gcnt;
};

__device__ __forceinline__ void p0_transpose_item(const float* W, int N, int k0, int n0, bf16* dst, int ldt, const float* ks, LAS float* scr, int lane) {
#pragma unroll 8
    for (int i = 0; i < 32; ++i) { const int kk = 2 * i + (lane >> 5); float v = W[(size_t)(k0 + kk) * N + n0 + (lane & 31)]; if (ks) v *= ks[kk]; scr[kk * 33 + (lane & 31)] = v; }
    LDS_WAIT(); asm volatile("" ::: "memory");
    const int c = lane & 7;
#pragma unroll
    for (int j = 0; j < 4; ++j) { const int n = (lane >> 3) + 8 * j; const LAS float* s = scr + (8 * c) * 33 + n;
        u32x4 o; o.x = pk2(s[0 * 33], s[1 * 33]); o.y = pk2(s[2 * 33], s[3 * 33]); o.z = pk2(s[4 * 33], s[5 * 33]); o.w = pk2(s[6 * 33], s[7 * 33]);
        *(GAS u32x4*)(dst + (size_t)n * ldt + k0 + 8 * c) = o; }
    LDS_WAIT(); asm volatile("" ::: "memory");
}
__device__ __forceinline__ int win_dest_row(int n0) {
    if (n0 < 512) return 256 * (n0 >> 7) + (n0 & 127);
    if (n0 < 1024) return n0 + 512;
    if (n0 < 1536) { const int j = n0 - 1024; return 256 * (j >> 7) + 128 + (j & 127); }
    if (n0 < 2048) { const int j = n0 - 1536; return 1536 + 256 * (j >> 7) + (j & 127); }
    { const int j = n0 - 2048; return 1536 + 256 * (j >> 7) + 128 + (j & 127); }
}
__device__ __forceinline__ void p0_prologue(Frame& F) {
    int tid = threadIdx.x; asm volatile("" : "+v"(tid)); const int lane = tid & 63, wave = __builtin_amdgcn_readfirstlane(tid >> 6);
    LAS float* scr = (LAS float*)(F.lds + RING_OFF + wave * 16384);
    const int gw = F.vcu * NWAVES + wave, NGW = F.G * NWAVES;
    constexpr int I_IN = 16 * 80, I_OUT = 16 * 32, I_13 = NE * 2 * 16 * 16, I_2 = NE * 8 * 32;
    constexpr int NITEMS = I_IN + I_OUT + I_13 + I_2;
    for (int it = gw; it < NITEMS; it += NGW) {
        int r = it;
        if (r < I_IN) { const int kb = r / 80, nb = r % 80, k0 = 64 * kb, n0 = 32 * nb;
            p0_transpose_item(F.w_in, DIN, k0, n0, F.Win_t + (size_t)win_dest_row(n0) * D, D, F.norm_mix_g + k0, scr, lane); continue; }
        r -= I_IN;
        if (r < I_OUT) { const int kb = r / 32, nb = r % 32, k0 = 64 * kb, n0 = 32 * nb;
            p0_transpose_item(F.w_out, D, k0, n0, F.Wout_t + (size_t)n0 * D, D, (k0 < DA ? F.beta_a + k0 : F.beta_b + (k0 - DA)), scr, lane); continue; }
        r -= I_OUT;
        if (r < I_13) { const int e = r / 512, rr = r % 512, which = rr / 256, item = rr % 256, kb = item / 16, nb = item % 16, k0 = 64 * kb, n0 = 32 * nb;
            const float* W = (which ? F.w3 : F.w1) + (size_t)e * D * DE;
            p0_transpose_item(W, DE, k0, n0, F.W13_t + ((size_t)e * 1024 + 256 * (n0 >> 7) + 128 * which + (n0 & 127)) * D, D, F.norm_ffn_g + k0, scr, lane); continue; }
        r -= I_13;
        { const int e = r / 256, item = r % 256, kb = item / 32, nb = item % 32, k0 = 64 * kb, n0 = 32 * nb;
            p0_transpose_item(F.w2 + (size_t)e * DE * D, D, k0, n0, F.W2_t + ((size_t)e * 1024 + n0) * DE, DE, nullptr, scr, lane); }
    }
    for (int i = gw * 64 + lane; i < 48 * D; i += NGW * 64) { const int o = i / D, k = i % D; float v = 0.f;
        if (o < 4) v = F.wrg[(size_t)k * 4 + o] * F.norm_ffn_g[k]; else if (o < 36) v = F.wre[(size_t)k * NE + (o - 4)] * F.norm_ffn_g[k];
        F.Wr_t[i] = (bf16)f2bf(v); }
    for (int m = gw; m < T; m += NGW) {
        const GAS f32x4* xr = (const GAS f32x4*)(F.x + (size_t)m * D) + lane;
        f32x4 v[4]; float s = 0.f;
#pragma unroll
        for (int j = 0; j < 4; ++j) { v[j] = xr[64 * j]; s += (v[j].x * v[j].x + v[j].y * v[j].y) + (v[j].z * v[j].z + v[j].w * v[j].w); }
        const float r = rsqrtf(wave_sum(s) * (1.f / D) + EPS);
        GAS u32x2* o8 = (GAS u32x2*)(F.XB + (size_t)m * D) + lane;
#pragma unroll
        for (int j = 0; j < 4; ++j) { u32x2 w; w.x = pk2(v[j].x * r, v[j].y * r); w.y = pk2(v[j].z * r, v[j].w * r); o8[64 * j] = w; }
    }
}

__device__ __forceinline__ void p2_mixer(Frame& F) {
    LAS unsigned char* L = F.lds;
    LAS unsigned* Ut = (LAS unsigned*)L;
    LAS float* UC = (LAS float*)(L + 62 * 1024);
    int tid = threadIdx.x; asm volatile("" : "+v"(tid)); const int lane = tid & 63, wave = __builtin_amdgcn_readfirstlane(tid >> 6);
    const int cp = tid & 255, th = tid >> 8;
    float wb0[31], wb1[31];
#pragma unroll
    for (int j = 0; j < 31; ++j) { const f32x2 w = *(const f32x2*)(F.conv_b_w + j * DB + 2 * cp); wb0[j] = w.x; wb1[j] = w.y; }
    const f32x2 bias2 = *(const f32x2*)(F.conv_b_bias + 2 * cp);
    float wa[3][8], lng[8], lnb[8];
#pragma unroll
    for (int j = 0; j < 8; ++j) { lng[j] = F.ln_b_g[lane * 8 + j]; lnb[j] = F.ln_b_b[lane * 8 + j];
#pragma unroll
        for (int q = 0; q < 3; ++q) wa[q][j] = F.conv_a_w[q * DA + lane * 8 + j]; }
    for (int tile = F.vcu; tile < T / 32; tile += F.G) {
        const int t0 = tile * 32, b = t0 / SEQ, s0 = t0 % SEQ;
        for (int ch = tid; ch < 62 * 64; ch += 512) { const int row = ch >> 6, c16 = ch & 63, s = s0 - 15 + row; u32x4 v = (u32x4){0u, 0u, 0u, 0u};
            if (s >= 0 && s < SEQ) v = *(const GAS u32x4*)(F.P + (size_t)(b * SEQ + s) * PW + 1024 + c16 * 8);
            *(LAS u32x4*)(L + row * 1024 + c16 * 16) = v; }
        __syncthreads();
#pragma unroll 1
        for (int sub = 0; sub < 2; ++sub) { const int i0 = th * 16 + sub * 8; float a0[8], a1[8];
#pragma unroll
            for (int i = 0; i < 8; ++i) { a0[i] = bias2.x; a1[i] = bias2.y; }
#pragma unroll
            for (int w = 0; w < 38; ++w) { const unsigned v = Ut[(i0 + w) * 256 + cp]; const float lo = bflo(v), hi = bfhi(v);
#pragma unroll
                for (int i = 0; i < 8; ++i) { const int j = w - i; if (j >= 0 && j < 31) { a0[i] += wb0[j] * lo; a1[i] += wb1[j] * hi; } } }
#pragma unroll
            for (int i = 0; i < 8; ++i) *(LAS f32x2*)(UC + (i0 + i) * 512 + 2 * cp) = (f32x2){a0[i], a1[i]};
        }
        __syncthreads();
#pragma unroll 1
        for (int q = 0; q < 4; ++q) { const int i = wave * 4 + q, t = t0 + i, s = s0 + i;
            const f32x4 ua = *(const LAS f32x4*)(UC + i * 512 + lane * 8), ub = *(const LAS f32x4*)(UC + i * 512 + lane * 8 + 4);
            float uv[8] = {ua[0], ua[1], ua[2], ua[3], ub[0], ub[1], ub[2], ub[3]};
            float s1 = 0.f;
#pragma unroll
            for (int j = 0; j < 8; ++j) s1 += uv[j];
            const float mu = wave_sum(s1) * (1.f / DB); float s2 = 0.f;
#pragma unroll
            for (int j = 0; j < 8; ++j) { uv[j] -= mu; s2 += uv[j] * uv[j]; }
            const float rstd = rsqrtf(wave_sum(s2) * (1.f / DB) + EPS); float hb = 0.f;
#pragma unroll
            for (int j = 0; j < 8; ++j) { const float z = uv[j] * rstd * lng[j] + lnb[j]; uv[j] = z * fast_sigmoid(z); hb += uv[j] * uv[j]; }
            hb += __shfl_xor(hb, 1); hb += __shfl_xor(hb, 2); hb += __shfl_xor(hb, 4);
            const float rb = rsqrtf(hb * (1.f / 64.f) + EPS);
            u32x4 ob; ob.x = pk2(uv[0] * rb, uv[1] * rb); ob.y = pk2(uv[2] * rb, uv[3] * rb); ob.z = pk2(uv[4] * rb, uv[5] * rb); ob.w = pk2(uv[6] * rb, uv[7] * rb);
            *(GAS u32x4*)(F.Y + (size_t)t * D + DA + lane * 8) = ob;
            const bf16* prow = F.P + (size_t)t * PW + lane * 8;
            const u32x4 z4 = (u32x4){0u, 0u, 0u, 0u};
            const u32x4 pm1 = (s > 0) ? *(const GAS u32x4*)(prow - PW) : z4, p0 = *(const GAS u32x4*)prow, pp1 = (s < SEQ - 1) ? *(const GAS u32x4*)(prow + PW) : z4, abv = *(const GAS u32x4*)(prow + 512);
            float ya[8]; float ha = 0.f;
#pragma unroll
            for (int j = 0; j < 4; ++j) {
                const float c0 = wa[0][2 * j] * bflo(pm1[j]) + wa[1][2 * j] * bflo(p0[j]) + wa[2][2 * j] * bflo(pp1[j]);
                const float c1 = wa[0][2 * j + 1] * bfhi(pm1[j]) + wa[1][2 * j + 1] * bfhi(p0[j]) + wa[2][2 * j + 1] * bfhi(pp1[j]);
                ya[2 * j] = bflo(abv[j]) * c0; ya[2 * j + 1] = bfhi(abv[j]) * c1; ha += ya[2 * j] * ya[2 * j] + ya[2 * j + 1] * ya[2 * j + 1]; }
            ha += __shfl_xor(ha, 1); ha += __shfl_xor(ha, 2); ha += __shfl_xor(ha, 4);
            const float ra = rsqrtf(ha * (1.f / 64.f) + EPS);
            u32x4 oa; oa.x = pk2(ya[0] * ra, ya[1] * ra); oa.y = pk2(ya[2] * ra, ya[3] * ra); oa.z = pk2(ya[4] * ra, ya[5] * ra); oa.w = pk2(ya[6] * ra, ya[7] * ra);
            *(GAS u32x4*)(F.Y + (size_t)t * D + lane * 8) = oa;
        }
    }
    __syncthreads();
}

__device__ __forceinline__ void p4_route(Frame& F) {
    LAS float* LG = (LAS float*)F.lds;
    LAS int* scnt = (LAS int*)(F.lds + 32768);
    int tid = threadIdx.x; asm volatile("" : "+v"(tid)); const int lane = tid & 63, wave = __builtin_amdgcn_readfirstlane(tid >> 6);
    for (int tile = F.vcu; tile < T / 128; tile += F.G) {
        if (tid < 32) scnt[tid] = 0;
        const int tq = tile * 128 + wave * 16;
        f32x4 acc[3];
#pragma unroll
        for (int nb = 0; nb < 3; ++nb) acc[nb] = (f32x4){0.f, 0.f, 0.f, 0.f};
        const bf16* arow = F.X1B + (size_t)(tq + (lane & 15)) * D + 8 * (lane >> 4);
        const bf16* brow = F.Wr_t + (size_t)(lane & 15) * D + 8 * (lane >> 4);
#pragma unroll 4
        for (int kk = 0; kk < 32; ++kk) { const bf16x8 a = *(const GAS bf16x8*)(arow + kk * 32);
#pragma unroll
            for (int nb = 0; nb < 3; ++nb) { const bf16x8 bq = *(const GAS bf16x8*)(brow + (size_t)nb * 16 * D + kk * 32); acc[nb] = __builtin_amdgcn_mfma_f32_16x16x32_bf16(a, bq, acc[nb], 0, 0, 0); } }
#pragma unroll
        for (int nb = 0; nb < 3; ++nb)
#pragma unroll
            for (int r = 0; r < 4; ++r) LG[(wave * 16 + 4 * (lane >> 4) + r) * 48 + nb * 16 + (lane & 15)] = acc[nb][r];
        __syncthreads();
        int e0 = 0, e1 = 0, p0 = 0, p1 = 0; float c0 = 0.f, c1 = 0.f, r2 = 0.f;
        if (lane < 16) {
            const int t = tq + lane; float ss = 0.f;
#pragma unroll
            for (int s = 0; s < 16; ++s) ss += F.SSQ[(size_t)s * T + t];
            r2 = rsqrtf(ss * (1.f / D) + EPS);
            const LAS float* lg = LG + (wave * 16 + lane) * 48;
            float g4[4];
#pragma unroll
            for (int i = 0; i < 4; ++i) g4[i] = lg[i] * r2 + F.brg[i];
            int g = 0; float m = g4[0];
#pragma unroll
            for (int i = 1; i < 4; ++i) if (g4[i] > m) { m = g4[i]; g = i; }
            float den = 0.f;
#pragma unroll
            for (int i = 0; i < 4; ++i) den += __expf(g4[i] - m);
            const float psel = 1.0f / den;
            int i0 = 0, i1 = -1; float m0 = -3.0e38f, m1 = -3.0e38f;
            for (int i = 0; i < 8; ++i) { const float v = lg[4 + g * 8 + i] * r2 + F.bre[g * 8 + i];
                if (v > m0) { m1 = m0; i1 = i0; m0 = v; i0 = i; } else if (v > m1) { m1 = v; i1 = i; } }
            const float ex = __expf(m1 - m0);
            e0 = g * 8 + i0; e1 = g * 8 + i1; c0 = psel / (1.0f + ex); c1 = psel * ex / (1.0f + ex);
            p0 = __hip_atomic_fetch_add(scnt + e0, 1, __ATOMIC_RELAXED, __HIP_MEMORY_SCOPE_WORKGROUP); p1 = __hip_atomic_fetch_add(scnt + e1, 1, __ATOMIC_RELAXED, __HIP_MEMORY_SCOPE_WORKGROUP);
        }
        __syncthreads();
        if (tid < 32) scnt[32 + tid] = (int)__hip_atomic_fetch_add(F.gcnt + tid, (unsigned)scnt[tid], RLX_AGENT);
        __syncthreads();
        if (lane < 16) {
            const int t = tq + lane; const size_t d0 = (size_t)e0 * CAP + scnt[32 + e0] + p0, d1 = (size_t)e1 * CAP + scnt[32 + e1] + p1;
            F.LTOK[d0] = (unsigned)t; F.LW[d0] = c0; F.LR2[d0] = r2;
            F.LTOK[d1] = (unsigned)t | (1u << 16); F.LW[d1] = c1; F.LR2[d1] = r2;
        }
        __syncthreads();
    }
}

__device__ __forceinline__ void p7_final(Frame& F) {
    int tid = threadIdx.x; asm volatile("" : "+v"(tid)); const int lane = tid & 63, wave = __builtin_amdgcn_readfirstlane(tid >> 6);
    const int gw = F.vcu * NWAVES + wave, NGW = F.G * NWAVES;
    f32x4 g[2][2];
#pragma unroll
    for (int j = 0; j < 2; ++j) { g[j][0] = *(const f32x4*)(F.gfin + j * 512 + lane * 8); g[j][1] = *(const f32x4*)(F.gfin + j * 512 + lane * 8 + 4); }
    for (int t = gw; t < T; t += NGW) {
        float v[2][8]; float ss = 0.f;
#pragma unroll
        for (int j = 0; j < 2; ++j) { const size_t o = (size_t)t * D + j * 512 + lane * 8;
            const u32x4 a = *(const GAS u32x4*)(F.X1B + o), c0 = *(const GAS u32x4*)(F.CB + o), c1 = *(const GAS u32x4*)(F.CB + (size_t)T * D + o);
#pragma unroll
            for (int q = 0; q < 4; ++q) { v[j][2 * q] = bflo(a[q]) + bflo(c0[q]) + bflo(c1[q]); v[j][2 * q + 1] = bfhi(a[q]) + bfhi(c0[q]) + bfhi(c1[q]); ss += v[j][2 * q] * v[j][2 * q] + v[j][2 * q + 1] * v[j][2 * q + 1]; } }
        const float r = rsqrtf(wave_sum(ss) * (1.f / D) + EPS);
#pragma unroll
        for (int j = 0; j < 2; ++j) { float* o = F.out + (size_t)t * D + j * 512 + lane * 8;
            *(GAS f32x4*)o = (f32x4){v[j][0] * r * g[j][0][0], v[j][1] * r * g[j][0][1], v[j][2] * r * g[j][0][2], v[j][3] * r * g[j][0][3]};
            *(GAS f32x4*)(o + 4) = (f32x4){v[j][4] * r * g[j][1][0], v[j][5] * r * g[j][1][1], v[j][6] * r * g[j][1][2], v[j][7] * r * g[j][1][3]}; }
    }
}

__device__ __forceinline__ void moe_sched_init(pg8::SchedMoe& S, Frame& F) {
    int lane = threadIdx.x & 63; asm volatile("" : "+v"(lane));
    int my_cnt = 0; if (lane < NE) my_cnt = (int)__hip_atomic_load(F.gcnt + lane, RLX_AGENT);
    const int tiles = (my_cnt + 255) >> 8; int incl = tiles;
#pragma unroll
    for (int o = 1; o < 32; o <<= 1) { const int v = __shfl_up(incl, o); if (lane >= o) incl += v; }
    S.my_start = incl - tiles; S.my_cnt = my_cnt; S.total_rt = __builtin_amdgcn_readlane(incl, 31);
    S.ltok = F.LTOK; S.G = F.G; S.c = (int)blockIdx.x;
}

struct Args { const float* in[20]; float* out; unsigned char* ws; int ph_lo, ph_hi, li, pad; };
__global__ void __launch_bounds__(NWAVES * 64, 2) mk_fwd(Args args) {
    extern __shared__ __attribute__((aligned(16))) unsigned char lds[];
    Frame F;
    F.lds = (LAS unsigned char*)lds;
    F.MISC = (volatile LAS unsigned*)(F.lds + MISC_OFF);
    F.G = gridDim.x; { const int bx = blockIdx.x; F.vcu = (F.G % 8 == 0) ? (bx % 8) * (F.G / 8) + bx / 8 : bx; }
    unsigned char* ws = args.ws;
    F.ctl = (gu32*)(ws + WS_CTL);
    F.x = args.in[0]; F.norm_mix_g = args.in[1]; F.w_in = args.in[2]; F.conv_a_w = args.in[3]; F.conv_b_w = args.in[4]; F.conv_b_bias = args.in[5]; F.ln_b_g = args.in[6]; F.ln_b_b = args.in[7];
    F.beta_a = args.in[8]; F.beta_b = args.in[9]; F.w_out = args.in[10]; F.norm_ffn_g = args.in[11]; F.wrg = args.in[12]; F.brg = args.in[13]; F.wre = args.in[14]; F.bre = args.in[15];
    F.w1 = args.in[16]; F.w3 = args.in[17]; F.w2 = args.in[18]; F.gfin = args.in[19]; F.out = args.out;
    F.Win_t = (bf16*)(ws + WS_WIN); F.Wout_t = (bf16*)(ws + WS_WOUT); F.Wr_t = (bf16*)(ws + WS_WR); F.W13_t = (bf16*)(ws + WS_W13); F.W2_t = (bf16*)(ws + WS_W2);
    F.XB = (bf16*)(ws + WS_XB); F.P = (bf16*)(ws + WS_P); F.Y = (bf16*)(ws + WS_Y); F.X1B = (bf16*)(ws + WS_X1B); F.H = (bf16*)(ws + WS_H); F.CB = (bf16*)(ws + WS_CB);
    F.SSQ = (float*)(ws + WS_SSQ); F.LW = (float*)(ws + WS_LW); F.LR2 = (float*)(ws + WS_LR2); F.LTOK = (unsigned*)(ws + WS_LTOK); F.gcnt = (unsigned*)(ws + WS_CTL) + CW_GCNT;
    for (int u = threadIdx.x; u < (LDS_BYTES - LDSCTL_OFF) / 4; u += NWAVES * 64) ((LAS unsigned*)(F.lds + LDSCTL_OFF))[u] = 0u;
    __syncthreads();
    XcdBarrier bar; bar.bar = (unsigned*)(F.ctl + CW_BAR); bar.x = 0; bar.st = nullptr;
    if (N_LAUNCHES == 1) bar = xcd_barrier_post((unsigned*)(F.ctl + CW_BAR), F.MISC + 8);
    const int lo = args.ph_lo, hi = args.ph_hi;
#define IN(k) (lo <= (k) && (k) < hi)
#define GRID_BAR(k) do { if (IN(k) && IN((k) + 1)) xcd_barrier(bar); } while (0)

    if (IN(0)) { p0_prologue(F); GRID_BAR(0); }
    if (IN(1)) {
        pg8::SchedDense S{(const char*)F.XB, (const char*)F.Win_t, T / 256, DIN / 256, F.G, (int)blockIdx.x, (size_t)256 * D * 2, (size_t)256 * D * 2};
        pg8::EpiP1 E{F.P};
        pg8::gemm_phase<pg8::EpiP1, pg8::SchedDense>(F.lds + RING_OFF, D, S, E);
        GRID_BAR(1);
    }
    if (IN(2)) { p2_mixer(F); GRID_BAR(2); }
    if (IN(3)) {
        pg8::SchedDense S{(const char*)F.Y, (const char*)F.Wout_t, T / 256, D / 256, F.G, (int)blockIdx.x, (size_t)256 * D * 2, (size_t)256 * D * 2};
        pg8::EpiX1 E{F.x, F.X1B, F.SSQ};
        pg8::gemm_phase<pg8::EpiX1, pg8::SchedDense>(F.lds + RING_OFF, D, S, E);
        GRID_BAR(3);
    }
    if (IN(4)) { p4_route(F); GRID_BAR(4); }
    if (IN(5)) {
        pg8::SchedMoeA S; moe_sched_init(S, F); S.A = (const char*)F.X1B; S.W = (const char*)F.W13_t; S.a_tile_bytes = 0; S.w_row_bytes = (size_t)D * 2;
        pg8::EpiH E{F.H, F.LR2};
        pg8::gemm_phase<pg8::EpiH, pg8::SchedMoeA>(F.lds + RING_OFF, D, S, E);
        GRID_BAR(5);
    }
    if (IN(6)) {
        pg8::SchedMoeB S; moe_sched_init(S, F); S.A = (const char*)F.H; S.W = (const char*)F.W2_t; S.a_tile_bytes = (size_t)256 * DE * 2; S.w_row_bytes = (size_t)DE * 2;
        pg8::EpiC E{F.CB, F.LTOK, F.LW};
        pg8::gemm_phase<pg8::EpiC, pg8::SchedMoeB>(F.lds + RING_OFF, DE, S, E);
        GRID_BAR(6);
    }
    if (IN(7)) p7_final(F);
#undef IN
#undef GRID_BAR
}

extern "C" void kernel_launch(void* const* d_in, const int* in_sizes, int n_in, void* d_out, int out_size, void* d_ws, size_t ws_size, hipStream_t stream) {
    static int grid = 0;
    if (grid == 0) {
        if (n_in != 20 || in_sizes[0] != T * D || out_size != T * D || ws_size < WS_END) { fprintf(stderr, "kernel_launch: unexpected shapes / workspace (n_in %d, in0 %d, out %d, ws %zu, need %zu)\n", n_in, n_in > 0 ? in_sizes[0] : -1, out_size, ws_size, (size_t)WS_END); grid = -1; return; }
        int dev = 0, cus = 0, per_cu = 0;
        if (hipGetDevice(&dev) != hipSuccess || hipDeviceGetAttribute(&cus, hipDeviceAttributeMultiprocessorCount, dev) != hipSuccess) { fprintf(stderr, "kernel_launch: device query failed\n"); grid = -1; return; }
        if (hipFuncSetAttribute((const void*)mk_fwd, hipFuncAttributeMaxDynamicSharedMemorySize, LDS_BYTES) != hipSuccess) { fprintf(stderr, "kernel_launch: hipFuncSetAttribute failed\n"); grid = -1; return; }
        if (hipOccupancyMaxActiveBlocksPerMultiprocessor(&per_cu, (const void*)mk_fwd, NWAVES * 64, LDS_BYTES) != hipSuccess || per_cu < 1) fprintf(stderr, "kernel_launch: occupancy query reports %d workgroups per CU\n", per_cu);
        (void)hipGetLastError();
        grid = cus;
    }
    if (grid < 0) return;
    if (hipMemsetAsync((char*)d_ws + WS_CTL, 0, CTL_ZERO_BYTES, stream) != hipSuccess) { fprintf(stderr, "kernel_launch: hipMemsetAsync failed\n"); return; }
    Args a{};
    for (int i = 0; i < 20; ++i) a.in[i] = (const float*)d_in[i];
    a.out = (float*)d_out; a.ws = (unsigned char*)d_ws;
    for (int li = 0; li < N_LAUNCHES; ++li) {
        a.ph_lo = (N_LAUNCHES == 1) ? 0 : li; a.ph_hi = (N_LAUNCHES == 1) ? NPHASES : li + 1; a.li = li;
        hipLaunchKernelGGL(mk_fwd, dim3(grid), dim3(NWAVES * 64), LDS_BYTES, stream, a);
        const hipError_t le = hipPeekAtLastError();
        if (le != hipSuccess) { fprintf(stderr, "kernel_launch: launch %d failed: %s\n", li, hipGetErrorName(le)); break; }
    }
}
```

```cpp
#include <hip/hip_runtime.h>
#include <cstdio>
#include <cstdint>

#define LAS __attribute__((address_space(3)))
#define GAS __attribute__((address_space(1)))
typedef unsigned short bf16;
typedef short bf16x8 __attribute__((ext_vector_type(8)));
typedef float f32x4 __attribute__((ext_vector_type(4)));
typedef float f32x2 __attribute__((ext_vector_type(2)));
typedef unsigned u32x4 __attribute__((ext_vector_type(4)));
typedef unsigned u32x2 __attribute__((ext_vector_type(2)));
typedef GAS unsigned gu32;

constexpr int T = 16384, SEQ = 2048, D = 1024, DA = 512, DB = 512, DIN = 2560, NE = 32, DE = 512, CAP = 16384, PW = 1536;
constexpr float EPS = 1e-6f;
constexpr int NWAVES = 8;
#ifndef MK_N_LAUNCHES
#define MK_N_LAUNCHES 1
#endif
constexpr int N_LAUNCHES = MK_N_LAUNCHES;
constexpr int NPHASES = 8;
#ifndef PROBE_PHASE
#define PROBE_PHASE -1
#endif

constexpr size_t MiB = 1u << 20;
constexpr size_t WS_CTL = 0, CTL_ZERO_BYTES = 1 * MiB;
constexpr size_t WS_WIN = 1 * MiB;
constexpr size_t WS_WOUT = 6 * MiB;
constexpr size_t WS_WR = 8 * MiB;
constexpr size_t WS_SSQ = 9 * MiB;
constexpr size_t WS_LTOK = 11 * MiB;
constexpr size_t WS_LW = 13 * MiB;
constexpr size_t WS_LR2 = 15 * MiB;
constexpr size_t WS_W13 = 17 * MiB;
constexpr size_t WS_W2 = 81 * MiB;
constexpr size_t WS_X1B = 113 * MiB;
constexpr size_t WS_XB = 145 * MiB;
constexpr size_t WS_P = 177 * MiB;
constexpr size_t WS_Y = 225 * MiB;
constexpr size_t WS_H = 145 * MiB;
constexpr size_t WS_CB = 185 * MiB;
constexpr size_t WS_END = 257 * MiB;
constexpr int CW_TMO = 0, CW_CODE = 1, CW_BAR = 4096, CW_GCNT = 16384;

constexpr int RING_OFF = 0, RING_BYTES = 131072;
constexpr int LDSCTL_OFF = RING_BYTES, MISC_OFF = LDSCTL_OFF + 320;
constexpr int LDS_BYTES = 147456;

#define RLX_AGENT __ATOMIC_RELAXED, __HIP_MEMORY_SCOPE_AGENT
#define LDS_WAIT() asm volatile("s_waitcnt lgkmcnt(0)" ::: "memory")
#define VM_WAIT() asm volatile("s_waitcnt vmcnt(0)" ::: "memory")
__device__ __forceinline__ unsigned f2bf(float f) { unsigned u = __builtin_bit_cast(unsigned, f); return (u + 0x7fffu + ((u >> 16) & 1u)) >> 16; }
__device__ __forceinline__ unsigned pk2(float lo, float hi) { return f2bf(lo) | (f2bf(hi) << 16); }
__device__ __forceinline__ unsigned cvt_pk_bf16(float lo, float hi) { unsigned r; asm volatile("v_cvt_pk_bf16_f32 %0, %1, %2" : "=v"(r) : "v"(lo), "v"(hi)); return r; }
__device__ __forceinline__ float bflo(unsigned v) { return __builtin_bit_cast(float, v << 16); }
__device__ __forceinline__ float bfhi(unsigned v) { return __builtin_bit_cast(float, v & 0xffff0000u); }
__device__ __forceinline__ float fast_sigmoid(float v) { return __builtin_amdgcn_rcpf(1.0f + __expf(-v)); }
__device__ __forceinline__ float wave_sum(float v) {
#pragma unroll
    for (int o = 1; o < 64; o <<= 1) v += __shfl_xor(v, o);
    return v;
}

namespace pg8 {
constexpr int BM = 256, BK = 64, HALF = 128, HTB = HALF * BK * 2, STAGE_BYTES = 8 * HTB, NXCD = 8, WGM = 8;
__host__ __device__ __forceinline__ int lds_byte(int r, int c) { const int st = (r >> 4) * 2 + (c >> 5), rr = r & 15, cc = c & 31, ob = rr * 64 + cc * 2; return st * 1024 + (ob ^ (((ob >> 9) & 1) << 5)); }
__host__ __device__ __forceinline__ void stage_rc(int b, int& R, int& C) { const int st = b / 1024, sb = b % 1024, swz = sb ^ (((sb >> 9) & 1) << 5); R = (st >> 1) * 16 + swz / 64; C = (st & 1) * 32 + (swz % 64) / 2; }
__host__ __device__ __forceinline__ int perm32(int rho) { const int n = rho >> 4, i = rho & 15; return 8 * (i >> 2) + 4 * n + (i & 3); }

struct Unit { int pm, pn, e, rt, cnt; };

__device__ __forceinline__ bool tile_order(int i, int G, int c, int nM, int nN, int& pm, int& pn) {
    const int nwg = nM * nN; const long L = (long)i * G + c; if (L >= nwg) return false;
    int wgid = (int)L; { const int q = nwg / NXCD, r = nwg % NXCD, xcd = wgid % NXCD, off = wgid / NXCD; wgid = (xcd < r ? xcd * (q + 1) : r * (q + 1) + (xcd - r) * q) + off; }
    const int nig = WGM * nN, gid = wgid / nig, fm = gid * WGM, gsz = (nM - fm) < WGM ? (nM - fm) : WGM;
    pm = fm + ((wgid % nig) % gsz); pn = (wgid % nig) / gsz; return true;
}

struct SchedDense {
    static constexpr bool GATHER = false;
    const char* A; const char* Bt; int nM, nN, G, c; size_t tstepA; int ldb;
    __device__ __forceinline__ bool next(int i, Unit& u) const { u.e = 0; u.rt = 0; u.cnt = 0; return tile_order(i, G, c, nM, nN, u.pm, u.pn); }
    __device__ __forceinline__ const char* a_base(const Unit& u) const { return A + (size_t)u.pm * tstepA; }
    __device__ __forceinline__ const char* b_base(const Unit& u) const { return Bt + (size_t)u.pn * 4096; }
    __device__ __forceinline__ void a_tokens(const Unit&, int, unsigned (&)[2]) const {}
};
struct SchedMoe {
    const char* A; const char* W; const unsigned* ltok; int total_rt, G, c, my_start, my_cnt; size_t a_tile_bytes, w_exp_bytes; static constexpr int ldb = 1024;
    __device__ __forceinline__ bool next(int i, Unit& u) const {
        if (!tile_order(i, G, c, total_rt, 4, u.pm, u.pn)) return false;
        const int lane = threadIdx.x & 63;
        const unsigned long long m = __ballot(lane < 32 && my_start <= u.pm);
        const int e = __builtin_amdgcn_readfirstlane(__popcll(m) - 1);
        u.e = e; u.rt = u.pm - __builtin_amdgcn_readlane(my_start, e); u.cnt = __builtin_amdgcn_readlane(my_cnt, e); return true;
    }
    __device__ __forceinline__ const char* b_base(const Unit& u) const { return W + (size_t)u.e * w_exp_bytes + (size_t)u.pn * 4096; }
};
struct SchedMoeA : SchedMoe {
    static constexpr bool GATHER = true;
    __device__ __forceinline__ const char* a_base(const Unit&) const { return A; }
    __device__ __forceinline__ void a_tokens(const Unit& u, int R, unsigned (&tk)[2]) const {
        asm volatile("" : "+v"(R));
#pragma unroll
        for (int h = 0; h < 2; ++h) { const int p0 = u.rt * 256 + 128 * h + R, p1 = p0 + 64; unsigned r0 = 0u, r1 = 0u;
            if (p0 < u.cnt) r0 = ltok[(size_t)u.e * CAP + p0]; if (p1 < u.cnt) r1 = ltok[(size_t)u.e * CAP + p1];
            tk[h] = (r0 & 0xffffu) | (r1 << 16); }
    }
};
struct SchedMoeB : SchedMoe {
    static constexpr bool GATHER = false;
    __device__ __forceinline__ const char* a_base(const Unit& u) const { return A + (size_t)u.pm * a_tile_bytes; }
    __device__ __forceinline__ void a_tokens(const Unit&, int, unsigned (&)[2]) const {}
};

struct EpiP1 {
    bf16* P;
    __device__ __forceinline__ void operator()(const f32x4 (&acc)[2][2][4][2], const Unit& u, int wr, int wc, int fr, int fq) const {
        const int row0 = u.pm * BM + wr * 64 + fr, cl = wc * 32 + 8 * fq;
        if (u.pn >= 4 && u.pn < 6) {
#pragma unroll
            for (int ai = 0; ai < 2; ++ai)
#pragma unroll
                for (int m = 0; m < 4; ++m) { bf16* rowp = P + (size_t)(row0 + ai * HALF + m * 16) * PW + 512 + (u.pn - 4) * 256 + cl;
#pragma unroll
                    for (int bj = 0; bj < 2; ++bj) { const f32x4 v0 = acc[ai][bj][m][0], v1 = acc[ai][bj][m][1];
                        u32x4 w; w.x = cvt_pk_bf16(v0[0], v0[1]); w.y = cvt_pk_bf16(v0[2], v0[3]); w.z = cvt_pk_bf16(v1[0], v1[1]); w.w = cvt_pk_bf16(v1[2], v1[3]);
                        *(u32x4*)(rowp + bj * HALF) = w; } }
        } else if (u.pn < 4) {
#pragma unroll
            for (int ai = 0; ai < 2; ++ai)
#pragma unroll
                for (int m = 0; m < 4; ++m) { bf16* rowp = P + (size_t)(row0 + ai * HALF + m * 16) * PW + u.pn * 128 + cl;
                    const f32x4 v0 = acc[ai][0][m][0] * acc[ai][1][m][0], v1 = acc[ai][0][m][1] * acc[ai][1][m][1];
                    u32x4 w; w.x = cvt_pk_bf16(v0[0], v0[1]); w.y = cvt_pk_bf16(v0[2], v0[3]); w.z = cvt_pk_bf16(v1[0], v1[1]); w.w = cvt_pk_bf16(v1[2], v1[3]);
                    *(u32x4*)rowp = w; }
        } else {
#pragma unroll
            for (int ai = 0; ai < 2; ++ai)
#pragma unroll
                for (int m = 0; m < 4; ++m) { bf16* rowp = P + (size_t)(row0 + ai * HALF + m * 16) * PW + 1024 + (u.pn - 6) * 128 + cl;
                    f32x4 v0, v1;
#pragma unroll
                    for (int j = 0; j < 4; ++j) { v0[j] = acc[ai][0][m][0][j] * fast_sigmoid(acc[ai][1][m][0][j]); v1[j] = acc[ai][0][m][1][j] * fast_sigmoid(acc[ai][1][m][1][j]); }
                    u32x4 w; w.x = cvt_pk_bf16(v0[0], v0[1]); w.y = cvt_pk_bf16(v0[2], v0[3]); w.z = cvt_pk_bf16(v1[0], v1[1]); w.w = cvt_pk_bf16(v1[2], v1[3]);
                    *(u32x4*)rowp = w; }
        }
    }
};
struct EpiX1 {
    const float* x; bf16* x1b; float* ssq;
    __device__ __forceinline__ void operator()(const f32x4 (&acc)[2][2][4][2], const Unit& u, int wr, int wc, int fr, int fq) const {
        const int row0 = u.pm * BM + wr * 64 + fr, col0 = u.pn * BM + wc * 32 + 8 * fq;
#pragma unroll
        for (int ai = 0; ai < 2; ++ai)
#pragma unroll
            for (int m = 0; m < 4; ++m) { const int row = row0 + ai * HALF + m * 16; const float* xr = x + (size_t)row * D + col0; bf16* orow = x1b + (size_t)row * D + col0; float s = 0.f;
#pragma unroll
                for (int bj = 0; bj < 2; ++bj) { const f32x4 a = *(const f32x4*)(xr + bj * HALF), b = *(const f32x4*)(xr + bj * HALF + 4);
                    const f32x4 v0 = acc[ai][bj][m][0] + a, v1 = acc[ai][bj][m][1] + b;
                    s += (v0[0] * v0[0] + v0[1] * v0[1]) + (v0[2] * v0[2] + v0[3] * v0[3]) + (v1[0] * v1[0] + v1[1] * v1[1]) + (v1[2] * v1[2] + v1[3] * v1[3]);
                    u32x4 w; w.x = cvt_pk_bf16(v0[0], v0[1]); w.y = cvt_pk_bf16(v0[2], v0[3]); w.z = cvt_pk_bf16(v1[0], v1[1]); w.w = cvt_pk_bf16(v1[2], v1[3]);
                    *(u32x4*)(orow + bj * HALF) = w; }
                s += __shfl_xor(s, 16); s += __shfl_xor(s, 32);
                if (fq == 0) ssq[(size_t)(u.pn * 4 + wc) * T + row] = s; }
    }
};
struct EpiH {
    bf16* H; const float* lr2;
    __device__ __forceinline__ void operator()(const f32x4 (&acc)[2][2][4][2], const Unit& u, int wr, int wc, int fr, int fq) const {
        const int cl = u.pn * 128 + wc * 32 + 8 * fq;
#pragma unroll
        for (int ai = 0; ai < 2; ++ai)
#pragma unroll
            for (int m = 0; m < 4; ++m) { const int rl = ai * HALF + wr * 64 + m * 16 + fr, pos = u.rt * 256 + rl; float rr = 0.f; if (pos < u.cnt) rr = lr2[(size_t)u.e * CAP + pos];
                f32x4 v0, v1;
#pragma unroll
                for (int j = 0; j < 4; ++j) { const float a0 = acc[ai][0][m][0][j] * rr, b0 = acc[ai][1][m][0][j] * rr, a1 = acc[ai][0][m][1][j] * rr, b1 = acc[ai][1][m][1][j] * rr;
                    v0[j] = a0 * fast_sigmoid(a0) * b0; v1[j] = a1 * fast_sigmoid(a1) * b1; }
                u32x4 w; w.x = cvt_pk_bf16(v0[0], v0[1]); w.y = cvt_pk_bf16(v0[2], v0[3]); w.z = cvt_pk_bf16(v1[0], v1[1]); w.w = cvt_pk_bf16(v1[2], v1[3]);
                *(u32x4*)(H + ((size_t)u.pm * 256 + rl) * DE + cl) = w; }
    }
};
struct EpiC {
    bf16* Cb; const unsigned* ltok; const float* lw;
    __device__ __forceinline__ void operator()(const f32x4 (&acc)[2][2][4][2], const Unit& u, int wr, int wc, int fr, int fq) const {
        const int cl = u.pn * 256 + wc * 32 + 8 * fq;
#pragma unroll
        for (int ai = 0; ai < 2; ++ai)
#pragma unroll
            for (int m = 0; m < 4; ++m) { const int rl = ai * HALF + wr * 64 + m * 16 + fr, pos = u.rt * 256 + rl;
                if (pos < u.cnt) { const unsigned rec = ltok[(size_t)u.e * CAP + pos]; const float cw = lw[(size_t)u.e * CAP + pos];
                    bf16* orow = Cb + ((size_t)(rec >> 16) * T + (rec & 0xffffu)) * D + cl;
#pragma unroll
                    for (int bj = 0; bj < 2; ++bj) { const f32x4 v0 = acc[ai][bj][m][0] * cw, v1 = acc[ai][bj][m][1] * cw;
                        u32x4 w; w.x = cvt_pk_bf16(v0[0], v0[1]); w.y = cvt_pk_bf16(v0[2], v0[3]); w.z = cvt_pk_bf16(v1[0], v1[1]); w.w = cvt_pk_bf16(v1[2], v1[3]);
                        *(u32x4*)(orow + bj * HALF) = w; } } }
    }
};

template <class Epi, class Sched>
__device__ __forceinline__ void gemm_phase(LAS unsigned char* lds, const int K, const Sched& S, const Epi& E) {
    constexpr bool GATHER = Sched::GATHER;
    const int tid = threadIdx.x, wid = __builtin_amdgcn_readfirstlane(tid >> 6), lane = tid & 63, wr = wid >> 2, wc = wid & 3, fr = lane & 15, fq = lane >> 4;
    const int nt = K / BK;
    const size_t kstep = (size_t)(BK * 2), hstep = (size_t)HALF * K * 2;
    const size_t kstepB = (size_t)128 * S.ldb, hstepB = 2048;
    unsigned voffA[2], voffB[2], ct[2] = {0u, 0u}, ntk[2] = {0u, 0u}; int R0; unsigned pc2;
    { int R, C; stage_rc(tid * 16, R, C); R0 = R; pc2 = (unsigned)C * 2u; }
#pragma unroll
    for (int i = 0; i < 2; ++i) { int R, C; stage_rc(tid * 16 + i * 8192, R, C); const int Rb = (R & ~31) + perm32(R & 31);
        voffA[i] = (unsigned)(R * K + C) * 2u; voffB[i] = (unsigned)((C >> 3) * S.ldb + Rb) * 16u; }
    const unsigned ldsw = (unsigned)wid * 1024u;
    const int aoff = lds_byte(wr * 64 + fr, fq * 8), boff = lds_byte(wc * 32 + fr, fq * 8);
#define PG8_SA(b, h) (((b) * 2 + (h)) * HTB)
#define PG8_SB(b, h) ((4 + (b) * 2 + (h)) * HTB)
#define PG8_STAGE(bufoff, gbase, voff) do { _Pragma("unroll") for (int _i = 0; _i < 2; ++_i) \
        __builtin_amdgcn_global_load_lds((const unsigned*)((const char*)(gbase) + (voff)[_i]), (LAS unsigned*)(lds + (bufoff) + ldsw + _i * 8192), 16, 0, 0); } while (0)
#define PG8_STAGE_A(bufoff, gbase, h, TK) do { _Pragma("unroll") for (int _i = 0; _i < 2; ++_i) { \
        const unsigned _o = GATHER ? ((((TK)[h] >> (16 * _i)) & 0xffffu) * 2048u + pc2) : voffA[_i]; const char* _b = GATHER ? (const char*)(gbase) : (const char*)(gbase) + (h) * hstep; \
        __builtin_amdgcn_global_load_lds((const unsigned*)(_b + _o), (LAS unsigned*)(lds + (bufoff) + ldsw + _i * 8192), 16, 0, 0); } } while (0)
#define PG8_LDA(dst, b, h) do { _Pragma("unroll") for (int m = 0; m < 4; ++m) _Pragma("unroll") for (int k = 0; k < 2; ++k) dst[m][k] = *(const LAS bf16x8*)(lds + PG8_SA(b, h) + aoff + m * 2048 + k * 1024); } while (0)
#define PG8_LDB(dst, b, h) do { _Pragma("unroll") for (int n = 0; n < 2; ++n) _Pragma("unroll") for (int k = 0; k < 2; ++k) dst[n][k] = *(const LAS bf16x8*)(lds + PG8_SB(b, h) + boff + n * 2048 + k * 1024); } while (0)
#define PG8_MMA(ai, bj, At, Bt) do { __builtin_amdgcn_s_setprio(1); _Pragma("unroll") for (int m = 0; m < 4; ++m) _Pragma("unroll") for (int n = 0; n < 2; ++n) _Pragma("unroll") for (int k = 0; k < 2; ++k) \
        acc[ai][bj][m][n] = __builtin_amdgcn_mfma_f32_16x16x32_bf16(Bt[n][k], At[m][k], acc[ai][bj][m][n], 0, 0, 0); __builtin_amdgcn_s_setprio(0); } while (0)
#define PG8_WAIT_V(n) asm volatile("s_waitcnt vmcnt(" #n ")" ::: "memory")
#define PG8_WAIT_L(n) asm volatile("s_waitcnt lgkmcnt(" #n ")" ::: "memory")
#define PG8_BAR __builtin_amdgcn_s_barrier()
#define PG8_SCHED __builtin_amdgcn_sched_barrier(0)
    Unit cur, nxt; int ui = 0;
    if (!S.next(0, cur)) return;
    f32x4 acc[2][2][4][2];
#pragma unroll
    for (int a = 0; a < 2; ++a)
#pragma unroll
        for (int b = 0; b < 2; ++b)
#pragma unroll
            for (int m = 0; m < 4; ++m)
#pragma unroll
                for (int n = 0; n < 2; ++n) acc[a][b][m][n] = (f32x4){0.f, 0.f, 0.f, 0.f};
    bf16x8 At[4][2], B0[2][2], B1[2][2];
    const char* cA = S.a_base(cur); const char* cB = S.b_base(cur);
    if constexpr (GATHER) { S.a_tokens(cur, R0, ct); asm volatile("" : "+v"(ct[0]), "+v"(ct[1])); }
    PG8_STAGE(PG8_SB(0, 0), cB, voffB); PG8_STAGE(PG8_SB(0, 1), cB + hstepB, voffB); PG8_STAGE_A(PG8_SA(0, 0), cA, 0, ct); PG8_STAGE_A(PG8_SA(0, 1), cA, 1, ct);
    if (wr == 1) PG8_BAR;
    PG8_WAIT_V(2); PG8_BAR;
    PG8_STAGE(PG8_SB(1, 0), cB + kstepB, voffB); PG8_STAGE_A(PG8_SA(1, 0), cA + kstep, 0, ct); PG8_STAGE(PG8_SB(1, 1), cB + hstepB + kstepB, voffB);
    PG8_WAIT_V(6); PG8_BAR;
    for (;;) {
        const bool has_next = S.next(ui + 1, nxt);
        const char* nA = cA; const char* nB = cB;
        if constexpr (GATHER) { ntk[0] = ct[0]; ntk[1] = ct[1]; }
        if (has_next) { nA = S.a_base(nxt); nB = S.b_base(nxt);
            if constexpr (GATHER) { S.a_tokens(nxt, R0, ntk); asm volatile("" : "+v"(ntk[0]), "+v"(ntk[1])); } }
        for (int t = 0; t < nt; t += 2) {
            const bool last = (t == nt - 2);
            const char* a1 = cA + (size_t)(t + 1) * kstep;
            const char* a2 = last ? nA : cA + (size_t)(t + 2) * kstep; const char* b2 = last ? nB : cB + (size_t)(t + 2) * kstepB;
            const char* a3 = a2 + kstep; const char* b3 = b2 + kstepB;
            unsigned t2[2]; t2[0] = (GATHER && last) ? ntk[0] : ct[0]; t2[1] = (GATHER && last) ? ntk[1] : ct[1];
            PG8_LDB(B0, 0, 0); PG8_LDB(B1, 0, 1); PG8_SCHED; PG8_LDA(At, 0, 0); PG8_STAGE_A(PG8_SA(1, 1), a1, 1, ct);
            PG8_WAIT_V(8); PG8_WAIT_L(0); PG8_BAR; PG8_MMA(0, 0, At, B0); PG8_MMA(0, 1, At, B1); PG8_BAR; PG8_SCHED;
            PG8_LDA(At, 0, 1); PG8_STAGE(PG8_SB(0, 0), b2, voffB); PG8_STAGE(PG8_SB(0, 1), b2 + hstepB, voffB); PG8_STAGE_A(PG8_SA(0, 0), a2, 0, t2);
            PG8_WAIT_V(8); PG8_WAIT_L(0); PG8_BAR; PG8_MMA(1, 0, At, B0); PG8_MMA(1, 1, At, B1); PG8_BAR; PG8_SCHED;
            PG8_LDB(B0, 1, 0); PG8_LDB(B1, 1, 1); PG8_SCHED; PG8_LDA(At, 1, 0); PG8_STAGE_A(PG8_SA(0, 1), a2, 1, t2);
            PG8_WAIT_V(8); PG8_WAIT_L(0); PG8_BAR; PG8_MMA(0, 0, At, B0); PG8_MMA(0, 1, At, B1); PG8_BAR; PG8_SCHED;
            PG8_LDA(At, 1, 1); PG8_STAGE(PG8_SB(1, 0), b3, voffB); PG8_STAGE(PG8_SB(1, 1), b3 + hstepB, voffB); PG8_STAGE_A(PG8_SA(1, 0), a3, 0, t2);
            PG8_WAIT_V(8); PG8_WAIT_L(0); PG8_BAR; PG8_MMA(1, 0, At, B0); PG8_MMA(1, 1, At, B1); PG8_BAR; PG8_SCHED;
        }
        if (wr == 0) PG8_BAR;
        E(acc, cur, wr, wc, fr, fq);
        if (!has_next) break;
#pragma unroll
        for (int a = 0; a < 2; ++a)
#pragma unroll
            for (int b = 0; b < 2; ++b)
#pragma unroll
                for (int m = 0; m < 4; ++m)
#pragma unroll
                    for (int n = 0; n < 2; ++n) acc[a][b][m][n] = (f32x4){0.f, 0.f, 0.f, 0.f};
        cur = nxt; cA = nA; cB = nB; ++ui;
        if constexpr (GATHER) { ct[0] = ntk[0]; ct[1] = ntk[1]; }
        if (wr == 1) PG8_BAR;
    }
    PG8_WAIT_V(0);
    PG8_BAR;
#undef PG8_SA
#undef PG8_SB
#undef PG8_STAGE
#undef PG8_STAGE_A
#undef PG8_LDA
#undef PG8_LDB
#undef PG8_MMA
#undef PG8_WAIT_V
#undef PG8_WAIT_L
#undef PG8_BAR
#undef PG8_SCHED
}
}

#define XB_TMO      128
#define XB_XCNT(j)  (256  + 64 * (j))
#define XB_XSUB(j)  (1280 + 64 * (j))
#define XB_XGEN(j)  (2304 + 64 * (j))
#define XB_TOP      3328
#define XB_TOPGEN   3392
#define XCD_BAR_WORDS 3456
#define XB_SPIN_CAP (1u << 18)
__device__ __forceinline__ unsigned xb_ld(unsigned* p)              { return __hip_atomic_load(p, __ATOMIC_RELAXED, __HIP_MEMORY_SCOPE_AGENT); }
__device__ __forceinline__ unsigned xb_add(unsigned* p, unsigned v) { return __hip_atomic_fetch_add(p, v, __ATOMIC_RELAXED, __HIP_MEMORY_SCOPE_AGENT); }
__device__ __forceinline__ unsigned xb_xcc_id() { return (unsigned)__builtin_amdgcn_s_getreg((3 << 11) | 20) & 0xFu; }
#define XB_SPIN(cond, bar) do { unsigned _sp = 0; while (cond) { __builtin_amdgcn_s_sleep(1); \
    if ((++_sp & 255u) == 0u) { if (xb_ld(&(bar)[XB_TMO])) break; if (_sp > XB_SPIN_CAP) { atomicAdd(&(bar)[XB_TMO], 1u); break; } } } } while (0)
struct XcdBarrier { unsigned* bar; unsigned x; volatile LAS unsigned* st; };
__device__ __forceinline__ XcdBarrier xcd_barrier_post(unsigned* bar, volatile LAS unsigned* st) {
    XcdBarrier b; b.bar = bar; b.x = xb_xcc_id(); b.st = st;
    if (threadIdx.x == 0) (void)xb_add(&bar[XB_XCNT(b.x)], 1u);
    return b;
}
__device__ __forceinline__ void xcd_barrier_complete(unsigned* bar, unsigned x, unsigned& nloc, unsigned& nx) {
    const unsigned G = gridDim.x * gridDim.y * gridDim.z;
    unsigned sum, cnt, mine, sp = 0u;
    for (;;) {
        sum = 0u; cnt = 0u; mine = 0u;
#pragma unroll
        for (unsigned j = 0; j < 16; ++j) { const unsigned c = xb_ld(&bar[XB_XCNT(j)]); sum += c; cnt += (c > 0u) ? 1u : 0u; mine = (j == x) ? c : mine; }
        if (sum == G) break;
        __builtin_amdgcn_s_sleep(1);
        if ((++sp & 255u) == 0u) { if (xb_ld(&bar[XB_TMO])) break; if (sp > XB_SPIN_CAP) { atomicAdd(&bar[XB_TMO], 1u); break; } }
    }
    nloc = mine > 0u ? mine : 1u; nx = cnt > 0u ? cnt : 1u;
}
__device__ __forceinline__ void xcd_barrier(const XcdBarrier& b) {
    asm volatile("s_waitcnt vmcnt(0)" ::: "memory");
    __syncthreads();
    if (threadIdx.x == 0) {
        unsigned* bar = b.bar;
        __builtin_amdgcn_s_waitcnt(0);
        unsigned nloc = b.st[0], nx = b.st[1];
        if (nloc == 0u) { xcd_barrier_complete(bar, b.x, nloc, nx); b.st[0] = nloc; b.st[1] = nx; }
        const unsigned old = xb_add(&bar[XB_XSUB(b.x)], 1u);
        const unsigned gen = old / nloc;
        if (old + 1u == (gen + 1u) * nloc) {
            __builtin_amdgcn_fence(__ATOMIC_RELEASE, "agent");
            asm volatile("s_waitcnt vmcnt(0)" ::: "memory");
            const unsigned og = xb_add(&bar[XB_TOP], 1u);
            const unsigned tg = og / nx;
            if (og + 1u == (tg + 1u) * nx) xb_add(&bar[XB_TOPGEN], 1u);
            else XB_SPIN(xb_ld(&bar[XB_TOPGEN]) == tg, bar);
            __builtin_amdgcn_fence(__ATOMIC_ACQUIRE, "agent");
            xb_add(&bar[XB_XGEN(b.x)], 1u);
            asm volatile("s_waitcnt vmcnt(0)" ::: "memory");
        } else {
            XB_SPIN(xb_ld(&bar[XB_XGEN(b.x)]) == gen, bar);
            __builtin_amdgcn_fence(__ATOMIC_ACQUIRE, "agent");
            asm volatile("s_waitcnt vmcnt(0)" ::: "memory");
        }
    }
    __syncthreads();
}

struct Frame {
    LAS unsigned char* lds;
    volatile LAS unsigned* MISC;
    gu32* ctl;
    int vcu, G;
    const float *x, *norm_mix_g, *w_in, *conv_a_w, *conv_b_w, *conv_b_bias, *ln_b_g, *ln_b_b, *beta_a, *beta_b, *w_out, *norm_ffn_g, *wrg, *brg, *wre, *bre, *w1, *w3, *w2, *gfin;
    float* out;
    bf16 *Win_t, *Wout_t, *Wr_t, *W13_t, *W2_t, *XB, *P, *Y, *X1B, *H, *CB;
    float *SSQ, *LW, *LR2; unsigned* LTOK; unsigned* gcnt;
};

struct CvtItem { const float* src; const float* ks; bf16* dst; int N; bool valid; };
__device__ __forceinline__ void cvt_load(const CvtItem& it, f32x4 (&v)[8]) {
    if (it.valid) {
#pragma unroll
        for (int j = 0; j < 8; ++j) v[j] = *(const GAS f32x4*)(it.src + (size_t)j * it.N);
    }
}
__device__ __forceinline__ void cvt_store(const CvtItem& it, f32x4 (&v)[8]) {
    if (it.valid) {
        if (it.ks) {
#pragma unroll
            for (int j = 0; j < 8; ++j) v[j] = v[j] * it.ks[j];
        }
#pragma unroll
        for (int c = 0; c < 4; ++c) { u32x4 g; g.x = cvt_pk_bf16(v[0][c], v[1][c]); g.y = cvt_pk_bf16(v[2][c], v[3][c]); g.z = cvt_pk_bf16(v[4][c], v[5][c]); g.w = cvt_pk_bf16(v[6][c], v[7][c]);
            *(GAS u32x4*)(it.dst + (size_t)c * 8) = g; }
    }
}
__device__ __forceinline__ int win_dest_row(int n0) {
    if (n0 < 512) return 256 * (n0 >> 7) + (n0 & 127);
    if (n0 < 1024) return n0 + 512;
    if (n0 < 1536) { const int j = n0 - 1024; return 256 * (j >> 7) + 128 + (j & 127); }
    if (n0 < 2048) { const int j = n0 - 1536; return 1536 + 256 * (j >> 7) + (j & 127); }
    { const int j = n0 - 2048; return 1536 + 256 * (j >> 7) + 128 + (j & 127); }
}
constexpr int I_IN = 128 * 10, I_OUT = 128 * 4, I_13 = NE * 2 * 128 * 2, I_2 = NE * 64 * 4, NITEMS = I_IN + I_OUT + I_13 + I_2;
__device__ __forceinline__ CvtItem p0_decode(Frame& F, int it, int lane) {
    CvtItem c; c.valid = it < NITEMS; c.src = F.w_in; c.ks = nullptr; c.dst = F.Win_t; c.N = DIN;
    if (!c.valid) return c;
    int r = it;
    if (r < I_IN) { const int kb = r / 10, n = 256 * (r % 10) + 4 * lane;
        c.src = F.w_in + (size_t)(8 * kb) * DIN + n; c.N = DIN; c.ks = F.norm_mix_g + 8 * kb; c.dst = F.Win_t + ((size_t)kb * DIN + win_dest_row(n)) * 8; return c; }
    r -= I_IN;
    if (r < I_OUT) { const int kb = r / 4, n = 256 * (r % 4) + 4 * lane;
        c.src = F.w_out + (size_t)(8 * kb) * D + n; c.N = D; c.ks = (8 * kb < DA) ? F.beta_a + 8 * kb : F.beta_b + (8 * kb - DA); c.dst = F.Wout_t + ((size_t)kb * D + n) * 8; return c; }
    r -= I_OUT;
    if (r < I_13) { const int e = r / 512, rr = r % 512, which = rr / 256, item = rr % 256, kb = item / 2, n = 256 * (item % 2) + 4 * lane;
        c.src = (which ? F.w3 : F.w1) + (size_t)e * D * DE + (size_t)(8 * kb) * DE + n; c.N = DE; c.ks = F.norm_ffn_g + 8 * kb;
        c.dst = F.W13_t + (size_t)e * 1024 * D + ((size_t)kb * 1024 + 256 * (n >> 7) + 128 * which + (n & 127)) * 8; return c; }
    r -= I_13;
    { const int e = r / 256, item = r % 256, kb = item / 4, n = 256 * (item % 4) + 4 * lane;
        c.src = F.w2 + (size_t)e * DE * D + (size_t)(8 * kb) * D + n; c.N = D; c.ks = nullptr; c.dst = F.W2_t + (size_t)e * 1024 * DE + ((size_t)kb * 1024 + n) * 8; return c; }
}
__device__ __forceinline__ void p0_prologue(Frame& F) {
    int tid = threadIdx.x; asm volatile("" : "+v"(tid)); const int lane = tid & 63, wave = __builtin_amdgcn_readfirstlane(tid >> 6);
    const int gw = F.vcu * NWAVES + wave, NGW = F.G * NWAVES;
    for (int it = gw; it < NITEMS; it += 2 * NGW) {
        const CvtItem c0 = p0_decode(F, it, lane), c1 = p0_decode(F, it + NGW, lane);
        f32x4 v0[8], v1[8];
        cvt_load(c0, v0); cvt_load(c1, v1);
        cvt_store(c0, v0); cvt_store(c1, v1);
    }
    for (int i = gw * 64 + lane; i < 48 * D; i += NGW * 64) { const int o = i / D, k = i % D; float v = 0.f;
        if (o < 4) v = F.wrg[(size_t)k * 4 + o] * F.norm_ffn_g[k]; else if (o < 36) v = F.wre[(size_t)k * NE + (o - 4)] * F.norm_ffn_g[k];
        F.Wr_t[i] = (bf16)f2bf(v); }
    for (int m = gw; m < T; m += NGW) {
        const GAS f32x4* xr = (const GAS f32x4*)(F.x + (size_t)m * D) + lane;
        f32x4 v[4]; float s = 0.f;
#pragma unroll
        for (int j = 0; j < 4; ++j) { v[j] = xr[64 * j]; s += (v[j].x * v[j].x + v[j].y * v[j].y) + (v[j].z * v[j].z + v[j].w * v[j].w); }
        const float r = rsqrtf(wave_sum(s) * (1.f / D) + EPS);
        GAS u32x2* o8 = (GAS u32x2*)(F.XB + (size_t)m * D) + lane;
#pragma unroll
        for (int j = 0; j < 4; ++j) { u32x2 w; w.x = pk2(v[j].x * r, v[j].y * r); w.y = pk2(v[j].z * r, v[j].w * r); o8[64 * j] = w; }
    }
}

__device__ __forceinline__ void p2_mixer(Frame& F) {
    LAS unsigned char* L = F.lds;
    LAS unsigned* Ut = (LAS unsigned*)L;
    LAS float* UC = (LAS float*)(L + 62 * 1024);
    int tid = threadIdx.x; asm volatile("" : "+v"(tid)); const int lane = tid & 63, wave = __builtin_amdgcn_readfirstlane(tid >> 6);
    const int cp = tid & 255, th = tid >> 8;
    float wb0[31], wb1[31];
#pragma unroll
    for (int j = 0; j < 31; ++j) { const f32x2 w = *(const f32x2*)(F.conv_b_w + j * DB + 2 * cp); wb0[j] = w.x; wb1[j] = w.y; }
    const f32x2 bias2 = *(const f32x2*)(F.conv_b_bias + 2 * cp);
    float wa[3][8], lng[8], lnb[8];
#pragma unroll
    for (int j = 0; j < 8; ++j) { lng[j] = F.ln_b_g[lane * 8 + j]; lnb[j] = F.ln_b_b[lane * 8 + j];
#pragma unroll
        for (int q = 0; q < 3; ++q) wa[q][j] = F.conv_a_w[q * DA + lane * 8 + j]; }
    for (int tile = F.vcu; tile < T / 32; tile += F.G) {
        const int t0 = tile * 32, b = t0 / SEQ, s0 = t0 % SEQ;
        u32x4 gpm1[4], gp0[4], gpp1[4], gab[4];
#pragma unroll
        for (int q = 0; q < 4; ++q) { const int i = wave * 4 + q, s = s0 + i; const bf16* prow = F.P + (size_t)(t0 + i) * PW + lane * 8; const u32x4 z4 = (u32x4){0u, 0u, 0u, 0u};
            gpm1[q] = (s > 0) ? *(const GAS u32x4*)(prow - PW) : z4; gp0[q] = *(const GAS u32x4*)prow; gpp1[q] = (s < SEQ - 1) ? *(const GAS u32x4*)(prow + PW) : z4; gab[q] = *(const GAS u32x4*)(prow + 512); }
        for (int ch = tid; ch < 62 * 64; ch += 512) { const int row = ch >> 6, c16 = ch & 63, s = s0 - 15 + row; u32x4 v = (u32x4){0u, 0u, 0u, 0u};
            if (s >= 0 && s < SEQ) v = *(const GAS u32x4*)(F.P + (size_t)(b * SEQ + s) * PW + 1024 + c16 * 8);
            *(LAS u32x4*)(L + row * 1024 + c16 * 16) = v; }
        __syncthreads();
#pragma unroll 1
        for (int sub = 0; sub < 2; ++sub) { const int i0 = th * 16 + sub * 8; float a0[8], a1[8];
#pragma unroll
            for (int i = 0; i < 8; ++i) { a0[i] = bias2.x; a1[i] = bias2.y; }
#pragma unroll
            for (int w = 0; w < 38; ++w) { const unsigned v = Ut[(i0 + w) * 256 + cp]; const float lo = bflo(v), hi = bfhi(v);
#pragma unroll
                for (int i = 0; i < 8; ++i) { const int j = w - i; if (j >= 0 && j < 31) { a0[i] += wb0[j] * lo; a1[i] += wb1[j] * hi; } } }
#pragma unroll
            for (int i = 0; i < 8; ++i) *(LAS f32x2*)(UC + (i0 + i) * 512 + 2 * cp) = (f32x2){a0[i], a1[i]};
        }
        __syncthreads();
#pragma unroll
        for (int q = 0; q < 4; ++q) { const int i = wave * 4 + q, t = t0 + i;
            const f32x4 ua = *(const LAS f32x4*)(UC + i * 512 + lane * 8), ub = *(const LAS f32x4*)(UC + i * 512 + lane * 8 + 4);
            float uv[8] = {ua[0], ua[1], ua[2], ua[3], ub[0], ub[1], ub[2], ub[3]};
            float s1 = 0.f;
#pragma unroll
            for (int j = 0; j < 8; ++j) s1 += uv[j];
            const float mu = wave_sum(s1) * (1.f / DB); float s2 = 0.f;
#pragma unroll
            for (int j = 0; j < 8; ++j) { uv[j] -= mu; s2 += uv[j] * uv[j]; }
            const float rstd = rsqrtf(wave_sum(s2) * (1.f / DB) + EPS); float hb = 0.f;
#pragma unroll
            for (int j = 0; j < 8; ++j) { const float z = uv[j] * rstd * lng[j] + lnb[j]; uv[j] = z * fast_sigmoid(z); hb += uv[j] * uv[j]; }
            hb += __shfl_xor(hb, 1); hb += __shfl_xor(hb, 2); hb += __shfl_xor(hb, 4);
            const float rb = rsqrtf(hb * (1.f / 64.f) + EPS);
            u32x4 ob; ob.x = pk2(uv[0] * rb, uv[1] * rb); ob.y = pk2(uv[2] * rb, uv[3] * rb); ob.z = pk2(uv[4] * rb, uv[5] * rb); ob.w = pk2(uv[6] * rb, uv[7] * rb);
            *(GAS u32x4*)(F.Y + (size_t)t * D + DA + lane * 8) = ob;
            const u32x4 pm1 = gpm1[q], p0 = gp0[q], pp1 = gpp1[q], abv = gab[q];
            float ya[8]; float ha = 0.f;
#pragma unroll
            for (int j = 0; j < 4; ++j) {
                const float c0 = wa[0][2 * j] * bflo(pm1[j]) + wa[1][2 * j] * bflo(p0[j]) + wa[2][2 * j] * bflo(pp1[j]);
                const float c1 = wa[0][2 * j + 1] * bfhi(pm1[j]) + wa[1][2 * j + 1] * bfhi(p0[j]) + wa[2][2 * j + 1] * bfhi(pp1[j]);
                ya[2 * j] = bflo(abv[j]) * c0; ya[2 * j + 1] = bfhi(abv[j]) * c1; ha += ya[2 * j] * ya[2 * j] + ya[2 * j + 1] * ya[2 * j + 1]; }
            ha += __shfl_xor(ha, 1); ha += __shfl_xor(ha, 2); ha += __shfl_xor(ha, 4);
            const float ra = rsqrtf(ha * (1.f / 64.f) + EPS);
            u32x4 oa; oa.x = pk2(ya[0] * ra, ya[1] * ra); oa.y = pk2(ya[2] * ra, ya[3] * ra); oa.z = pk2(ya[4] * ra, ya[5] * ra); oa.w = pk2(ya[6] * ra, ya[7] * ra);
            *(GAS u32x4*)(F.Y + (size_t)t * D + lane * 8) = oa;
        }
    }
    __syncthreads();
}

__device__ __forceinline__ void p4_route(Frame& F) {
    int tid = threadIdx.x; asm volatile("" : "+v"(tid)); const int lane = tid & 63, wave = __builtin_amdgcn_readfirstlane(tid >> 6);
    LAS float* LGp = (LAS float*)F.lds;
    LAS int* scnt = (LAS int*)(F.lds + 102400);
    bf16x8 bfr[4][3];
    { const bf16* brow = F.Wr_t + (size_t)(lane & 15) * D + 128 * wave + 8 * (lane >> 4);
#pragma unroll
      for (int ks = 0; ks < 4; ++ks)
#pragma unroll
        for (int nb = 0; nb < 3; ++nb) bfr[ks][nb] = *(const GAS bf16x8*)(brow + (size_t)nb * 16 * D + ks * 32); }
    for (int tile = F.vcu; tile < T / 64; tile += F.G) {
        if (tid < 32) scnt[tid] = 0;
        const int tb = tile * 64;
        bf16x8 af[4][4];
#pragma unroll
        for (int tg = 0; tg < 4; ++tg)
#pragma unroll
            for (int ks = 0; ks < 4; ++ks) af[tg][ks] = *(const GAS bf16x8*)(F.X1B + (size_t)(tb + 16 * tg + (lane & 15)) * D + 128 * wave + ks * 32 + 8 * (lane >> 4));
#pragma unroll
        for (int tg = 0; tg < 4; ++tg) { f32x4 acc[3];
#pragma unroll
            for (int nb = 0; nb < 3; ++nb) acc[nb] = (f32x4){0.f, 0.f, 0.f, 0.f};
#pragma unroll
            for (int ks = 0; ks < 4; ++ks)
#pragma unroll
                for (int nb = 0; nb < 3; ++nb) acc[nb] = __builtin_amdgcn_mfma_f32_16x16x32_bf16(af[tg][ks], bfr[ks][nb], acc[nb], 0, 0, 0);
#pragma unroll
            for (int nb = 0; nb < 3; ++nb)
#pragma unroll
                for (int r = 0; r < 4; ++r) LGp[(wave * 64 + 16 * tg + 4 * (lane >> 4) + r) * 49 + nb * 16 + (lane & 15)] = acc[nb][r]; }
        __syncthreads();
        int e0 = 0, e1 = 0, p0 = 0, p1 = 0; float c0 = 0.f, c1 = 0.f, r2 = 0.f;
        if (tid < 64) {
            const int t = tb + tid; float ss = 0.f;
#pragma unroll
            for (int s = 0; s < 16; ++s) ss += F.SSQ[(size_t)s * T + t];
            r2 = rsqrtf(ss * (1.f / D) + EPS);
            const LAS float* lg = LGp + tid * 49;
            float g4[4];
#pragma unroll
            for (int i = 0; i < 4; ++i) { float a = 0.f;
#pragma unroll
                for (int w = 0; w < 8; ++w) a += lg[w * 64 * 49 + i];
                g4[i] = a * r2 + F.brg[i]; }
            int g = 0; float m = g4[0];
#pragma unroll
            for (int i = 1; i < 4; ++i) if (g4[i] > m) { m = g4[i]; g = i; }
            float den = 0.f;
#pragma unroll
            for (int i = 0; i < 4; ++i) den += __expf(g4[i] - m);
            const float psel = 1.0f / den;
            int i0 = 0, i1 = -1; float m0 = -3.0e38f, m1 = -3.0e38f;
            for (int i = 0; i < 8; ++i) { float a = 0.f;
#pragma unroll
                for (int w = 0; w < 8; ++w) a += lg[w * 64 * 49 + 4 + g * 8 + i];
                const float v = a * r2 + F.bre[g * 8 + i];
                if (v > m0) { m1 = m0; i1 = i0; m0 = v; i0 = i; } else if (v > m1) { m1 = v; i1 = i; } }
            const float ex = __expf(m1 - m0);
            e0 = g * 8 + i0; e1 = g * 8 + i1; c0 = psel / (1.0f + ex); c1 = psel * ex / (1.0f + ex);
            p0 = __hip_atomic_fetch_add(scnt + e0, 1, __ATOMIC_RELAXED, __HIP_MEMORY_SCOPE_WORKGROUP); p1 = __hip_atomic_fetch_add(scnt + e1, 1, __ATOMIC_RELAXED, __HIP_MEMORY_SCOPE_WORKGROUP);
        }
        __syncthreads();
        if (tid < 32) scnt[32 + tid] = (int)__hip_atomic_fetch_add(F.gcnt + tid, (unsigned)scnt[tid], RLX_AGENT);
        __syncthreads();
        if (tid < 64) {
            const int t = tb + tid; const size_t d0 = (size_t)e0 * CAP + scnt[32 + e0] + p0, d1 = (size_t)e1 * CAP + scnt[32 + e1] + p1;
            F.LTOK[d0] = (unsigned)t; F.LW[d0] = c0; F.LR2[d0] = r2;
            F.LTOK[d1] = (unsigned)t | (1u << 16); F.LW[d1] = c1; F.LR2[d1] = r2;
        }
        __syncthreads();
    }
}

__device__ __forceinline__ void p7_final(Frame& F) {
    int tid = threadIdx.x; asm volatile("" : "+v"(tid)); const int lane = tid & 63, wave = __builtin_amdgcn_readfirstlane(tid >> 6);
    const int gw = F.vcu * NWAVES + wave, NGW = F.G * NWAVES;
    f32x4 g[2][2];
#pragma unroll
    for (int j = 0; j < 2; ++j) { g[j][0] = *(const f32x4*)(F.gfin + j * 512 + lane * 8); g[j][1] = *(const f32x4*)(F.gfin + j * 512 + lane * 8 + 4); }
    for (int t = gw; t < T; t += NGW) {
        float v[2][8]; float ss = 0.f;
#pragma unroll
        for (int j = 0; j < 2; ++j) { const size_t o = (size_t)t * D + j * 512 + lane * 8;
            const u32x4 a = *(const GAS u32x4*)(F.X1B + o), c0 = *(const GAS u32x4*)(F.CB + o), c1 = *(const GAS u32x4*)(F.CB + (size_t)T * D + o);
#pragma unroll
            for (int q = 0; q < 4; ++q) { v[j][2 * q] = bflo(a[q]) + bflo(c0[q]) + bflo(c1[q]); v[j][2 * q + 1] = bfhi(a[q]) + bfhi(c0[q]) + bfhi(c1[q]); ss += v[j][2 * q] * v[j][2 * q] + v[j][2 * q + 1] * v[j][2 * q + 1]; } }
        const float r = rsqrtf(wave_sum(ss) * (1.f / D) + EPS);
#pragma unroll
        for (int j = 0; j < 2; ++j) { float* o = F.out + (size_t)t * D + j * 512 + lane * 8;
            *(GAS f32x4*)o = (f32x4){v[j][0] * r * g[j][0][0], v[j][1] * r * g[j][0][1], v[j][2] * r * g[j][0][2], v[j][3] * r * g[j][0][3]};
            *(GAS f32x4*)(o + 4) = (f32x4){v[j][4] * r * g[j][1][0], v[j][5] * r * g[j][1][1], v[j][6] * r * g[j][1][2], v[j][7] * r * g[j][1][3]}; }
    }
}

__device__ __forceinline__ void moe_sched_init(pg8::SchedMoe& S, Frame& F) {
    int lane = threadIdx.x & 63; asm volatile("" : "+v"(lane));
    int my_cnt = 0; if (lane < NE) my_cnt = (int)__hip_atomic_load(F.gcnt + lane, RLX_AGENT);
    const int tiles = (my_cnt + 255) >> 8; int incl = tiles;
#pragma unroll
    for (int o = 1; o < 32; o <<= 1) { const int v = __shfl_up(incl, o); if (lane >= o) incl += v; }
    S.my_start = incl - tiles; S.my_cnt = my_cnt; S.total_rt = __builtin_amdgcn_readlane(incl, 31);
    S.ltok = F.LTOK; S.G = F.G; S.c = (int)blockIdx.x;
}

struct Args { const float* in[20]; float* out; unsigned char* ws; int ph_lo, ph_hi, li, pad; };
__global__ void __launch_bounds__(NWAVES * 64, 2) mk_fwd(Args args) {
    extern __shared__ __attribute__((aligned(16))) unsigned char lds[];
    Frame F;
    F.lds = (LAS unsigned char*)lds;
    F.MISC = (volatile LAS unsigned*)(F.lds + MISC_OFF);
    F.G = gridDim.x; { const int bx = blockIdx.x; F.vcu = (F.G % 8 == 0) ? (bx % 8) * (F.G / 8) + bx / 8 : bx; }
    unsigned char* ws = args.ws;
    F.ctl = (gu32*)(ws + WS_CTL);
    F.x = args.in[0]; F.norm_mix_g = args.in[1]; F.w_in = args.in[2]; F.conv_a_w = args.in[3]; F.conv_b_w = args.in[4]; F.conv_b_bias = args.in[5]; F.ln_b_g = args.in[6]; F.ln_b_b = args.in[7];
    F.beta_a = args.in[8]; F.beta_b = args.in[9]; F.w_out = args.in[10]; F.norm_ffn_g = args.in[11]; F.wrg = args.in[12]; F.brg = args.in[13]; F.wre = args.in[14]; F.bre = args.in[15];
    F.w1 = args.in[16]; F.w3 = args.in[17]; F.w2 = args.in[18]; F.gfin = args.in[19]; F.out = args.out;
    F.Win_t = (bf16*)(ws + WS_WIN); F.Wout_t = (bf16*)(ws + WS_WOUT); F.Wr_t = (bf16*)(ws + WS_WR); F.W13_t = (bf16*)(ws + WS_W13); F.W2_t = (bf16*)(ws + WS_W2);
    F.XB = (bf16*)(ws + WS_XB); F.P = (bf16*)(ws + WS_P); F.Y = (bf16*)(ws + WS_Y); F.X1B = (bf16*)(ws + WS_X1B); F.H = (bf16*)(ws + WS_H); F.CB = (bf16*)(ws + WS_CB);
    F.SSQ = (float*)(ws + WS_SSQ); F.LW = (float*)(ws + WS_LW); F.LR2 = (float*)(ws + WS_LR2); F.LTOK = (unsigned*)(ws + WS_LTOK); F.gcnt = (unsigned*)(ws + WS_CTL) + CW_GCNT;
    for (int u = threadIdx.x; u < (LDS_BYTES - LDSCTL_OFF) / 4; u += NWAVES * 64) ((LAS unsigned*)(F.lds + LDSCTL_OFF))[u] = 0u;
    __syncthreads();
    XcdBarrier bar; bar.bar = (unsigned*)(F.ctl + CW_BAR); bar.x = 0; bar.st = nullptr;
    if (N_LAUNCHES == 1) bar = xcd_barrier_post((unsigned*)(F.ctl + CW_BAR), F.MISC + 8);
    const int lo = args.ph_lo, hi = args.ph_hi;
#define IN(k) (lo <= (k) && (k) < hi)
#define GRID_BAR(k) do { if (IN(k) && IN((k) + 1)) xcd_barrier(bar); if (PROBE_PHASE >= 0 && blockIdx.x == 0 && threadIdx.x == 0) ((unsigned long long*)(ws + WS_WR + 512 * 1024))[(k) + 1] = __builtin_amdgcn_s_memrealtime(); } while (0)
    if (PROBE_PHASE >= 0 && blockIdx.x == 0 && threadIdx.x == 0) ((unsigned long long*)(ws + WS_WR + 512 * 1024))[0] = __builtin_amdgcn_s_memrealtime();

    if (IN(0)) { p0_prologue(F); GRID_BAR(0); }
    if (IN(1)) {
        pg8::SchedDense S{(const char*)F.XB, (const char*)F.Win_t, T / 256, DIN / 256, F.G, (int)blockIdx.x, (size_t)256 * D * 2, DIN};
        pg8::EpiP1 E{F.P};
        pg8::gemm_phase<pg8::EpiP1, pg8::SchedDense>(F.lds + RING_OFF, D, S, E);
        GRID_BAR(1);
    }
    if (IN(2)) { p2_mixer(F); GRID_BAR(2); }
    if (IN(3)) {
        pg8::SchedDense S{(const char*)F.Y, (const char*)F.Wout_t, T / 256, D / 256, F.G, (int)blockIdx.x, (size_t)256 * D * 2, D};
        pg8::EpiX1 E{F.x, F.X1B, F.SSQ};
        pg8::gemm_phase<pg8::EpiX1, pg8::SchedDense>(F.lds + RING_OFF, D, S, E);
        GRID_BAR(3);
    }
    if (IN(4)) { p4_route(F); GRID_BAR(4); }
    if (IN(5)) {
        pg8::SchedMoeA S; moe_sched_init(S, F); S.A = (const char*)F.X1B; S.W = (const char*)F.W13_t; S.a_tile_bytes = 0; S.w_exp_bytes = (size_t)1024 * D * 2;
        pg8::EpiH E{F.H, F.LR2};
        pg8::gemm_phase<pg8::EpiH, pg8::SchedMoeA>(F.lds + RING_OFF, D, S, E);
        GRID_BAR(5);
    }
    if (IN(6)) {
        pg8::SchedMoeB S; moe_sched_init(S, F); S.A = (const char*)F.H; S.W = (const char*)F.W2_t; S.a_tile_bytes = (size_t)256 * DE * 2; S.w_exp_bytes = (size_t)1024 * DE * 2;
        pg8::EpiC E{F.CB, F.LTOK, F.LW};
        pg8::gemm_phase<pg8::EpiC, pg8::SchedMoeB>(F.lds + RING_OFF, DE, S, E);
        GRID_BAR(6);
    }
    if (IN(7)) { p7_final(F);
        if (PROBE_PHASE >= 0 && blockIdx.x == 0 && threadIdx.x == 0) { unsigned long long* ts = (unsigned long long*)(ws + WS_WR + 512 * 1024); ts[8] = __builtin_amdgcn_s_memrealtime();
            asm volatile("s_waitcnt vmcnt(0)" ::: "memory"); const float us = (float)(ts[PROBE_PHASE + 1] - ts[PROBE_PHASE]) * 0.01f; F.out[0] += us * 0.1f; } }
#undef IN
#undef GRID_BAR
}

extern "C" void kernel_launch(void* const* d_in, const int* in_sizes, int n_in, void* d_out, int out_size, void* d_ws, size_t ws_size, hipStream_t stream) {
    static int grid = 0;
    if (grid == 0) {
        if (n_in != 20 || in_sizes[0] != T * D || out_size != T * D || ws_size < WS_END) { fprintf(stderr, "kernel_launch: unexpected shapes / workspace (n_in %d, in0 %d, out %d, ws %zu, need %zu)\n", n_in, n_in > 0 ? in_sizes[0] : -1, out_size, ws_size, (size_t)WS_END); grid = -1; return; }
        int dev = 0, cus = 0, per_cu = 0;
        if (hipGetDevice(&dev) != hipSuccess || hipDeviceGetAttribute(&cus, hipDeviceAttributeMultiprocessorCount, dev) != hipSuccess) { fprintf(stderr, "kernel_launch: device query failed\n"); grid = -1; return; }
        if (hipFuncSetAttribute((const void*)mk_fwd, hipFuncAttributeMaxDynamicSharedMemorySize, LDS_BYTES) != hipSuccess) { fprintf(stderr, "kernel_launch: hipFuncSetAttribute failed\n"); grid = -1; return; }
        if (hipOccupancyMaxActiveBlocksPerMultiprocessor(&per_cu, (const void*)mk_fwd, NWAVES * 64, LDS_BYTES) != hipSuccess || per_cu < 1) fprintf(stderr, "kernel_launch: occupancy query reports %d workgroups per CU\n", per_cu);
        (void)hipGetLastError();
        grid = cus;
    }
    if (grid < 0) return;
    if (hipMemsetAsync((char*)d_ws + WS_CTL, 0, CTL_ZERO_BYTES, stream) != hipSuccess) { fprintf(stderr, "kernel_launch: hipMemsetAsync failed\n"); return; }
    Args a{};
    for (int i = 0; i < 20; ++i) a.in[i] = (const float*)d_in[i];
    a.out = (float*)d_out; a.ws = (unsigned char*)d_ws;
    for (int li = 0; li < N_LAUNCHES; ++li) {
        a.ph_lo = (N_LAUNCHES == 1) ? 0 : li; a.ph_hi = (N_LAUNCHES == 1) ? NPHASES : li + 1; a.li = li;
        hipLaunchKernelGGL(mk_fwd, dim3(grid), dim3(NWAVES * 64), LDS_BYTES, stream, a);
        const hipError_t le = hipPeekAtLastError();
        if (le != hipSuccess) { fprintf(stderr, "kernel_launch: launch %d failed: %s\n", li, hipGetErrorName(le)); break; }
    }
}
```

```cpp
#include <hip/hip_runtime.h>
#include <cstdio>
#include <cstdint>

#define LAS __attribute__((address_space(3)))
#define GAS __attribute__((address_space(1)))
typedef unsigned short bf16;
typedef short bf16x8 __attribute__((ext_vector_type(8)));
typedef float f32x4 __attribute__((ext_vector_type(4)));
typedef float f32x2 __attribute__((ext_vector_type(2)));
typedef unsigned u32x4 __attribute__((ext_vector_type(4)));
typedef unsigned u32x2 __attribute__((ext_vector_type(2)));
typedef GAS unsigned gu32;
typedef int i32x4 __attribute__((ext_vector_type(4)));
typedef int i32x8 __attribute__((ext_vector_type(8)));
typedef unsigned char fp8;

constexpr int T = 16384, SEQ = 2048, D = 1024, DA = 512, DB = 512, DIN = 2560, NE = 32, DE = 512, CAP = 16384, PW = 1536;
constexpr float EPS = 1e-6f;
constexpr int NWAVES = 8;
#ifndef MK_N_LAUNCHES
#define MK_N_LAUNCHES 1
#endif
constexpr int N_LAUNCHES = MK_N_LAUNCHES;
constexpr int NPHASES = 8;
#ifndef PROBE_PHASE
#define PROBE_PHASE -1
#endif

constexpr size_t MiB = 1u << 20;
constexpr size_t WS_CTL = 0, CTL_ZERO_BYTES = 1 * MiB;
constexpr size_t WS_WIN = 1 * MiB;
constexpr size_t WS_WOUT = 6 * MiB;
constexpr size_t WS_WR = 8 * MiB;
constexpr size_t WS_SSQ = 9 * MiB;
constexpr size_t WS_LTOK = 11 * MiB;
constexpr size_t WS_LW = 13 * MiB;
constexpr size_t WS_LR2 = 15 * MiB;
constexpr size_t WS_W13 = 17 * MiB;
constexpr size_t WS_W2 = 49 * MiB;
constexpr size_t WS_X1B = 65 * MiB;
constexpr size_t WS_X1F8 = 97 * MiB;
constexpr size_t WS_XB = 113 * MiB;
constexpr size_t WS_P = 145 * MiB;
constexpr size_t WS_Y = 193 * MiB;
constexpr size_t WS_H = 113 * MiB;
constexpr size_t WS_CB = 133 * MiB;
constexpr size_t WS_END = 225 * MiB;
constexpr int CW_TMO = 0, CW_CODE = 1, CW_BAR = 4096, CW_GCNT = 16384;

constexpr int RING_OFF = 0, RING_BYTES = 131072;
constexpr int LDSCTL_OFF = RING_BYTES, MISC_OFF = LDSCTL_OFF + 320;
constexpr int LDS_BYTES = 147456;

#define RLX_AGENT __ATOMIC_RELAXED, __HIP_MEMORY_SCOPE_AGENT
#define LDS_WAIT() asm volatile("s_waitcnt lgkmcnt(0)" ::: "memory")
#define VM_WAIT() asm volatile("s_waitcnt vmcnt(0)" ::: "memory")
__device__ __forceinline__ unsigned f2bf(float f) { unsigned u = __builtin_bit_cast(unsigned, f); return (u + 0x7fffu + ((u >> 16) & 1u)) >> 16; }
__device__ __forceinline__ unsigned pk2(float lo, float hi) { return f2bf(lo) | (f2bf(hi) << 16); }
__device__ __forceinline__ unsigned cvt_pk_bf16(float lo, float hi) { unsigned r; asm volatile("v_cvt_pk_bf16_f32 %0, %1, %2" : "=v"(r) : "v"(lo), "v"(hi)); return r; }
__device__ __forceinline__ unsigned pk4_fp8(float a, float b, float c, float d) { int w = 0; w = __builtin_amdgcn_cvt_pk_fp8_f32(a, b, w, false); w = __builtin_amdgcn_cvt_pk_fp8_f32(c, d, w, true); return (unsigned)w; }
__device__ __forceinline__ float bflo(unsigned v) { return __builtin_bit_cast(float, v << 16); }
__device__ __forceinline__ float bfhi(unsigned v) { return __builtin_bit_cast(float, v & 0xffff0000u); }
__device__ __forceinline__ float fast_sigmoid(float v) { return __builtin_amdgcn_rcpf(1.0f + __expf(-v)); }
__device__ __forceinline__ int lane_id() { unsigned m = ~0u; asm volatile("" : "+s"(m)); return (int)__builtin_amdgcn_mbcnt_hi(m, __builtin_amdgcn_mbcnt_lo(m, 0u)); }
__device__ __forceinline__ float wave_sum(float v) {
#pragma unroll
    for (int o = 1; o < 64; o <<= 1) v += __shfl_xor(v, o);
    return v;
}

namespace pg8 {
constexpr int BM = 256, BK = 64, HALF = 128, HTB = HALF * BK * 2, STAGE_BYTES = 8 * HTB, NXCD = 8, WGM = 8;
__host__ __device__ __forceinline__ int lds_byte(int r, int c) { const int st = (r >> 4) * 2 + (c >> 5), rr = r & 15, cc = c & 31, ob = rr * 64 + cc * 2; return st * 1024 + (ob ^ (((ob >> 9) & 1) << 5)); }
__host__ __device__ __forceinline__ void stage_rc(int b, int& R, int& C) { const int st = b / 1024, sb = b % 1024, swz = sb ^ (((sb >> 9) & 1) << 5); R = (st >> 1) * 16 + swz / 64; C = (st & 1) * 32 + (swz % 64) / 2; }
__host__ __device__ __forceinline__ int perm32(int rho) { const int n = rho >> 4, i = rho & 15; return 8 * (i >> 2) + 4 * n + (i & 3); }

struct Unit { int pm, pn, e, rt, cnt; };

__device__ __forceinline__ bool tile_order(int i, int G, int c, int nM, int nN, int& pm, int& pn) {
    const int nwg = nM * nN; const int L = i * G + c; if (L >= nwg) return false;
    int wgid = L; { const int q = nwg / NXCD, r = nwg % NXCD, xcd = wgid % NXCD, off = wgid / NXCD; wgid = (xcd < r ? xcd * (q + 1) : r * (q + 1) + (xcd - r) * q) + off; }
    const int nig = WGM * nN, gid = wgid / nig, fm = gid * WGM, gsz = (nM - fm) < WGM ? (nM - fm) : WGM;
    pm = fm + ((wgid % nig) % gsz); pn = (wgid % nig) / gsz; return true;
}

struct SchedDense {
    static constexpr bool GATHER = false;
    const char* A; const char* Bt; int nM, nN, G, c; size_t tstepA; int ldb;
    __device__ __forceinline__ bool next(int i, Unit& u) const { u.e = 0; u.rt = 0; u.cnt = 0; return tile_order(i, G, c, nM, nN, u.pm, u.pn); }
    __device__ __forceinline__ const char* a_buf() const { return A; }
    __device__ __forceinline__ const char* b_buf() const { return Bt; }
    __device__ __forceinline__ unsigned a_soff(const Unit& u) const { return (unsigned)u.pm * (unsigned)tstepA; }
    __device__ __forceinline__ unsigned b_soff(const Unit& u) const { return (unsigned)u.pn * 4096u; }
    __device__ __forceinline__ void a_tokens(const Unit&, int, unsigned (&)[2]) const {}
};
struct SchedMoe {
    const char* A; const char* W; const unsigned* ltok; const LAS int* tab; int total_rt, G, c; size_t a_tile_bytes, w_exp_bytes; static constexpr int ldb = 1024;
    __device__ __forceinline__ bool next(int i, Unit& u) const {
        if (!tile_order(i, G, c, total_rt, 4, u.pm, u.pn)) return false;
        const int lane = lane_id();
        const unsigned long long m = __ballot(lane < 32 && tab[lane & 31] <= u.pm);
        const int e = __builtin_amdgcn_readfirstlane(__popcll(m) - 1);
        u.e = e; u.rt = u.pm - __builtin_amdgcn_readfirstlane(tab[e]); u.cnt = __builtin_amdgcn_readfirstlane(tab[32 + e]); return true;
    }
    __device__ __forceinline__ const char* a_buf() const { return A; }
    __device__ __forceinline__ const char* b_buf() const { return W; }
    __device__ __forceinline__ unsigned b_soff(const Unit& u) const { return (unsigned)u.e * (unsigned)w_exp_bytes + (unsigned)u.pn * 4096u; }
};
struct SchedMoeA : SchedMoe {
    static constexpr bool GATHER = true;
    __device__ __forceinline__ unsigned a_soff(const Unit&) const { return 0u; }
    __device__ __forceinline__ void a_tokens(const Unit& u, int R, unsigned (&tk)[2]) const {
        asm volatile("" : "+v"(R));
        const __amdgpu_buffer_rsrc_t rl = __builtin_amdgcn_make_buffer_rsrc((void*)ltok, 0, NE * CAP * 4, 0x00020000);
#pragma unroll
        for (int h = 0; h < 2; ++h) { const int p0 = u.rt * 256 + 128 * h + R, p1 = p0 + 64;
            const unsigned r0 = (unsigned)__builtin_amdgcn_raw_buffer_load_b32(rl, p0 < u.cnt ? (u.e * CAP + p0) * 4 : 0x7ffffff0, 0, 0);
            const unsigned r1 = (unsigned)__builtin_amdgcn_raw_buffer_load_b32(rl, p1 < u.cnt ? (u.e * CAP + p1) * 4 : 0x7ffffff0, 0, 0);
            tk[h] = (r0 & 0xffffu) | (r1 << 16); }
    }
};
struct SchedMoeB : SchedMoe {
    static constexpr bool GATHER = false;
    __device__ __forceinline__ unsigned a_soff(const Unit& u) const { return (unsigned)u.pm * (unsigned)a_tile_bytes; }
    __device__ __forceinline__ void a_tokens(const Unit&, int, unsigned (&)[2]) const {}
};

struct EpiP1 {
    bf16* P;
    __device__ __forceinline__ void operator()(const f32x4 (&acc)[2][2][4][2], const Unit& u, int wr, int wc, int fr, int fq) const {
        asm volatile("" : "+v"(fr), "+v"(fq));
        const int row0 = u.pm * BM + wr * 64 + fr, cl = wc * 32 + 8 * fq;
        if (u.pn >= 4 && u.pn < 6) {
#pragma unroll
            for (int ai = 0; ai < 2; ++ai)
#pragma unroll
                for (int m = 0; m < 4; ++m) { bf16* rowp = P + (size_t)(row0 + ai * HALF + m * 16) * PW + 512 + (u.pn - 4) * 256 + cl;
#pragma unroll
                    for (int bj = 0; bj < 2; ++bj) { const f32x4 v0 = acc[ai][bj][m][0], v1 = acc[ai][bj][m][1];
                        u32x4 w; w.x = cvt_pk_bf16(v0[0], v0[1]); w.y = cvt_pk_bf16(v0[2], v0[3]); w.z = cvt_pk_bf16(v1[0], v1[1]); w.w = cvt_pk_bf16(v1[2], v1[3]);
                        *(u32x4*)(rowp + bj * HALF) = w; } }
        } else if (u.pn < 4) {
#pragma unroll
            for (int ai = 0; ai < 2; ++ai)
#pragma unroll
                for (int m = 0; m < 4; ++m) { bf16* rowp = P + (size_t)(row0 + ai * HALF + m * 16) * PW + u.pn * 128 + cl;
                    const f32x4 v0 = acc[ai][0][m][0] * acc[ai][1][m][0], v1 = acc[ai][0][m][1] * acc[ai][1][m][1];
                    u32x4 w; w.x = cvt_pk_bf16(v0[0], v0[1]); w.y = cvt_pk_bf16(v0[2], v0[3]); w.z = cvt_pk_bf16(v1[0], v1[1]); w.w = cvt_pk_bf16(v1[2], v1[3]);
                    *(u32x4*)rowp = w; }
        } else {
#pragma unroll
            for (int ai = 0; ai < 2; ++ai)
#pragma unroll
                for (int m = 0; m < 4; ++m) { bf16* rowp = P + (size_t)(row0 + ai * HALF + m * 16) * PW + 1024 + (u.pn - 6) * 128 + cl;
                    f32x4 v0, v1;
#pragma unroll
                    for (int j = 0; j < 4; ++j) { v0[j] = acc[ai][0][m][0][j] * fast_sigmoid(acc[ai][1][m][0][j]); v1[j] = acc[ai][0][m][1][j] * fast_sigmoid(acc[ai][1][m][1][j]); }
                    u32x4 w; w.x = cvt_pk_bf16(v0[0], v0[1]); w.y = cvt_pk_bf16(v0[2], v0[3]); w.z = cvt_pk_bf16(v1[0], v1[1]); w.w = cvt_pk_bf16(v1[2], v1[3]);
                    *(u32x4*)rowp = w; }
        }
    }
};
struct EpiX1 {
    const float* x; bf16* x1b; float* ssq; fp8* x1f8;
    __device__ __forceinline__ void operator()(const f32x4 (&acc)[2][2][4][2], const Unit& u, int wr, int wc, int fr, int fq) const {
        asm volatile("" : "+v"(fr), "+v"(fq));
        const int row0 = u.pm * BM + wr * 64 + fr, col0 = u.pn * BM + wc * 32 + 8 * fq;
#pragma unroll
        for (int ai = 0; ai < 2; ++ai)
#pragma unroll
            for (int m = 0; m < 4; ++m) { const int row = row0 + ai * HALF + m * 16; const float* xr = x + (size_t)row * D + col0; bf16* orow = x1b + (size_t)row * D + col0; fp8* qrow = x1f8 + (size_t)row * D + col0; float s = 0.f;
#pragma unroll
                for (int bj = 0; bj < 2; ++bj) { const f32x4 a = *(const f32x4*)(xr + bj * HALF), b = *(const f32x4*)(xr + bj * HALF + 4);
                    const f32x4 v0 = acc[ai][bj][m][0] + a, v1 = acc[ai][bj][m][1] + b;
                    s += (v0[0] * v0[0] + v0[1] * v0[1]) + (v0[2] * v0[2] + v0[3] * v0[3]) + (v1[0] * v1[0] + v1[1] * v1[1]) + (v1[2] * v1[2] + v1[3] * v1[3]);
                    u32x4 w; w.x = cvt_pk_bf16(v0[0], v0[1]); w.y = cvt_pk_bf16(v0[2], v0[3]); w.z = cvt_pk_bf16(v1[0], v1[1]); w.w = cvt_pk_bf16(v1[2], v1[3]);
                    *(u32x4*)(orow + bj * HALF) = w;
                    u32x2 q; q.x = pk4_fp8(v0[0], v0[1], v0[2], v0[3]); q.y = pk4_fp8(v1[0], v1[1], v1[2], v1[3]); *(u32x2*)(qrow + bj * HALF) = q; }
                s += __shfl_xor(s, 16); s += __shfl_xor(s, 32);
                if (fq == 0) ssq[(size_t)(u.pn * 4 + wc) * T + row] = s; }
    }
};
struct EpiH {
    fp8* H; const float* lr2;
    __device__ __forceinline__ void operator()(const f32x4 (&acc)[2][2][4][2], const Unit& u, int wr, int wc, int fr, int fq) const {
        asm volatile("" : "+v"(fr), "+v"(fq));
        const int cl = u.pn * 128 + wc * 32 + 8 * fq;
#pragma unroll
        for (int ai = 0; ai < 2; ++ai)
#pragma unroll
            for (int m = 0; m < 4; ++m) { const int rl = ai * HALF + wr * 64 + m * 16 + fr, pos = u.rt * 256 + rl; float rr = 0.f; if (pos < u.cnt) rr = lr2[(size_t)u.e * CAP + pos] * (1.0f / 32.0f);
                f32x4 v0, v1;
#pragma unroll
                for (int j = 0; j < 4; ++j) { const float a0 = acc[ai][0][m][0][j] * rr, b0 = acc[ai][1][m][0][j] * rr, a1 = acc[ai][0][m][1][j] * rr, b1 = acc[ai][1][m][1][j] * rr;
                    v0[j] = a0 * fast_sigmoid(a0) * b0; v1[j] = a1 * fast_sigmoid(a1) * b1; }
                u32x2 w; w.x = pk4_fp8(v0[0], v0[1], v0[2], v0[3]); w.y = pk4_fp8(v1[0], v1[1], v1[2], v1[3]);
                *(u32x2*)(H + ((size_t)u.pm * 256 + rl) * DE + cl) = w; }
    }
};
struct EpiC {
    bf16* Cb; const unsigned* ltok; const float* lw;
    __device__ __forceinline__ void operator()(const f32x4 (&acc)[2][2][4][2], const Unit& u, int wr, int wc, int fr, int fq) const {
        asm volatile("" : "+v"(fr), "+v"(fq));
        const int cl = u.pn * 256 + wc * 32 + 8 * fq;
#pragma unroll
        for (int ai = 0; ai < 2; ++ai)
#pragma unroll
            for (int m = 0; m < 4; ++m) { const int rl = ai * HALF + wr * 64 + m * 16 + fr, pos = u.rt * 256 + rl;
                if (pos < u.cnt) { const unsigned rec = ltok[(size_t)u.e * CAP + pos]; const float cw = lw[(size_t)u.e * CAP + pos] * (1.0f / 16.0f);
                    bf16* orow = Cb + ((size_t)(rec >> 16) * T + (rec & 0xffffu)) * D + cl;
#pragma unroll
                    for (int bj = 0; bj < 2; ++bj) { const f32x4 v0 = acc[ai][bj][m][0] * cw, v1 = acc[ai][bj][m][1] * cw;
                        u32x4 w; w.x = cvt_pk_bf16(v0[0], v0[1]); w.y = cvt_pk_bf16(v0[2], v0[3]); w.z = cvt_pk_bf16(v1[0], v1[1]); w.w = cvt_pk_bf16(v1[2], v1[3]);
                        *(u32x4*)(orow + bj * HALF) = w; } } }
    }
};

template <class Epi, class Sched, bool F8>
__device__ __forceinline__ void gemm_phase(LAS unsigned char* lds, const int Kb, const Sched& S, const Epi& E, const int wid) {
    constexpr bool GATHER = Sched::GATHER;
    const int lane = lane_id(), tid = wid * 64 + lane, wr = wid >> 2, wc = wid & 3, fr = lane & 15, fq = lane >> 4;
    int nt = Kb / 128; asm volatile("" : "+s"(nt));
    const unsigned kstep = 128u, hstep = (unsigned)(HALF * Kb);
    const unsigned kstepB = 128u * (unsigned)S.ldb, hstepB = 2048u;
    const __amdgpu_buffer_rsrc_t rsA = __builtin_amdgcn_make_buffer_rsrc((void*)S.a_buf(), 0, 0x7fffffff, 0x00020000);
    const __amdgpu_buffer_rsrc_t rsB = __builtin_amdgcn_make_buffer_rsrc((void*)S.b_buf(), 0, 0x7fffffff, 0x00020000);
    unsigned voffA[2], voffB[2], ct[2] = {0u, 0u}, ntk[2] = {0u, 0u}; unsigned pc2;
    { int R, C; stage_rc(tid * 16, R, C); pc2 = (unsigned)C * 2u; }
#define PG8_R0() ({ int _t = wid * 64 + lane_id(); asm volatile("" : "+v"(_t)); int _R, _C; stage_rc(_t * 16, _R, _C); _R; })
#pragma unroll
    for (int i = 0; i < 2; ++i) { int R, C; stage_rc(tid * 16 + i * 8192, R, C); const int Rb = (R & ~31) + perm32(R & 31);
        voffA[i] = (unsigned)(R * Kb) + (unsigned)C * 2u; voffB[i] = (unsigned)((C >> 3) * S.ldb + Rb) * 16u; }
    const unsigned ldsw = (unsigned)wid * 1024u;
    const int aoff = lds_byte(wr * 64 + fr, fq * 8), boff = lds_byte(wc * 32 + fr, fq * 8);
    const LAS unsigned char* ldsA = lds + aoff; const LAS unsigned char* ldsB = lds + 4 * HTB + boff;
    asm volatile("" : "+v"(ldsA), "+v"(ldsB));
#define PG8_SA(b, h) (((b) * 2 + (h)) * HTB)
#define PG8_SB(b, h) ((4 + (b) * 2 + (h)) * HTB)
#define PG8_STAGE(bufoff, soff, voff) do { _Pragma("unroll") for (int _i = 0; _i < 2; ++_i) \
        __builtin_amdgcn_raw_ptr_buffer_load_lds(rsB, (LAS void*)(lds + (bufoff) + ldsw + _i * 8192), 16, (int)(voff)[_i], (int)(soff), 0, 0); } while (0)
#define PG8_STAGE_A(bufoff, soff, h, TK) do { _Pragma("unroll") for (int _i = 0; _i < 2; ++_i) { \
        const unsigned _o = GATHER ? ((((TK)[h] >> (16 * _i)) & 0xffffu) * (unsigned)Kb + pc2) : voffA[_i]; const unsigned _so = GATHER ? (unsigned)(soff) : (unsigned)(soff) + (h) * hstep; \
        __builtin_amdgcn_raw_ptr_buffer_load_lds(rsA, (LAS void*)(lds + (bufoff) + ldsw + _i * 8192), 16, (int)_o, (int)_so, 0, 0); } } while (0)
#define PG8_LDA(dst, b, h) do { _Pragma("unroll") for (int m = 0; m < 4; ++m) { if constexpr (F8) { const i32x4 _lo = *(const LAS i32x4*)(ldsA + PG8_SA(b, h) + m * 2048), _hi = *(const LAS i32x4*)(ldsA + PG8_SA(b, h) + m * 2048 + 1024); \
            dst##8[m] = __builtin_shufflevector(_lo, _hi, 0, 1, 2, 3, 4, 5, 6, 7); } else { _Pragma("unroll") for (int k = 0; k < 2; ++k) dst[m][k] = *(const LAS bf16x8*)(ldsA + PG8_SA(b, h) + m * 2048 + k * 1024); } } } while (0)
#define PG8_LDB(dst, b, h) do { _Pragma("unroll") for (int n = 0; n < 2; ++n) { if constexpr (F8) { const i32x4 _lo = *(const LAS i32x4*)(ldsB + (PG8_SB(b, h) - 4 * HTB) + n * 2048), _hi = *(const LAS i32x4*)(ldsB + (PG8_SB(b, h) - 4 * HTB) + n * 2048 + 1024); \
            dst##8[n] = __builtin_shufflevector(_lo, _hi, 0, 1, 2, 3, 4, 5, 6, 7); } else { _Pragma("unroll") for (int k = 0; k < 2; ++k) dst[n][k] = *(const LAS bf16x8*)(ldsB + (PG8_SB(b, h) - 4 * HTB) + n * 2048 + k * 1024); } } } while (0)
#define PG8_MMA(ai, bj, At, Bt) do { __builtin_amdgcn_s_setprio(1); _Pragma("unroll") for (int m = 0; m < 4; ++m) _Pragma("unroll") for (int n = 0; n < 2; ++n) { \
        if constexpr (F8) acc[ai][bj][m][n] = __builtin_amdgcn_mfma_scale_f32_16x16x128_f8f6f4(Bt##8[n], At##8[m], acc[ai][bj][m][n], 0, 0, 0, 0x7F7F7F7F, 0, 0x7F7F7F7F); \
        else { _Pragma("unroll") for (int k = 0; k < 2; ++k) acc[ai][bj][m][n] = __builtin_amdgcn_mfma_f32_16x16x32_bf16(Bt[n][k], At[m][k], acc[ai][bj][m][n], 0, 0, 0); } } \
        __builtin_amdgcn_s_setprio(0); } while (0)
#define PG8_WAIT_V(n) asm volatile("s_waitcnt vmcnt(" #n ")" ::: "memory")
#define PG8_WAIT_L(n) asm volatile("s_waitcnt lgkmcnt(" #n ")" ::: "memory")
#define PG8_BAR __builtin_amdgcn_s_barrier()
#define PG8_SCHED __builtin_amdgcn_sched_barrier(0)
    Unit cur, nxt; int ui = 0;
    if (!S.next(0, cur)) return;
    f32x4 acc[2][2][4][2];
#pragma unroll
    for (int a = 0; a < 2; ++a)
#pragma unroll
        for (int b = 0; b < 2; ++b)
#pragma unroll
            for (int m = 0; m < 4; ++m)
#pragma unroll
                for (int n = 0; n < 2; ++n) acc[a][b][m][n] = (f32x4){0.f, 0.f, 0.f, 0.f};
    bf16x8 At[4][2], B0[2][2], B1[2][2]; i32x8 At8[4], B08[2], B18[2];
    unsigned cA = S.a_soff(cur), cB = S.b_soff(cur);
    if constexpr (GATHER) { S.a_tokens(cur, PG8_R0(), ct); asm volatile("" : "+v"(ct[0]), "+v"(ct[1])); }
    PG8_STAGE(PG8_SB(0, 0), cB, voffB); PG8_STAGE(PG8_SB(0, 1), cB + hstepB, voffB); PG8_STAGE_A(PG8_SA(0, 0), cA, 0, ct); PG8_STAGE_A(PG8_SA(0, 1), cA, 1, ct);
    if (wr == 1) PG8_BAR;
    PG8_WAIT_V(2); PG8_BAR;
    PG8_STAGE(PG8_SB(1, 0), cB + kstepB, voffB); PG8_STAGE_A(PG8_SA(1, 0), cA + kstep, 0, ct); PG8_STAGE(PG8_SB(1, 1), cB + hstepB + kstepB, voffB);
    PG8_WAIT_V(6); PG8_BAR;
    for (;;) {
        const bool has_next = S.next(ui + 1, nxt);
        unsigned nA = cA, nB = cB;
        if constexpr (GATHER) { ntk[0] = ct[0]; ntk[1] = ct[1]; }
        if (has_next) { nA = S.a_soff(nxt); nB = S.b_soff(nxt);
            if constexpr (GATHER) { S.a_tokens(nxt, PG8_R0(), ntk); asm volatile("" : "+v"(ntk[0]), "+v"(ntk[1])); } }
#pragma unroll 1
        for (int t = 0; t < nt; t += 2) {
            const bool last = (t == nt - 2);
            const unsigned a1 = cA + (unsigned)(t + 1) * kstep;
            const unsigned a2 = last ? nA : cA + (unsigned)(t + 2) * kstep, b2 = last ? nB : cB + (unsigned)(t + 2) * kstepB;
            const unsigned a3 = a2 + kstep, b3 = b2 + kstepB;
            unsigned tc[2] = {ct[0], ct[1]}, t2[2];
            if constexpr (GATHER) asm volatile("" : "+v"(tc[0]), "+v"(tc[1]));
            t2[0] = (GATHER && last) ? ntk[0] : tc[0]; t2[1] = (GATHER && last) ? ntk[1] : tc[1];
            PG8_LDB(B0, 0, 0); PG8_LDB(B1, 0, 1); PG8_SCHED; PG8_LDA(At, 0, 0); PG8_STAGE_A(PG8_SA(1, 1), a1, 1, tc);
            PG8_WAIT_V(8); PG8_WAIT_L(0); PG8_BAR; PG8_MMA(0, 0, At, B0); PG8_MMA(0, 1, At, B1); PG8_BAR; PG8_SCHED;
            PG8_LDA(At, 0, 1); PG8_STAGE(PG8_SB(0, 0), b2, voffB); PG8_STAGE(PG8_SB(0, 1), b2 + hstepB, voffB); PG8_STAGE_A(PG8_SA(0, 0), a2, 0, t2);
            PG8_WAIT_V(8); PG8_WAIT_L(0); PG8_BAR; PG8_MMA(1, 0, At, B0); PG8_MMA(1, 1, At, B1); PG8_BAR; PG8_SCHED;
            PG8_LDB(B0, 1, 0); PG8_LDB(B1, 1, 1); PG8_SCHED; PG8_LDA(At, 1, 0); PG8_STAGE_A(PG8_SA(0, 1), a2, 1, t2);
            PG8_WAIT_V(8); PG8_WAIT_L(0); PG8_BAR; PG8_MMA(0, 0, At, B0); PG8_MMA(0, 1, At, B1); PG8_BAR; PG8_SCHED;
            PG8_LDA(At, 1, 1); PG8_STAGE(PG8_SB(1, 0), b3, voffB); PG8_STAGE(PG8_SB(1, 1), b3 + hstepB, voffB); PG8_STAGE_A(PG8_SA(1, 0), a3, 0, t2);
            PG8_WAIT_V(8); PG8_WAIT_L(0); PG8_BAR; PG8_MMA(1, 0, At, B0); PG8_MMA(1, 1, At, B1); PG8_BAR; PG8_SCHED;
        }
        if (wr == 0) PG8_BAR;
        { int _l = lane_id(); asm volatile("" : "+v"(_l)); E(acc, cur, wr, wc, _l & 15, (_l >> 4) & 3); }
        if (!has_next) break;
#pragma unroll
        for (int a = 0; a < 2; ++a)
#pragma unroll
            for (int b = 0; b < 2; ++b)
#pragma unroll
                for (int m = 0; m < 4; ++m)
#pragma unroll
                    for (int n = 0; n < 2; ++n) acc[a][b][m][n] = (f32x4){0.f, 0.f, 0.f, 0.f};
        cur = nxt; cA = nA; cB = nB; ++ui;
        if constexpr (GATHER) { ct[0] = ntk[0]; ct[1] = ntk[1]; }
        if (wr == 1) PG8_BAR;
    }
    PG8_WAIT_V(0);
    PG8_BAR;
#undef PG8_SA
#undef PG8_SB
#undef PG8_STAGE
#undef PG8_STAGE_A
#undef PG8_R0
#undef PG8_LDA
#undef PG8_LDB
#undef PG8_MMA
#undef PG8_WAIT_V
#undef PG8_WAIT_L
#undef PG8_BAR
#undef PG8_SCHED
}
}

#define XB_TMO      128
#define XB_XCNT(j)  (256  + 64 * (j))
#define XB_XSUB(j)  (1280 + 64 * (j))
#define XB_XGEN(j)  (2304 + 64 * (j))
#define XB_TOP      3328
#define XB_TOPGEN   3392
#define XCD_BAR_WORDS 3456
#define XB_SPIN_CAP (1u << 18)
__device__ __forceinline__ unsigned xb_ld(unsigned* p)              { return __hip_atomic_load(p, __ATOMIC_RELAXED, __HIP_MEMORY_SCOPE_AGENT); }
__device__ __forceinline__ unsigned xb_add(unsigned* p, unsigned v) { return __hip_atomic_fetch_add(p, v, __ATOMIC_RELAXED, __HIP_MEMORY_SCOPE_AGENT); }
__device__ __forceinline__ unsigned xb_xcc_id() { return (unsigned)__builtin_amdgcn_s_getreg((3 << 11) | 20) & 0xFu; }
#define XB_SPIN(cond, bar) do { unsigned _sp = 0; while (cond) { __builtin_amdgcn_s_sleep(1); \
    if ((++_sp & 255u) == 0u) { if (xb_ld(&(bar)[XB_TMO])) break; if (_sp > XB_SPIN_CAP) { atomicAdd(&(bar)[XB_TMO], 1u); break; } } } } while (0)
struct XcdBarrier { unsigned* bar; unsigned x; volatile LAS unsigned* st; int wave; };
__device__ __forceinline__ XcdBarrier xcd_barrier_post(unsigned* bar, volatile LAS unsigned* st, int wave) {
    XcdBarrier b; b.bar = bar; b.x = xb_xcc_id(); b.st = st; b.wave = wave;
    if (wave == 0 && lane_id() == 0) (void)xb_add(&bar[XB_XCNT(b.x)], 1u);
    return b;
}
__device__ __forceinline__ void xcd_barrier_complete(unsigned* bar, unsigned x, unsigned& nloc, unsigned& nx) {
    const unsigned G = gridDim.x * gridDim.y * gridDim.z;
    unsigned sum, cnt, mine, sp = 0u;
    for (;;) {
        sum = 0u; cnt = 0u; mine = 0u;
#pragma unroll
        for (unsigned j = 0; j < 16; ++j) { const unsigned c = xb_ld(&bar[XB_XCNT(j)]); sum += c; cnt += (c > 0u) ? 1u : 0u; mine = (j == x) ? c : mine; }
        if (sum == G) break;
        __builtin_amdgcn_s_sleep(1);
        if ((++sp & 255u) == 0u) { if (xb_ld(&bar[XB_TMO])) break; if (sp > XB_SPIN_CAP) { atomicAdd(&bar[XB_TMO], 1u); break; } }
    }
    nloc = mine > 0u ? mine : 1u; nx = cnt > 0u ? cnt : 1u;
}
__device__ __forceinline__ void xcd_barrier(const XcdBarrier& b) {
    asm volatile("s_waitcnt vmcnt(0)" ::: "memory");
    __syncthreads();
    if (b.wave == 0 && lane_id() == 0) {
        unsigned* bar = b.bar;
        __builtin_amdgcn_s_waitcnt(0);
        unsigned nloc = b.st[0], nx = b.st[1];
        if (nloc == 0u) { xcd_barrier_complete(bar, b.x, nloc, nx); b.st[0] = nloc; b.st[1] = nx; }
        const unsigned old = xb_add(&bar[XB_XSUB(b.x)], 1u);
        const unsigned gen = old / nloc;
        if (old + 1u == (gen + 1u) * nloc) {
            __builtin_amdgcn_fence(__ATOMIC_RELEASE, "agent");
            asm volatile("s_waitcnt vmcnt(0)" ::: "memory");
            const unsigned og = xb_add(&bar[XB_TOP], 1u);
            const unsigned tg = og / nx;
            if (og + 1u == (tg + 1u) * nx) xb_add(&bar[XB_TOPGEN], 1u);
            else XB_SPIN(xb_ld(&bar[XB_TOPGEN]) == tg, bar);
            __builtin_amdgcn_fence(__ATOMIC_ACQUIRE, "agent");
            xb_add(&bar[XB_XGEN(b.x)], 1u);
            asm volatile("s_waitcnt vmcnt(0)" ::: "memory");
        } else {
            XB_SPIN(xb_ld(&bar[XB_XGEN(b.x)]) == gen, bar);
            __builtin_amdgcn_fence(__ATOMIC_ACQUIRE, "agent");
            asm volatile("s_waitcnt vmcnt(0)" ::: "memory");
        }
    }
    __syncthreads();
}

struct Frame {
    LAS unsigned char* lds;
    volatile LAS unsigned* MISC;
    gu32* ctl;
    int vcu, G, wave;
    const float *x, *norm_mix_g, *w_in, *conv_a_w, *conv_b_w, *conv_b_bias, *ln_b_g, *ln_b_b, *beta_a, *beta_b, *w_out, *norm_ffn_g, *wrg, *brg, *wre, *bre, *w1, *w3, *w2, *gfin;
    float* out;
    bf16 *Win_t, *Wout_t, *Wr_t, *XB, *P, *Y, *X1B, *CB; fp8 *W13_t, *W2_t, *H, *X1F8;
    float *SSQ, *LW, *LR2; unsigned* LTOK; unsigned* gcnt;
};

struct CvtItem { const float* src; const float* ks; bf16* dst; int N; bool valid; };
__device__ __forceinline__ void cvt_load(const CvtItem& it, f32x4 (&v)[8]) {
    if (it.valid) {
#pragma unroll
        for (int j = 0; j < 8; ++j) v[j] = *(const GAS f32x4*)(it.src + (size_t)j * it.N);
    }
}
__device__ __forceinline__ void cvt_store(const CvtItem& it, f32x4 (&v)[8]) {
    if (it.valid) {
        if (it.ks) {
#pragma unroll
            for (int j = 0; j < 8; ++j) v[j] = v[j] * it.ks[j];
        }
#pragma unroll
        for (int c = 0; c < 4; ++c) { u32x4 g; g.x = cvt_pk_bf16(v[0][c], v[1][c]); g.y = cvt_pk_bf16(v[2][c], v[3][c]); g.z = cvt_pk_bf16(v[4][c], v[5][c]); g.w = cvt_pk_bf16(v[6][c], v[7][c]);
            *(GAS u32x4*)(it.dst + (size_t)c * 8) = g; }
    }
}
__device__ __forceinline__ int win_dest_row(int n0) {
    if (n0 < 512) return 256 * (n0 >> 7) + (n0 & 127);
    if (n0 < 1024) return n0 + 512;
    if (n0 < 1536) { const int j = n0 - 1024; return 256 * (j >> 7) + 128 + (j & 127); }
    if (n0 < 2048) { const int j = n0 - 1536; return 1536 + 256 * (j >> 7) + (j & 127); }
    { const int j = n0 - 2048; return 1536 + 256 * (j >> 7) + 128 + (j & 127); }
}
constexpr int I_IN = 128 * 10, I_OUT = 128 * 4, NITEMS = I_IN + I_OUT;
constexpr int J_13 = NE * 2 * 64 * 2, J_2 = NE * 32 * 4, NITEMS8 = J_13 + J_2;
__device__ __forceinline__ CvtItem p0_decode(Frame& F, int it, int lane) {
    CvtItem c; c.valid = it < NITEMS; c.src = F.w_in; c.ks = nullptr; c.dst = F.Win_t; c.N = DIN;
    if (!c.valid) return c;
    int r = it;
    if (r < I_IN) { const int kb = r / 10, n = 256 * (r % 10) + 4 * lane;
        c.src = F.w_in + (size_t)(8 * kb) * DIN + n; c.N = DIN; c.ks = F.norm_mix_g + 8 * kb; c.dst = F.Win_t + ((size_t)kb * DIN + win_dest_row(n)) * 8; return c; }
    r -= I_IN;
    { const int kb = r / 4, n = 256 * (r % 4) + 4 * lane;
        c.src = F.w_out + (size_t)(8 * kb) * D + n; c.N = D; c.ks = (8 * kb < DA) ? F.beta_a + 8 * kb : F.beta_b + (8 * kb - DA); c.dst = F.Wout_t + ((size_t)kb * D + n) * 8; return c; }
}
struct CvtItem8 { const float* src; const float* ks; fp8* dst; int N; float scale; };
__device__ __forceinline__ CvtItem8 p0_decode8(Frame& F, int it, int lane) {
    CvtItem8 c; int r = it;
    if (r < J_13) { const int e = r / 256, rr = r % 256, which = rr / 128, item = rr % 128, kb = item / 2, n = 256 * (item % 2) + 4 * lane;
        c.src = (which ? F.w3 : F.w1) + (size_t)e * D * DE + (size_t)(16 * kb) * DE + n; c.N = DE; c.ks = F.norm_ffn_g + 16 * kb; c.scale = 32.0f;
        c.dst = F.W13_t + (size_t)e * 1024 * D + ((size_t)kb * 1024 + 256 * (n >> 7) + 128 * which + (n & 127)) * 16; return c; }
    r -= J_13;
    { const int e = r / 128, item = r % 128, kb = item / 4, n = 256 * (item % 4) + 4 * lane;
        c.src = F.w2 + (size_t)e * DE * D + (size_t)(16 * kb) * D + n; c.N = D; c.ks = nullptr; c.scale = 16.0f; c.dst = F.W2_t + (size_t)e * 1024 * DE + ((size_t)kb * 1024 + n) * 16; return c; }
}
__device__ __forceinline__ void p0_prologue(Frame& F) {
    const int wave = F.wave; int lane = lane_id(); asm volatile("" : "+v"(lane)); const int tid = wave * 64 + lane;
    const int gw = F.vcu * NWAVES + wave, NGW = F.G * NWAVES;
    for (int it = gw; it < NITEMS; it += 2 * NGW) {
        const CvtItem c0 = p0_decode(F, it, lane), c1 = p0_decode(F, it + NGW, lane);
        f32x4 v0[8], v1[8];
        cvt_load(c0, v0); cvt_load(c1, v1);
        cvt_store(c0, v0); cvt_store(c1, v1);
    }
    for (int it = gw; it < NITEMS8; it += NGW) {
        const CvtItem8 c = p0_decode8(F, it, lane);
        f32x4 v[16];
#pragma unroll
        for (int j = 0; j < 16; ++j) v[j] = *(const GAS f32x4*)(c.src + (size_t)j * c.N);
#pragma unroll
        for (int j = 0; j < 16; ++j) v[j] = v[j] * (c.ks ? c.ks[j] * c.scale : c.scale);
#pragma unroll
        for (int q = 0; q < 4; ++q) { u32x4 g;
#pragma unroll
            for (int w = 0; w < 4; ++w) g[w] = pk4_fp8(v[4 * w][q], v[4 * w + 1][q], v[4 * w + 2][q], v[4 * w + 3][q]);
            *(GAS u32x4*)(c.dst + (size_t)q * 16) = g; }
    }
    for (int i = gw * 64 + lane; i < 48 * D; i += NGW * 64) { const int o = i / D, k = i % D; float v = 0.f;
        if (o < 4) v = F.wrg[(size_t)k * 4 + o] * F.norm_ffn_g[k]; else if (o < 36) v = F.wre[(size_t)k * NE + (o - 4)] * F.norm_ffn_g[k];
        F.Wr_t[i] = (bf16)f2bf(v); }
    for (int m = gw; m < T; m += NGW) {
        const GAS f32x4* xr = (const GAS f32x4*)(F.x + (size_t)m * D) + lane;
        f32x4 v[4]; float s = 0.f;
#pragma unroll
        for (int j = 0; j < 4; ++j) { v[j] = xr[64 * j]; s += (v[j].x * v[j].x + v[j].y * v[j].y) + (v[j].z * v[j].z + v[j].w * v[j].w); }
        const float r = rsqrtf(wave_sum(s) * (1.f / D) + EPS);
        GAS u32x2* o8 = (GAS u32x2*)(F.XB + (size_t)m * D) + lane;
#pragma unroll
        for (int j = 0; j < 4; ++j) { u32x2 w; w.x = pk2(v[j].x * r, v[j].y * r); w.y = pk2(v[j].z * r, v[j].w * r); o8[64 * j] = w; }
    }
}

__device__ __forceinline__ void p2_mixer(Frame& F) {
    LAS unsigned char* L = F.lds;
    LAS unsigned* Ut = (LAS unsigned*)L;
    LAS float* UC = (LAS float*)(L + 62 * 1024);
    const int wave = F.wave; int lane = lane_id(); asm volatile("" : "+v"(lane)); const int tid = wave * 64 + lane;
    const int cp = tid & 255, th = tid >> 8;
    float wb0[31], wb1[31];
#pragma unroll
    for (int j = 0; j < 31; ++j) { const f32x2 w = *(const f32x2*)(F.conv_b_w + j * DB + 2 * cp); wb0[j] = w.x; wb1[j] = w.y; }
    const f32x2 bias2 = *(const f32x2*)(F.conv_b_bias + 2 * cp);
    float wa[3][8], lng[8], lnb[8];
#pragma unroll
    for (int j = 0; j < 8; ++j) { lng[j] = F.ln_b_g[lane * 8 + j]; lnb[j] = F.ln_b_b[lane * 8 + j];
#pragma unroll
        for (int q = 0; q < 3; ++q) wa[q][j] = F.conv_a_w[q * DA + lane * 8 + j]; }
    for (int tile = F.vcu; tile < T / 32; tile += F.G) {
        const int t0 = tile * 32, b = t0 / SEQ, s0 = t0 % SEQ;
        u32x4 gpm1[4], gp0[4], gpp1[4], gab[4];
#pragma unroll
        for (int q = 0; q < 4; ++q) { const int i = wave * 4 + q, s = s0 + i; const bf16* prow = F.P + (size_t)(t0 + i) * PW + lane * 8; const u32x4 z4 = (u32x4){0u, 0u, 0u, 0u};
            gpm1[q] = (s > 0) ? *(const GAS u32x4*)(prow - PW) : z4; gp0[q] = *(const GAS u32x4*)prow; gpp1[q] = (s < SEQ - 1) ? *(const GAS u32x4*)(prow + PW) : z4; gab[q] = *(const GAS u32x4*)(prow + 512); }
        for (int ch = tid; ch < 62 * 64; ch += 512) { const int row = ch >> 6, c16 = ch & 63, s = s0 - 15 + row; u32x4 v = (u32x4){0u, 0u, 0u, 0u};
            if (s >= 0 && s < SEQ) v = *(const GAS u32x4*)(F.P + (size_t)(b * SEQ + s) * PW + 1024 + c16 * 8);
            *(LAS u32x4*)(L + row * 1024 + c16 * 16) = v; }
        __syncthreads();
#pragma unroll 1
        for (int sub = 0; sub < 2; ++sub) { const int i0 = th * 16 + sub * 8; float a0[8], a1[8];
#pragma unroll
            for (int i = 0; i < 8; ++i) { a0[i] = bias2.x; a1[i] = bias2.y; }
#pragma unroll
            for (int w = 0; w < 38; ++w) { const unsigned v = Ut[(i0 + w) * 256 + cp]; const float lo = bflo(v), hi = bfhi(v);
#pragma unroll
                for (int i = 0; i < 8; ++i) { const int j = w - i; if (j >= 0 && j < 31) { a0[i] += wb0[j] * lo; a1[i] += wb1[j] * hi; } } }
#pragma unroll
            for (int i = 0; i < 8; ++i) *(LAS f32x2*)(UC + (i0 + i) * 512 + 2 * cp) = (f32x2){a0[i], a1[i]};
        }
        __syncthreads();
#pragma unroll
        for (int q = 0; q < 4; ++q) { const int i = wave * 4 + q, t = t0 + i;
            const f32x4 ua = *(const LAS f32x4*)(UC + i * 512 + lane * 8), ub = *(const LAS f32x4*)(UC + i * 512 + lane * 8 + 4);
            float uv[8] = {ua[0], ua[1], ua[2], ua[3], ub[0], ub[1], ub[2], ub[3]};
            float s1 = 0.f;
#pragma unroll
            for (int j = 0; j < 8; ++j) s1 += uv[j];
            const float mu = wave_sum(s1) * (1.f / DB); float s2 = 0.f;
#pragma unroll
            for (int j = 0; j < 8; ++j) { uv[j] -= mu; s2 += uv[j] * uv[j]; }
            const float rstd = rsqrtf(wave_sum(s2) * (1.f / DB) + EPS); float hb = 0.f;
#pragma unroll
            for (int j = 0; j < 8; ++j) { const float z = uv[j] * rstd * lng[j] + lnb[j]; uv[j] = z * fast_sigmoid(z); hb += uv[j] * uv[j]; }
            hb += __shfl_xor(hb, 1); hb += __shfl_xor(hb, 2); hb += __shfl_xor(hb, 4);
            const float rb = rsqrtf(hb * (1.f / 64.f) + EPS);
            u32x4 ob; ob.x = pk2(uv[0] * rb, uv[1] * rb); ob.y = pk2(uv[2] * rb, uv[3] * rb); ob.z = pk2(uv[4] * rb, uv[5] * rb); ob.w = pk2(uv[6] * rb, uv[7] * rb);
            *(GAS u32x4*)(F.Y + (size_t)t * D + DA + lane * 8) = ob;
            const u32x4 pm1 = gpm1[q], p0 = gp0[q], pp1 = gpp1[q], abv = gab[q];
            float ya[8]; float ha = 0.f;
#pragma unroll
            for (int j = 0; j < 4; ++j) {
                const float c0 = wa[0][2 * j] * bflo(pm1[j]) + wa[1][2 * j] * bflo(p0[j]) + wa[2][2 * j] * bflo(pp1[j]);
                const float c1 = wa[0][2 * j + 1] * bfhi(pm1[j]) + wa[1][2 * j + 1] * bfhi(p0[j]) + wa[2][2 * j + 1] * bfhi(pp1[j]);
                ya[2 * j] = bflo(abv[j]) * c0; ya[2 * j + 1] = bfhi(abv[j]) * c1; ha += ya[2 * j] * ya[2 * j] + ya[2 * j + 1] * ya[2 * j + 1]; }
            ha += __shfl_xor(ha, 1); ha += __shfl_xor(ha, 2); ha += __shfl_xor(ha, 4);
            const float ra = rsqrtf(ha * (1.f / 64.f) + EPS);
            u32x4 oa; oa.x = pk2(ya[0] * ra, ya[1] * ra); oa.y = pk2(ya[2] * ra, ya[3] * ra); oa.z = pk2(ya[4] * ra, ya[5] * ra); oa.w = pk2(ya[6] * ra, ya[7] * ra);
            *(GAS u32x4*)(F.Y + (size_t)t * D + lane * 8) = oa;
        }
    }
    __syncthreads();
}

__device__ __forceinline__ void p4_route(Frame& F) {
    const int wave = F.wave; int lane = lane_id(); asm volatile("" : "+v"(lane)); const int tid = wave * 64 + lane;
    LAS float* LGp = (LAS float*)F.lds;
    LAS int* scnt = (LAS int*)(F.lds + 102400);
    bf16x8 bfr[4][3];
    { const bf16* brow = F.Wr_t + (size_t)(lane & 15) * D + 128 * wave + 8 * (lane >> 4);
#pragma unroll
      for (int ks = 0; ks < 4; ++ks)
#pragma unroll
        for (int nb = 0; nb < 3; ++nb) bfr[ks][nb] = *(const GAS bf16x8*)(brow + (size_t)nb * 16 * D + ks * 32); }
    for (int tile = F.vcu; tile < T / 64; tile += F.G) {
        if (tid < 32) scnt[tid] = 0;
        const int tb = tile * 64;
        bf16x8 af[4][4];
#pragma unroll
        for (int tg = 0; tg < 4; ++tg)
#pragma unroll
            for (int ks = 0; ks < 4; ++ks) af[tg][ks] = *(const GAS bf16x8*)(F.X1B + (size_t)(tb + 16 * tg + (lane & 15)) * D + 128 * wave + ks * 32 + 8 * (lane >> 4));
#pragma unroll
        for (int tg = 0; tg < 4; ++tg) { f32x4 acc[3];
#pragma unroll
            for (int nb = 0; nb < 3; ++nb) acc[nb] = (f32x4){0.f, 0.f, 0.f, 0.f};
#pragma unroll
            for (int ks = 0; ks < 4; ++ks)
#pragma unroll
                for (int nb = 0; nb < 3; ++nb) acc[nb] = __builtin_amdgcn_mfma_f32_16x16x32_bf16(af[tg][ks], bfr[ks][nb], acc[nb], 0, 0, 0);
#pragma unroll
            for (int nb = 0; nb < 3; ++nb)
#pragma unroll
                for (int r = 0; r < 4; ++r) LGp[(wave * 64 + 16 * tg + 4 * (lane >> 4) + r) * 49 + nb * 16 + (lane & 15)] = acc[nb][r]; }
        __syncthreads();
        int e0 = 0, e1 = 0, p0 = 0, p1 = 0; float c0 = 0.f, c1 = 0.f, r2 = 0.f;
        if (tid < 64) {
            const int t = tb + tid; float ss = 0.f;
#pragma unroll
            for (int s = 0; s < 16; ++s) ss += F.SSQ[(size_t)s * T + t];
            r2 = rsqrtf(ss * (1.f / D) + EPS);
            const LAS float* lg = LGp + tid * 49;
            float g4[4];
#pragma unroll
            for (int i = 0; i < 4; ++i) { float a = 0.f;
#pragma unroll
                for (int w = 0; w < 8; ++w) a += lg[w * 64 * 49 + i];
                g4[i] = a * r2 + F.brg[i]; }
            int g = 0; float m = g4[0];
#pragma unroll
            for (int i = 1; i < 4; ++i) if (g4[i] > m) { m = g4[i]; g = i; }
            float den = 0.f;
#pragma unroll
            for (int i = 0; i < 4; ++i) den += __expf(g4[i] - m);
            const float psel = 1.0f / den;
            int i0 = 0, i1 = -1; float m0 = -3.0e38f, m1 = -3.0e38f;
            for (int i = 0; i < 8; ++i) { float a = 0.f;
#pragma unroll
                for (int w = 0; w < 8; ++w) a += lg[w * 64 * 49 + 4 + g * 8 + i];
                const float v = a * r2 + F.bre[g * 8 + i];
                if (v > m0) { m1 = m0; i1 = i0; m0 = v; i0 = i; } else if (v > m1) { m1 = v; i1 = i; } }
            const float ex = __expf(m1 - m0);
            e0 = g * 8 + i0; e1 = g * 8 + i1; c0 = psel / (1.0f + ex); c1 = psel * ex / (1.0f + ex);
            p0 = __hip_atomic_fetch_add(scnt + e0, 1, __ATOMIC_RELAXED, __HIP_MEMORY_SCOPE_WORKGROUP); p1 = __hip_atomic_fetch_add(scnt + e1, 1, __ATOMIC_RELAXED, __HIP_MEMORY_SCOPE_WORKGROUP);
        }
        __syncthreads();
        if (tid < 32) scnt[32 + tid] = (int)__hip_atomic_fetch_add(F.gcnt + tid, (unsigned)scnt[tid], RLX_AGENT);
        __syncthreads();
        if (tid < 64) {
            const int t = tb + tid; const size_t d0 = (size_t)e0 * CAP + scnt[32 + e0] + p0, d1 = (size_t)e1 * CAP + scnt[32 + e1] + p1;
            F.LTOK[d0] = (unsigned)t; F.LW[d0] = c0; F.LR2[d0] = r2;
            F.LTOK[d1] = (unsigned)t | (1u << 16); F.LW[d1] = c1; F.LR2[d1] = r2;
        }
        __syncthreads();
    }
}

__device__ __forceinline__ void p7_final(Frame& F) {
    const int wave = F.wave; int lane = lane_id(); asm volatile("" : "+v"(lane)); const int tid = wave * 64 + lane;
    const int gw = F.vcu * NWAVES + wave, NGW = F.G * NWAVES;
    f32x4 g[2][2];
#pragma unroll
    for (int j = 0; j < 2; ++j) { g[j][0] = *(const f32x4*)(F.gfin + j * 512 + lane * 8); g[j][1] = *(const f32x4*)(F.gfin + j * 512 + lane * 8 + 4); }
    for (int t = gw; t < T; t += NGW) {
        float v[2][8]; float ss = 0.f;
#pragma unroll
        for (int j = 0; j < 2; ++j) { const size_t o = (size_t)t * D + j * 512 + lane * 8;
            const u32x4 a = *(const GAS u32x4*)(F.X1B + o), c0 = *(const GAS u32x4*)(F.CB + o), c1 = *(const GAS u32x4*)(F.CB + (size_t)T * D + o);
#pragma unroll
            for (int q = 0; q < 4; ++q) { v[j][2 * q] = bflo(a[q]) + bflo(c0[q]) + bflo(c1[q]); v[j][2 * q + 1] = bfhi(a[q]) + bfhi(c0[q]) + bfhi(c1[q]); ss += v[j][2 * q] * v[j][2 * q] + v[j][2 * q + 1] * v[j][2 * q + 1]; } }
        const float r = rsqrtf(wave_sum(ss) * (1.f / D) + EPS);
#pragma unroll
        for (int j = 0; j < 2; ++j) { float* o = F.out + (size_t)t * D + j * 512 + lane * 8;
            *(GAS f32x4*)o = (f32x4){v[j][0] * r * g[j][0][0], v[j][1] * r * g[j][0][1], v[j][2] * r * g[j][0][2], v[j][3] * r * g[j][0][3]};
            *(GAS f32x4*)(o + 4) = (f32x4){v[j][4] * r * g[j][1][0], v[j][5] * r * g[j][1][1], v[j][6] * r * g[j][1][2], v[j][7] * r * g[j][1][3]}; }
    }
}

__device__ __forceinline__ void moe_sched_init(pg8::SchedMoe& S, Frame& F) {
    int lane = lane_id(); asm volatile("" : "+v"(lane));
    LAS int* tab = (LAS int*)(F.lds + LDSCTL_OFF + 1024);
    int my_cnt = 0; if (lane < NE) my_cnt = (int)__hip_atomic_load(F.gcnt + lane, RLX_AGENT);
    const int tiles = (my_cnt + 255) >> 8; int incl = tiles;
#pragma unroll
    for (int o = 1; o < 32; o <<= 1) { const int v = __shfl_up(incl, o); if (lane >= o) incl += v; }
    if (F.wave == 0 && lane < NE) { tab[lane] = incl - tiles; tab[32 + lane] = my_cnt; }
    S.total_rt = __builtin_amdgcn_readlane(incl, 31); S.tab = tab;
    S.ltok = F.LTOK; S.G = F.G; S.c = (int)blockIdx.x;
    __syncthreads();
}

struct Args { const float* in[20]; float* out; unsigned char* ws; int ph_lo, ph_hi, li, pad; };
__global__ void __launch_bounds__(NWAVES * 64, 2) mk_fwd(Args args) {
    extern __shared__ __attribute__((aligned(16))) unsigned char lds[];
    Frame F;
    F.lds = (LAS unsigned char*)lds;
    F.MISC = (volatile LAS unsigned*)(F.lds + MISC_OFF);
    F.wave = __builtin_amdgcn_readfirstlane((int)threadIdx.x >> 6);
    F.G = gridDim.x; { const int bx = blockIdx.x; F.vcu = (F.G % 8 == 0) ? (bx % 8) * (F.G / 8) + bx / 8 : bx; }
    unsigned char* ws = args.ws;
    F.ctl = (gu32*)(ws + WS_CTL);
    F.x = args.in[0]; F.norm_mix_g = args.in[1]; F.w_in = args.in[2]; F.conv_a_w = args.in[3]; F.conv_b_w = args.in[4]; F.conv_b_bias = args.in[5]; F.ln_b_g = args.in[6]; F.ln_b_b = args.in[7];
    F.beta_a = args.in[8]; F.beta_b = args.in[9]; F.w_out = args.in[10]; F.norm_ffn_g = args.in[11]; F.wrg = args.in[12]; F.brg = args.in[13]; F.wre = args.in[14]; F.bre = args.in[15];
    F.w1 = args.in[16]; F.w3 = args.in[17]; F.w2 = args.in[18]; F.gfin = args.in[19]; F.out = args.out;
    F.Win_t = (bf16*)(ws + WS_WIN); F.Wout_t = (bf16*)(ws + WS_WOUT); F.Wr_t = (bf16*)(ws + WS_WR); F.W13_t = (fp8*)(ws + WS_W13); F.W2_t = (fp8*)(ws + WS_W2); F.X1F8 = (fp8*)(ws + WS_X1F8);
    F.XB = (bf16*)(ws + WS_XB); F.P = (bf16*)(ws + WS_P); F.Y = (bf16*)(ws + WS_Y); F.X1B = (bf16*)(ws + WS_X1B); F.H = (fp8*)(ws + WS_H); F.CB = (bf16*)(ws + WS_CB);
    F.SSQ = (float*)(ws + WS_SSQ); F.LW = (float*)(ws + WS_LW); F.LR2 = (float*)(ws + WS_LR2); F.LTOK = (unsigned*)(ws + WS_LTOK); F.gcnt = (unsigned*)(ws + WS_CTL) + CW_GCNT;
    for (int u = F.wave * 64 + lane_id(); u < (LDS_BYTES - LDSCTL_OFF) / 4; u += NWAVES * 64) ((LAS unsigned*)(F.lds + LDSCTL_OFF))[u] = 0u;
    __syncthreads();
    XcdBarrier bar; bar.bar = (unsigned*)(F.ctl + CW_BAR); bar.x = 0; bar.st = nullptr; bar.wave = F.wave;
    if (N_LAUNCHES == 1) bar = xcd_barrier_post((unsigned*)(F.ctl + CW_BAR), F.MISC + 8, F.wave);
    const int lo = args.ph_lo, hi = args.ph_hi;
#define IN(k) (lo <= (k) && (k) < hi)
#define GRID_BAR(k) do { if (IN(k) && IN((k) + 1)) xcd_barrier(bar); if (PROBE_PHASE >= 0 && blockIdx.x == 0 && F.wave == 0 && lane_id() == 0) ((unsigned long long*)(ws + WS_WR + 512 * 1024))[(k) + 1] = __builtin_amdgcn_s_memrealtime(); } while (0)
    if (PROBE_PHASE >= 0 && blockIdx.x == 0 && F.wave == 0 && lane_id() == 0) ((unsigned long long*)(ws + WS_WR + 512 * 1024))[0] = __builtin_amdgcn_s_memrealtime();

    if (IN(0)) { p0_prologue(F); GRID_BAR(0); }
    if (IN(1)) {
        pg8::SchedDense S{(const char*)F.XB, (const char*)F.Win_t, T / 256, DIN / 256, F.G, (int)blockIdx.x, (size_t)256 * D * 2, DIN};
        pg8::EpiP1 E{F.P};
        pg8::gemm_phase<pg8::EpiP1, pg8::SchedDense, false>(F.lds + RING_OFF, D * 2, S, E, F.wave);
        GRID_BAR(1);
    }
    if (IN(2)) { p2_mixer(F); GRID_BAR(2); }
    if (IN(3)) {
        pg8::SchedDense S{(const char*)F.Y, (const char*)F.Wout_t, T / 256, D / 256, F.G, (int)blockIdx.x, (size_t)256 * D * 2, D};
        pg8::EpiX1 E{F.x, F.X1B, F.SSQ, F.X1F8};
        pg8::gemm_phase<pg8::EpiX1, pg8::SchedDense, false>(F.lds + RING_OFF, D * 2, S, E, F.wave);
        GRID_BAR(3);
    }
    if (IN(4)) { p4_route(F); GRID_BAR(4); }
    if (IN(5)) {
        pg8::SchedMoeA S; moe_sched_init(S, F); S.A = (const char*)F.X1F8; S.W = (const char*)F.W13_t; S.a_tile_bytes = 0; S.w_exp_bytes = (size_t)1024 * D;
        pg8::EpiH E{F.H, F.LR2};
        pg8::gemm_phase<pg8::EpiH, pg8::SchedMoeA, true>(F.lds + RING_OFF, D, S, E, F.wave);
        GRID_BAR(5);
    }
    if (IN(6)) {
        pg8::SchedMoeB S; moe_sched_init(S, F); S.A = (const char*)F.H; S.W = (const char*)F.W2_t; S.a_tile_bytes = (size_t)256 * DE; S.w_exp_bytes = (size_t)1024 * DE;
        pg8::EpiC E{F.CB, F.LTOK, F.LW};
        pg8::gemm_phase<pg8::EpiC, pg8::SchedMoeB, true>(F.lds + RING_OFF, DE, S, E, F.wave);
        GRID_BAR(6);
    }
    if (IN(7)) { p7_final(F);
        if (PROBE_PHASE >= 0 && blockIdx.x == 0 && F.wave == 0 && lane_id() == 0) { unsigned long long* ts = (unsigned long long*)(ws + WS_WR + 512 * 1024); ts[8] = __builtin_amdgcn_s_memrealtime();
            asm volatile("s_waitcnt vmcnt(0)" ::: "memory"); const float us = (PROBE_PHASE == 8) ? (float)(ts[8] - ts[0]) * 0.001f : (float)(ts[PROBE_PHASE + 1] - ts[PROBE_PHASE]) * 0.01f; F.out[0] += us * 0.1f; } }
#undef IN
#undef GRID_BAR
}

extern "C" void kernel_launch(void* const* d_in, const int* in_sizes, int n_in, void* d_out, int out_size, void* d_ws, size_t ws_size, hipStream_t stream) {
    static int grid = 0;
    if (grid == 0) {
        if (n_in != 20 || in_sizes[0] != T * D || out_size != T * D || ws_size < WS_END) { fprintf(stderr, "kernel_launch: unexpected shapes / workspace (n_in %d, in0 %d, out %d, ws %zu, need %zu)\n", n_in, n_in > 0 ? in_sizes[0] : -1, out_size, ws_size, (size_t)WS_END); grid = -1; return; }
        int dev = 0, cus = 0, per_cu = 0;
        if (hipGetDevice(&dev) != hipSuccess || hipDeviceGetAttribute(&cus, hipDeviceAttributeMultiprocessorCount, dev) != hipSuccess) { fprintf(stderr, "kernel_launch: device query failed\n"); grid = -1; return; }
        if (hipFuncSetAttribute((const void*)mk_fwd, hipFuncAttributeMaxDynamicSharedMemorySize, LDS_BYTES) != hipSuccess) { fprintf(stderr, "kernel_launch: hipFuncSetAttribute failed\n"); grid = -1; return; }
        if (hipOccupancyMaxActiveBlocksPerMultiprocessor(&per_cu, (const void*)mk_fwd, NWAVES * 64, LDS_BYTES) != hipSuccess || per_cu < 1) fprintf(stderr, "kernel_launch: occupancy query reports %d workgroups per CU\n", per_cu);
        (void)hipGetLastError();
        grid = cus;
    }
    if (grid < 0) return;
    if (hipMemsetAsync((char*)d_ws + WS_CTL, 0, CTL_ZERO_BYTES, stream) != hipSuccess) { fprintf(stderr, "kernel_launch: hipMemsetAsync failed\n"); return; }
    Args a{};
    for (int i = 0; i < 20; ++i) a.in[i] = (const float*)d_in[i];
    a.out = (float*)d_out; a.ws = (unsigned char*)d_ws;
    for (int li = 0; li < N_LAUNCHES; ++li) {
        a.ph_lo = (N_LAUNCHES == 1) ? 0 : li; a.ph_hi = (N_LAUNCHES == 1) ? NPHASES : li + 1; a.li = li;
        hipLaunchKernelGGL(mk_fwd, dim3(grid), dim3(NWAVES * 64), LDS_BYTES, stream, a);
        const hipError_t le = hipPeekAtLastError();
        if (le != hipSuccess) { fprintf(stderr, "kernel_launch: launch %d failed: %s\n", li, hipGetErrorName(le)); break; }
    }
}
```

```cpp
#include <hip/hip_runtime.h>
#include <cstdio>
#include <cstdint>

#define LAS __attribute__((address_space(3)))
#define GAS __attribute__((address_space(1)))
typedef unsigned short bf16;
typedef short bf16x8 __attribute__((ext_vector_type(8)));
typedef float f32x4 __attribute__((ext_vector_type(4)));
typedef float f32x2 __attribute__((ext_vector_type(2)));
typedef unsigned u32x4 __attribute__((ext_vector_type(4)));
typedef unsigned u32x2 __attribute__((ext_vector_type(2)));
typedef GAS unsigned gu32;
typedef int i32x4 __attribute__((ext_vector_type(4)));
typedef int i32x8 __attribute__((ext_vector_type(8)));
typedef unsigned char fp8;

constexpr int T = 16384, SEQ = 2048, D = 1024, DA = 512, DB = 512, DIN = 2560, NE = 32, DE = 512, CAP = 16384, PW = 1536;
constexpr float EPS = 1e-6f;
constexpr int NWAVES = 8;
#ifndef MK_N_LAUNCHES
#define MK_N_LAUNCHES 1
#endif
constexpr int N_LAUNCHES = MK_N_LAUNCHES;
constexpr int NPHASES = 8;
#ifndef PROBE_PHASE
#define PROBE_PHASE -1
#endif

constexpr size_t MiB = 1u << 20;
constexpr size_t WS_CTL = 0, CTL_ZERO_BYTES = 1 * MiB;
constexpr size_t WS_WIN = 1 * MiB;
constexpr size_t WS_WOUT = 6 * MiB;
constexpr size_t WS_WR = 8 * MiB;
constexpr size_t WS_SSQ = 9 * MiB;
constexpr size_t WS_LTOK = 11 * MiB;
constexpr size_t WS_LW = 13 * MiB;
constexpr size_t WS_LR2 = 15 * MiB;
constexpr size_t WS_W13 = 17 * MiB;
constexpr size_t WS_W2 = 49 * MiB;
constexpr size_t WS_X1B = 65 * MiB;
constexpr size_t WS_X1F8 = 97 * MiB;
constexpr size_t WS_XB = 113 * MiB;
constexpr size_t WS_P = 145 * MiB;
constexpr size_t WS_Y = 193 * MiB;
constexpr size_t WS_H = 113 * MiB;
constexpr size_t WS_CB = 133 * MiB;
constexpr size_t WS_END = 225 * MiB;
constexpr int CW_TMO = 0, CW_CODE = 1, CW_BAR = 4096, CW_GCNT = 16384;

constexpr int RING_OFF = 0, RING_BYTES = 131072;
constexpr int LDSCTL_OFF = RING_BYTES, MISC_OFF = LDSCTL_OFF + 320;
constexpr int LDS_BYTES = 147456;

#define RLX_AGENT __ATOMIC_RELAXED, __HIP_MEMORY_SCOPE_AGENT
#define LDS_WAIT() asm volatile("s_waitcnt lgkmcnt(0)" ::: "memory")
#define VM_WAIT() asm volatile("s_waitcnt vmcnt(0)" ::: "memory")
__device__ __forceinline__ unsigned f2bf(float f) { unsigned u = __builtin_bit_cast(unsigned, f); return (u + 0x7fffu + ((u >> 16) & 1u)) >> 16; }
__device__ __forceinline__ unsigned pk2(float lo, float hi) { return f2bf(lo) | (f2bf(hi) << 16); }
__device__ __forceinline__ unsigned cvt_pk_bf16(float lo, float hi) { unsigned r; asm volatile("v_cvt_pk_bf16_f32 %0, %1, %2" : "=v"(r) : "v"(lo), "v"(hi)); return r; }
__device__ __forceinline__ unsigned pk4_fp8(float a, float b, float c, float d) { int w = 0; w = __builtin_amdgcn_cvt_pk_fp8_f32(a, b, w, false); w = __builtin_amdgcn_cvt_pk_fp8_f32(c, d, w, true); return (unsigned)w; }
__device__ __forceinline__ float bflo(unsigned v) { return __builtin_bit_cast(float, v << 16); }
__device__ __forceinline__ float bfhi(unsigned v) { return __builtin_bit_cast(float, v & 0xffff0000u); }
__device__ __forceinline__ float fast_sigmoid(float v) { return __builtin_amdgcn_rcpf(1.0f + __expf(-v)); }
__device__ __forceinline__ int lane_id() { unsigned m = ~0u; asm volatile("" : "+s"(m)); return (int)__builtin_amdgcn_mbcnt_hi(m, __builtin_amdgcn_mbcnt_lo(m, 0u)); }
__device__ __forceinline__ float wave_sum(float v) {
#pragma unroll
    for (int o = 1; o < 64; o <<= 1) v += __shfl_xor(v, o);
    return v;
}

namespace pg8 {
constexpr int BM = 256, BK = 64, HALF = 128, HTB = HALF * BK * 2, STAGE_BYTES = 8 * HTB, NXCD = 8, WGM = 8;
__host__ __device__ __forceinline__ int lds_byte(int r, int c) { const int st = (r >> 4) * 2 + (c >> 5), rr = r & 15, cc = c & 31, ob = rr * 64 + cc * 2; return st * 1024 + (ob ^ (((ob >> 9) & 1) << 5)); }
__host__ __device__ __forceinline__ void stage_rc(int b, int& R, int& C) { const int st = b / 1024, sb = b % 1024, swz = sb ^ (((sb >> 9) & 1) << 5); R = (st >> 1) * 16 + swz / 64; C = (st & 1) * 32 + (swz % 64) / 2; }
__host__ __device__ __forceinline__ int perm32(int rho) { const int n = rho >> 4, i = rho & 15; return 8 * (i >> 2) + 4 * n + (i & 3); }

struct Unit { int pm, pn, e, rt, cnt; };

__device__ __forceinline__ bool tile_order(int i, int G, int c, int nM, int nN, int& pm, int& pn) {
    const int nwg = nM * nN; const int L = i * G + c; if (L >= nwg) return false;
    int wgid = L; { const int q = nwg / NXCD, r = nwg % NXCD, xcd = wgid % NXCD, off = wgid / NXCD; wgid = (xcd < r ? xcd * (q + 1) : r * (q + 1) + (xcd - r) * q) + off; }
    const int nig = WGM * nN, gid = wgid / nig, fm = gid * WGM, gsz = (nM - fm) < WGM ? (nM - fm) : WGM;
    pm = fm + ((wgid % nig) % gsz); pn = (wgid % nig) / gsz; return true;
}

struct SchedDense {
    static constexpr bool GATHER = false;
    const char* A; const char* Bt; int nM, nN, G, c; size_t tstepA; int nkt;
    __device__ __forceinline__ bool next(int i, Unit& u) const { u.e = 0; u.rt = 0; u.cnt = 0; return tile_order(i, G, c, nM, nN, u.pm, u.pn); }
    __device__ __forceinline__ const char* a_buf() const { return A; }
    __device__ __forceinline__ const char* b_buf() const { return Bt; }
    __device__ __forceinline__ unsigned a_soff(const Unit& u) const { return (unsigned)u.pm * (unsigned)tstepA; }
    __device__ __forceinline__ unsigned b_soff(const Unit& u) const { return (unsigned)(u.pn * nkt) * 32768u; }
    __device__ __forceinline__ void a_tokens(const Unit&, int, unsigned (&)[2]) const {}
};
struct SchedMoe {
    const char* A; const char* W; const unsigned* ltok; const LAS int* tab; int total_rt, G, c; size_t a_tile_bytes, w_exp_bytes; int nkt;
    __device__ __forceinline__ bool next(int i, Unit& u) const {
        if (!tile_order(i, G, c, total_rt, 4, u.pm, u.pn)) return false;
        const int lane = lane_id();
        const unsigned long long m = __ballot(lane < 32 && tab[lane & 31] <= u.pm);
        const int e = __builtin_amdgcn_readfirstlane(__popcll(m) - 1);
        u.e = e; u.rt = u.pm - __builtin_amdgcn_readfirstlane(tab[e]); u.cnt = __builtin_amdgcn_readfirstlane(tab[32 + e]); return true;
    }
    __device__ __forceinline__ const char* a_buf() const { return A; }
    __device__ __forceinline__ const char* b_buf() const { return W; }
    __device__ __forceinline__ unsigned b_soff(const Unit& u) const { return (unsigned)u.e * (unsigned)w_exp_bytes + (unsigned)(u.pn * nkt) * 32768u; }
};
struct SchedMoeA : SchedMoe {
    static constexpr bool GATHER = true;
    __device__ __forceinline__ unsigned a_soff(const Unit&) const { return 0u; }
    __device__ __forceinline__ void a_tokens(const Unit& u, int R, unsigned (&tk)[2]) const {
        asm volatile("" : "+v"(R));
        const __amdgpu_buffer_rsrc_t rl = __builtin_amdgcn_make_buffer_rsrc((void*)ltok, 0, NE * CAP * 4, 0x00020000);
#pragma unroll
        for (int h = 0; h < 2; ++h) { const int p0 = u.rt * 256 + 128 * h + R, p1 = p0 + 64;
            const unsigned r0 = (unsigned)__builtin_amdgcn_raw_buffer_load_b32(rl, p0 < u.cnt ? (u.e * CAP + p0) * 4 : 0x7ffffff0, 0, 0);
            const unsigned r1 = (unsigned)__builtin_amdgcn_raw_buffer_load_b32(rl, p1 < u.cnt ? (u.e * CAP + p1) * 4 : 0x7ffffff0, 0, 0);
            tk[h] = (r0 & 0xffffu) | (r1 << 16); }
    }
};
struct SchedMoeB : SchedMoe {
    static constexpr bool GATHER = false;
    __device__ __forceinline__ unsigned a_soff(const Unit& u) const { return (unsigned)u.pm * (unsigned)a_tile_bytes; }
    __device__ __forceinline__ void a_tokens(const Unit&, int, unsigned (&)[2]) const {}
};

struct EpiP1 {
    bf16* P;
    __device__ __forceinline__ void operator()(const f32x4 (&acc)[2][2][4][2], const Unit& u, int wr, int wc, int fr, int fq) const {
        asm volatile("" : "+v"(fr), "+v"(fq));
        const int row0 = u.pm * BM + wr * 64 + fr, cl = wc * 32 + 8 * fq;
        if (u.pn >= 4 && u.pn < 6) {
#pragma unroll
            for (int ai = 0; ai < 2; ++ai)
#pragma unroll
                for (int m = 0; m < 4; ++m) { bf16* rowp = P + (size_t)(row0 + ai * HALF + m * 16) * PW + 512 + (u.pn - 4) * 256 + cl;
#pragma unroll
                    for (int bj = 0; bj < 2; ++bj) { const f32x4 v0 = acc[ai][bj][m][0], v1 = acc[ai][bj][m][1];
                        u32x4 w; w.x = cvt_pk_bf16(v0[0], v0[1]); w.y = cvt_pk_bf16(v0[2], v0[3]); w.z = cvt_pk_bf16(v1[0], v1[1]); w.w = cvt_pk_bf16(v1[2], v1[3]);
                        *(u32x4*)(rowp + bj * HALF) = w; } }
        } else if (u.pn < 4) {
#pragma unroll
            for (int ai = 0; ai < 2; ++ai)
#pragma unroll
                for (int m = 0; m < 4; ++m) { bf16* rowp = P + (size_t)(row0 + ai * HALF + m * 16) * PW + u.pn * 128 + cl;
                    const f32x4 v0 = acc[ai][0][m][0] * acc[ai][1][m][0], v1 = acc[ai][0][m][1] * acc[ai][1][m][1];
                    u32x4 w; w.x = cvt_pk_bf16(v0[0], v0[1]); w.y = cvt_pk_bf16(v0[2], v0[3]); w.z = cvt_pk_bf16(v1[0], v1[1]); w.w = cvt_pk_bf16(v1[2], v1[3]);
                    *(u32x4*)rowp = w; }
        } else {
#pragma unroll
            for (int ai = 0; ai < 2; ++ai)
#pragma unroll
                for (int m = 0; m < 4; ++m) { bf16* rowp = P + (size_t)(row0 + ai * HALF + m * 16) * PW + 1024 + (u.pn - 6) * 128 + cl;
                    f32x4 v0, v1;
#pragma unroll
                    for (int j = 0; j < 4; ++j) { v0[j] = acc[ai][0][m][0][j] * fast_sigmoid(acc[ai][1][m][0][j]); v1[j] = acc[ai][0][m][1][j] * fast_sigmoid(acc[ai][1][m][1][j]); }
                    u32x4 w; w.x = cvt_pk_bf16(v0[0], v0[1]); w.y = cvt_pk_bf16(v0[2], v0[3]); w.z = cvt_pk_bf16(v1[0], v1[1]); w.w = cvt_pk_bf16(v1[2], v1[3]);
                    *(u32x4*)rowp = w; }
        }
    }
};
struct EpiX1 {
    const float* x; bf16* x1b; float* ssq; fp8* x1f8;
    __device__ __forceinline__ void operator()(const f32x4 (&acc)[2][2][4][2], const Unit& u, int wr, int wc, int fr, int fq) const {
        asm volatile("" : "+v"(fr), "+v"(fq));
        const int row0 = u.pm * BM + wr * 64 + fr, col0 = u.pn * BM + wc * 32 + 8 * fq;
#pragma unroll
        for (int ai = 0; ai < 2; ++ai)
#pragma unroll
            for (int m = 0; m < 4; ++m) { const int row = row0 + ai * HALF + m * 16; const float* xr = x + (size_t)row * D + col0; bf16* orow = x1b + (size_t)row * D + col0; fp8* qrow = x1f8 + (size_t)row * D + col0; float s = 0.f;
#pragma unroll
                for (int bj = 0; bj < 2; ++bj) { const f32x4 a = *(const f32x4*)(xr + bj * HALF), b = *(const f32x4*)(xr + bj * HALF + 4);
                    const f32x4 v0 = acc[ai][bj][m][0] + a, v1 = acc[ai][bj][m][1] + b;
                    s += (v0[0] * v0[0] + v0[1] * v0[1]) + (v0[2] * v0[2] + v0[3] * v0[3]) + (v1[0] * v1[0] + v1[1] * v1[1]) + (v1[2] * v1[2] + v1[3] * v1[3]);
                    u32x4 w; w.x = cvt_pk_bf16(v0[0], v0[1]); w.y = cvt_pk_bf16(v0[2], v0[3]); w.z = cvt_pk_bf16(v1[0], v1[1]); w.w = cvt_pk_bf16(v1[2], v1[3]);
                    *(u32x4*)(orow + bj * HALF) = w;
                    u32x2 q; q.x = pk4_fp8(v0[0], v0[1], v0[2], v0[3]); q.y = pk4_fp8(v1[0], v1[1], v1[2], v1[3]); *(u32x2*)(qrow + bj * HALF) = q; }
                s += __shfl_xor(s, 16); s += __shfl_xor(s, 32);
                if (fq == 0) ssq[(size_t)(u.pn * 4 + wc) * T + row] = s; }
    }
};
struct EpiH {
    fp8* H; const float* lr2;
    __device__ __forceinline__ void operator()(const f32x4 (&acc)[2][2][4][2], const Unit& u, int wr, int wc, int fr, int fq) const {
        asm volatile("" : "+v"(fr), "+v"(fq));
        const int cl = u.pn * 128 + wc * 32 + 8 * fq;
#pragma unroll
        for (int ai = 0; ai < 2; ++ai)
#pragma unroll
            for (int m = 0; m < 4; ++m) { const int rl = ai * HALF + wr * 64 + m * 16 + fr, pos = u.rt * 256 + rl; float rr = 0.f; if (pos < u.cnt) rr = lr2[(size_t)u.e * CAP + pos] * (1.0f / 32.0f);
                f32x4 v0, v1;
#pragma unroll
                for (int j = 0; j < 4; ++j) { const float a0 = acc[ai][0][m][0][j] * rr, b0 = acc[ai][1][m][0][j] * rr, a1 = acc[ai][0][m][1][j] * rr, b1 = acc[ai][1][m][1][j] * rr;
                    v0[j] = a0 * fast_sigmoid(a0) * b0; v1[j] = a1 * fast_sigmoid(a1) * b1; }
                u32x2 w; w.x = pk4_fp8(v0[0], v0[1], v0[2], v0[3]); w.y = pk4_fp8(v1[0], v1[1], v1[2], v1[3]);
                *(u32x2*)(H + ((size_t)u.pm * 256 + rl) * DE + cl) = w; }
    }
};
struct EpiC {
    bf16* Cb; const unsigned* ltok; const float* lw;
    __device__ __forceinline__ void operator()(const f32x4 (&acc)[2][2][4][2], const Unit& u, int wr, int wc, int fr, int fq) const {
        asm volatile("" : "+v"(fr), "+v"(fq));
        const int cl = u.pn * 256 + wc * 32 + 8 * fq;
#pragma unroll
        for (int ai = 0; ai < 2; ++ai)
#pragma unroll
            for (int m = 0; m < 4; ++m) { const int rl = ai * HALF + wr * 64 + m * 16 + fr, pos = u.rt * 256 + rl;
                if (pos < u.cnt) { const unsigned rec = ltok[(size_t)u.e * CAP + pos]; const float cw = lw[(size_t)u.e * CAP + pos] * (1.0f / 16.0f);
                    bf16* orow = Cb + ((size_t)(rec >> 16) * T + (rec & 0xffffu)) * D + cl;
#pragma unroll
                    for (int bj = 0; bj < 2; ++bj) { const f32x4 v0 = acc[ai][bj][m][0] * cw, v1 = acc[ai][bj][m][1] * cw;
                        u32x4 w; w.x = cvt_pk_bf16(v0[0], v0[1]); w.y = cvt_pk_bf16(v0[2], v0[3]); w.z = cvt_pk_bf16(v1[0], v1[1]); w.w = cvt_pk_bf16(v1[2], v1[3]);
                        *(u32x4*)(orow + bj * HALF) = w; } } }
    }
};

template <class Epi, class Sched, bool F8>
__device__ __forceinline__ void gemm_phase(LAS unsigned char* lds, const int Kb, const Sched& S, const Epi& E, const int wid) {
    constexpr bool GATHER = Sched::GATHER;
    const int lane = lane_id(), tid = wid * 64 + lane, wr = wid >> 2, wc = wid & 3, fr = lane & 15, fq = lane >> 4;
    int nt = Kb / 128; asm volatile("" : "+s"(nt));
    const unsigned kstep = 128u, hstep = (unsigned)(HALF * Kb);
    const unsigned kstepB = 32768u, hstepB = 2048u;
    const __amdgpu_buffer_rsrc_t rsA = __builtin_amdgcn_make_buffer_rsrc((void*)S.a_buf(), 0, 0x7fffffff, 0x00020000);
    const __amdgpu_buffer_rsrc_t rsB = __builtin_amdgcn_make_buffer_rsrc((void*)S.b_buf(), 0, 0x7fffffff, 0x00020000);
    unsigned voffA[2], voffB[2], ct[2] = {0u, 0u}, ntk[2] = {0u, 0u}; unsigned pc2;
    { int R, C; stage_rc(tid * 16, R, C); pc2 = (unsigned)C * 2u; }
#define PG8_R0() ({ int _t = wid * 64 + lane_id(); asm volatile("" : "+v"(_t)); int _R, _C; stage_rc(_t * 16, _R, _C); _R; })
#pragma unroll
    for (int i = 0; i < 2; ++i) { int R, C; stage_rc(tid * 16 + i * 8192, R, C);
        voffA[i] = (unsigned)(R * Kb) + (unsigned)C * 2u;
        const int st = wid + 8 * i; voffB[i] = (unsigned)((((st & 1) * 4 + (lane >> 4)) * 256) + (st >> 1) * 16 + (lane & 15)) * 16u; }
    const unsigned ldsw = (unsigned)wid * 1024u;
    const int aoff = lds_byte(wr * 64 + fr, fq * 8), boff = wc * 4096 + (fq * 16 + fr) * 16;
    const LAS unsigned char* ldsA = lds + aoff; const LAS unsigned char* ldsB = lds + 4 * HTB + boff;
    asm volatile("" : "+v"(ldsA), "+v"(ldsB));
#define PG8_SA(b, h) (((b) * 2 + (h)) * HTB)
#define PG8_SB(b, h) ((4 + (b) * 2 + (h)) * HTB)
#define PG8_STAGE(bufoff, soff, voff) do { _Pragma("unroll") for (int _i = 0; _i < 2; ++_i) \
        __builtin_amdgcn_raw_ptr_buffer_load_lds(rsB, (LAS void*)(lds + (bufoff) + ldsw + _i * 8192), 16, (int)(voff)[_i], (int)(soff), 0, 0); } while (0)
#define PG8_STAGE_A(bufoff, soff, h, TK) do { _Pragma("unroll") for (int _i = 0; _i < 2; ++_i) { \
        const unsigned _o = GATHER ? ((((TK)[h] >> (16 * _i)) & 0xffffu) * (unsigned)Kb + pc2) : voffA[_i]; const unsigned _so = GATHER ? (unsigned)(soff) : (unsigned)(soff) + (h) * hstep; \
        __builtin_amdgcn_raw_ptr_buffer_load_lds(rsA, (LAS void*)(lds + (bufoff) + ldsw + _i * 8192), 16, (int)_o, (int)_so, 0, 0); } } while (0)
#define PG8_LDA(dst, b, h) do { _Pragma("unroll") for (int m = 0; m < 4; ++m) { if constexpr (F8) { const i32x4 _lo = *(const LAS i32x4*)(ldsA + PG8_SA(b, h) + m * 2048), _hi = *(const LAS i32x4*)(ldsA + PG8_SA(b, h) + m * 2048 + 1024); \
            dst##8[m] = __builtin_shufflevector(_lo, _hi, 0, 1, 2, 3, 4, 5, 6, 7); } else { _Pragma("unroll") for (int k = 0; k < 2; ++k) dst[m][k] = *(const LAS bf16x8*)(ldsA + PG8_SA(b, h) + m * 2048 + k * 1024); } } } while (0)
#define PG8_LDB(dst, b, h) do { _Pragma("unroll") for (int n = 0; n < 2; ++n) { if constexpr (F8) { const i32x4 _lo = *(const LAS i32x4*)(ldsB + (PG8_SB(b, h) - 4 * HTB) + n * 2048), _hi = *(const LAS i32x4*)(ldsB + (PG8_SB(b, h) - 4 * HTB) + n * 2048 + 1024); \
            dst##8[n] = __builtin_shufflevector(_lo, _hi, 0, 1, 2, 3, 4, 5, 6, 7); } else { _Pragma("unroll") for (int k = 0; k < 2; ++k) dst[n][k] = *(const LAS bf16x8*)(ldsB + (PG8_SB(b, h) - 4 * HTB) + n * 2048 + k * 1024); } } } while (0)
#define PG8_MMA(ai, bj, At, Bt) do { __builtin_amdgcn_s_setprio(1); _Pragma("unroll") for (int m = 0; m < 4; ++m) _Pragma("unroll") for (int n = 0; n < 2; ++n) { \
        if constexpr (F8) acc[ai][bj][m][n] = __builtin_amdgcn_mfma_scale_f32_16x16x128_f8f6f4(Bt##8[n], At##8[m], acc[ai][bj][m][n], 0, 0, 0, 0x7F7F7F7F, 0, 0x7F7F7F7F); \
        else { _Pragma("unroll") for (int k = 0; k < 2; ++k) acc[ai][bj][m][n] = __builtin_amdgcn_mfma_f32_16x16x32_bf16(Bt[n][k], At[m][k], acc[ai][bj][m][n], 0, 0, 0); } } \
        __builtin_amdgcn_s_setprio(0); } while (0)
#define PG8_WAIT_V(n) asm volatile("s_waitcnt vmcnt(" #n ")" ::: "memory")
#define PG8_WAIT_L(n) asm volatile("s_waitcnt lgkmcnt(" #n ")" ::: "memory")
#define PG8_BAR __builtin_amdgcn_s_barrier()
#define PG8_SCHED __builtin_amdgcn_sched_barrier(0)
    Unit cur, nxt; int ui = 0;
    if (!S.next(0, cur)) return;
    f32x4 acc[2][2][4][2];
#pragma unroll
    for (int a = 0; a < 2; ++a)
#pragma unroll
        for (int b = 0; b < 2; ++b)
#pragma unroll
            for (int m = 0; m < 4; ++m)
#pragma unroll
                for (int n = 0; n < 2; ++n) acc[a][b][m][n] = (f32x4){0.f, 0.f, 0.f, 0.f};
    bf16x8 At[4][2], B0[2][2], B1[2][2]; i32x8 At8[4], B08[2], B18[2];
    unsigned cA = S.a_soff(cur), cB = S.b_soff(cur);
    if constexpr (GATHER) { S.a_tokens(cur, PG8_R0(), ct); asm volatile("" : "+v"(ct[0]), "+v"(ct[1])); }
    PG8_STAGE(PG8_SB(0, 0), cB, voffB); PG8_STAGE(PG8_SB(0, 1), cB + hstepB, voffB); PG8_STAGE_A(PG8_SA(0, 0), cA, 0, ct); PG8_STAGE_A(PG8_SA(0, 1), cA, 1, ct);
    if (wr == 1) PG8_BAR;
    PG8_WAIT_V(2); PG8_BAR;
    PG8_STAGE(PG8_SB(1, 0), cB + kstepB, voffB); PG8_STAGE_A(PG8_SA(1, 0), cA + kstep, 0, ct); PG8_STAGE(PG8_SB(1, 1), cB + hstepB + kstepB, voffB);
    PG8_WAIT_V(6); PG8_BAR;
    for (;;) {
        const bool has_next = S.next(ui + 1, nxt);
        unsigned nA = cA, nB = cB;
        if constexpr (GATHER) { ntk[0] = ct[0]; ntk[1] = ct[1]; }
        if (has_next) { nA = S.a_soff(nxt); nB = S.b_soff(nxt);
            if constexpr (GATHER) { S.a_tokens(nxt, PG8_R0(), ntk); asm volatile("" : "+v"(ntk[0]), "+v"(ntk[1])); } }
#pragma unroll 1
        for (int t = 0; t < nt; t += 2) {
            const bool last = (t == nt - 2);
            const unsigned a1 = cA + (unsigned)(t + 1) * kstep;
            const unsigned a2 = last ? nA : cA + (unsigned)(t + 2) * kstep, b2 = last ? nB : cB + (unsigned)(t + 2) * kstepB;
            const unsigned a3 = a2 + kstep, b3 = b2 + kstepB;
            unsigned tc[2] = {ct[0], ct[1]}, t2[2];
            if constexpr (GATHER) asm volatile("" : "+v"(tc[0]), "+v"(tc[1]));
            t2[0] = (GATHER && last) ? ntk[0] : tc[0]; t2[1] = (GATHER && last) ? ntk[1] : tc[1];
            PG8_LDB(B0, 0, 0); PG8_LDB(B1, 0, 1); PG8_SCHED; PG8_LDA(At, 0, 0); PG8_STAGE_A(PG8_SA(1, 1), a1, 1, tc);
            PG8_WAIT_V(8); PG8_WAIT_L(0); PG8_BAR; PG8_MMA(0, 0, At, B0); PG8_MMA(0, 1, At, B1); PG8_BAR; PG8_SCHED;
            PG8_LDA(At, 0, 1); PG8_STAGE(PG8_SB(0, 0), b2, voffB); PG8_STAGE(PG8_SB(0, 1), b2 + hstepB, voffB); PG8_STAGE_A(PG8_SA(0, 0), a2, 0, t2);
            PG8_WAIT_V(8); PG8_WAIT_L(0); PG8_BAR; PG8_MMA(1, 0, At, B0); PG8_MMA(1, 1, At, B1); PG8_BAR; PG8_SCHED;
            PG8_LDB(B0, 1, 0); PG8_LDB(B1, 1, 1); PG8_SCHED; PG8_LDA(At, 1, 0); PG8_STAGE_A(PG8_SA(0, 1), a2, 1, t2);
            PG8_WAIT_V(8); PG8_WAIT_L(0); PG8_BAR; PG8_MMA(0, 0, At, B0); PG8_MMA(0, 1, At, B1); PG8_BAR; PG8_SCHED;
            PG8_LDA(At, 1, 1); PG8_STAGE(PG8_SB(1, 0), b3, voffB); PG8_STAGE(PG8_SB(1, 1), b3 + hstepB, voffB); PG8_STAGE_A(PG8_SA(1, 0), a3, 0, t2);
            PG8_WAIT_V(8); PG8_WAIT_L(0); PG8_BAR; PG8_MMA(1, 0, At, B0); PG8_MMA(1, 1, At, B1); PG8_BAR; PG8_SCHED;
        }
        if (wr == 0) PG8_BAR;
        { int _l = lane_id(); asm volatile("" : "+v"(_l)); E(acc, cur, wr, wc, _l & 15, (_l >> 4) & 3); }
        if (!has_next) break;
#pragma unroll
        for (int a = 0; a < 2; ++a)
#pragma unroll
            for (int b = 0; b < 2; ++b)
#pragma unroll
                for (int m = 0; m < 4; ++m)
#pragma unroll
                    for (int n = 0; n < 2; ++n) acc[a][b][m][n] = (f32x4){0.f, 0.f, 0.f, 0.f};
        cur = nxt; cA = nA; cB = nB; ++ui;
        if constexpr (GATHER) { ct[0] = ntk[0]; ct[1] = ntk[1]; }
        if (wr == 1) PG8_BAR;
    }
    PG8_WAIT_V(0);
    PG8_BAR;
#undef PG8_SA
#undef PG8_SB
#undef PG8_STAGE
#undef PG8_STAGE_A
#undef PG8_R0
#undef PG8_LDA
#undef PG8_LDB
#undef PG8_MMA
#undef PG8_WAIT_V
#undef PG8_WAIT_L
#undef PG8_BAR
#undef PG8_SCHED
}
}

#define XB_TMO      128
#define XB_XCNT(j)  (256  + 64 * (j))
#define XB_XSUB(j)  (1280 + 64 * (j))
#define XB_XGEN(j)  (2304 + 64 * (j))
#define XB_TOP      3328
#define XB_TOPGEN   3392
#define XCD_BAR_WORDS 3456
#define XB_SPIN_CAP (1u << 18)
__device__ __forceinline__ unsigned xb_ld(unsigned* p)              { return __hip_atomic_load(p, __ATOMIC_RELAXED, __HIP_MEMORY_SCOPE_AGENT); }
__device__ __forceinline__ unsigned xb_add(unsigned* p, unsigned v) { return __hip_atomic_fetch_add(p, v, __ATOMIC_RELAXED, __HIP_MEMORY_SCOPE_AGENT); }
__device__ __forceinline__ unsigned xb_xcc_id() { return (unsigned)__builtin_amdgcn_s_getreg((3 << 11) | 20) & 0xFu; }
#define XB_SPIN(cond, bar) do { unsigned _sp = 0; while (cond) { __builtin_amdgcn_s_sleep(1); \
    if ((++_sp & 255u) == 0u) { if (xb_ld(&(bar)[XB_TMO])) break; if (_sp > XB_SPIN_CAP) { atomicAdd(&(bar)[XB_TMO], 1u); break; } } } } while (0)
struct XcdBarrier { unsigned* bar; unsigned x; volatile LAS unsigned* st; int wave; };
__device__ __forceinline__ XcdBarrier xcd_barrier_post(unsigned* bar, volatile LAS unsigned* st, int wave) {
    XcdBarrier b; b.bar = bar; b.x = xb_xcc_id(); b.st = st; b.wave = wave;
    if (wave == 0 && lane_id() == 0) (void)xb_add(&bar[XB_XCNT(b.x)], 1u);
    return b;
}
__device__ __forceinline__ void xcd_barrier_complete(unsigned* bar, unsigned x, unsigned& nloc, unsigned& nx) {
    const unsigned G = gridDim.x * gridDim.y * gridDim.z;
    unsigned sum, cnt, mine, sp = 0u;
    for (;;) {
        sum = 0u; cnt = 0u; mine = 0u;
#pragma unroll
        for (unsigned j = 0; j < 16; ++j) { const unsigned c = xb_ld(&bar[XB_XCNT(j)]); sum += c; cnt += (c > 0u) ? 1u : 0u; mine = (j == x) ? c : mine; }
        if (sum == G) break;
        __builtin_amdgcn_s_sleep(1);
        if ((++sp & 255u) == 0u) { if (xb_ld(&bar[XB_TMO])) break; if (sp > XB_SPIN_CAP) { atomicAdd(&bar[XB_TMO], 1u); break; } }
    }
    nloc = mine > 0u ? mine : 1u; nx = cnt > 0u ? cnt : 1u;
}
__device__ __forceinline__ void xcd_barrier(const XcdBarrier& b) {
    asm volatile("s_waitcnt vmcnt(0)" ::: "memory");
    __syncthreads();
    if (b.wave == 0 && lane_id() == 0) {
        unsigned* bar = b.bar;
        __builtin_amdgcn_s_waitcnt(0);
        unsigned nloc = b.st[0], nx = b.st[1];
        if (nloc == 0u) { xcd_barrier_complete(bar, b.x, nloc, nx); b.st[0] = nloc; b.st[1] = nx; }
        const unsigned old = xb_add(&bar[XB_XSUB(b.x)], 1u);
        const unsigned gen = old / nloc;
        if (old + 1u == (gen + 1u) * nloc) {
            __builtin_amdgcn_fence(__ATOMIC_RELEASE, "agent");
            asm volatile("s_waitcnt vmcnt(0)" ::: "memory");
            const unsigned og = xb_add(&bar[XB_TOP], 1u);
            const unsigned tg = og / nx;
            if (og + 1u == (tg + 1u) * nx) xb_add(&bar[XB_TOPGEN], 1u);
            else XB_SPIN(xb_ld(&bar[XB_TOPGEN]) == tg, bar);
            __builtin_amdgcn_fence(__ATOMIC_ACQUIRE, "agent");
            xb_add(&bar[XB_XGEN(b.x)], 1u);
            asm volatile("s_waitcnt vmcnt(0)" ::: "memory");
        } else {
            XB_SPIN(xb_ld(&bar[XB_XGEN(b.x)]) == gen, bar);
            __builtin_amdgcn_fence(__ATOMIC_ACQUIRE, "agent");
            asm volatile("s_waitcnt vmcnt(0)" ::: "memory");
        }
    }
    __syncthreads();
}

struct Frame {
    LAS unsigned char* lds;
    volatile LAS unsigned* MISC;
    gu32* ctl;
    int vcu, G, wave;
    const float *x, *norm_mix_g, *w_in, *conv_a_w, *conv_b_w, *conv_b_bias, *ln_b_g, *ln_b_b, *beta_a, *beta_b, *w_out, *norm_ffn_g, *wrg, *brg, *wre, *bre, *w1, *w3, *w2, *gfin;
    float* out;
    bf16 *Win_t, *Wout_t, *Wr_t, *XB, *P, *Y, *X1B, *CB; fp8 *W13_t, *W2_t, *H, *X1F8;
    float *SSQ, *LW, *LR2; unsigned* LTOK; unsigned* gcnt;
};

struct CvtItem { const float* src; const float* ks; bf16* dst; int N; bool valid; };
__device__ __forceinline__ void cvt_load(const CvtItem& it, f32x4 (&v)[8]) {
    if (it.valid) {
#pragma unroll
        for (int j = 0; j < 8; ++j) v[j] = *(const GAS f32x4*)(it.src + (size_t)j * it.N);
    }
}
__device__ __forceinline__ void cvt_store(const CvtItem& it, f32x4 (&v)[8]) {
    if (it.valid) {
        if (it.ks) {
#pragma unroll
            for (int j = 0; j < 8; ++j) v[j] = v[j] * it.ks[j];
        }
#pragma unroll
        for (int c = 0; c < 4; ++c) { u32x4 g; g.x = cvt_pk_bf16(v[0][c], v[1][c]); g.y = cvt_pk_bf16(v[2][c], v[3][c]); g.z = cvt_pk_bf16(v[4][c], v[5][c]); g.w = cvt_pk_bf16(v[6][c], v[7][c]);
            *(GAS u32x4*)(it.dst + (size_t)c * 8) = g; }
    }
}
__device__ __forceinline__ int win_dest_row(int n0) {
    if (n0 < 512) return 256 * (n0 >> 7) + (n0 & 127);
    if (n0 < 1024) return n0 + 512;
    if (n0 < 1536) { const int j = n0 - 1024; return 256 * (j >> 7) + 128 + (j & 127); }
    if (n0 < 2048) { const int j = n0 - 1536; return 1536 + 256 * (j >> 7) + (j & 127); }
    { const int j = n0 - 2048; return 1536 + 256 * (j >> 7) + 128 + (j & 127); }
}
__device__ __forceinline__ size_t gran_idx(int kb, int drow, int nkt) { const int w = drow & 31, slot = (drow & 224) + 16 * ((w >> 2) & 1) + 4 * (w >> 3) + (w & 3);
    return ((size_t)(((drow >> 8) * nkt + (kb >> 3)) * 8 + (kb & 7)) * 256 + slot); }
constexpr int I_IN = 128 * 10, I_OUT = 128 * 4, NITEMS = I_IN + I_OUT;
constexpr int J_13 = NE * 2 * 64 * 2, J_2 = NE * 32 * 4, NITEMS8 = J_13 + J_2;
__device__ __forceinline__ CvtItem p0_decode(Frame& F, int it, int lane) {
    CvtItem c; c.valid = it < NITEMS; c.src = F.w_in; c.ks = nullptr; c.dst = F.Win_t; c.N = DIN;
    if (!c.valid) return c;
    int r = it;
    if (r < I_IN) { const int kb = r / 10, n = 256 * (r % 10) + 4 * lane;
        c.src = F.w_in + (size_t)(8 * kb) * DIN + n; c.N = DIN; c.ks = F.norm_mix_g + 8 * kb; c.dst = F.Win_t + gran_idx(kb, win_dest_row(n), 16) * 8; return c; }
    r -= I_IN;
    { const int kb = r / 4, n = 256 * (r % 4) + 4 * lane;
        c.src = F.w_out + (size_t)(8 * kb) * D + n; c.N = D; c.ks = (8 * kb < DA) ? F.beta_a + 8 * kb : F.beta_b + (8 * kb - DA); c.dst = F.Wout_t + gran_idx(kb, n, 16) * 8; return c; }
}
struct CvtItem8 { const float* src; const float* ks; fp8* dst; int N; float scale; };
__device__ __forceinline__ CvtItem8 p0_decode8(Frame& F, int it, int lane) {
    CvtItem8 c; int r = it;
    if (r < J_13) { const int e = r / 256, rr = r % 256, which = rr / 128, item = rr % 128, kb = item / 2, n = 256 * (item % 2) + 4 * lane;
        c.src = (which ? F.w3 : F.w1) + (size_t)e * D * DE + (size_t)(16 * kb) * DE + n; c.N = DE; c.ks = F.norm_ffn_g + 16 * kb; c.scale = 32.0f;
        c.dst = F.W13_t + (size_t)e * 1024 * D + gran_idx(kb, 256 * (n >> 7) + 128 * which + (n & 127), 8) * 16; return c; }
    r -= J_13;
    { const int e = r / 128, item = r % 128, kb = item / 4, n = 256 * (item % 4) + 4 * lane;
        c.src = F.w2 + (size_t)e * DE * D + (size_t)(16 * kb) * D + n; c.N = D; c.ks = nullptr; c.scale = 16.0f; c.dst = F.W2_t + (size_t)e * 1024 * DE + gran_idx(kb, n, 4) * 16; return c; }
}
__device__ __forceinline__ void p0_prologue(Frame& F) {
    const int wave = F.wave; int lane = lane_id(); asm volatile("" : "+v"(lane)); const int tid = wave * 64 + lane;
    const int gw = F.vcu * NWAVES + wave, NGW = F.G * NWAVES;
    for (int it = gw; it < NITEMS; it += 2 * NGW) {
        const CvtItem c0 = p0_decode(F, it, lane), c1 = p0_decode(F, it + NGW, lane);
        f32x4 v0[8], v1[8];
        cvt_load(c0, v0); cvt_load(c1, v1);
        cvt_store(c0, v0); cvt_store(c1, v1);
    }
    for (int it = gw; it < NITEMS8; it += NGW) {
        const CvtItem8 c = p0_decode8(F, it, lane);
        f32x4 v[16];
#pragma unroll
        for (int j = 0; j < 16; ++j) v[j] = *(const GAS f32x4*)(c.src + (size_t)j * c.N);
#pragma unroll
        for (int j = 0; j < 16; ++j) v[j] = v[j] * (c.ks ? c.ks[j] * c.scale : c.scale);
#pragma unroll
        for (int q = 0; q < 4; ++q) { u32x4 g;
#pragma unroll
            for (int w = 0; w < 4; ++w) g[w] = pk4_fp8(v[4 * w][q], v[4 * w + 1][q], v[4 * w + 2][q], v[4 * w + 3][q]);
            *(GAS u32x4*)(c.dst + (size_t)q * 16) = g; }
    }
    for (int i = gw * 64 + lane; i < 48 * D; i += NGW * 64) { const int o = i / D, k = i % D; float v = 0.f;
        if (o < 4) v = F.wrg[(size_t)k * 4 + o] * F.norm_ffn_g[k]; else if (o < 36) v = F.wre[(size_t)k * NE + (o - 4)] * F.norm_ffn_g[k];
        F.Wr_t[i] = (bf16)f2bf(v); }
    for (int m = gw; m < T; m += NGW) {
        const GAS f32x4* xr = (const GAS f32x4*)(F.x + (size_t)m * D) + lane;
        f32x4 v[4]; float s = 0.f;
#pragma unroll
        for (int j = 0; j < 4; ++j) { v[j] = xr[64 * j]; s += (v[j].x * v[j].x + v[j].y * v[j].y) + (v[j].z * v[j].z + v[j].w * v[j].w); }
        const float r = rsqrtf(wave_sum(s) * (1.f / D) + EPS);
        GAS u32x2* o8 = (GAS u32x2*)(F.XB + (size_t)m * D) + lane;
#pragma unroll
        for (int j = 0; j < 4; ++j) { u32x2 w; w.x = pk2(v[j].x * r, v[j].y * r); w.y = pk2(v[j].z * r, v[j].w * r); o8[64 * j] = w; }
    }
}

__device__ __forceinline__ void p2_mixer(Frame& F) {
    LAS unsigned char* L = F.lds;
    LAS unsigned* Ut = (LAS unsigned*)L;
    LAS float* UC = (LAS float*)(L + 62 * 1024);
    const int wave = F.wave; int lane = lane_id(); asm volatile("" : "+v"(lane)); const int tid = wave * 64 + lane;
    const int cp = tid & 255, th = tid >> 8;
    float wb0[31], wb1[31];
#pragma unroll
    for (int j = 0; j < 31; ++j) { const f32x2 w = *(const f32x2*)(F.conv_b_w + j * DB + 2 * cp); wb0[j] = w.x; wb1[j] = w.y; }
    const f32x2 bias2 = *(const f32x2*)(F.conv_b_bias + 2 * cp);
    float wa[3][8], lng[8], lnb[8];
#pragma unroll
    for (int j = 0; j < 8; ++j) { lng[j] = F.ln_b_g[lane * 8 + j]; lnb[j] = F.ln_b_b[lane * 8 + j];
#pragma unroll
        for (int q = 0; q < 3; ++q) wa[q][j] = F.conv_a_w[q * DA + lane * 8 + j]; }
    for (int tile = F.vcu; tile < T / 32; tile += F.G) {
        const int t0 = tile * 32, b = t0 / SEQ, s0 = t0 % SEQ;
        u32x4 gpm1[4], gp0[4], gpp1[4], gab[4];
#pragma unroll
        for (int q = 0; q < 4; ++q) { const int i = wave * 4 + q, s = s0 + i; const bf16* prow = F.P + (size_t)(t0 + i) * PW + lane * 8; const u32x4 z4 = (u32x4){0u, 0u, 0u, 0u};
            gpm1[q] = (s > 0) ? *(const GAS u32x4*)(prow - PW) : z4; gp0[q] = *(const GAS u32x4*)prow; gpp1[q] = (s < SEQ - 1) ? *(const GAS u32x4*)(prow + PW) : z4; gab[q] = *(const GAS u32x4*)(prow + 512); }
        for (int ch = tid; ch < 62 * 64; ch += 512) { const int row = ch >> 6, c16 = ch & 63, s = s0 - 15 + row; u32x4 v = (u32x4){0u, 0u, 0u, 0u};
            if (s >= 0 && s < SEQ) v = *(const GAS u32x4*)(F.P + (size_t)(b * SEQ + s) * PW + 1024 + c16 * 8);
            *(LAS u32x4*)(L + row * 1024 + c16 * 16) = v; }
        __syncthreads();
#pragma unroll 1
        for (int sub = 0; sub < 2; ++sub) { const int i0 = th * 16 + sub * 8; float a0[8], a1[8];
#pragma unroll
            for (int i = 0; i < 8; ++i) { a0[i] = bias2.x; a1[i] = bias2.y; }
#pragma unroll
            for (int w = 0; w < 38; ++w) { const unsigned v = Ut[(i0 + w) * 256 + cp]; const float lo = bflo(v), hi = bfhi(v);
#pragma unroll
                for (int i = 0; i < 8; ++i) { const int j = w - i; if (j >= 0 && j < 31) { a0[i] += wb0[j] * lo; a1[i] += wb1[j] * hi; } } }
#pragma unroll
            for (int i = 0; i < 8; ++i) *(LAS f32x2*)(UC + (i0 + i) * 512 + 2 * cp) = (f32x2){a0[i], a1[i]};
        }
        __syncthreads();
#pragma unroll
        for (int q = 0; q < 4; ++q) { const int i = wave * 4 + q, t = t0 + i;
            const f32x4 ua = *(const LAS f32x4*)(UC + i * 512 + lane * 8), ub = *(const LAS f32x4*)(UC + i * 512 + lane * 8 + 4);
            float uv[8] = {ua[0], ua[1], ua[2], ua[3], ub[0], ub[1], ub[2], ub[3]};
            float s1 = 0.f;
#pragma unroll
            for (int j = 0; j < 8; ++j) s1 += uv[j];
            const float mu = wave_sum(s1) * (1.f / DB); float s2 = 0.f;
#pragma unroll
            for (int j = 0; j < 8; ++j) { uv[j] -= mu; s2 += uv[j] * uv[j]; }
            const float rstd = rsqrtf(wave_sum(s2) * (1.f / DB) + EPS); float hb = 0.f;
#pragma unroll
            for (int j = 0; j < 8; ++j) { const float z = uv[j] * rstd * lng[j] + lnb[j]; uv[j] = z * fast_sigmoid(z); hb += uv[j] * uv[j]; }
            hb += __shfl_xor(hb, 1); hb += __shfl_xor(hb, 2); hb += __shfl_xor(hb, 4);
            const float rb = rsqrtf(hb * (1.f / 64.f) + EPS);
            u32x4 ob; ob.x = pk2(uv[0] * rb, uv[1] * rb); ob.y = pk2(uv[2] * rb, uv[3] * rb); ob.z = pk2(uv[4] * rb, uv[5] * rb); ob.w = pk2(uv[6] * rb, uv[7] * rb);
            *(GAS u32x4*)(F.Y + (size_t)t * D + DA + lane * 8) = ob;
            const u32x4 pm1 = gpm1[q], p0 = gp0[q], pp1 = gpp1[q], abv = gab[q];
            float ya[8]; float ha = 0.f;
#pragma unroll
            for (int j = 0; j < 4; ++j) {
                const float c0 = wa[0][2 * j] * bflo(pm1[j]) + wa[1][2 * j] * bflo(p0[j]) + wa[2][2 * j] * bflo(pp1[j]);
                const float c1 = wa[0][2 * j + 1] * bfhi(pm1[j]) + wa[1][2 * j + 1] * bfhi(p0[j]) + wa[2][2 * j + 1] * bfhi(pp1[j]);
                ya[2 * j] = bflo(abv[j]) * c0; ya[2 * j + 1] = bfhi(abv[j]) * c1; ha += ya[2 * j] * ya[2 * j] + ya[2 * j + 1] * ya[2 * j + 1]; }
            ha += __shfl_xor(ha, 1); ha += __shfl_xor(ha, 2); ha += __shfl_xor(ha, 4);
            const float ra = rsqrtf(ha * (1.f / 64.f) + EPS);
            u32x4 oa; oa.x = pk2(ya[0] * ra, ya[1] * ra); oa.y = pk2(ya[2] * ra, ya[3] * ra); oa.z = pk2(ya[4] * ra, ya[5] * ra); oa.w = pk2(ya[6] * ra, ya[7] * ra);
            *(GAS u32x4*)(F.Y + (size_t)t * D + lane * 8) = oa;
        }
    }
    __syncthreads();
}

__device__ __forceinline__ void p4_route(Frame& F) {
    const int wave = F.wave; int lane = lane_id(); asm volatile("" : "+v"(lane)); const int tid = wave * 64 + lane;
    LAS float* LGp = (LAS float*)F.lds;
    LAS int* scnt = (LAS int*)(F.lds + 102400);
    bf16x8 bfr[4][3];
    { const bf16* brow = F.Wr_t + (size_t)(lane & 15) * D + 128 * wave + 8 * (lane >> 4);
#pragma unroll
      for (int ks = 0; ks < 4; ++ks)
#pragma unroll
        for (int nb = 0; nb < 3; ++nb) bfr[ks][nb] = *(const GAS bf16x8*)(brow + (size_t)nb * 16 * D + ks * 32); }
    for (int tile = F.vcu; tile < T / 64; tile += F.G) {
        if (tid < 32) scnt[tid] = 0;
        const int tb = tile * 64;
        bf16x8 af[4][4];
#pragma unroll
        for (int tg = 0; tg < 4; ++tg)
#pragma unroll
            for (int ks = 0; ks < 4; ++ks) af[tg][ks] = *(const GAS bf16x8*)(F.X1B + (size_t)(tb + 16 * tg + (lane & 15)) * D + 128 * wave + ks * 32 + 8 * (lane >> 4));
#pragma unroll
        for (int tg = 0; tg < 4; ++tg) { f32x4 acc[3];
#pragma unroll
            for (int nb = 0; nb < 3; ++nb) acc[nb] = (f32x4){0.f, 0.f, 0.f, 0.f};
#pragma unroll
            for (int ks = 0; ks < 4; ++ks)
#pragma unroll
                for (int nb = 0; nb < 3; ++nb) acc[nb] = __builtin_amdgcn_mfma_f32_16x16x32_bf16(af[tg][ks], bfr[ks][nb], acc[nb], 0, 0, 0);
#pragma unroll
            for (int nb = 0; nb < 3; ++nb)
#pragma unroll
                for (int r = 0; r < 4; ++r) LGp[(wave * 64 + 16 * tg + 4 * (lane >> 4) + r) * 49 + nb * 16 + (lane & 15)] = acc[nb][r]; }
        __syncthreads();
        int e0 = 0, e1 = 0, p0 = 0, p1 = 0; float c0 = 0.f, c1 = 0.f, r2 = 0.f;
        if (tid < 64) {
            const int t = tb + tid; float ss = 0.f;
#pragma unroll
            for (int s = 0; s < 16; ++s) ss += F.SSQ[(size_t)s * T + t];
            r2 = rsqrtf(ss * (1.f / D) + EPS);
            const LAS float* lg = LGp + tid * 49;
            float g4[4];
#pragma unroll
            for (int i = 0; i < 4; ++i) { float a = 0.f;
#pragma unroll
                for (int w = 0; w < 8; ++w) a += lg[w * 64 * 49 + i];
                g4[i] = a * r2 + F.brg[i]; }
            int g = 0; float m = g4[0];
#pragma unroll
            for (int i = 1; i < 4; ++i) if (g4[i] > m) { m = g4[i]; g = i; }
            float den = 0.f;
#pragma unroll
            for (int i = 0; i < 4; ++i) den += __expf(g4[i] - m);
            const float psel = 1.0f / den;
            int i0 = 0, i1 = -1; float m0 = -3.0e38f, m1 = -3.0e38f;
            for (int i = 0; i < 8; ++i) { float a = 0.f;
#pragma unroll
                for (int w = 0; w < 8; ++w) a += lg[w * 64 * 49 + 4 + g * 8 + i];
                const float v = a * r2 + F.bre[g * 8 + i];
                if (v > m0) { m1 = m0; i1 = i0; m0 = v; i0 = i; } else if (v > m1) { m1 = v; i1 = i; } }
            const float ex = __expf(m1 - m0);
            e0 = g * 8 + i0; e1 = g * 8 + i1; c0 = psel / (1.0f + ex); c1 = psel * ex / (1.0f + ex);
            p0 = __hip_atomic_fetch_add(scnt + e0, 1, __ATOMIC_RELAXED, __HIP_MEMORY_SCOPE_WORKGROUP); p1 = __hip_atomic_fetch_add(scnt + e1, 1, __ATOMIC_RELAXED, __HIP_MEMORY_SCOPE_WORKGROUP);
        }
        __syncthreads();
        if (tid < 32) scnt[32 + tid] = (int)__hip_atomic_fetch_add(F.gcnt + tid, (unsigned)scnt[tid], RLX_AGENT);
        __syncthreads();
        if (tid < 64) {
            const int t = tb + tid; const size_t d0 = (size_t)e0 * CAP + scnt[32 + e0] + p0, d1 = (size_t)e1 * CAP + scnt[32 + e1] + p1;
            F.LTOK[d0] = (unsigned)t; F.LW[d0] = c0; F.LR2[d0] = r2;
            F.LTOK[d1] = (unsigned)t | (1u << 16); F.LW[d1] = c1; F.LR2[d1] = r2;
        }
        __syncthreads();
    }
}

__device__ __forceinline__ void p7_final(Frame& F) {
    const int wave = F.wave; int lane = lane_id(); asm volatile("" : "+v"(lane)); const int tid = wave * 64 + lane;
    const int gw = F.vcu * NWAVES + wave, NGW = F.G * NWAVES;
    f32x4 g[2][2];
#pragma unroll
    for (int j = 0; j < 2; ++j) { g[j][0] = *(const f32x4*)(F.gfin + j * 512 + lane * 8); g[j][1] = *(const f32x4*)(F.gfin + j * 512 + lane * 8 + 4); }
    for (int t = gw; t < T; t += NGW) {
        float v[2][8]; float ss = 0.f;
#pragma unroll
        for (int j = 0; j < 2; ++j) { const size_t o = (size_t)t * D + j * 512 + lane * 8;
            const u32x4 a = *(const GAS u32x4*)(F.X1B + o), c0 = *(const GAS u32x4*)(F.CB + o), c1 = *(const GAS u32x4*)(F.CB + (size_t)T * D + o);
#pragma unroll
            for (int q = 0; q < 4; ++q) { v[j][2 * q] = bflo(a[q]) + bflo(c0[q]) + bflo(c1[q]); v[j][2 * q + 1] = bfhi(a[q]) + bfhi(c0[q]) + bfhi(c1[q]); ss += v[j][2 * q] * v[j][2 * q] + v[j][2 * q + 1] * v[j][2 * q + 1]; } }
        const float r = rsqrtf(wave_sum(ss) * (1.f / D) + EPS);
#pragma unroll
        for (int j = 0; j < 2; ++j) { float* o = F.out + (size_t)t * D + j * 512 + lane * 8;
            *(GAS f32x4*)o = (f32x4){v[j][0] * r * g[j][0][0], v[j][1] * r * g[j][0][1], v[j][2] * r * g[j][0][2], v[j][3] * r * g[j][0][3]};
            *(GAS f32x4*)(o + 4) = (f32x4){v[j][4] * r * g[j][1][0], v[j][5] * r * g[j][1][1], v[j][6] * r * g[j][1][2], v[j][7] * r * g[j][1][3]}; }
    }
}

__device__ __forceinline__ void moe_sched_init(pg8::SchedMoe& S, Frame& F) {
    int lane = lane_id(); asm volatile("" : "+v"(lane));
    LAS int* tab = (LAS int*)(F.lds + LDSCTL_OFF + 1024);
    int my_cnt = 0; if (lane < NE) my_cnt = (int)__hip_atomic_load(F.gcnt + lane, RLX_AGENT);
    const int tiles = (my_cnt + 255) >> 8; int incl = tiles;
#pragma unroll
    for (int o = 1; o < 32; o <<= 1) { const int v = __shfl_up(incl, o); if (lane >= o) incl += v; }
    if (F.wave == 0 && lane < NE) { tab[lane] = incl - tiles; tab[32 + lane] = my_cnt; }
    S.total_rt = __builtin_amdgcn_readlane(incl, 31); S.tab = tab;
    S.ltok = F.LTOK; S.G = F.G; S.c = (int)blockIdx.x;
    __syncthreads();
}

struct Args { const float* in[20]; float* out; unsigned char* ws; int ph_lo, ph_hi, li, pad; };
__global__ void __launch_bounds__(NWAVES * 64, 2) mk_fwd(Args args) {
    extern __shared__ __attribute__((aligned(16))) unsigned char lds[];
    Frame F;
    F.lds = (LAS unsigned char*)lds;
    F.MISC = (volatile LAS unsigned*)(F.lds + MISC_OFF);
    F.wave = __builtin_amdgcn_readfirstlane((int)threadIdx.x >> 6);
    F.G = gridDim.x; { const int bx = blockIdx.x; F.vcu = (F.G % 8 == 0) ? (bx % 8) * (F.G / 8) + bx / 8 : bx; }
    unsigned char* ws = args.ws;
    F.ctl = (gu32*)(ws + WS_CTL);
    F.x = args.in[0]; F.norm_mix_g = args.in[1]; F.w_in = args.in[2]; F.conv_a_w = args.in[3]; F.conv_b_w = args.in[4]; F.conv_b_bias = args.in[5]; F.ln_b_g = args.in[6]; F.ln_b_b = args.in[7];
    F.beta_a = args.in[8]; F.beta_b = args.in[9]; F.w_out = args.in[10]; F.norm_ffn_g = args.in[11]; F.wrg = args.in[12]; F.brg = args.in[13]; F.wre = args.in[14]; F.bre = args.in[15];
    F.w1 = args.in[16]; F.w3 = args.in[17]; F.w2 = args.in[18]; F.gfin = args.in[19]; F.out = args.out;
    F.Win_t = (bf16*)(ws + WS_WIN); F.Wout_t = (bf16*)(ws + WS_WOUT); F.Wr_t = (bf16*)(ws + WS_WR); F.W13_t = (fp8*)(ws + WS_W13); F.W2_t = (fp8*)(ws + WS_W2); F.X1F8 = (fp8*)(ws + WS_X1F8);
    F.XB = (bf16*)(ws + WS_XB); F.P = (bf16*)(ws + WS_P); F.Y = (bf16*)(ws + WS_Y); F.X1B = (bf16*)(ws + WS_X1B); F.H = (fp8*)(ws + WS_H); F.CB = (bf16*)(ws + WS_CB);
    F.SSQ = (float*)(ws + WS_SSQ); F.LW = (float*)(ws + WS_LW); F.LR2 = (float*)(ws + WS_LR2); F.LTOK = (unsigned*)(ws + WS_LTOK); F.gcnt = (unsigned*)(ws + WS_CTL) + CW_GCNT;
    for (int u = F.wave * 64 + lane_id(); u < (LDS_BYTES - LDSCTL_OFF) / 4; u += NWAVES * 64) ((LAS unsigned*)(F.lds + LDSCTL_OFF))[u] = 0u;
    __syncthreads();
    XcdBarrier bar; bar.bar = (unsigned*)(F.ctl + CW_BAR); bar.x = 0; bar.st = nullptr; bar.wave = F.wave;
    if (N_LAUNCHES == 1) bar = xcd_barrier_post((unsigned*)(F.ctl + CW_BAR), F.MISC + 8, F.wave);
    const int lo = args.ph_lo, hi = args.ph_hi;
#define IN(k) (lo <= (k) && (k) < hi)
#define GRID_BAR(k) do { if (IN(k) && IN((k) + 1)) xcd_barrier(bar); if (PROBE_PHASE >= 0 && blockIdx.x == 0 && F.wave == 0 && lane_id() == 0) ((unsigned long long*)(ws + WS_WR + 512 * 1024))[(k) + 1] = __builtin_amdgcn_s_memrealtime(); } while (0)
    if (PROBE_PHASE >= 0 && blockIdx.x == 0 && F.wave == 0 && lane_id() == 0) ((unsigned long long*)(ws + WS_WR + 512 * 1024))[0] = __builtin_amdgcn_s_memrealtime();

    if (IN(0)) { p0_prologue(F); GRID_BAR(0); }
    if (IN(1)) {
        pg8::SchedDense S{(const char*)F.XB, (const char*)F.Win_t, T / 256, DIN / 256, F.G, (int)blockIdx.x, (size_t)256 * D * 2, 16};
        pg8::EpiP1 E{F.P};
        pg8::gemm_phase<pg8::EpiP1, pg8::SchedDense, false>(F.lds + RING_OFF, D * 2, S, E, F.wave);
        GRID_BAR(1);
    }
    if (IN(2)) { p2_mixer(F); GRID_BAR(2); }
    if (IN(3)) {
        pg8::SchedDense S{(const char*)F.Y, (const char*)F.Wout_t, T / 256, D / 256, F.G, (int)blockIdx.x, (size_t)256 * D * 2, 16};
        pg8::EpiX1 E{F.x, F.X1B, F.SSQ, F.X1F8};
        pg8::gemm_phase<pg8::EpiX1, pg8::SchedDense, false>(F.lds + RING_OFF, D * 2, S, E, F.wave);
        GRID_BAR(3);
    }
    if (IN(4)) { p4_route(F); GRID_BAR(4); }
    if (IN(5)) {
        pg8::SchedMoeA S; moe_sched_init(S, F); S.A = (const char*)F.X1F8; S.W = (const char*)F.W13_t; S.a_tile_bytes = 0; S.w_exp_bytes = (size_t)1024 * D; S.nkt = 8;
        pg8::EpiH E{F.H, F.LR2};
        pg8::gemm_phase<pg8::EpiH, pg8::SchedMoeA, true>(F.lds + RING_OFF, D, S, E, F.wave);
        GRID_BAR(5);
    }
    if (IN(6)) {
        pg8::SchedMoeB S; moe_sched_init(S, F); S.A = (const char*)F.H; S.W = (const char*)F.W2_t; S.a_tile_bytes = (size_t)256 * DE; S.w_exp_bytes = (size_t)1024 * DE; S.nkt = 4;
        pg8::EpiC E{F.CB, F.LTOK, F.LW};
        pg8::gemm_phase<pg8::EpiC, pg8::SchedMoeB, true>(F.lds + RING_OFF, DE, S, E, F.wave);
        GRID_BAR(6);
    }
    if (IN(7)) { p7_final(F);
        if (PROBE_PHASE >= 0 && blockIdx.x == 0 && F.wave == 0 && lane_id() == 0) { unsigned long long* ts = (unsigned long long*)(ws + WS_WR + 512 * 1024); ts[8] = __builtin_amdgcn_s_memrealtime();
            asm volatile("s_waitcnt vmcnt(0)" ::: "memory"); const float us = (PROBE_PHASE == 8) ? (float)(ts[8] - ts[0]) * 0.001f : (float)(ts[PROBE_PHASE + 1] - ts[PROBE_PHASE]) * 0.01f; F.out[0] += us * 0.1f; } }
#undef IN
#undef GRID_BAR
}

extern "C" void kernel_launch(void* const* d_in, const int* in_sizes, int n_in, void* d_out, int out_size, void* d_ws, size_t ws_size, hipStream_t stream) {
    static int grid = 0;
    if (grid == 0) {
        if (n_in != 20 || in_sizes[0] != T * D || out_size != T * D || ws_size < WS_END) { fprintf(stderr, "kernel_launch: unexpected shapes / workspace (n_in %d, in0 %d, out %d, ws %zu, need %zu)\n", n_in, n_in > 0 ? in_sizes[0] : -1, out_size, ws_size, (size_t)WS_END); grid = -1; return; }
        int dev = 0, cus = 0, per_cu = 0;
        if (hipGetDevice(&dev) != hipSuccess || hipDeviceGetAttribute(&cus, hipDeviceAttributeMultiprocessorCount, dev) != hipSuccess) { fprintf(stderr, "kernel_launch: device query failed\n"); grid = -1; return; }
        if (hipFuncSetAttribute((const void*)mk_fwd, hipFuncAttributeMaxDynamicSharedMemorySize, LDS_BYTES) != hipSuccess) { fprintf(stderr, "kernel_launch: hipFuncSetAttribute failed\n"); grid = -1; return; }
        if (hipOccupancyMaxActiveBlocksPerMultiprocessor(&per_cu, (const void*)mk_fwd, NWAVES * 64, LDS_BYTES) != hipSuccess || per_cu < 1) fprintf(stderr, "kernel_launch: occupancy query reports %d workgroups per CU\n", per_cu);
        (void)hipGetLastError();
        grid = cus;
    }
    if (grid < 0) return;
    if (hipMemsetAsync((char*)d_ws + WS_CTL, 0, CTL_ZERO_BYTES, stream) != hipSuccess) { fprintf(stderr, "kernel_launch: hipMemsetAsync failed\n"); return; }
    Args a{};
    for (int i = 0; i < 20; ++i) a.in[i] = (const float*)d_in[i];
    a.out = (float*)d_out; a.ws = (unsigned char*)d_ws;
    for (int li = 0; li < N_LAUNCHES; ++li) {
        a.ph_lo = (N_LAUNCHES == 1) ? 0 : li; a.ph_hi = (N_LAUNCHES == 1) ? NPHASES : li + 1; a.li = li;
        hipLaunchKernelGGL(mk_fwd, dim3(grid), dim3(NWAVES * 64), LDS_BYTES, stream, a);
        const hipError_t le = hipPeekAtLastError();
        if (le != hipSuccess) { fprintf(stderr, "kernel_launch: launch %d failed: %s\n", li, hipGetErrorName(le)); break; }
    }
}
```

```cpp
#include <hip/hip_runtime.h>
#include <cstdio>
#include <cstdint>

#define LAS __attribute__((address_space(3)))
#define GAS __attribute__((address_space(1)))
typedef unsigned short bf16;
typedef short bf16x8 __attribute__((ext_vector_type(8)));
typedef float f32x4 __attribute__((ext_vector_type(4)));
typedef float f32x2 __attribute__((ext_vector_type(2)));
typedef unsigned u32x4 __attribute__((ext_vector_type(4)));
typedef unsigned u32x2 __attribute__((ext_vector_type(2)));
typedef GAS unsigned gu32;
typedef int i32x4 __attribute__((ext_vector_type(4)));
typedef int i32x8 __attribute__((ext_vector_type(8)));
typedef unsigned char fp8;

constexpr int T = 16384, SEQ = 2048, D = 1024, DA = 512, DB = 512, DIN = 2560, NE = 32, DE = 512, CAP = 16384, PW = 1536;
constexpr float EPS = 1e-6f;
constexpr int NWAVES = 8;
#ifndef MK_N_LAUNCHES
#define MK_N_LAUNCHES 1
#endif
constexpr int N_LAUNCHES = MK_N_LAUNCHES;
constexpr int NPHASES = 8;
#ifndef PROBE_PHASE
#define PROBE_PHASE -1
#endif

constexpr size_t MiB = 1u << 20;
constexpr size_t WS_CTL = 0, CTL_ZERO_BYTES = 1 * MiB;
constexpr size_t WS_WIN = 1 * MiB;
constexpr size_t WS_WOUT = 6 * MiB;
constexpr size_t WS_WR = 8 * MiB;
constexpr size_t WS_SSQ = 9 * MiB;
constexpr size_t WS_LTOK = 11 * MiB;
constexpr size_t WS_LW = 13 * MiB;
constexpr size_t WS_LR2 = 15 * MiB;
constexpr size_t WS_W13 = 17 * MiB;
constexpr size_t WS_W2 = 49 * MiB;
constexpr size_t WS_X1B = 65 * MiB;
constexpr size_t WS_X1F8 = 97 * MiB;
constexpr size_t WS_XB = 113 * MiB;
constexpr size_t WS_P = 145 * MiB;
constexpr size_t WS_Y = 193 * MiB;
constexpr size_t WS_H = 113 * MiB;
constexpr size_t WS_CB = 133 * MiB;
constexpr size_t WS_END = 225 * MiB;
constexpr int CW_TMO = 0, CW_CODE = 1, CW_BAR = 4096, CW_GCNT = 16384;

constexpr int RING_OFF = 0, RING_BYTES = 131072;
constexpr int LDSCTL_OFF = RING_BYTES, MISC_OFF = LDSCTL_OFF + 320;
constexpr int LDS_BYTES = 147456;

#define RLX_AGENT __ATOMIC_RELAXED, __HIP_MEMORY_SCOPE_AGENT
#define LDS_WAIT() asm volatile("s_waitcnt lgkmcnt(0)" ::: "memory")
#define VM_WAIT() asm volatile("s_waitcnt vmcnt(0)" ::: "memory")
__device__ __forceinline__ unsigned f2bf(float f) { unsigned u = __builtin_bit_cast(unsigned, f); return (u + 0x7fffu + ((u >> 16) & 1u)) >> 16; }
__device__ __forceinline__ unsigned pk2(float lo, float hi) { return f2bf(lo) | (f2bf(hi) << 16); }
__device__ __forceinline__ unsigned cvt_pk_bf16(float lo, float hi) { unsigned r; asm volatile("v_cvt_pk_bf16_f32 %0, %1, %2" : "=v"(r) : "v"(lo), "v"(hi)); return r; }
__device__ __forceinline__ unsigned pk4_fp8(float a, float b, float c, float d) { int w = 0; w = __builtin_amdgcn_cvt_pk_fp8_f32(a, b, w, false); w = __builtin_amdgcn_cvt_pk_fp8_f32(c, d, w, true); return (unsigned)w; }
__device__ __forceinline__ float bflo(unsigned v) { return __builtin_bit_cast(float, v << 16); }
__device__ __forceinline__ float bfhi(unsigned v) { return __builtin_bit_cast(float, v & 0xffff0000u); }
__device__ __forceinline__ float fast_sigmoid(float v) { return __builtin_amdgcn_rcpf(1.0f + __expf(-v)); }
__device__ __forceinline__ int lane_id() { unsigned m = ~0u; asm volatile("" : "+s"(m)); return (int)__builtin_amdgcn_mbcnt_hi(m, __builtin_amdgcn_mbcnt_lo(m, 0u)); }
__device__ __forceinline__ float wave_sum(float v) {
#pragma unroll
    for (int o = 1; o < 64; o <<= 1) v += __shfl_xor(v, o);
    return v;
}

namespace pg8 {
constexpr int BM = 256, BK = 64, HALF = 128, HTB = HALF * BK * 2, STAGE_BYTES = 8 * HTB, NXCD = 8, WGM = 8;
__host__ __device__ __forceinline__ int lds_byte(int r, int c) { const int st = (r >> 4) * 2 + (c >> 5), rr = r & 15, cc = c & 31, ob = rr * 64 + cc * 2; return st * 1024 + (ob ^ (((ob >> 9) & 1) << 5)); }
__host__ __device__ __forceinline__ void stage_rc(int b, int& R, int& C) { const int st = b / 1024, sb = b % 1024, swz = sb ^ (((sb >> 9) & 1) << 5); R = (st >> 1) * 16 + swz / 64; C = (st & 1) * 32 + (swz % 64) / 2; }
__host__ __device__ __forceinline__ int perm32(int rho) { const int n = rho >> 4, i = rho & 15; return 8 * (i >> 2) + 4 * n + (i & 3); }

struct Unit { int pm, pn, e, rt, cnt; };

__device__ __forceinline__ bool tile_order(int i, int G, int c, int nM, int nN, int& pm, int& pn) {
    const int nwg = nM * nN; const int L = i * G + c; if (L >= nwg) return false;
    int wgid = L; { const int q = nwg / NXCD, r = nwg % NXCD, xcd = wgid % NXCD, off = wgid / NXCD; wgid = (xcd < r ? xcd * (q + 1) : r * (q + 1) + (xcd - r) * q) + off; }
    const int nig = WGM * nN, gid = wgid / nig, fm = gid * WGM, gsz = (nM - fm) < WGM ? (nM - fm) : WGM;
    pm = fm + ((wgid % nig) % gsz); pn = (wgid % nig) / gsz; return true;
}

struct SchedDense {
    static constexpr bool GATHER = false;
    const char* A; const char* Bt; int nM, nN, G, c; size_t tstepA; int nkt;
    __device__ __forceinline__ bool next(int i, Unit& u) const { u.e = 0; u.rt = 0; u.cnt = 0; return tile_order(i, G, c, nM, nN, u.pm, u.pn); }
    __device__ __forceinline__ const char* a_buf() const { return A; }
    __device__ __forceinline__ const char* b_buf() const { return Bt; }
    __device__ __forceinline__ unsigned a_soff(const Unit& u) const { return (unsigned)u.pm * (unsigned)tstepA; }
    __device__ __forceinline__ unsigned b_soff(const Unit& u) const { return (unsigned)(u.pn * nkt) * 32768u; }
    __device__ __forceinline__ void a_tokens(const Unit&, int, unsigned (&)[2]) const {}
};
struct SchedMoe {
    const char* A; const char* W; const unsigned* ltok; const LAS int* tab; int total_rt, G, c; size_t a_tile_bytes, w_exp_bytes; int nkt;
    __device__ __forceinline__ bool next(int i, Unit& u) const {
        if (!tile_order(i, G, c, total_rt, 4, u.pm, u.pn)) return false;
        const int lane = lane_id();
        const unsigned long long m = __ballot(lane < 32 && tab[lane & 31] <= u.pm);
        const int e = __builtin_amdgcn_readfirstlane(__popcll(m) - 1);
        u.e = e; u.rt = u.pm - __builtin_amdgcn_readfirstlane(tab[e]); u.cnt = __builtin_amdgcn_readfirstlane(tab[32 + e]); return true;
    }
    __device__ __forceinline__ const char* a_buf() const { return A; }
    __device__ __forceinline__ const char* b_buf() const { return W; }
    __device__ __forceinline__ unsigned b_soff(const Unit& u) const { return (unsigned)u.e * (unsigned)w_exp_bytes + (unsigned)(u.pn * nkt) * 32768u; }
};
struct SchedMoeA : SchedMoe {
    static constexpr bool GATHER = true;
    __device__ __forceinline__ unsigned a_soff(const Unit&) const { return 0u; }
    __device__ __forceinline__ void a_tokens(const Unit& u, int R, unsigned (&tk)[2]) const {
        asm volatile("" : "+v"(R));
        const __amdgpu_buffer_rsrc_t rl = __builtin_amdgcn_make_buffer_rsrc((void*)ltok, 0, NE * CAP * 4, 0x00020000);
#pragma unroll
        for (int h = 0; h < 2; ++h) { const int p0 = u.rt * 256 + 128 * h + R, p1 = p0 + 64;
            const unsigned r0 = (unsigned)__builtin_amdgcn_raw_buffer_load_b32(rl, p0 < u.cnt ? (u.e * CAP + p0) * 4 : 0x7ffffff0, 0, 0);
            const unsigned r1 = (unsigned)__builtin_amdgcn_raw_buffer_load_b32(rl, p1 < u.cnt ? (u.e * CAP + p1) * 4 : 0x7ffffff0, 0, 0);
            tk[h] = (r0 & 0xffffu) | (r1 << 16); }
    }
};
struct SchedMoeB : SchedMoe {
    static constexpr bool GATHER = false;
    __device__ __forceinline__ unsigned a_soff(const Unit& u) const { return (unsigned)u.pm * (unsigned)a_tile_bytes; }
    __device__ __forceinline__ void a_tokens(const Unit&, int, unsigned (&)[2]) const {}
};

struct EpiP1 {
    bf16* P;
    __device__ __forceinline__ void operator()(const f32x4 (&acc)[2][2][4][2], const Unit& u, int wr, int wc, int fr, int fq) const {
        asm volatile("" : "+v"(fr), "+v"(fq));
        const int row0 = u.pm * BM + wr * 64 + fr, cl = wc * 32 + 8 * fq;
        if (u.pn >= 4 && u.pn < 6) {
#pragma unroll
            for (int ai = 0; ai < 2; ++ai)
#pragma unroll
                for (int m = 0; m < 4; ++m) { bf16* rowp = P + (size_t)(row0 + ai * HALF + m * 16) * PW + 512 + (u.pn - 4) * 256 + cl;
#pragma unroll
                    for (int bj = 0; bj < 2; ++bj) { const f32x4 v0 = acc[ai][bj][m][0], v1 = acc[ai][bj][m][1];
                        u32x4 w; w.x = cvt_pk_bf16(v0[0], v0[1]); w.y = cvt_pk_bf16(v0[2], v0[3]); w.z = cvt_pk_bf16(v1[0], v1[1]); w.w = cvt_pk_bf16(v1[2], v1[3]);
                        *(u32x4*)(rowp + bj * HALF) = w; } }
        } else if (u.pn < 4) {
#pragma unroll
            for (int ai = 0; ai < 2; ++ai)
#pragma unroll
                for (int m = 0; m < 4; ++m) { bf16* rowp = P + (size_t)(row0 + ai * HALF + m * 16) * PW + u.pn * 128 + cl;
                    const f32x4 v0 = acc[ai][0][m][0] * acc[ai][1][m][0], v1 = acc[ai][0][m][1] * acc[ai][1][m][1];
                    u32x4 w; w.x = cvt_pk_bf16(v0[0], v0[1]); w.y = cvt_pk_bf16(v0[2], v0[3]); w.z = cvt_pk_bf16(v1[0], v1[1]); w.w = cvt_pk_bf16(v1[2], v1[3]);
                    *(u32x4*)rowp = w; }
        } else {
#pragma unroll
            for (int ai = 0; ai < 2; ++ai)
#pragma unroll
                for (int m = 0; m < 4; ++m) { bf16* rowp = P + (size_t)(row0 + ai * HALF + m * 16) * PW + 1024 + (u.pn - 6) * 128 + cl;
                    f32x4 v0, v1;
#pragma unroll
                    for (int j = 0; j < 4; ++j) { v0[j] = acc[ai][0][m][0][j] * fast_sigmoid(acc[ai][1][m][0][j]); v1[j] = acc[ai][0][m][1][j] * fast_sigmoid(acc[ai][1][m][1][j]); }
                    u32x4 w; w.x = cvt_pk_bf16(v0[0], v0[1]); w.y = cvt_pk_bf16(v0[2], v0[3]); w.z = cvt_pk_bf16(v1[0], v1[1]); w.w = cvt_pk_bf16(v1[2], v1[3]);
                    *(u32x4*)rowp = w; }
        }
    }
};
struct EpiX1 {
    const bf16* xb; const float* ri; bf16* x1b; float* ssq; fp8* x1f8;
    __device__ __forceinline__ void operator()(const f32x4 (&acc)[2][2][4][2], const Unit& u, int wr, int wc, int fr, int fq) const {
        asm volatile("" : "+v"(fr), "+v"(fq));
        const int row0 = u.pm * BM + wr * 64 + fr, col0 = u.pn * BM + wc * 32 + 8 * fq;
#pragma unroll
        for (int ai = 0; ai < 2; ++ai)
#pragma unroll
            for (int m = 0; m < 4; ++m) { const int row = row0 + ai * HALF + m * 16; const bf16* xr = xb + (size_t)row * D + col0; const float rinv = ri[row]; bf16* orow = x1b + (size_t)row * D + col0; fp8* qrow = x1f8 + (size_t)row * D + col0; float s = 0.f;
#pragma unroll
                for (int bj = 0; bj < 2; ++bj) { const u32x4 xq = *(const u32x4*)(xr + bj * HALF);
                    const f32x4 a = (f32x4){bflo(xq[0]), bfhi(xq[0]), bflo(xq[1]), bfhi(xq[1])} * rinv, b = (f32x4){bflo(xq[2]), bfhi(xq[2]), bflo(xq[3]), bfhi(xq[3])} * rinv;
                    const f32x4 v0 = acc[ai][bj][m][0] + a, v1 = acc[ai][bj][m][1] + b;
                    s += (v0[0] * v0[0] + v0[1] * v0[1]) + (v0[2] * v0[2] + v0[3] * v0[3]) + (v1[0] * v1[0] + v1[1] * v1[1]) + (v1[2] * v1[2] + v1[3] * v1[3]);
                    u32x4 w; w.x = cvt_pk_bf16(v0[0], v0[1]); w.y = cvt_pk_bf16(v0[2], v0[3]); w.z = cvt_pk_bf16(v1[0], v1[1]); w.w = cvt_pk_bf16(v1[2], v1[3]);
                    *(u32x4*)(orow + bj * HALF) = w;
                    u32x2 q; q.x = pk4_fp8(v0[0], v0[1], v0[2], v0[3]); q.y = pk4_fp8(v1[0], v1[1], v1[2], v1[3]); *(u32x2*)(qrow + bj * HALF) = q; }
                s += __shfl_xor(s, 16); s += __shfl_xor(s, 32);
                if (fq == 0) ssq[(size_t)(u.pn * 4 + wc) * T + row] = s; }
    }
};
struct EpiH {
    fp8* H; const float* lr2;
    __device__ __forceinline__ void operator()(const f32x4 (&acc)[2][2][4][2], const Unit& u, int wr, int wc, int fr, int fq) const {
        asm volatile("" : "+v"(fr), "+v"(fq));
        const int cl = u.pn * 128 + wc * 32 + 8 * fq;
#pragma unroll
        for (int ai = 0; ai < 2; ++ai)
#pragma unroll
            for (int m = 0; m < 4; ++m) { const int rl = ai * HALF + wr * 64 + m * 16 + fr, pos = u.rt * 256 + rl; float rr = 0.f; if (pos < u.cnt) rr = lr2[(size_t)u.e * CAP + pos] * (1.0f / 32.0f);
                f32x4 v0, v1;
#pragma unroll
                for (int j = 0; j < 4; ++j) { const float a0 = acc[ai][0][m][0][j] * rr, b0 = acc[ai][1][m][0][j] * rr, a1 = acc[ai][0][m][1][j] * rr, b1 = acc[ai][1][m][1][j] * rr;
                    v0[j] = a0 * fast_sigmoid(a0) * b0; v1[j] = a1 * fast_sigmoid(a1) * b1; }
                u32x2 w; w.x = pk4_fp8(v0[0], v0[1], v0[2], v0[3]); w.y = pk4_fp8(v1[0], v1[1], v1[2], v1[3]);
                *(u32x2*)(H + ((size_t)u.pm * 256 + rl) * DE + cl) = w; }
    }
};
struct EpiC {
    fp8* Cb; const unsigned* ltok; const float* lw;
    __device__ __forceinline__ void operator()(const f32x4 (&acc)[2][2][4][2], const Unit& u, int wr, int wc, int fr, int fq) const {
        asm volatile("" : "+v"(fr), "+v"(fq));
        const int cl = u.pn * 256 + wc * 32 + 8 * fq;
#pragma unroll
        for (int ai = 0; ai < 2; ++ai)
#pragma unroll
            for (int m = 0; m < 4; ++m) { const int rl = ai * HALF + wr * 64 + m * 16 + fr, pos = u.rt * 256 + rl;
                if (pos < u.cnt) { const unsigned rec = ltok[(size_t)u.e * CAP + pos]; const float cw = lw[(size_t)u.e * CAP + pos] * 4.0f;
                    fp8* orow = Cb + ((size_t)(rec >> 16) * T + (rec & 0xffffu)) * D + cl;
#pragma unroll
                    for (int bj = 0; bj < 2; ++bj) { const f32x4 v0 = acc[ai][bj][m][0] * cw, v1 = acc[ai][bj][m][1] * cw;
                        u32x2 w; w.x = pk4_fp8(v0[0], v0[1], v0[2], v0[3]); w.y = pk4_fp8(v1[0], v1[1], v1[2], v1[3]);
                        *(u32x2*)(orow + bj * HALF) = w; } } }
    }
};

template <class Epi, class Sched, bool F8>
__device__ __forceinline__ void gemm_phase(LAS unsigned char* lds, const int Kb, const Sched& S, const Epi& E, const int wid) {
    constexpr bool GATHER = Sched::GATHER;
    const int lane = lane_id(), tid = wid * 64 + lane, wr = wid >> 2, wc = wid & 3, fr = lane & 15, fq = lane >> 4;
    int nt = Kb / 128; asm volatile("" : "+s"(nt));
    const unsigned kstep = 128u, hstep = (unsigned)(HALF * Kb);
    const unsigned kstepB = 32768u, hstepB = 2048u;
    const __amdgpu_buffer_rsrc_t rsA = __builtin_amdgcn_make_buffer_rsrc((void*)S.a_buf(), 0, 0x7fffffff, 0x00020000);
    const __amdgpu_buffer_rsrc_t rsB = __builtin_amdgcn_make_buffer_rsrc((void*)S.b_buf(), 0, 0x7fffffff, 0x00020000);
    unsigned voffA[2], voffB[2], ct[2] = {0u, 0u}, ntk[2] = {0u, 0u}; unsigned pc2;
    { int R, C; stage_rc(tid * 16, R, C); pc2 = (unsigned)C * 2u; }
#define PG8_R0() ({ int _t = wid * 64 + lane_id(); asm volatile("" : "+v"(_t)); int _R, _C; stage_rc(_t * 16, _R, _C); _R; })
#pragma unroll
    for (int i = 0; i < 2; ++i) { int R, C; stage_rc(tid * 16 + i * 8192, R, C);
        voffA[i] = (unsigned)(R * Kb) + (unsigned)C * 2u;
        const int st = wid + 8 * i; voffB[i] = (unsigned)((((st & 1) * 4 + (lane >> 4)) * 256) + (st >> 1) * 16 + (lane & 15)) * 16u; }
    const unsigned ldsw = (unsigned)wid * 1024u;
    const int aoff = lds_byte(wr * 64 + fr, fq * 8), boff = wc * 4096 + (fq * 16 + fr) * 16;
    const LAS unsigned char* ldsA = lds + aoff; const LAS unsigned char* ldsB = lds + 4 * HTB + boff;
    asm volatile("" : "+v"(ldsA), "+v"(ldsB));
#define PG8_SA(b, h) (((b) * 2 + (h)) * HTB)
#define PG8_SB(b, h) ((4 + (b) * 2 + (h)) * HTB)
#define PG8_STAGE(bufoff, soff, voff) do { _Pragma("unroll") for (int _i = 0; _i < 2; ++_i) \
        __builtin_amdgcn_raw_ptr_buffer_load_lds(rsB, (LAS void*)(lds + (bufoff) + ldsw + _i * 8192), 16, (int)(voff)[_i], (int)(soff), 0, 0); } while (0)
#define PG8_STAGE_A(bufoff, soff, h, TK) do { _Pragma("unroll") for (int _i = 0; _i < 2; ++_i) { \
        const unsigned _o = GATHER ? ((((TK)[h] >> (16 * _i)) & 0xffffu) * (unsigned)Kb + pc2) : voffA[_i]; const unsigned _so = GATHER ? (unsigned)(soff) : (unsigned)(soff) + (h) * hstep; \
        __builtin_amdgcn_raw_ptr_buffer_load_lds(rsA, (LAS void*)(lds + (bufoff) + ldsw + _i * 8192), 16, (int)_o, (int)_so, 0, 0); } } while (0)
#define PG8_LDA(dst, b, h) do { _Pragma("unroll") for (int m = 0; m < 4; ++m) { if constexpr (F8) { const i32x4 _lo = *(const LAS i32x4*)(ldsA + PG8_SA(b, h) + m * 2048), _hi = *(const LAS i32x4*)(ldsA + PG8_SA(b, h) + m * 2048 + 1024); \
            dst##8[m] = __builtin_shufflevector(_lo, _hi, 0, 1, 2, 3, 4, 5, 6, 7); } else { _Pragma("unroll") for (int k = 0; k < 2; ++k) dst[m][k] = *(const LAS bf16x8*)(ldsA + PG8_SA(b, h) + m * 2048 + k * 1024); } } } while (0)
#define PG8_LDB(dst, b, h) do { _Pragma("unroll") for (int n = 0; n < 2; ++n) { if constexpr (F8) { const i32x4 _lo = *(const LAS i32x4*)(ldsB + (PG8_SB(b, h) - 4 * HTB) + n * 2048), _hi = *(const LAS i32x4*)(ldsB + (PG8_SB(b, h) - 4 * HTB) + n * 2048 + 1024); \
            dst##8[n] = __builtin_shufflevector(_lo, _hi, 0, 1, 2, 3, 4, 5, 6, 7); } else { _Pragma("unroll") for (int k = 0; k < 2; ++k) dst[n][k] = *(const LAS bf16x8*)(ldsB + (PG8_SB(b, h) - 4 * HTB) + n * 2048 + k * 1024); } } } while (0)
#define PG8_MMA(ai, bj, At, Bt) do { __builtin_amdgcn_s_setprio(1); _Pragma("unroll") for (int m = 0; m < 4; ++m) _Pragma("unroll") for (int n = 0; n < 2; ++n) { \
        if constexpr (F8) acc[ai][bj][m][n] = __builtin_amdgcn_mfma_scale_f32_16x16x128_f8f6f4(Bt##8[n], At##8[m], acc[ai][bj][m][n], 0, 0, 0, 0x7F7F7F7F, 0, 0x7F7F7F7F); \
        else { _Pragma("unroll") for (int k = 0; k < 2; ++k) acc[ai][bj][m][n] = __builtin_amdgcn_mfma_f32_16x16x32_bf16(Bt[n][k], At[m][k], acc[ai][bj][m][n], 0, 0, 0); } } \
        __builtin_amdgcn_s_setprio(0); } while (0)
#define PG8_WAIT_V(n) asm volatile("s_waitcnt vmcnt(" #n ")" ::: "memory")
#define PG8_WAIT_L(n) asm volatile("s_waitcnt lgkmcnt(" #n ")" ::: "memory")
#define PG8_BAR __builtin_amdgcn_s_barrier()
#define PG8_SCHED __builtin_amdgcn_sched_barrier(0)
    Unit cur, nxt; int ui = 0;
    if (!S.next(0, cur)) return;
    f32x4 acc[2][2][4][2];
#pragma unroll
    for (int a = 0; a < 2; ++a)
#pragma unroll
        for (int b = 0; b < 2; ++b)
#pragma unroll
            for (int m = 0; m < 4; ++m)
#pragma unroll
                for (int n = 0; n < 2; ++n) acc[a][b][m][n] = (f32x4){0.f, 0.f, 0.f, 0.f};
    bf16x8 At[4][2], B0[2][2], B1[2][2]; i32x8 At8[4], B08[2], B18[2];
    unsigned cA = S.a_soff(cur), cB = S.b_soff(cur);
    if constexpr (GATHER) { S.a_tokens(cur, PG8_R0(), ct); asm volatile("" : "+v"(ct[0]), "+v"(ct[1])); }
    PG8_STAGE(PG8_SB(0, 0), cB, voffB); PG8_STAGE(PG8_SB(0, 1), cB + hstepB, voffB); PG8_STAGE_A(PG8_SA(0, 0), cA, 0, ct); PG8_STAGE_A(PG8_SA(0, 1), cA, 1, ct);
    if (wr == 1) PG8_BAR;
    PG8_WAIT_V(2); PG8_BAR;
    PG8_STAGE(PG8_SB(1, 0), cB + kstepB, voffB); PG8_STAGE_A(PG8_SA(1, 0), cA + kstep, 0, ct); PG8_STAGE(PG8_SB(1, 1), cB + hstepB + kstepB, voffB);
    PG8_WAIT_V(6); PG8_BAR;
    for (;;) {
        const bool has_next = S.next(ui + 1, nxt);
        unsigned nA = cA, nB = cB;
        if constexpr (GATHER) { ntk[0] = ct[0]; ntk[1] = ct[1]; }
        if (has_next) { nA = S.a_soff(nxt); nB = S.b_soff(nxt);
            if constexpr (GATHER) { S.a_tokens(nxt, PG8_R0(), ntk); asm volatile("" : "+v"(ntk[0]), "+v"(ntk[1])); } }
#pragma unroll 1
        for (int t = 0; t < nt; t += 2) {
            const bool last = (t == nt - 2);
            const unsigned a1 = cA + (unsigned)(t + 1) * kstep;
            const unsigned a2 = last ? nA : cA + (unsigned)(t + 2) * kstep, b2 = last ? nB : cB + (unsigned)(t + 2) * kstepB;
            const unsigned a3 = a2 + kstep, b3 = b2 + kstepB;
            unsigned tc[2] = {ct[0], ct[1]}, t2[2];
            if constexpr (GATHER) asm volatile("" : "+v"(tc[0]), "+v"(tc[1]));
            t2[0] = (GATHER && last) ? ntk[0] : tc[0]; t2[1] = (GATHER && last) ? ntk[1] : tc[1];
            PG8_LDB(B0, 0, 0); PG8_LDB(B1, 0, 1); PG8_SCHED; PG8_LDA(At, 0, 0); PG8_STAGE_A(PG8_SA(1, 1), a1, 1, tc);
            PG8_WAIT_V(8); PG8_WAIT_L(0); PG8_BAR; PG8_MMA(0, 0, At, B0); PG8_MMA(0, 1, At, B1); PG8_BAR; PG8_SCHED;
            PG8_LDA(At, 0, 1); PG8_STAGE(PG8_SB(0, 0), b2, voffB); PG8_STAGE(PG8_SB(0, 1), b2 + hstepB, voffB); PG8_STAGE_A(PG8_SA(0, 0), a2, 0, t2);
            PG8_WAIT_V(8); PG8_WAIT_L(0); PG8_BAR; PG8_MMA(1, 0, At, B0); PG8_MMA(1, 1, At, B1); PG8_BAR; PG8_SCHED;
            PG8_LDB(B0, 1, 0); PG8_LDB(B1, 1, 1); PG8_SCHED; PG8_LDA(At, 1, 0); PG8_STAGE_A(PG8_SA(0, 1), a2, 1, t2);
            PG8_WAIT_V(8); PG8_WAIT_L(0); PG8_BAR; PG8_MMA(0, 0, At, B0); PG8_MMA(0, 1, At, B1); PG8_BAR; PG8_SCHED;
            PG8_LDA(At, 1, 1); PG8_STAGE(PG8_SB(1, 0), b3, voffB); PG8_STAGE(PG8_SB(1, 1), b3 + hstepB, voffB); PG8_STAGE_A(PG8_SA(1, 0), a3, 0, t2);
            PG8_WAIT_V(8); PG8_WAIT_L(0); PG8_BAR; PG8_MMA(1, 0, At, B0); PG8_MMA(1, 1, At, B1); PG8_BAR; PG8_SCHED;
        }
        if (wr == 0) PG8_BAR;
        { int _l = lane_id(); asm volatile("" : "+v"(_l)); E(acc, cur, wr, wc, _l & 15, (_l >> 4) & 3); }
        if (!has_next) break;
#pragma unroll
        for (int a = 0; a < 2; ++a)
#pragma unroll
            for (int b = 0; b < 2; ++b)
#pragma unroll
                for (int m = 0; m < 4; ++m)
#pragma unroll
                    for (int n = 0; n < 2; ++n) acc[a][b][m][n] = (f32x4){0.f, 0.f, 0.f, 0.f};
        cur = nxt; cA = nA; cB = nB; ++ui;
        if constexpr (GATHER) { ct[0] = ntk[0]; ct[1] = ntk[1]; }
        if (wr == 1) PG8_BAR;
    }
    PG8_WAIT_V(0);
    PG8_BAR;
#undef PG8_SA
#undef PG8_SB
#undef PG8_STAGE
#undef PG8_STAGE_A
#undef PG8_R0
#undef PG8_LDA
#undef PG8_LDB
#undef PG8_MMA
#undef PG8_WAIT_V
#undef PG8_WAIT_L
#undef PG8_BAR
#undef PG8_SCHED
}
}

#define XB_TMO      128
#define XB_XCNT(j)  (256  + 64 * (j))
#define XB_XSUB(j)  (1280 + 64 * (j))
#define XB_XGEN(j)  (2304 + 64 * (j))
#define XB_TOP      3328
#define XB_TOPGEN   3392
#define XCD_BAR_WORDS 3456
#define XB_SPIN_CAP (1u << 18)
__device__ __forceinline__ unsigned xb_ld(unsigned* p)              { return __hip_atomic_load(p, __ATOMIC_RELAXED, __HIP_MEMORY_SCOPE_AGENT); }
__device__ __forceinline__ unsigned xb_add(unsigned* p, unsigned v) { return __hip_atomic_fetch_add(p, v, __ATOMIC_RELAXED, __HIP_MEMORY_SCOPE_AGENT); }
__device__ __forceinline__ unsigned xb_xcc_id() { return (unsigned)__builtin_amdgcn_s_getreg((3 << 11) | 20) & 0xFu; }
#define XB_SPIN(cond, bar) do { unsigned _sp = 0; while (cond) { __builtin_amdgcn_s_sleep(1); \
    if ((++_sp & 255u) == 0u) { if (xb_ld(&(bar)[XB_TMO])) break; if (_sp > XB_SPIN_CAP) { atomicAdd(&(bar)[XB_TMO], 1u); break; } } } } while (0)
struct XcdBarrier { unsigned* bar; unsigned x; volatile LAS unsigned* st; int wave; };
__device__ __forceinline__ XcdBarrier xcd_barrier_post(unsigned* bar, volatile LAS unsigned* st, int wave) {
    XcdBarrier b; b.bar = bar; b.x = xb_xcc_id(); b.st = st; b.wave = wave;
    if (wave == 0 && lane_id() == 0) (void)xb_add(&bar[XB_XCNT(b.x)], 1u);
    return b;
}
__device__ __forceinline__ void xcd_barrier_complete(unsigned* bar, unsigned x, unsigned& nloc, unsigned& nx) {
    const unsigned G = gridDim.x * gridDim.y * gridDim.z;
    unsigned sum, cnt, mine, sp = 0u;
    for (;;) {
        sum = 0u; cnt = 0u; mine = 0u;
#pragma unroll
        for (unsigned j = 0; j < 16; ++j) { const unsigned c = xb_ld(&bar[XB_XCNT(j)]); sum += c; cnt += (c > 0u) ? 1u : 0u; mine = (j == x) ? c : mine; }
        if (sum == G) break;
        __builtin_amdgcn_s_sleep(1);
        if ((++sp & 255u) == 0u) { if (xb_ld(&bar[XB_TMO])) break; if (sp > XB_SPIN_CAP) { atomicAdd(&bar[XB_TMO], 1u); break; } }
    }
    nloc = mine > 0u ? mine : 1u; nx = cnt > 0u ? cnt : 1u;
}
__device__ __forceinline__ void xcd_barrier(const XcdBarrier& b) {
    asm volatile("s_waitcnt vmcnt(0)" ::: "memory");
    __syncthreads();
    if (b.wave == 0 && lane_id() == 0) {
        unsigned* bar = b.bar;
        __builtin_amdgcn_s_waitcnt(0);
        unsigned nloc = b.st[0], nx = b.st[1];
        if (nloc == 0u) { xcd_barrier_complete(bar, b.x, nloc, nx); b.st[0] = nloc; b.st[1] = nx; }
        const unsigned old = xb_add(&bar[XB_XSUB(b.x)], 1u);
        const unsigned gen = old / nloc;
        if (old + 1u == (gen + 1u) * nloc) {
            __builtin_amdgcn_fence(__ATOMIC_RELEASE, "agent");
            asm volatile("s_waitcnt vmcnt(0)" ::: "memory");
            const unsigned og = xb_add(&bar[XB_TOP], 1u);
            const unsigned tg = og / nx;
            if (og + 1u == (tg + 1u) * nx) xb_add(&bar[XB_TOPGEN], 1u);
            else XB_SPIN(xb_ld(&bar[XB_TOPGEN]) == tg, bar);
            __builtin_amdgcn_fence(__ATOMIC_ACQUIRE, "agent");
            xb_add(&bar[XB_XGEN(b.x)], 1u);
            asm volatile("s_waitcnt vmcnt(0)" ::: "memory");
        } else {
            XB_SPIN(xb_ld(&bar[XB_XGEN(b.x)]) == gen, bar);
            __builtin_amdgcn_fence(__ATOMIC_ACQUIRE, "agent");
            asm volatile("s_waitcnt vmcnt(0)" ::: "memory");
        }
    }
    __syncthreads();
}

struct Frame {
    LAS unsigned char* lds;
    volatile LAS unsigned* MISC;
    gu32* ctl;
    int vcu, G, wave;
    const float *x, *norm_mix_g, *w_in, *conv_a_w, *conv_b_w, *conv_b_bias, *ln_b_g, *ln_b_b, *beta_a, *beta_b, *w_out, *norm_ffn_g, *wrg, *brg, *wre, *bre, *w1, *w3, *w2, *gfin;
    float* out;
    bf16 *Win_t, *Wout_t, *Wr_t, *XB, *P, *Y, *X1B; fp8 *W13_t, *W2_t, *H, *X1F8, *CB; float* RI;
    float *SSQ, *LW, *LR2; unsigned* LTOK; unsigned* gcnt;
};

struct CvtItem { const float* src; const float* ks; bf16* dst; int N; bool valid; };
__device__ __forceinline__ void cvt_load(const CvtItem& it, f32x4 (&v)[8]) {
    if (it.valid) {
#pragma unroll
        for (int j = 0; j < 8; ++j) v[j] = *(const GAS f32x4*)(it.src + (size_t)j * it.N);
    }
}
__device__ __forceinline__ void cvt_store(const CvtItem& it, f32x4 (&v)[8]) {
    if (it.valid) {
        if (it.ks) {
#pragma unroll
            for (int j = 0; j < 8; ++j) v[j] = v[j] * it.ks[j];
        }
#pragma unroll
        for (int c = 0; c < 4; ++c) { u32x4 g; g.x = cvt_pk_bf16(v[0][c], v[1][c]); g.y = cvt_pk_bf16(v[2][c], v[3][c]); g.z = cvt_pk_bf16(v[4][c], v[5][c]); g.w = cvt_pk_bf16(v[6][c], v[7][c]);
            *(GAS u32x4*)(it.dst + (size_t)c * 8) = g; }
    }
}
__device__ __forceinline__ int win_dest_row(int n0) {
    if (n0 < 512) return 256 * (n0 >> 7) + (n0 & 127);
    if (n0 < 1024) return n0 + 512;
    if (n0 < 1536) { const int j = n0 - 1024; return 256 * (j >> 7) + 128 + (j & 127); }
    if (n0 < 2048) { const int j = n0 - 1536; return 1536 + 256 * (j >> 7) + (j & 127); }
    { const int j = n0 - 2048; return 1536 + 256 * (j >> 7) + 128 + (j & 127); }
}
__device__ __forceinline__ size_t gran_idx(int kb, int drow, int nkt) { const int w = drow & 31, slot = (drow & 224) + 16 * ((w >> 2) & 1) + 4 * (w >> 3) + (w & 3);
    return ((size_t)(((drow >> 8) * nkt + (kb >> 3)) * 8 + (kb & 7)) * 256 + slot); }
constexpr int I_IN = 128 * 10, I_OUT = 128 * 4, NITEMS = I_IN + I_OUT;
constexpr int J_13 = NE * 2 * 64 * 2, J_2 = NE * 32 * 4, NITEMS8 = J_13 + J_2;
__device__ __forceinline__ CvtItem p0_decode(Frame& F, int it, int lane) {
    CvtItem c; c.valid = it < NITEMS; c.src = F.w_in; c.ks = nullptr; c.dst = F.Win_t; c.N = DIN;
    if (!c.valid) return c;
    int r = it;
    if (r < I_IN) { const int kb = r / 10, n = 256 * (r % 10) + 4 * lane;
        c.src = F.w_in + (size_t)(8 * kb) * DIN + n; c.N = DIN; c.ks = F.norm_mix_g + 8 * kb; c.dst = F.Win_t + gran_idx(kb, win_dest_row(n), 16) * 8; return c; }
    r -= I_IN;
    { const int kb = r / 4, n = 256 * (r % 4) + 4 * lane;
        c.src = F.w_out + (size_t)(8 * kb) * D + n; c.N = D; c.ks = (8 * kb < DA) ? F.beta_a + 8 * kb : F.beta_b + (8 * kb - DA); c.dst = F.Wout_t + gran_idx(kb, n, 16) * 8; return c; }
}
struct CvtItem8 { const float* src; const float* ks; fp8* dst; int N; float scale; };
__device__ __forceinline__ CvtItem8 p0_decode8(Frame& F, int it, int lane) {
    CvtItem8 c; int r = it;
    if (r < J_13) { const int e = r / 256, rr = r % 256, which = rr / 128, item = rr % 128, kb = item / 2, n = 256 * (item % 2) + 4 * lane;
        c.src = (which ? F.w3 : F.w1) + (size_t)e * D * DE + (size_t)(16 * kb) * DE + n; c.N = DE; c.ks = F.norm_ffn_g + 16 * kb; c.scale = 32.0f;
        c.dst = F.W13_t + (size_t)e * 1024 * D + gran_idx(kb, 256 * (n >> 7) + 128 * which + (n & 127), 8) * 16; return c; }
    r -= J_13;
    { const int e = r / 128, item = r % 128, kb = item / 4, n = 256 * (item % 4) + 4 * lane;
        c.src = F.w2 + (size_t)e * DE * D + (size_t)(16 * kb) * D + n; c.N = D; c.ks = nullptr; c.scale = 16.0f; c.dst = F.W2_t + (size_t)e * 1024 * DE + gran_idx(kb, n, 4) * 16; return c; }
}
__device__ __forceinline__ void p0_prologue(Frame& F) {
    const int wave = F.wave; int lane = lane_id(); asm volatile("" : "+v"(lane)); const int tid = wave * 64 + lane;
    const int gw = F.vcu * NWAVES + wave, NGW = F.G * NWAVES;
    for (int it = gw; it < NITEMS; it += 2 * NGW) {
        const CvtItem c0 = p0_decode(F, it, lane), c1 = p0_decode(F, it + NGW, lane);
        f32x4 v0[8], v1[8];
        cvt_load(c0, v0); cvt_load(c1, v1);
        cvt_store(c0, v0); cvt_store(c1, v1);
    }
    for (int it = gw; it < NITEMS8; it += NGW) {
        const CvtItem8 c = p0_decode8(F, it, lane);
        f32x4 v[16];
#pragma unroll
        for (int j = 0; j < 16; ++j) v[j] = *(const GAS f32x4*)(c.src + (size_t)j * c.N);
#pragma unroll
        for (int j = 0; j < 16; ++j) v[j] = v[j] * (c.ks ? c.ks[j] * c.scale : c.scale);
#pragma unroll
        for (int q = 0; q < 4; ++q) { u32x4 g;
#pragma unroll
            for (int w = 0; w < 4; ++w) g[w] = pk4_fp8(v[4 * w][q], v[4 * w + 1][q], v[4 * w + 2][q], v[4 * w + 3][q]);
            *(GAS u32x4*)(c.dst + (size_t)q * 16) = g; }
    }
    for (int i = gw * 64 + lane; i < 48 * D; i += NGW * 64) { const int o = i / D, k = i % D; float v = 0.f;
        if (o < 4) v = F.wrg[(size_t)k * 4 + o] * F.norm_ffn_g[k]; else if (o < 36) v = F.wre[(size_t)k * NE + (o - 4)] * F.norm_ffn_g[k];
        F.Wr_t[i] = (bf16)f2bf(v); }
    for (int m = gw; m < T; m += NGW) {
        const GAS f32x4* xr = (const GAS f32x4*)(F.x + (size_t)m * D) + lane;
        f32x4 v[4]; float s = 0.f;
#pragma unroll
        for (int j = 0; j < 4; ++j) { v[j] = xr[64 * j]; s += (v[j].x * v[j].x + v[j].y * v[j].y) + (v[j].z * v[j].z + v[j].w * v[j].w); }
        const float r = rsqrtf(wave_sum(s) * (1.f / D) + EPS);
        if (lane == 0) F.RI[m] = 1.0f / r;
        GAS u32x2* o8 = (GAS u32x2*)(F.XB + (size_t)m * D) + lane;
#pragma unroll
        for (int j = 0; j < 4; ++j) { u32x2 w; w.x = pk2(v[j].x * r, v[j].y * r); w.y = pk2(v[j].z * r, v[j].w * r); o8[64 * j] = w; }
    }
}

__device__ __forceinline__ void p2_mixer(Frame& F) {
    LAS unsigned char* L = F.lds;
    LAS unsigned* Ut = (LAS unsigned*)L;
    LAS float* UC = (LAS float*)(L + 62 * 1024);
    const int wave = F.wave; int lane = lane_id(); asm volatile("" : "+v"(lane)); const int tid = wave * 64 + lane;
    const int cp = tid & 255, th = tid >> 8;
    float wb0[31], wb1[31];
#pragma unroll
    for (int j = 0; j < 31; ++j) { const f32x2 w = *(const f32x2*)(F.conv_b_w + j * DB + 2 * cp); wb0[j] = w.x; wb1[j] = w.y; }
    const f32x2 bias2 = *(const f32x2*)(F.conv_b_bias + 2 * cp);
    float wa[3][8], lng[8], lnb[8];
#pragma unroll
    for (int j = 0; j < 8; ++j) { lng[j] = F.ln_b_g[lane * 8 + j]; lnb[j] = F.ln_b_b[lane * 8 + j];
#pragma unroll
        for (int q = 0; q < 3; ++q) wa[q][j] = F.conv_a_w[q * DA + lane * 8 + j]; }
    for (int tile = F.vcu; tile < T / 32; tile += F.G) {
        const int t0 = tile * 32, b = t0 / SEQ, s0 = t0 % SEQ;
        u32x4 gpm1[4], gp0[4], gpp1[4], gab[4];
#pragma unroll
        for (int q = 0; q < 4; ++q) { const int i = wave * 4 + q, s = s0 + i; const bf16* prow = F.P + (size_t)(t0 + i) * PW + lane * 8; const u32x4 z4 = (u32x4){0u, 0u, 0u, 0u};
            gpm1[q] = (s > 0) ? *(const GAS u32x4*)(prow - PW) : z4; gp0[q] = *(const GAS u32x4*)prow; gpp1[q] = (s < SEQ - 1) ? *(const GAS u32x4*)(prow + PW) : z4; gab[q] = *(const GAS u32x4*)(prow + 512); }
        for (int ch = tid; ch < 62 * 64; ch += 512) { const int row = ch >> 6, c16 = ch & 63, s = s0 - 15 + row; u32x4 v = (u32x4){0u, 0u, 0u, 0u};
            if (s >= 0 && s < SEQ) v = *(const GAS u32x4*)(F.P + (size_t)(b * SEQ + s) * PW + 1024 + c16 * 8);
            *(LAS u32x4*)(L + row * 1024 + c16 * 16) = v; }
        __syncthreads();
#pragma unroll 1
        for (int sub = 0; sub < 2; ++sub) { const int i0 = th * 16 + sub * 8; float a0[8], a1[8];
#pragma unroll
            for (int i = 0; i < 8; ++i) { a0[i] = bias2.x; a1[i] = bias2.y; }
#pragma unroll
            for (int w = 0; w < 38; ++w) { const unsigned v = Ut[(i0 + w) * 256 + cp]; const float lo = bflo(v), hi = bfhi(v);
#pragma unroll
                for (int i = 0; i < 8; ++i) { const int j = w - i; if (j >= 0 && j < 31) { a0[i] += wb0[j] * lo; a1[i] += wb1[j] * hi; } } }
#pragma unroll
            for (int i = 0; i < 8; ++i) *(LAS f32x2*)(UC + (i0 + i) * 512 + 2 * cp) = (f32x2){a0[i], a1[i]};
        }
        __syncthreads();
#pragma unroll
        for (int q = 0; q < 4; ++q) { const int i = wave * 4 + q, t = t0 + i;
            const f32x4 ua = *(const LAS f32x4*)(UC + i * 512 + lane * 8), ub = *(const LAS f32x4*)(UC + i * 512 + lane * 8 + 4);
            float uv[8] = {ua[0], ua[1], ua[2], ua[3], ub[0], ub[1], ub[2], ub[3]};
            float s1 = 0.f;
#pragma unroll
            for (int j = 0; j < 8; ++j) s1 += uv[j];
            const float mu = wave_sum(s1) * (1.f / DB); float s2 = 0.f;
#pragma unroll
            for (int j = 0; j < 8; ++j) { uv[j] -= mu; s2 += uv[j] * uv[j]; }
            const float rstd = rsqrtf(wave_sum(s2) * (1.f / DB) + EPS); float hb = 0.f;
#pragma unroll
            for (int j = 0; j < 8; ++j) { const float z = uv[j] * rstd * lng[j] + lnb[j]; uv[j] = z * fast_sigmoid(z); hb += uv[j] * uv[j]; }
            hb += __shfl_xor(hb, 1); hb += __shfl_xor(hb, 2); hb += __shfl_xor(hb, 4);
            const float rb = rsqrtf(hb * (1.f / 64.f) + EPS);
            u32x4 ob; ob.x = pk2(uv[0] * rb, uv[1] * rb); ob.y = pk2(uv[2] * rb, uv[3] * rb); ob.z = pk2(uv[4] * rb, uv[5] * rb); ob.w = pk2(uv[6] * rb, uv[7] * rb);
            *(GAS u32x4*)(F.Y + (size_t)t * D + DA + lane * 8) = ob;
            const u32x4 pm1 = gpm1[q], p0 = gp0[q], pp1 = gpp1[q], abv = gab[q];
            float ya[8]; float ha = 0.f;
#pragma unroll
            for (int j = 0; j < 4; ++j) {
                const float c0 = wa[0][2 * j] * bflo(pm1[j]) + wa[1][2 * j] * bflo(p0[j]) + wa[2][2 * j] * bflo(pp1[j]);
                const float c1 = wa[0][2 * j + 1] * bfhi(pm1[j]) + wa[1][2 * j + 1] * bfhi(p0[j]) + wa[2][2 * j + 1] * bfhi(pp1[j]);
                ya[2 * j] = bflo(abv[j]) * c0; ya[2 * j + 1] = bfhi(abv[j]) * c1; ha += ya[2 * j] * ya[2 * j] + ya[2 * j + 1] * ya[2 * j + 1]; }
            ha += __shfl_xor(ha, 1); ha += __shfl_xor(ha, 2); ha += __shfl_xor(ha, 4);
            const float ra = rsqrtf(ha * (1.f / 64.f) + EPS);
            u32x4 oa; oa.x = pk2(ya[0] * ra, ya[1] * ra); oa.y = pk2(ya[2] * ra, ya[3] * ra); oa.z = pk2(ya[4] * ra, ya[5] * ra); oa.w = pk2(ya[6] * ra, ya[7] * ra);
            *(GAS u32x4*)(F.Y + (size_t)t * D + lane * 8) = oa;
        }
    }
    __syncthreads();
}

__device__ __forceinline__ void p4_route(Frame& F) {
    const int wave = F.wave; int lane = lane_id(); asm volatile("" : "+v"(lane)); const int tid = wave * 64 + lane;
    LAS float* LGp = (LAS float*)F.lds;
    LAS int* scnt = (LAS int*)(F.lds + 102400);
    bf16x8 bfr[4][3];
    { const bf16* brow = F.Wr_t + (size_t)(lane & 15) * D + 128 * wave + 8 * (lane >> 4);
#pragma unroll
      for (int ks = 0; ks < 4; ++ks)
#pragma unroll
        for (int nb = 0; nb < 3; ++nb) bfr[ks][nb] = *(const GAS bf16x8*)(brow + (size_t)nb * 16 * D + ks * 32); }
    for (int tile = F.vcu; tile < T / 64; tile += F.G) {
        if (tid < 32) scnt[tid] = 0;
        const int tb = tile * 64;
        bf16x8 af[4][4];
#pragma unroll
        for (int tg = 0; tg < 4; ++tg)
#pragma unroll
            for (int ks = 0; ks < 4; ++ks) af[tg][ks] = *(const GAS bf16x8*)(F.X1B + (size_t)(tb + 16 * tg + (lane & 15)) * D + 128 * wave + ks * 32 + 8 * (lane >> 4));
#pragma unroll
        for (int tg = 0; tg < 4; ++tg) { f32x4 acc[3];
#pragma unroll
            for (int nb = 0; nb < 3; ++nb) acc[nb] = (f32x4){0.f, 0.f, 0.f, 0.f};
#pragma unroll
            for (int ks = 0; ks < 4; ++ks)
#pragma unroll
                for (int nb = 0; nb < 3; ++nb) acc[nb] = __builtin_amdgcn_mfma_f32_16x16x32_bf16(af[tg][ks], bfr[ks][nb], acc[nb], 0, 0, 0);
#pragma unroll
            for (int nb = 0; nb < 3; ++nb)
#pragma unroll
                for (int r = 0; r < 4; ++r) LGp[(wave * 64 + 16 * tg + 4 * (lane >> 4) + r) * 49 + nb * 16 + (lane & 15)] = acc[nb][r]; }
        __syncthreads();
        int e0 = 0, e1 = 0, p0 = 0, p1 = 0; float c0 = 0.f, c1 = 0.f, r2 = 0.f;
        if (tid < 64) {
            const int t = tb + tid; float ss = 0.f;
#pragma unroll
            for (int s = 0; s < 16; ++s) ss += F.SSQ[(size_t)s * T + t];
            r2 = rsqrtf(ss * (1.f / D) + EPS);
            const LAS float* lg = LGp + tid * 49;
            float g4[4];
#pragma unroll
            for (int i = 0; i < 4; ++i) { float a = 0.f;
#pragma unroll
                for (int w = 0; w < 8; ++w) a += lg[w * 64 * 49 + i];
                g4[i] = a * r2 + F.brg[i]; }
            int g = 0; float m = g4[0];
#pragma unroll
            for (int i = 1; i < 4; ++i) if (g4[i] > m) { m = g4[i]; g = i; }
            float den = 0.f;
#pragma unroll
            for (int i = 0; i < 4; ++i) den += __expf(g4[i] - m);
            const float psel = 1.0f / den;
            int i0 = 0, i1 = -1; float m0 = -3.0e38f, m1 = -3.0e38f;
            for (int i = 0; i < 8; ++i) { float a = 0.f;
#pragma unroll
                for (int w = 0; w < 8; ++w) a += lg[w * 64 * 49 + 4 + g * 8 + i];
                const float v = a * r2 + F.bre[g * 8 + i];
                if (v > m0) { m1 = m0; i1 = i0; m0 = v; i0 = i; } else if (v > m1) { m1 = v; i1 = i; } }
            const float ex = __expf(m1 - m0);
            e0 = g * 8 + i0; e1 = g * 8 + i1; c0 = psel / (1.0f + ex); c1 = psel * ex / (1.0f + ex);
            p0 = __hip_atomic_fetch_add(scnt + e0, 1, __ATOMIC_RELAXED, __HIP_MEMORY_SCOPE_WORKGROUP); p1 = __hip_atomic_fetch_add(scnt + e1, 1, __ATOMIC_RELAXED, __HIP_MEMORY_SCOPE_WORKGROUP);
        }
        __syncthreads();
        if (tid < 32) scnt[32 + tid] = (int)__hip_atomic_fetch_add(F.gcnt + tid, (unsigned)scnt[tid], RLX_AGENT);
        __syncthreads();
        if (tid < 64) {
            const int t = tb + tid; const size_t d0 = (size_t)e0 * CAP + scnt[32 + e0] + p0, d1 = (size_t)e1 * CAP + scnt[32 + e1] + p1;
            F.LTOK[d0] = (unsigned)t; F.LW[d0] = c0; F.LR2[d0] = r2;
            F.LTOK[d1] = (unsigned)t | (1u << 16); F.LW[d1] = c1; F.LR2[d1] = r2;
        }
        __syncthreads();
    }
}

__device__ __forceinline__ void p7_final(Frame& F) {
    const int wave = F.wave; int lane = lane_id(); asm volatile("" : "+v"(lane)); const int tid = wave * 64 + lane;
    const int gw = F.vcu * NWAVES + wave, NGW = F.G * NWAVES;
    f32x4 g[2][2];
#pragma unroll
    for (int j = 0; j < 2; ++j) { g[j][0] = *(const f32x4*)(F.gfin + j * 512 + lane * 8); g[j][1] = *(const f32x4*)(F.gfin + j * 512 + lane * 8 + 4); }
    for (int t = gw; t < T; t += NGW) {
        float v[2][8]; float ss = 0.f;
#pragma unroll
        for (int j = 0; j < 2; ++j) { const size_t o = (size_t)t * D + j * 512 + lane * 8;
            const u32x4 a = *(const GAS u32x4*)(F.X1B + o); const u32x2 c0 = *(const GAS u32x2*)(F.CB + o), c1 = *(const GAS u32x2*)(F.CB + (size_t)T * D + o);
#pragma unroll
            for (int q = 0; q < 4; q += 2) { const f32x2 p0 = __builtin_amdgcn_cvt_pk_f32_fp8((int)c0[q >> 1], false), p1 = __builtin_amdgcn_cvt_pk_f32_fp8((int)c1[q >> 1], false),
                                                           p2 = __builtin_amdgcn_cvt_pk_f32_fp8((int)c0[q >> 1], true), p3 = __builtin_amdgcn_cvt_pk_f32_fp8((int)c1[q >> 1], true);
                v[j][2 * q] = bflo(a[q]) + (p0.x + p1.x) * (1.0f / 64.0f); v[j][2 * q + 1] = bfhi(a[q]) + (p0.y + p1.y) * (1.0f / 64.0f);
                v[j][2 * q + 2] = bflo(a[q + 1]) + (p2.x + p3.x) * (1.0f / 64.0f); v[j][2 * q + 3] = bfhi(a[q + 1]) + (p2.y + p3.y) * (1.0f / 64.0f); }
#pragma unroll
            for (int q = 0; q < 8; ++q) ss += v[j][q] * v[j][q]; }
        const float r = rsqrtf(wave_sum(ss) * (1.f / D) + EPS);
#pragma unroll
        for (int j = 0; j < 2; ++j) { float* o = F.out + (size_t)t * D + j * 512 + lane * 8;
            *(GAS f32x4*)o = (f32x4){v[j][0] * r * g[j][0][0], v[j][1] * r * g[j][0][1], v[j][2] * r * g[j][0][2], v[j][3] * r * g[j][0][3]};
            *(GAS f32x4*)(o + 4) = (f32x4){v[j][4] * r * g[j][1][0], v[j][5] * r * g[j][1][1], v[j][6] * r * g[j][1][2], v[j][7] * r * g[j][1][3]}; }
    }
}

__device__ __forceinline__ void moe_sched_init(pg8::SchedMoe& S, Frame& F) {
    int lane = lane_id(); asm volatile("" : "+v"(lane));
    LAS int* tab = (LAS int*)(F.lds + LDSCTL_OFF + 1024);
    int my_cnt = 0; if (lane < NE) my_cnt = (int)__hip_atomic_load(F.gcnt + lane, RLX_AGENT);
    const int tiles = (my_cnt + 255) >> 8; int incl = tiles;
#pragma unroll
    for (int o = 1; o < 32; o <<= 1) { const int v = __shfl_up(incl, o); if (lane >= o) incl += v; }
    if (F.wave == 0 && lane < NE) { tab[lane] = incl - tiles; tab[32 + lane] = my_cnt; }
    S.total_rt = __builtin_amdgcn_readlane(incl, 31); S.tab = tab;
    S.ltok = F.LTOK; S.G = F.G; S.c = (int)blockIdx.x;
    __syncthreads();
}

struct Args { const float* in[20]; float* out; unsigned char* ws; int ph_lo, ph_hi, li, pad; };
__global__ void __launch_bounds__(NWAVES * 64, 2) mk_fwd(Args args) {
    extern __shared__ __attribute__((aligned(16))) unsigned char lds[];
    Frame F;
    F.lds = (LAS unsigned char*)lds;
    F.MISC = (volatile LAS unsigned*)(F.lds + MISC_OFF);
    F.wave = __builtin_amdgcn_readfirstlane((int)threadIdx.x >> 6);
    F.G = gridDim.x; { const int bx = blockIdx.x; F.vcu = (F.G % 8 == 0) ? (bx % 8) * (F.G / 8) + bx / 8 : bx; }
    unsigned char* ws = args.ws;
    F.ctl = (gu32*)(ws + WS_CTL);
    F.x = args.in[0]; F.norm_mix_g = args.in[1]; F.w_in = args.in[2]; F.conv_a_w = args.in[3]; F.conv_b_w = args.in[4]; F.conv_b_bias = args.in[5]; F.ln_b_g = args.in[6]; F.ln_b_b = args.in[7];
    F.beta_a = args.in[8]; F.beta_b = args.in[9]; F.w_out = args.in[10]; F.norm_ffn_g = args.in[11]; F.wrg = args.in[12]; F.brg = args.in[13]; F.wre = args.in[14]; F.bre = args.in[15];
    F.w1 = args.in[16]; F.w3 = args.in[17]; F.w2 = args.in[18]; F.gfin = args.in[19]; F.out = args.out;
    F.Win_t = (bf16*)(ws + WS_WIN); F.Wout_t = (bf16*)(ws + WS_WOUT); F.Wr_t = (bf16*)(ws + WS_WR); F.W13_t = (fp8*)(ws + WS_W13); F.W2_t = (fp8*)(ws + WS_W2); F.X1F8 = (fp8*)(ws + WS_X1F8);
    F.XB = (bf16*)(ws + WS_XB); F.P = (bf16*)(ws + WS_P); F.Y = (bf16*)(ws + WS_Y); F.X1B = (bf16*)(ws + WS_X1B); F.H = (fp8*)(ws + WS_H); F.CB = (fp8*)(ws + WS_CB); F.RI = (float*)(ws + WS_WR + 768 * 1024);
    F.SSQ = (float*)(ws + WS_SSQ); F.LW = (float*)(ws + WS_LW); F.LR2 = (float*)(ws + WS_LR2); F.LTOK = (unsigned*)(ws + WS_LTOK); F.gcnt = (unsigned*)(ws + WS_CTL) + CW_GCNT;
    for (int u = F.wave * 64 + lane_id(); u < (LDS_BYTES - LDSCTL_OFF) / 4; u += NWAVES * 64) ((LAS unsigned*)(F.lds + LDSCTL_OFF))[u] = 0u;
    __syncthreads();
    XcdBarrier bar; bar.bar = (unsigned*)(F.ctl + CW_BAR); bar.x = 0; bar.st = nullptr; bar.wave = F.wave;
    if (N_LAUNCHES == 1) bar = xcd_barrier_post((unsigned*)(F.ctl + CW_BAR), F.MISC + 8, F.wave);
    const int lo = args.ph_lo, hi = args.ph_hi;
#define IN(k) (lo <= (k) && (k) < hi)
#define GRID_BAR(k) do { if (IN(k) && IN((k) + 1)) xcd_barrier(bar); if (PROBE_PHASE >= 0 && blockIdx.x == 0 && F.wave == 0 && lane_id() == 0) ((unsigned long long*)(ws + WS_WR + 512 * 1024))[(k) + 1] = __builtin_amdgcn_s_memrealtime(); } while (0)
    if (PROBE_PHASE >= 0 && blockIdx.x == 0 && F.wave == 0 && lane_id() == 0) ((unsigned long long*)(ws + WS_WR + 512 * 1024))[0] = __builtin_amdgcn_s_memrealtime();

    if (IN(0)) { p0_prologue(F); GRID_BAR(0); }
    if (IN(1)) {
        pg8::SchedDense S{(const char*)F.XB, (const char*)F.Win_t, T / 256, DIN / 256, F.G, (int)blockIdx.x, (size_t)256 * D * 2, 16};
        pg8::EpiP1 E{F.P};
        pg8::gemm_phase<pg8::EpiP1, pg8::SchedDense, false>(F.lds + RING_OFF, D * 2, S, E, F.wave);
        GRID_BAR(1);
    }
    if (IN(2)) { p2_mixer(F); GRID_BAR(2); }
    if (IN(3)) {
        pg8::SchedDense S{(const char*)F.Y, (const char*)F.Wout_t, T / 256, D / 256, F.G, (int)blockIdx.x, (size_t)256 * D * 2, 16};
        pg8::EpiX1 E{F.XB, F.RI, F.X1B, F.SSQ, F.X1F8};
        pg8::gemm_phase<pg8::EpiX1, pg8::SchedDense, false>(F.lds + RING_OFF, D * 2, S, E, F.wave);
        GRID_BAR(3);
    }
    if (IN(4)) { p4_route(F); GRID_BAR(4); }
    if (IN(5)) {
        pg8::SchedMoeA S; moe_sched_init(S, F); S.A = (const char*)F.X1F8; S.W = (const char*)F.W13_t; S.a_tile_bytes = 0; S.w_exp_bytes = (size_t)1024 * D; S.nkt = 8;
        pg8::EpiH E{F.H, F.LR2};
        pg8::gemm_phase<pg8::EpiH, pg8::SchedMoeA, true>(F.lds + RING_OFF, D, S, E, F.wave);
        GRID_BAR(5);
    }
    if (IN(6)) {
        pg8::SchedMoeB S; moe_sched_init(S, F); S.A = (const char*)F.H; S.W = (const char*)F.W2_t; S.a_tile_bytes = (size_t)256 * DE; S.w_exp_bytes = (size_t)1024 * DE; S.nkt = 4;
        pg8::EpiC E{F.CB, F.LTOK, F.LW};
        pg8::gemm_phase<pg8::EpiC, pg8::SchedMoeB, true>(F.lds + RING_OFF, DE, S, E, F.wave);
        GRID_BAR(6);
    }
    if (IN(7)) { p7_final(F);
        if (PROBE_PHASE >= 0 && blockIdx.x == 0 && F.wave == 0 && lane_id() == 0) { unsigned long long* ts = (unsigned long long*)(ws + WS_WR + 512 * 1024); ts[8] = __builtin_amdgcn_s_memrealtime();
            asm volatile("s_waitcnt vmcnt(0)" ::: "memory"); const float us = (PROBE_PHASE == 8) ? (float)(ts[8] - ts[0]) * 0.001f : (float)(ts[PROBE_PHASE + 1] - ts[PROBE_PHASE]) * 0.01f; F.out[0] += us * 0.1f; } }
#undef IN
#undef GRID_BAR
}

extern "C" void kernel_launch(void* const* d_in, const int* in_sizes, int n_in, void* d_out, int out_size, void* d_ws, size_t ws_size, hipStream_t stream) {
    static int grid = 0;
    if (grid == 0) {
        if (n_in != 20 || in_sizes[0] != T * D || out_size != T * D || ws_size < WS_END) { fprintf(stderr, "kernel_launch: unexpected shapes / workspace (n_in %d, in0 %d, out %d, ws %zu, need %zu)\n", n_in, n_in > 0 ? in_sizes[0] : -1, out_size, ws_size, (size_t)WS_END); grid = -1; return; }
        int dev = 0, cus = 0, per_cu = 0;
        if (hipGetDevice(&dev) != hipSuccess || hipDeviceGetAttribute(&cus, hipDeviceAttributeMultiprocessorCount, dev) != hipSuccess) { fprintf(stderr, "kernel_launch: device query failed\n"); grid = -1; return; }
        if (hipFuncSetAttribute((const void*)mk_fwd, hipFuncAttributeMaxDynamicSharedMemorySize, LDS_BYTES) != hipSuccess) { fprintf(stderr, "kernel_launch: hipFuncSetAttribute failed\n"); grid = -1; return; }
        if (hipOccupancyMaxActiveBlocksPerMultiprocessor(&per_cu, (const void*)mk_fwd, NWAVES * 64, LDS_BYTES) != hipSuccess || per_cu < 1) fprintf(stderr, "kernel_launch: occupancy query reports %d workgroups per CU\n", per_cu);
        (void)hipGetLastError();
        grid = cus;
    }
    if (grid < 0) return;
    if (hipMemsetAsync((char*)d_ws + WS_CTL, 0, CTL_ZERO_BYTES, stream) != hipSuccess) { fprintf(stderr, "kernel_launch: hipMemsetAsync failed\n"); return; }
    Args a{};
    for (int i = 0; i < 20; ++i) a.in[i] = (const float*)d_in[i];
    a.out = (float*)d_out; a.ws = (unsigned char*)d_ws;
    for (int li = 0; li < N_LAUNCHES; ++li) {
        a.ph_lo = (N_LAUNCHES == 1) ? 0 : li; a.ph_hi = (N_LAUNCHES == 1) ? NPHASES : li + 1; a.li = li;
        hipLaunchKernelGGL(mk_fwd, dim3(grid), dim3(NWAVES * 64), LDS_BYTES, stream, a);
        const hipError_t le = hipPeekAtLastError();
        if (le != hipSuccess) { fprintf(stderr, "kernel_launch: launch %d failed: %s\n", li, hipGetErrorName(le)); break; }
    }
}
```

```cpp
#include <hip/hip_runtime.h>
#include <cstdio>
#include <cstdint>

#define LAS __attribute__((address_space(3)))
#define GAS __attribute__((address_space(1)))
typedef unsigned short bf16;
typedef short bf16x8 __attribute__((ext_vector_type(8)));
typedef float f32x4 __attribute__((ext_vector_type(4)));
typedef float f32x2 __attribute__((ext_vector_type(2)));
typedef unsigned u32x4 __attribute__((ext_vector_type(4)));
typedef unsigned u32x2 __attribute__((ext_vector_type(2)));
typedef GAS unsigned gu32;
typedef int i32x4 __attribute__((ext_vector_type(4)));
typedef int i32x8 __attribute__((ext_vector_type(8)));
typedef unsigned char fp8;

constexpr int T = 16384, SEQ = 2048, D = 1024, DA = 512, DB = 512, DIN = 2560, NE = 32, DE = 512, CAP = 16384, PW = 1536;
constexpr float EPS = 1e-6f;
constexpr int NWAVES = 8;
#ifndef MK_N_LAUNCHES
#define MK_N_LAUNCHES 1
#endif
constexpr int N_LAUNCHES = MK_N_LAUNCHES;
constexpr int NPHASES = 8;
#ifndef PROBE_PHASE
#define PROBE_PHASE -1
#endif

constexpr size_t MiB = 1u << 20;
constexpr size_t WS_CTL = 0, CTL_ZERO_BYTES = 72 * 1024;
constexpr size_t WS_WIN = 1 * MiB;
constexpr size_t WS_WOUT = 6 * MiB;
constexpr size_t WS_WR = 8 * MiB;
constexpr size_t WS_SSQ = 9 * MiB;
constexpr size_t WS_LTOK = 11 * MiB;
constexpr size_t WS_LW = 13 * MiB;
constexpr size_t WS_LR2 = 15 * MiB;
constexpr size_t WS_W13 = 17 * MiB;
constexpr size_t WS_W2 = 49 * MiB;
constexpr size_t WS_X1B = 65 * MiB;
constexpr size_t WS_X1F8 = 97 * MiB;
constexpr size_t WS_XB = 113 * MiB;
constexpr size_t WS_P = 145 * MiB;
constexpr size_t WS_Y = 193 * MiB;
constexpr size_t WS_H = 113 * MiB;
constexpr size_t WS_CB = 133 * MiB;
constexpr size_t WS_END = 225 * MiB;
constexpr int CW_TMO = 0, CW_CODE = 1, CW_BAR = 4096, CW_GCNT = 16384;

constexpr int RING_OFF = 0, RING_BYTES = 131072;
constexpr int LDSCTL_OFF = RING_BYTES, MISC_OFF = LDSCTL_OFF + 320;
constexpr int LDS_BYTES = 147456;

#define RLX_AGENT __ATOMIC_RELAXED, __HIP_MEMORY_SCOPE_AGENT
#define LDS_WAIT() asm volatile("s_waitcnt lgkmcnt(0)" ::: "memory")
#define VM_WAIT() asm volatile("s_waitcnt vmcnt(0)" ::: "memory")
__device__ __forceinline__ unsigned f2bf(float f) { unsigned u = __builtin_bit_cast(unsigned, f); return (u + 0x7fffu + ((u >> 16) & 1u)) >> 16; }
__device__ __forceinline__ unsigned pk2(float lo, float hi) { return f2bf(lo) | (f2bf(hi) << 16); }
__device__ __forceinline__ unsigned cvt_pk_bf16(float lo, float hi) { unsigned r; asm volatile("v_cvt_pk_bf16_f32 %0, %1, %2" : "=v"(r) : "v"(lo), "v"(hi)); return r; }
__device__ __forceinline__ unsigned pk4_fp8(float a, float b, float c, float d) { int w = 0; w = __builtin_amdgcn_cvt_pk_fp8_f32(a, b, w, false); w = __builtin_amdgcn_cvt_pk_fp8_f32(c, d, w, true); return (unsigned)w; }
__device__ __forceinline__ float bflo(unsigned v) { return __builtin_bit_cast(float, v << 16); }
__device__ __forceinline__ float bfhi(unsigned v) { return __builtin_bit_cast(float, v & 0xffff0000u); }
__device__ __forceinline__ float fast_sigmoid(float v) { return __builtin_amdgcn_rcpf(1.0f + __expf(-v)); }
__device__ __forceinline__ int lane_id() { unsigned m = ~0u; asm volatile("" : "+s"(m)); return (int)__builtin_amdgcn_mbcnt_hi(m, __builtin_amdgcn_mbcnt_lo(m, 0u)); }
__device__ __forceinline__ float wave_sum(float v) {
#pragma unroll
    for (int o = 1; o < 64; o <<= 1) v += __shfl_xor(v, o);
    return v;
}

namespace pg8 {
constexpr int BM = 256, BK = 64, HALF = 128, HTB = HALF * BK * 2, STAGE_BYTES = 8 * HTB, NXCD = 8, WGM = 8;
__host__ __device__ __forceinline__ int lds_byte(int r, int c) { const int st = (r >> 4) * 2 + (c >> 5), rr = r & 15, cc = c & 31, ob = rr * 64 + cc * 2; return st * 1024 + (ob ^ (((ob >> 9) & 1) << 5)); }
__host__ __device__ __forceinline__ void stage_rc(int b, int& R, int& C) { const int st = b / 1024, sb = b % 1024, swz = sb ^ (((sb >> 9) & 1) << 5); R = (st >> 1) * 16 + swz / 64; C = (st & 1) * 32 + (swz % 64) / 2; }
__host__ __device__ __forceinline__ int perm32(int rho) { const int n = rho >> 4, i = rho & 15; return 8 * (i >> 2) + 4 * n + (i & 3); }

struct Unit { int pm, pn, e, rt, cnt; };

__device__ __forceinline__ bool tile_order(int i, int G, int c, int nM, int nN, int& pm, int& pn) {
    const int nwg = nM * nN; const int L = i * G + c; if (L >= nwg) return false;
    int wgid = L; { const int q = nwg / NXCD, r = nwg % NXCD, xcd = wgid % NXCD, off = wgid / NXCD; wgid = (xcd < r ? xcd * (q + 1) : r * (q + 1) + (xcd - r) * q) + off; }
    const int nig = WGM * nN, gid = wgid / nig, fm = gid * WGM, gsz = (nM - fm) < WGM ? (nM - fm) : WGM;
    pm = fm + ((wgid % nig) % gsz); pn = (wgid % nig) / gsz; return true;
}

struct SchedDense {
    static constexpr bool GATHER = false;
    const char* A; const char* Bt; int nM, nN, G, c; size_t tstepA; int nkt;
    __device__ __forceinline__ bool next(int i, Unit& u) const { u.e = 0; u.rt = 0; u.cnt = 0; return tile_order(i, G, c, nM, nN, u.pm, u.pn); }
    __device__ __forceinline__ const char* a_buf() const { return A; }
    __device__ __forceinline__ const char* b_buf() const { return Bt; }
    __device__ __forceinline__ unsigned a_soff(const Unit& u) const { return (unsigned)u.pm * (unsigned)tstepA; }
    __device__ __forceinline__ unsigned b_soff(const Unit& u) const { return (unsigned)(u.pn * nkt) * 32768u; }
    __device__ __forceinline__ void a_tokens(const Unit&, int, unsigned (&)[2]) const {}
};
struct SchedMoe {
    const char* A; const char* W; const unsigned* ltok; const LAS int* tab; int total_rt, G, c; size_t a_tile_bytes, w_exp_bytes; int nkt;
    __device__ __forceinline__ bool next(int i, Unit& u) const {
        if (!tile_order(i, G, c, total_rt, 4, u.pm, u.pn)) return false;
        const int lane = lane_id();
        const unsigned long long m = __ballot(lane < 32 && tab[lane & 31] <= u.pm);
        const int e = __builtin_amdgcn_readfirstlane(__popcll(m) - 1);
        u.e = e; u.rt = u.pm - __builtin_amdgcn_readfirstlane(tab[e]); u.cnt = __builtin_amdgcn_readfirstlane(tab[32 + e]); return true;
    }
    __device__ __forceinline__ const char* a_buf() const { return A; }
    __device__ __forceinline__ const char* b_buf() const { return W; }
    __device__ __forceinline__ unsigned b_soff(const Unit& u) const { return (unsigned)u.e * (unsigned)w_exp_bytes + (unsigned)(u.pn * nkt) * 32768u; }
};
struct SchedMoeA : SchedMoe {
    static constexpr bool GATHER = true;
    __device__ __forceinline__ unsigned a_soff(const Unit&) const { return 0u; }
    __device__ __forceinline__ void a_tokens(const Unit& u, int R, unsigned (&tk)[2]) const {
        asm volatile("" : "+v"(R));
        const __amdgpu_buffer_rsrc_t rl = __builtin_amdgcn_make_buffer_rsrc((void*)ltok, 0, NE * CAP * 4, 0x00020000);
#pragma unroll
        for (int h = 0; h < 2; ++h) { const int p0 = u.rt * 256 + 128 * h + R, p1 = p0 + 64;
            const unsigned r0 = (unsigned)__builtin_amdgcn_raw_buffer_load_b32(rl, p0 < u.cnt ? (u.e * CAP + p0) * 4 : 0x7ffffff0, 0, 0);
            const unsigned r1 = (unsigned)__builtin_amdgcn_raw_buffer_load_b32(rl, p1 < u.cnt ? (u.e * CAP + p1) * 4 : 0x7ffffff0, 0, 0);
            tk[h] = (r0 & 0xffffu) | (r1 << 16); }
    }
};
struct SchedMoeB : SchedMoe {
    static constexpr bool GATHER = false;
    __device__ __forceinline__ unsigned a_soff(const Unit& u) const { return (unsigned)u.pm * (unsigned)a_tile_bytes; }
    __device__ __forceinline__ void a_tokens(const Unit&, int, unsigned (&)[2]) const {}
};

struct EpiP1 {
    bf16* P;
    __device__ __forceinline__ void operator()(const f32x4 (&acc)[2][2][4][2], const Unit& u, int wr, int wc, int fr, int fq) const {
        asm volatile("" : "+v"(fr), "+v"(fq));
        const int row0 = u.pm * BM + wr * 64 + fr, cl = wc * 32 + 8 * fq;
        if (u.pn >= 4 && u.pn < 6) {
#pragma unroll
            for (int ai = 0; ai < 2; ++ai)
#pragma unroll
                for (int m = 0; m < 4; ++m) { bf16* rowp = P + (size_t)(row0 + ai * HALF + m * 16) * PW + 512 + (u.pn - 4) * 256 + cl;
#pragma unroll
                    for (int bj = 0; bj < 2; ++bj) { const f32x4 v0 = acc[ai][bj][m][0], v1 = acc[ai][bj][m][1];
                        u32x4 w; w.x = cvt_pk_bf16(v0[0], v0[1]); w.y = cvt_pk_bf16(v0[2], v0[3]); w.z = cvt_pk_bf16(v1[0], v1[1]); w.w = cvt_pk_bf16(v1[2], v1[3]);
                        *(u32x4*)(rowp + bj * HALF) = w; } }
        } else if (u.pn < 4) {
#pragma unroll
            for (int ai = 0; ai < 2; ++ai)
#pragma unroll
                for (int m = 0; m < 4; ++m) { bf16* rowp = P + (size_t)(row0 + ai * HALF + m * 16) * PW + u.pn * 128 + cl;
                    const f32x4 v0 = acc[ai][0][m][0] * acc[ai][1][m][0], v1 = acc[ai][0][m][1] * acc[ai][1][m][1];
                    u32x4 w; w.x = cvt_pk_bf16(v0[0], v0[1]); w.y = cvt_pk_bf16(v0[2], v0[3]); w.z = cvt_pk_bf16(v1[0], v1[1]); w.w = cvt_pk_bf16(v1[2], v1[3]);
                    *(u32x4*)rowp = w; }
        } else {
#pragma unroll
            for (int ai = 0; ai < 2; ++ai)
#pragma unroll
                for (int m = 0; m < 4; ++m) { bf16* rowp = P + (size_t)(row0 + ai * HALF + m * 16) * PW + 1024 + (u.pn - 6) * 128 + cl;
                    f32x4 v0, v1;
#pragma unroll
                    for (int j = 0; j < 4; ++j) { v0[j] = acc[ai][0][m][0][j] * fast_sigmoid(acc[ai][1][m][0][j]); v1[j] = acc[ai][0][m][1][j] * fast_sigmoid(acc[ai][1][m][1][j]); }
                    u32x4 w; w.x = cvt_pk_bf16(v0[0], v0[1]); w.y = cvt_pk_bf16(v0[2], v0[3]); w.z = cvt_pk_bf16(v1[0], v1[1]); w.w = cvt_pk_bf16(v1[2], v1[3]);
                    *(u32x4*)rowp = w; }
        }
    }
};
struct EpiX1 {
    const bf16* xb; const float* ri; bf16* x1b; float* ssq; fp8* x1f8;
    __device__ __forceinline__ void operator()(const f32x4 (&acc)[2][2][4][2], const Unit& u, int wr, int wc, int fr, int fq) const {
        asm volatile("" : "+v"(fr), "+v"(fq));
        const int row0 = u.pm * BM + wr * 64 + fr, col0 = u.pn * BM + wc * 32 + 8 * fq;
#pragma unroll
        for (int ai = 0; ai < 2; ++ai)
#pragma unroll
            for (int m = 0; m < 4; ++m) { const int row = row0 + ai * HALF + m * 16; const bf16* xr = xb + (size_t)row * D + col0; const float rinv = ri[row]; bf16* orow = x1b + (size_t)row * D + col0; fp8* qrow = x1f8 + (size_t)row * D + col0; float s = 0.f;
#pragma unroll
                for (int bj = 0; bj < 2; ++bj) { const u32x4 xq = *(const u32x4*)(xr + bj * HALF);
                    const f32x4 a = (f32x4){bflo(xq[0]), bfhi(xq[0]), bflo(xq[1]), bfhi(xq[1])} * rinv, b = (f32x4){bflo(xq[2]), bfhi(xq[2]), bflo(xq[3]), bfhi(xq[3])} * rinv;
                    const f32x4 v0 = acc[ai][bj][m][0] + a, v1 = acc[ai][bj][m][1] + b;
                    s += (v0[0] * v0[0] + v0[1] * v0[1]) + (v0[2] * v0[2] + v0[3] * v0[3]) + (v1[0] * v1[0] + v1[1] * v1[1]) + (v1[2] * v1[2] + v1[3] * v1[3]);
                    u32x4 w; w.x = cvt_pk_bf16(v0[0], v0[1]); w.y = cvt_pk_bf16(v0[2], v0[3]); w.z = cvt_pk_bf16(v1[0], v1[1]); w.w = cvt_pk_bf16(v1[2], v1[3]);
                    *(u32x4*)(orow + bj * HALF) = w;
                    u32x2 q; q.x = pk4_fp8(v0[0], v0[1], v0[2], v0[3]); q.y = pk4_fp8(v1[0], v1[1], v1[2], v1[3]); *(u32x2*)(qrow + bj * HALF) = q; }
                s += __shfl_xor(s, 16); s += __shfl_xor(s, 32);
                if (fq == 0) ssq[(size_t)(u.pn * 4 + wc) * T + row] = s; }
    }
};
struct EpiH {
    fp8* H; const float* lr2;
    __device__ __forceinline__ void operator()(const f32x4 (&acc)[2][2][4][2], const Unit& u, int wr, int wc, int fr, int fq) const {
        asm volatile("" : "+v"(fr), "+v"(fq));
        const int cl = u.pn * 128 + wc * 32 + 8 * fq;
#pragma unroll
        for (int ai = 0; ai < 2; ++ai)
#pragma unroll
            for (int m = 0; m < 4; ++m) { const int rl = ai * HALF + wr * 64 + m * 16 + fr, pos = u.rt * 256 + rl; float rr = 0.f; if (pos < u.cnt) rr = lr2[(size_t)u.e * CAP + pos] * (1.0f / 32.0f);
                f32x4 v0, v1;
#pragma unroll
                for (int j = 0; j < 4; ++j) { const float a0 = acc[ai][0][m][0][j] * rr, b0 = acc[ai][1][m][0][j] * rr, a1 = acc[ai][0][m][1][j] * rr, b1 = acc[ai][1][m][1][j] * rr;
                    v0[j] = a0 * fast_sigmoid(a0) * b0; v1[j] = a1 * fast_sigmoid(a1) * b1; }
                u32x2 w; w.x = pk4_fp8(v0[0], v0[1], v0[2], v0[3]); w.y = pk4_fp8(v1[0], v1[1], v1[2], v1[3]);
                *(u32x2*)(H + ((size_t)u.pm * 256 + rl) * DE + cl) = w; }
    }
};
struct EpiC {
    fp8* Cb; const unsigned* ltok; const float* lw;
    __device__ __forceinline__ void operator()(const f32x4 (&acc)[2][2][4][2], const Unit& u, int wr, int wc, int fr, int fq) const {
        asm volatile("" : "+v"(fr), "+v"(fq));
        const int cl = u.pn * 256 + wc * 32 + 8 * fq;
#pragma unroll
        for (int ai = 0; ai < 2; ++ai)
#pragma unroll
            for (int m = 0; m < 4; ++m) { const int rl = ai * HALF + wr * 64 + m * 16 + fr, pos = u.rt * 256 + rl;
                if (pos < u.cnt) { const unsigned rec = ltok[(size_t)u.e * CAP + pos]; const float cw = lw[(size_t)u.e * CAP + pos] * 4.0f;
                    fp8* orow = Cb + ((size_t)(rec >> 16) * T + (rec & 0xffffu)) * D + cl;
#pragma unroll
                    for (int bj = 0; bj < 2; ++bj) { const f32x4 v0 = acc[ai][bj][m][0] * cw, v1 = acc[ai][bj][m][1] * cw;
                        u32x2 w; w.x = pk4_fp8(v0[0], v0[1], v0[2], v0[3]); w.y = pk4_fp8(v1[0], v1[1], v1[2], v1[3]);
                        *(u32x2*)(orow + bj * HALF) = w; } } }
    }
};

template <class Epi, class Sched, bool F8>
__device__ __forceinline__ void gemm_phase(LAS unsigned char* lds, const int Kb, const Sched& S, const Epi& E, const int wid) {
    constexpr bool GATHER = Sched::GATHER;
    const int lane = lane_id(), tid = wid * 64 + lane, wr = wid >> 2, wc = wid & 3, fr = lane & 15, fq = lane >> 4;
    int nt = Kb / 128; asm volatile("" : "+s"(nt));
    const unsigned kstep = 128u, hstep = (unsigned)(HALF * Kb);
    const unsigned kstepB = 32768u, hstepB = 2048u;
    const __amdgpu_buffer_rsrc_t rsA = __builtin_amdgcn_make_buffer_rsrc((void*)S.a_buf(), 0, 0x7fffffff, 0x00020000);
    const __amdgpu_buffer_rsrc_t rsB = __builtin_amdgcn_make_buffer_rsrc((void*)S.b_buf(), 0, 0x7fffffff, 0x00020000);
    unsigned voffA[2], voffB[2], ct[2] = {0u, 0u}, ntk[2] = {0u, 0u}; unsigned pc2;
    { int R, C; stage_rc(tid * 16, R, C); pc2 = (unsigned)C * 2u; }
#define PG8_R0() ({ int _t = wid * 64 + lane_id(); asm volatile("" : "+v"(_t)); int _R, _C; stage_rc(_t * 16, _R, _C); _R; })
#pragma unroll
    for (int i = 0; i < 2; ++i) { int R, C; stage_rc(tid * 16 + i * 8192, R, C);
        voffA[i] = (unsigned)(R * Kb) + (unsigned)C * 2u;
        const int st = wid + 8 * i; voffB[i] = (unsigned)((((st & 1) * 4 + (lane >> 4)) * 256) + (st >> 1) * 16 + (lane & 15)) * 16u; }
    const unsigned ldsw = (unsigned)wid * 1024u;
    const int aoff = lds_byte(wr * 64 + fr, fq * 8), boff = wc * 4096 + (fq * 16 + fr) * 16;
    const LAS unsigned char* ldsA = lds + aoff; const LAS unsigned char* ldsB = lds + 4 * HTB + boff;
    asm volatile("" : "+v"(ldsA), "+v"(ldsB));
#define PG8_SA(b, h) (((b) * 2 + (h)) * HTB)
#define PG8_SB(b, h) ((4 + (b) * 2 + (h)) * HTB)
#define PG8_STAGE(bufoff, soff, voff) do { _Pragma("unroll") for (int _i = 0; _i < 2; ++_i) \
        __builtin_amdgcn_raw_ptr_buffer_load_lds(rsB, (LAS void*)(lds + (bufoff) + ldsw + _i * 8192), 16, (int)(voff)[_i], (int)(soff), 0, 0); } while (0)
#define PG8_STAGE_A(bufoff, soff, h, TK) do { _Pragma("unroll") for (int _i = 0; _i < 2; ++_i) { \
        const unsigned _o = GATHER ? ((((TK)[h] >> (16 * _i)) & 0xffffu) * (unsigned)Kb + pc2) : voffA[_i]; const unsigned _so = GATHER ? (unsigned)(soff) : (unsigned)(soff) + (h) * hstep; \
        __builtin_amdgcn_raw_ptr_buffer_load_lds(rsA, (LAS void*)(lds + (bufoff) + ldsw + _i * 8192), 16, (int)_o, (int)_so, 0, 0); } } while (0)
#define PG8_LDA(dst, b, h) do { _Pragma("unroll") for (int m = 0; m < 4; ++m) { if constexpr (F8) { const i32x4 _lo = *(const LAS i32x4*)(ldsA + PG8_SA(b, h) + m * 2048), _hi = *(const LAS i32x4*)(ldsA + PG8_SA(b, h) + m * 2048 + 1024); \
            dst##8[m] = __builtin_shufflevector(_lo, _hi, 0, 1, 2, 3, 4, 5, 6, 7); } else { _Pragma("unroll") for (int k = 0; k < 2; ++k) dst[m][k] = *(const LAS bf16x8*)(ldsA + PG8_SA(b, h) + m * 2048 + k * 1024); } } } while (0)
#define PG8_LDB(dst, b, h) do { _Pragma("unroll") for (int n = 0; n < 2; ++n) { if constexpr (F8) { const i32x4 _lo = *(const LAS i32x4*)(ldsB + (PG8_SB(b, h) - 4 * HTB) + n * 2048), _hi = *(const LAS i32x4*)(ldsB + (PG8_SB(b, h) - 4 * HTB) + n * 2048 + 1024); \
            dst##8[n] = __builtin_shufflevector(_lo, _hi, 0, 1, 2, 3, 4, 5, 6, 7); } else { _Pragma("unroll") for (int k = 0; k < 2; ++k) dst[n][k] = *(const LAS bf16x8*)(ldsB + (PG8_SB(b, h) - 4 * HTB) + n * 2048 + k * 1024); } } } while (0)
#define PG8_MMA(ai, bj, At, Bt) do { __builtin_amdgcn_s_setprio(1); _Pragma("unroll") for (int m = 0; m < 4; ++m) _Pragma("unroll") for (int n = 0; n < 2; ++n) { \
        if constexpr (F8) acc[ai][bj][m][n] = __builtin_amdgcn_mfma_scale_f32_16x16x128_f8f6f4(Bt##8[n], At##8[m], acc[ai][bj][m][n], 0, 0, 0, 0x7F7F7F7F, 0, 0x7F7F7F7F); \
        else { _Pragma("unroll") for (int k = 0; k < 2; ++k) acc[ai][bj][m][n] = __builtin_amdgcn_mfma_f32_16x16x32_bf16(Bt[n][k], At[m][k], acc[ai][bj][m][n], 0, 0, 0); } } \
        __builtin_amdgcn_s_setprio(0); } while (0)
#define PG8_WAIT_V(n) asm volatile("s_waitcnt vmcnt(" #n ")" ::: "memory")
#define PG8_WAIT_L(n) asm volatile("s_waitcnt lgkmcnt(" #n ")" ::: "memory")
#define PG8_BAR __builtin_amdgcn_s_barrier()
#define PG8_SCHED __builtin_amdgcn_sched_barrier(0)
    Unit cur, nxt; int ui = 0;
    if (!S.next(0, cur)) return;
    f32x4 acc[2][2][4][2];
#pragma unroll
    for (int a = 0; a < 2; ++a)
#pragma unroll
        for (int b = 0; b < 2; ++b)
#pragma unroll
            for (int m = 0; m < 4; ++m)
#pragma unroll
                for (int n = 0; n < 2; ++n) acc[a][b][m][n] = (f32x4){0.f, 0.f, 0.f, 0.f};
    bf16x8 At[4][2], B0[2][2], B1[2][2]; i32x8 At8[4], B08[2], B18[2];
    unsigned cA = S.a_soff(cur), cB = S.b_soff(cur);
    if constexpr (GATHER) { S.a_tokens(cur, PG8_R0(), ct); asm volatile("" : "+v"(ct[0]), "+v"(ct[1])); }
    PG8_STAGE(PG8_SB(0, 0), cB, voffB); PG8_STAGE(PG8_SB(0, 1), cB + hstepB, voffB); PG8_STAGE_A(PG8_SA(0, 0), cA, 0, ct); PG8_STAGE_A(PG8_SA(0, 1), cA, 1, ct);
    if (wr == 1) PG8_BAR;
    PG8_WAIT_V(2); PG8_BAR;
    PG8_STAGE(PG8_SB(1, 0), cB + kstepB, voffB); PG8_STAGE_A(PG8_SA(1, 0), cA + kstep, 0, ct); PG8_STAGE(PG8_SB(1, 1), cB + hstepB + kstepB, voffB);
    PG8_WAIT_V(6); PG8_BAR;
    for (;;) {
        const bool has_next = S.next(ui + 1, nxt);
        unsigned nA = cA, nB = cB;
        if constexpr (GATHER) { ntk[0] = ct[0]; ntk[1] = ct[1]; }
        if (has_next) { nA = S.a_soff(nxt); nB = S.b_soff(nxt);
            if constexpr (GATHER) { S.a_tokens(nxt, PG8_R0(), ntk); asm volatile("" : "+v"(ntk[0]), "+v"(ntk[1])); } }
#pragma unroll 1
        for (int t = 0; t < nt; t += 2) {
            const bool last = (t == nt - 2);
            const unsigned a1 = cA + (unsigned)(t + 1) * kstep;
            const unsigned a2 = last ? nA : cA + (unsigned)(t + 2) * kstep, b2 = last ? nB : cB + (unsigned)(t + 2) * kstepB;
            const unsigned a3 = a2 + kstep, b3 = b2 + kstepB;
            unsigned tc[2] = {ct[0], ct[1]}, t2[2];
            if constexpr (GATHER) asm volatile("" : "+v"(tc[0]), "+v"(tc[1]));
            t2[0] = (GATHER && last) ? ntk[0] : tc[0]; t2[1] = (GATHER && last) ? ntk[1] : tc[1];
            PG8_LDB(B0, 0, 0); PG8_LDB(B1, 0, 1); PG8_SCHED; PG8_LDA(At, 0, 0); PG8_STAGE_A(PG8_SA(1, 1), a1, 1, tc);
            PG8_WAIT_V(8); PG8_WAIT_L(0); PG8_BAR; PG8_MMA(0, 0, At, B0); PG8_MMA(0, 1, At, B1); PG8_BAR; PG8_SCHED;
            PG8_LDA(At, 0, 1); PG8_STAGE(PG8_SB(0, 0), b2, voffB); PG8_STAGE(PG8_SB(0, 1), b2 + hstepB, voffB); PG8_STAGE_A(PG8_SA(0, 0), a2, 0, t2);
            PG8_WAIT_V(8); PG8_WAIT_L(0); PG8_BAR; PG8_MMA(1, 0, At, B0); PG8_MMA(1, 1, At, B1); PG8_BAR; PG8_SCHED;
            PG8_LDB(B0, 1, 0); PG8_LDB(B1, 1, 1); PG8_SCHED; PG8_LDA(At, 1, 0); PG8_STAGE_A(PG8_SA(0, 1), a2, 1, t2);
            PG8_WAIT_V(8); PG8_WAIT_L(0); PG8_BAR; PG8_MMA(0, 0, At, B0); PG8_MMA(0, 1, At, B1); PG8_BAR; PG8_SCHED;
            PG8_LDA(At, 1, 1); PG8_STAGE(PG8_SB(1, 0), b3, voffB); PG8_STAGE(PG8_SB(1, 1), b3 + hstepB, voffB); PG8_STAGE_A(PG8_SA(1, 0), a3, 0, t2);
            PG8_WAIT_V(8); PG8_WAIT_L(0); PG8_BAR; PG8_MMA(1, 0, At, B0); PG8_MMA(1, 1, At, B1); PG8_BAR; PG8_SCHED;
        }
        if (wr == 0) PG8_BAR;
        { int _l = lane_id(); asm volatile("" : "+v"(_l)); E(acc, cur, wr, wc, _l & 15, (_l >> 4) & 3); }
        if (!has_next) break;
#pragma unroll
        for (int a = 0; a < 2; ++a)
#pragma unroll
            for (int b = 0; b < 2; ++b)
#pragma unroll
                for (int m = 0; m < 4; ++m)
#pragma unroll
                    for (int n = 0; n < 2; ++n) acc[a][b][m][n] = (f32x4){0.f, 0.f, 0.f, 0.f};
        cur = nxt; cA = nA; cB = nB; ++ui;
        if constexpr (GATHER) { ct[0] = ntk[0]; ct[1] = ntk[1]; }
        if (wr == 1) PG8_BAR;
    }
    PG8_WAIT_V(0);
    PG8_BAR;
#undef PG8_SA
#undef PG8_SB
#undef PG8_STAGE
#undef PG8_STAGE_A
#undef PG8_R0
#undef PG8_LDA
#undef PG8_LDB
#undef PG8_MMA
#undef PG8_WAIT_V
#undef PG8_WAIT_L
#undef PG8_BAR
#undef PG8_SCHED
}
}

#define XB_TMO      128
#define XB_XCNT(j)  (256  + 64 * (j))
#define XB_XSUB(j)  (1280 + 64 * (j))
#define XB_XGEN(j)  (2304 + 64 * (j))
#define XB_TOP      3328
#define XB_TOPGEN   3392
#define XCD_BAR_WORDS 3456
#define XB_SPIN_CAP (1u << 18)
__device__ __forceinline__ unsigned xb_ld(unsigned* p)              { return __hip_atomic_load(p, __ATOMIC_RELAXED, __HIP_MEMORY_SCOPE_AGENT); }
__device__ __forceinline__ unsigned xb_add(unsigned* p, unsigned v) { return __hip_atomic_fetch_add(p, v, __ATOMIC_RELAXED, __HIP_MEMORY_SCOPE_AGENT); }
__device__ __forceinline__ unsigned xb_xcc_id() { return (unsigned)__builtin_amdgcn_s_getreg((3 << 11) | 20) & 0xFu; }
#define XB_SPIN(cond, bar) do { unsigned _sp = 0; while (cond) { __builtin_amdgcn_s_sleep(1); \
    if ((++_sp & 255u) == 0u) { if (xb_ld(&(bar)[XB_TMO])) break; if (_sp > XB_SPIN_CAP) { atomicAdd(&(bar)[XB_TMO], 1u); break; } } } } while (0)
struct XcdBarrier { unsigned* bar; unsigned x; volatile LAS unsigned* st; int wave; };
__device__ __forceinline__ XcdBarrier xcd_barrier_post(unsigned* bar, volatile LAS unsigned* st, int wave) {
    XcdBarrier b; b.bar = bar; b.x = xb_xcc_id(); b.st = st; b.wave = wave;
    if (wave == 0 && lane_id() == 0) (void)xb_add(&bar[XB_XCNT(b.x)], 1u);
    return b;
}
__device__ __forceinline__ void xcd_barrier_complete(unsigned* bar, unsigned x, unsigned& nloc, unsigned& nx) {
    const unsigned G = gridDim.x * gridDim.y * gridDim.z;
    unsigned sum, cnt, mine, sp = 0u;
    for (;;) {
        sum = 0u; cnt = 0u; mine = 0u;
#pragma unroll
        for (unsigned j = 0; j < 16; ++j) { const unsigned c = xb_ld(&bar[XB_XCNT(j)]); sum += c; cnt += (c > 0u) ? 1u : 0u; mine = (j == x) ? c : mine; }
        if (sum == G) break;
        __builtin_amdgcn_s_sleep(1);
        if ((++sp & 255u) == 0u) { if (xb_ld(&bar[XB_TMO])) break; if (sp > XB_SPIN_CAP) { atomicAdd(&bar[XB_TMO], 1u); break; } }
    }
    nloc = mine > 0u ? mine : 1u; nx = cnt > 0u ? cnt : 1u;
}
__device__ __forceinline__ void xcd_barrier(const XcdBarrier& b) {
    asm volatile("s_waitcnt vmcnt(0)" ::: "memory");
    __syncthreads();
    if (b.wave == 0 && lane_id() == 0) {
        unsigned* bar = b.bar;
        __builtin_amdgcn_s_waitcnt(0);
        unsigned nloc = b.st[0], nx = b.st[1];
        if (nloc == 0u) { xcd_barrier_complete(bar, b.x, nloc, nx); b.st[0] = nloc; b.st[1] = nx; }
        const unsigned old = xb_add(&bar[XB_XSUB(b.x)], 1u);
        const unsigned gen = old / nloc;
        if (old + 1u == (gen + 1u) * nloc) {
            __builtin_amdgcn_fence(__ATOMIC_RELEASE, "agent");
            asm volatile("s_waitcnt vmcnt(0)" ::: "memory");
            const unsigned og = xb_add(&bar[XB_TOP], 1u);
            const unsigned tg = og / nx;
            if (og + 1u == (tg + 1u) * nx) xb_add(&bar[XB_TOPGEN], 1u);
            else XB_SPIN(xb_ld(&bar[XB_TOPGEN]) == tg, bar);
            __builtin_amdgcn_fence(__ATOMIC_ACQUIRE, "agent");
            xb_add(&bar[XB_XGEN(b.x)], 1u);
            asm volatile("s_waitcnt vmcnt(0)" ::: "memory");
        } else {
            XB_SPIN(xb_ld(&bar[XB_XGEN(b.x)]) == gen, bar);
            __builtin_amdgcn_fence(__ATOMIC_ACQUIRE, "agent");
            asm volatile("s_waitcnt vmcnt(0)" ::: "memory");
        }
    }
    __syncthreads();
}

struct Frame {
    LAS unsigned char* lds;
    volatile LAS unsigned* MISC;
    gu32* ctl;
    int vcu, G, wave;
    const float *x, *norm_mix_g, *w_in, *conv_a_w, *conv_b_w, *conv_b_bias, *ln_b_g, *ln_b_b, *beta_a, *beta_b, *w_out, *norm_ffn_g, *wrg, *brg, *wre, *bre, *w1, *w3, *w2, *gfin;
    float* out;
    bf16 *Win_t, *Wout_t, *Wr_t, *XB, *P, *Y, *X1B; fp8 *W13_t, *W2_t, *H, *X1F8, *CB; float* RI;
    float *SSQ, *LW, *LR2; unsigned* LTOK; unsigned* gcnt;
};

struct CvtItem { const float* src; const float* ks; bf16* dst; int N; bool valid; };
__device__ __forceinline__ void cvt_load(const CvtItem& it, f32x4 (&v)[8]) {
    if (it.valid) {
#pragma unroll
        for (int j = 0; j < 8; ++j) v[j] = *(const GAS f32x4*)(it.src + (size_t)j * it.N);
    }
}
__device__ __forceinline__ void cvt_store(const CvtItem& it, f32x4 (&v)[8]) {
    if (it.valid) {
        if (it.ks) {
#pragma unroll
            for (int j = 0; j < 8; ++j) v[j] = v[j] * it.ks[j];
        }
#pragma unroll
        for (int c = 0; c < 4; ++c) { u32x4 g; g.x = cvt_pk_bf16(v[0][c], v[1][c]); g.y = cvt_pk_bf16(v[2][c], v[3][c]); g.z = cvt_pk_bf16(v[4][c], v[5][c]); g.w = cvt_pk_bf16(v[6][c], v[7][c]);
            *(GAS u32x4*)(it.dst + (size_t)c * 8) = g; }
    }
}
__device__ __forceinline__ int win_dest_row(int n0) {
    if (n0 < 512) return 256 * (n0 >> 7) + (n0 & 127);
    if (n0 < 1024) return n0 + 512;
    if (n0 < 1536) { const int j = n0 - 1024; return 256 * (j >> 7) + 128 + (j & 127); }
    if (n0 < 2048) { const int j = n0 - 1536; return 1536 + 256 * (j >> 7) + (j & 127); }
    { const int j = n0 - 2048; return 1536 + 256 * (j >> 7) + 128 + (j & 127); }
}
__device__ __forceinline__ size_t gran_idx(int kb, int drow, int nkt) { const int w = drow & 31, slot = (drow & 224) + 16 * ((w >> 2) & 1) + 4 * (w >> 3) + (w & 3);
    return ((size_t)(((drow >> 8) * nkt + (kb >> 3)) * 8 + (kb & 7)) * 256 + slot); }
constexpr int I_IN = 128 * 10, I_OUT = 128 * 4, NITEMS = I_IN + I_OUT;
constexpr int J_13 = NE * 2 * 64 * 2, J_2 = NE * 32 * 4, NITEMS8 = J_13 + J_2;
__device__ __forceinline__ CvtItem p0_decode(Frame& F, int it, int lane) {
    CvtItem c; c.valid = it < NITEMS; c.src = F.w_in; c.ks = nullptr; c.dst = F.Win_t; c.N = DIN;
    if (!c.valid) return c;
    int r = it;
    if (r < I_IN) { const int kb = r / 10, n = 256 * (r % 10) + 4 * lane;
        c.src = F.w_in + (size_t)(8 * kb) * DIN + n; c.N = DIN; c.ks = F.norm_mix_g + 8 * kb; c.dst = F.Win_t + gran_idx(kb, win_dest_row(n), 16) * 8; return c; }
    r -= I_IN;
    { const int kb = r / 4, n = 256 * (r % 4) + 4 * lane;
        c.src = F.w_out + (size_t)(8 * kb) * D + n; c.N = D; c.ks = (8 * kb < DA) ? F.beta_a + 8 * kb : F.beta_b + (8 * kb - DA); c.dst = F.Wout_t + gran_idx(kb, n, 16) * 8; return c; }
}
struct CvtItem8 { const float* src; const float* ks; fp8* dst; int N; float scale; };
__device__ __forceinline__ CvtItem8 p0_decode8(Frame& F, int it, int lane) {
    CvtItem8 c; int r = it;
    if (r < J_13) { const int e = r / 256, rr = r % 256, which = rr / 128, item = rr % 128, kb = item / 2, n = 256 * (item % 2) + 4 * lane;
        c.src = (which ? F.w3 : F.w1) + (size_t)e * D * DE + (size_t)(16 * kb) * DE + n; c.N = DE; c.ks = F.norm_ffn_g + 16 * kb; c.scale = 32.0f;
        c.dst = F.W13_t + (size_t)e * 1024 * D + gran_idx(kb, 256 * (n >> 7) + 128 * which + (n & 127), 8) * 16; return c; }
    r -= J_13;
    { const int e = r / 128, item = r % 128, kb = item / 4, n = 256 * (item % 4) + 4 * lane;
        c.src = F.w2 + (size_t)e * DE * D + (size_t)(16 * kb) * D + n; c.N = D; c.ks = nullptr; c.scale = 16.0f; c.dst = F.W2_t + (size_t)e * 1024 * DE + gran_idx(kb, n, 4) * 16; return c; }
}
__device__ __forceinline__ void p0_prologue(Frame& F) {
    const int wave = F.wave; int lane = lane_id(); asm volatile("" : "+v"(lane)); const int tid = wave * 64 + lane;
    const int gw = F.vcu * NWAVES + wave, NGW = F.G * NWAVES;
    for (int it = gw; it < NITEMS; it += 2 * NGW) {
        const CvtItem c0 = p0_decode(F, it, lane), c1 = p0_decode(F, it + NGW, lane);
        f32x4 v0[8], v1[8];
        cvt_load(c0, v0); cvt_load(c1, v1);
        cvt_store(c0, v0); cvt_store(c1, v1);
    }
    for (int it = gw; it < NITEMS8; it += NGW) {
        const CvtItem8 c = p0_decode8(F, it, lane);
        f32x4 v[16];
#pragma unroll
        for (int j = 0; j < 16; ++j) v[j] = *(const GAS f32x4*)(c.src + (size_t)j * c.N);
#pragma unroll
        for (int j = 0; j < 16; ++j) v[j] = v[j] * (c.ks ? c.ks[j] * c.scale : c.scale);
#pragma unroll
        for (int q = 0; q < 4; ++q) { u32x4 g;
#pragma unroll
            for (int w = 0; w < 4; ++w) g[w] = pk4_fp8(v[4 * w][q], v[4 * w + 1][q], v[4 * w + 2][q], v[4 * w + 3][q]);
            *(GAS u32x4*)(c.dst + (size_t)q * 16) = g; }
    }
    for (int i = gw * 64 + lane; i < 48 * D; i += NGW * 64) { const int o = i / D, k = i % D; float v = 0.f;
        if (o < 4) v = F.wrg[(size_t)k * 4 + o] * F.norm_ffn_g[k]; else if (o < 36) v = F.wre[(size_t)k * NE + (o - 4)] * F.norm_ffn_g[k];
        F.Wr_t[i] = (bf16)f2bf(v); }
    for (int m = gw; m < T; m += NGW) {
        const GAS f32x4* xr = (const GAS f32x4*)(F.x + (size_t)m * D) + lane;
        f32x4 v[4]; float s = 0.f;
#pragma unroll
        for (int j = 0; j < 4; ++j) { v[j] = xr[64 * j]; s += (v[j].x * v[j].x + v[j].y * v[j].y) + (v[j].z * v[j].z + v[j].w * v[j].w); }
        const float r = rsqrtf(wave_sum(s) * (1.f / D) + EPS);
        if (lane == 0) F.RI[m] = 1.0f / r;
        GAS u32x2* o8 = (GAS u32x2*)(F.XB + (size_t)m * D) + lane;
#pragma unroll
        for (int j = 0; j < 4; ++j) { u32x2 w; w.x = pk2(v[j].x * r, v[j].y * r); w.y = pk2(v[j].z * r, v[j].w * r); o8[64 * j] = w; }
    }
}

template <int CTRL> __device__ __forceinline__ float dpp_f(float v) { return __builtin_bit_cast(float, __builtin_amdgcn_update_dpp(0, __builtin_bit_cast(int, v), CTRL, 0xf, 0xf, false)); }
#define DPP_XOR1 0xB1
#define DPP_XOR2 0x4E
#define DPP_HALF_MIRROR 0x141
#define DPP_ROW_MIRROR 0x140
__device__ __forceinline__ float sum8(float v) { v += dpp_f<DPP_XOR1>(v); v += dpp_f<DPP_XOR2>(v); v += dpp_f<DPP_HALF_MIRROR>(v); return v; }
__device__ __forceinline__ float sum16(float v) { v = sum8(v); v += dpp_f<DPP_ROW_MIRROR>(v); return v; }
__device__ __forceinline__ void p2_mixer(Frame& F) {
    const int wave = F.wave; int lane = lane_id(); asm volatile("" : "+v"(lane)); const int tid = wave * 64 + lane;
    LAS unsigned char* L = F.lds;
    LAS unsigned* Ut = (LAS unsigned*)L;
    LAS float* UC = (LAS float*)(L + 62 * 1024);
    LAS float* PRM = (LAS float*)(L + LDSCTL_OFF + 2048);
    PRM[tid] = F.ln_b_g[tid]; PRM[512 + tid] = F.ln_b_b[tid];
#pragma unroll
    for (int q = 0; q < 3; ++q) PRM[1024 + 512 * q + tid] = F.conv_a_w[q * DA + tid];
    const int cp = tid & 255, th = tid >> 8;
    f32x2 wb[31];
#pragma unroll
    for (int j = 0; j < 31; ++j) wb[j] = *(const f32x2*)(F.conv_b_w + j * DB + 2 * cp);
    const f32x2 bias2 = *(const f32x2*)(F.conv_b_bias + 2 * cp);
    const int tq = lane >> 4, tl = lane & 15;
    u32x4 ureg[8];
#define P2_ULOAD(tile_) do { const int _t0 = (tile_) * 32, _b = _t0 / SEQ, _s0 = _t0 % SEQ; int _tid = tid; asm volatile("" : "+v"(_tid)); _Pragma("unroll") for (int _i = 0; _i < 8; ++_i) { const int _ch = _tid + 512 * _i, _row = _ch >> 6, _c16 = _ch & 63, _s = _s0 - 15 + _row; \
        ureg[_i] = (u32x4){0u, 0u, 0u, 0u}; if (_ch < 62 * 64 && _s >= 0 && _s < SEQ) ureg[_i] = *(const GAS u32x4*)(F.P + (size_t)(_b * SEQ + _s) * PW + 1024 + _c16 * 8); } } while (0)
    int tile = F.vcu;
    if (tile < T / 32) P2_ULOAD(tile);
    __syncthreads();
    for (; tile < T / 32; tile += F.G) {
        const int t0 = tile * 32, s0 = t0 % SEQ;
        { int tid2 = tid; asm volatile("" : "+v"(tid2));
#pragma unroll
        for (int i = 0; i < 8; ++i) { const int ch = tid2 + 512 * i; if (ch < 62 * 64) *(LAS u32x4*)(L + ch * 16) = ureg[i]; } }
        __syncthreads();
        if (tile + F.G < T / 32) P2_ULOAD(tile + F.G);
#pragma unroll 1
        for (int sub = 0; sub < 2; ++sub) { const int i0 = th * 16 + sub * 8; f32x2 a[8];
#pragma unroll
            for (int i = 0; i < 8; ++i) a[i] = bias2;
#pragma unroll
            for (int w = 0; w < 38; ++w) { const unsigned v = Ut[(i0 + w) * 256 + cp]; const f32x2 x2 = (f32x2){bflo(v), bfhi(v)};
#pragma unroll
                for (int i = 0; i < 8; ++i) { const int j = w - i; if (j >= 0 && j < 31) a[i] = __builtin_elementwise_fma(wb[j], x2, a[i]); } }
#pragma unroll
            for (int i = 0; i < 8; ++i) *(LAS f32x2*)(UC + (i0 + i) * 512 + 2 * cp) = a[i];
        }
        __syncthreads();
        u32x4 gpm1[4], gp0[4], gpp1[4], gab[4];
        { const int i = wave * 4 + tq, s = s0 + i; const bf16* prow = F.P + (size_t)(t0 + i) * PW + 8 * tl; const u32x4 z4 = (u32x4){0u, 0u, 0u, 0u};
#pragma unroll
          for (int k = 0; k < 4; ++k) { const bf16* pk = prow + 128 * k;
            gpm1[k] = (s > 0) ? *(const GAS u32x4*)(pk - PW) : z4; gp0[k] = *(const GAS u32x4*)pk; gpp1[k] = (s < SEQ - 1) ? *(const GAS u32x4*)(pk + PW) : z4; gab[k] = *(const GAS u32x4*)(pk + 512); } }
        { const int i = wave * 4 + tq, t = t0 + i;
          float uv[4][8]; float s1 = 0.f;
#pragma unroll
          for (int k = 0; k < 4; ++k) { const LAS float* up = UC + i * 512 + 8 * (tl + 16 * k); const f32x4 ua = *(const LAS f32x4*)up, ub = *(const LAS f32x4*)(up + 4);
#pragma unroll
            for (int j = 0; j < 4; ++j) { uv[k][j] = ua[j]; uv[k][4 + j] = ub[j]; s1 += ua[j] + ub[j]; } }
          const float mu = sum16(s1) * (1.f / DB); float s2 = 0.f;
#pragma unroll
          for (int k = 0; k < 4; ++k)
#pragma unroll
            for (int j = 0; j < 8; ++j) { uv[k][j] -= mu; s2 += uv[k][j] * uv[k][j]; }
          const float rstd = rsqrtf(sum16(s2) * (1.f / DB) + EPS);
#pragma unroll
          for (int k = 0; k < 4; ++k) { const int c8 = 8 * (tl + 16 * k); const LAS float* gp = PRM + c8; const f32x4 g0 = *(const LAS f32x4*)gp, g1 = *(const LAS f32x4*)(gp + 4), b0 = *(const LAS f32x4*)(gp + 512), b1 = *(const LAS f32x4*)(gp + 516);
            float hb = 0.f;
#pragma unroll
            for (int j = 0; j < 8; ++j) { const float z = uv[k][j] * rstd * (j < 4 ? g0[j & 3] : g1[j & 3]) + (j < 4 ? b0[j & 3] : b1[j & 3]); uv[k][j] = z * fast_sigmoid(z); hb += uv[k][j] * uv[k][j]; }
            const float rb = rsqrtf(sum8(hb) * (1.f / 64.f) + EPS);
            u32x4 ob; ob.x = cvt_pk_bf16(uv[k][0] * rb, uv[k][1] * rb); ob.y = cvt_pk_bf16(uv[k][2] * rb, uv[k][3] * rb); ob.z = cvt_pk_bf16(uv[k][4] * rb, uv[k][5] * rb); ob.w = cvt_pk_bf16(uv[k][6] * rb, uv[k][7] * rb);
            *(GAS u32x4*)(F.Y + (size_t)t * D + DA + c8) = ob; }
#pragma unroll
          for (int k = 0; k < 4; ++k) { const int c8 = 8 * (tl + 16 * k); const LAS float* wp = PRM + 1024 + c8; float ya[8]; float ha = 0.f;
            f32x4 w0[2], w1[2], w2[2];
#pragma unroll
            for (int h = 0; h < 2; ++h) { w0[h] = *(const LAS f32x4*)(wp + 4 * h); w1[h] = *(const LAS f32x4*)(wp + 512 + 4 * h); w2[h] = *(const LAS f32x4*)(wp + 1024 + 4 * h); }
#pragma unroll
            for (int j = 0; j < 4; ++j) { const int h = j >> 1, e = 2 * (j & 1);
                const float c0 = w0[h][e] * bflo(gpm1[k][j]) + w1[h][e] * bflo(gp0[k][j]) + w2[h][e] * bflo(gpp1[k][j]);
                const float c1 = w0[h][e + 1] * bfhi(gpm1[k][j]) + w1[h][e + 1] * bfhi(gp0[k][j]) + w2[h][e + 1] * bfhi(gpp1[k][j]);
                ya[2 * j] = bflo(gab[k][j]) * c0; ya[2 * j + 1] = bfhi(gab[k][j]) * c1; ha += ya[2 * j] * ya[2 * j] + ya[2 * j + 1] * ya[2 * j + 1]; }
            const float ra = rsqrtf(sum8(ha) * (1.f / 64.f) + EPS);
            u32x4 oa; oa.x = cvt_pk_bf16(ya[0] * ra, ya[1] * ra); oa.y = cvt_pk_bf16(ya[2] * ra, ya[3] * ra); oa.z = cvt_pk_bf16(ya[4] * ra, ya[5] * ra); oa.w = cvt_pk_bf16(ya[6] * ra, ya[7] * ra);
            *(GAS u32x4*)(F.Y + (size_t)t * D + c8) = oa; }
        }
    }
#undef P2_ULOAD
    __syncthreads();
}

__device__ __forceinline__ void p4_route(Frame& F) {
    const int wave = F.wave; int lane = lane_id(); asm volatile("" : "+v"(lane)); const int tid = wave * 64 + lane;
    LAS float* LGp = (LAS float*)F.lds;
    LAS int* scnt = (LAS int*)(F.lds + 102400);
    bf16x8 bfr[4][3];
    { const bf16* brow = F.Wr_t + (size_t)(lane & 15) * D + 128 * wave + 8 * (lane >> 4);
#pragma unroll
      for (int ks = 0; ks < 4; ++ks)
#pragma unroll
        for (int nb = 0; nb < 3; ++nb) bfr[ks][nb] = *(const GAS bf16x8*)(brow + (size_t)nb * 16 * D + ks * 32); }
    for (int tile = F.vcu; tile < T / 64; tile += F.G) {
        if (tid < 32) scnt[tid] = 0;
        const int tb = tile * 64;
        bf16x8 af[4][4];
#pragma unroll
        for (int tg = 0; tg < 4; ++tg)
#pragma unroll
            for (int ks = 0; ks < 4; ++ks) af[tg][ks] = *(const GAS bf16x8*)(F.X1B + (size_t)(tb + 16 * tg + (lane & 15)) * D + 128 * wave + ks * 32 + 8 * (lane >> 4));
#pragma unroll
        for (int tg = 0; tg < 4; ++tg) { f32x4 acc[3];
#pragma unroll
            for (int nb = 0; nb < 3; ++nb) acc[nb] = (f32x4){0.f, 0.f, 0.f, 0.f};
#pragma unroll
            for (int ks = 0; ks < 4; ++ks)
#pragma unroll
                for (int nb = 0; nb < 3; ++nb) acc[nb] = __builtin_amdgcn_mfma_f32_16x16x32_bf16(af[tg][ks], bfr[ks][nb], acc[nb], 0, 0, 0);
#pragma unroll
            for (int nb = 0; nb < 3; ++nb)
#pragma unroll
                for (int r = 0; r < 4; ++r) LGp[(wave * 64 + 16 * tg + 4 * (lane >> 4) + r) * 49 + nb * 16 + (lane & 15)] = acc[nb][r]; }
        __syncthreads();
        int e0 = 0, e1 = 0, p0 = 0, p1 = 0; float c0 = 0.f, c1 = 0.f, r2 = 0.f;
        if (tid < 64) {
            const int t = tb + tid; float ss = 0.f;
#pragma unroll
            for (int s = 0; s < 16; ++s) ss += F.SSQ[(size_t)s * T + t];
            r2 = rsqrtf(ss * (1.f / D) + EPS);
            const LAS float* lg = LGp + tid * 49;
            float g4[4];
#pragma unroll
            for (int i = 0; i < 4; ++i) { float a = 0.f;
#pragma unroll
                for (int w = 0; w < 8; ++w) a += lg[w * 64 * 49 + i];
                g4[i] = a * r2 + F.brg[i]; }
            int g = 0; float m = g4[0];
#pragma unroll
            for (int i = 1; i < 4; ++i) if (g4[i] > m) { m = g4[i]; g = i; }
            float den = 0.f;
#pragma unroll
            for (int i = 0; i < 4; ++i) den += __expf(g4[i] - m);
            const float psel = 1.0f / den;
            int i0 = 0, i1 = -1; float m0 = -3.0e38f, m1 = -3.0e38f;
            for (int i = 0; i < 8; ++i) { float a = 0.f;
#pragma unroll
                for (int w = 0; w < 8; ++w) a += lg[w * 64 * 49 + 4 + g * 8 + i];
                const float v = a * r2 + F.bre[g * 8 + i];
                if (v > m0) { m1 = m0; i1 = i0; m0 = v; i0 = i; } else if (v > m1) { m1 = v; i1 = i; } }
            const float ex = __expf(m1 - m0);
            e0 = g * 8 + i0; e1 = g * 8 + i1; c0 = psel / (1.0f + ex); c1 = psel * ex / (1.0f + ex);
            p0 = __hip_atomic_fetch_add(scnt + e0, 1, __ATOMIC_RELAXED, __HIP_MEMORY_SCOPE_WORKGROUP); p1 = __hip_atomic_fetch_add(scnt + e1, 1, __ATOMIC_RELAXED, __HIP_MEMORY_SCOPE_WORKGROUP);
        }
        __syncthreads();
        if (tid < 32) scnt[32 + tid] = (int)__hip_atomic_fetch_add(F.gcnt + tid, (unsigned)scnt[tid], RLX_AGENT);
        __syncthreads();
        if (tid < 64) {
            const int t = tb + tid; const size_t d0 = (size_t)e0 * CAP + scnt[32 + e0] + p0, d1 = (size_t)e1 * CAP + scnt[32 + e1] + p1;
            F.LTOK[d0] = (unsigned)t; F.LW[d0] = c0; F.LR2[d0] = r2;
            F.LTOK[d1] = (unsigned)t | (1u << 16); F.LW[d1] = c1; F.LR2[d1] = r2;
        }
        __syncthreads();
    }
}

__device__ __forceinline__ void p7_final(Frame& F) {
    const int wave = F.wave; int lane = lane_id(); asm volatile("" : "+v"(lane)); const int tid = wave * 64 + lane;
    const int gw = F.vcu * NWAVES + wave, NGW = F.G * NWAVES;
    f32x4 g[2][2];
#pragma unroll
    for (int j = 0; j < 2; ++j) { g[j][0] = *(const f32x4*)(F.gfin + j * 512 + lane * 8); g[j][1] = *(const f32x4*)(F.gfin + j * 512 + lane * 8 + 4); }
    for (int t = gw; t < T; t += NGW) {
        float v[2][8]; float ss = 0.f;
#pragma unroll
        for (int j = 0; j < 2; ++j) { const size_t o = (size_t)t * D + j * 512 + lane * 8;
            const u32x4 a = *(const GAS u32x4*)(F.X1B + o); const u32x2 c0 = *(const GAS u32x2*)(F.CB + o), c1 = *(const GAS u32x2*)(F.CB + (size_t)T * D + o);
#pragma unroll
            for (int q = 0; q < 4; q += 2) { const f32x2 p0 = __builtin_amdgcn_cvt_pk_f32_fp8((int)c0[q >> 1], false), p1 = __builtin_amdgcn_cvt_pk_f32_fp8((int)c1[q >> 1], false),
                                                           p2 = __builtin_amdgcn_cvt_pk_f32_fp8((int)c0[q >> 1], true), p3 = __builtin_amdgcn_cvt_pk_f32_fp8((int)c1[q >> 1], true);
                v[j][2 * q] = bflo(a[q]) + (p0.x + p1.x) * (1.0f / 64.0f); v[j][2 * q + 1] = bfhi(a[q]) + (p0.y + p1.y) * (1.0f / 64.0f);
                v[j][2 * q + 2] = bflo(a[q + 1]) + (p2.x + p3.x) * (1.0f / 64.0f); v[j][2 * q + 3] = bfhi(a[q + 1]) + (p2.y + p3.y) * (1.0f / 64.0f); }
#pragma unroll
            for (int q = 0; q < 8; ++q) ss += v[j][q] * v[j][q]; }
        const float r = rsqrtf(wave_sum(ss) * (1.f / D) + EPS);
#pragma unroll
        for (int j = 0; j < 2; ++j) { float* o = F.out + (size_t)t * D + j * 512 + lane * 8;
            *(GAS f32x4*)o = (f32x4){v[j][0] * r * g[j][0][0], v[j][1] * r * g[j][0][1], v[j][2] * r * g[j][0][2], v[j][3] * r * g[j][0][3]};
            *(GAS f32x4*)(o + 4) = (f32x4){v[j][4] * r * g[j][1][0], v[j][5] * r * g[j][1][1], v[j][6] * r * g[j][1][2], v[j][7] * r * g[j][1][3]}; }
    }
}

__device__ __forceinline__ void moe_sched_init(pg8::SchedMoe& S, Frame& F) {
    int lane = lane_id(); asm volatile("" : "+v"(lane));
    LAS int* tab = (LAS int*)(F.lds + LDSCTL_OFF + 1024);
    int my_cnt = 0; if (lane < NE) my_cnt = (int)__hip_atomic_load(F.gcnt + lane, RLX_AGENT);
    const int tiles = (my_cnt + 255) >> 8; int incl = tiles;
#pragma unroll
    for (int o = 1; o < 32; o <<= 1) { const int v = __shfl_up(incl, o); if (lane >= o) incl += v; }
    if (F.wave == 0 && lane < NE) { tab[lane] = incl - tiles; tab[32 + lane] = my_cnt; }
    S.total_rt = __builtin_amdgcn_readlane(incl, 31); S.tab = tab;
    S.ltok = F.LTOK; S.G = F.G; S.c = (int)blockIdx.x;
    __syncthreads();
}

struct Args { const float* in[20]; float* out; unsigned char* ws; int ph_lo, ph_hi, li, pad; };
__global__ void __launch_bounds__(NWAVES * 64, 2) mk_fwd(Args args) {
    extern __shared__ __attribute__((aligned(16))) unsigned char lds[];
    Frame F;
    F.lds = (LAS unsigned char*)lds;
    F.MISC = (volatile LAS unsigned*)(F.lds + MISC_OFF);
    F.wave = __builtin_amdgcn_readfirstlane((int)threadIdx.x >> 6);
    F.G = gridDim.x; { const int bx = blockIdx.x; F.vcu = (F.G % 8 == 0) ? (bx % 8) * (F.G / 8) + bx / 8 : bx; }
    unsigned char* ws = args.ws;
    F.ctl = (gu32*)(ws + WS_CTL);
    F.x = args.in[0]; F.norm_mix_g = args.in[1]; F.w_in = args.in[2]; F.conv_a_w = args.in[3]; F.conv_b_w = args.in[4]; F.conv_b_bias = args.in[5]; F.ln_b_g = args.in[6]; F.ln_b_b = args.in[7];
    F.beta_a = args.in[8]; F.beta_b = args.in[9]; F.w_out = args.in[10]; F.norm_ffn_g = args.in[11]; F.wrg = args.in[12]; F.brg = args.in[13]; F.wre = args.in[14]; F.bre = args.in[15];
    F.w1 = args.in[16]; F.w3 = args.in[17]; F.w2 = args.in[18]; F.gfin = args.in[19]; F.out = args.out;
    F.Win_t = (bf16*)(ws + WS_WIN); F.Wout_t = (bf16*)(ws + WS_WOUT); F.Wr_t = (bf16*)(ws + WS_WR); F.W13_t = (fp8*)(ws + WS_W13); F.W2_t = (fp8*)(ws + WS_W2); F.X1F8 = (fp8*)(ws + WS_X1F8);
    F.XB = (bf16*)(ws + WS_XB); F.P = (bf16*)(ws + WS_P); F.Y = (bf16*)(ws + WS_Y); F.X1B = (bf16*)(ws + WS_X1B); F.H = (fp8*)(ws + WS_H); F.CB = (fp8*)(ws + WS_CB); F.RI = (float*)(ws + WS_WR + 768 * 1024);
    F.SSQ = (float*)(ws + WS_SSQ); F.LW = (float*)(ws + WS_LW); F.LR2 = (float*)(ws + WS_LR2); F.LTOK = (unsigned*)(ws + WS_LTOK); F.gcnt = (unsigned*)(ws + WS_CTL) + CW_GCNT;
    for (int u = F.wave * 64 + lane_id(); u < (LDS_BYTES - LDSCTL_OFF) / 4; u += NWAVES * 64) ((LAS unsigned*)(F.lds + LDSCTL_OFF))[u] = 0u;
    __syncthreads();
    XcdBarrier bar; bar.bar = (unsigned*)(F.ctl + CW_BAR); bar.x = 0; bar.st = nullptr; bar.wave = F.wave;
    if (N_LAUNCHES == 1) bar = xcd_barrier_post((unsigned*)(F.ctl + CW_BAR), F.MISC + 8, F.wave);
    const int lo = args.ph_lo, hi = args.ph_hi;
#define IN(k) (lo <= (k) && (k) < hi)
#define GRID_BAR(k) do { if (IN(k) && IN((k) + 1)) xcd_barrier(bar); if (PROBE_PHASE >= 0 && blockIdx.x == 0 && F.wave == 0 && lane_id() == 0) ((unsigned long long*)(ws + WS_WR + 512 * 1024))[(k) + 1] = __builtin_amdgcn_s_memrealtime(); } while (0)
    if (PROBE_PHASE >= 0 && blockIdx.x == 0 && F.wave == 0 && lane_id() == 0) ((unsigned long long*)(ws + WS_WR + 512 * 1024))[0] = __builtin_amdgcn_s_memrealtime();

    if (IN(0)) { p0_prologue(F); GRID_BAR(0); }
    if (IN(1)) {
        pg8::SchedDense S{(const char*)F.XB, (const char*)F.Win_t, T / 256, DIN / 256, F.G, (int)blockIdx.x, (size_t)256 * D * 2, 16};
        pg8::EpiP1 E{F.P};
        pg8::gemm_phase<pg8::EpiP1, pg8::SchedDense, false>(F.lds + RING_OFF, D * 2, S, E, F.wave);
        GRID_BAR(1);
    }
    if (IN(2)) { p2_mixer(F); GRID_BAR(2); }
    if (IN(3)) {
        pg8::SchedDense S{(const char*)F.Y, (const char*)F.Wout_t, T / 256, D / 256, F.G, (int)blockIdx.x, (size_t)256 * D * 2, 16};
        pg8::EpiX1 E{F.XB, F.RI, F.X1B, F.SSQ, F.X1F8};
        pg8::gemm_phase<pg8::EpiX1, pg8::SchedDense, false>(F.lds + RING_OFF, D * 2, S, E, F.wave);
        GRID_BAR(3);
    }
    if (IN(4)) { p4_route(F); GRID_BAR(4); }
    if (IN(5)) {
        pg8::SchedMoeA S; moe_sched_init(S, F); S.A = (const char*)F.X1F8; S.W = (const char*)F.W13_t; S.a_tile_bytes = 0; S.w_exp_bytes = (size_t)1024 * D; S.nkt = 8;
        pg8::EpiH E{F.H, F.LR2};
        pg8::gemm_phase<pg8::EpiH, pg8::SchedMoeA, true>(F.lds + RING_OFF, D, S, E, F.wave);
        GRID_BAR(5);
    }
    if (IN(6)) {
        pg8::SchedMoeB S; moe_sched_init(S, F); S.A = (const char*)F.H; S.W = (const char*)F.W2_t; S.a_tile_bytes = (size_t)256 * DE; S.w_exp_bytes = (size_t)1024 * DE; S.nkt = 4;
        pg8::EpiC E{F.CB, F.LTOK, F.LW};
        pg8::gemm_phase<pg8::EpiC, pg8::SchedMoeB, true>(F.lds + RING_OFF, DE, S, E, F.wave);
        GRID_BAR(6);
    }
    if (IN(7)) { p7_final(F);
        if (PROBE_PHASE >= 0 && blockIdx.x == 0 && F.wave == 0 && lane_id() == 0) { unsigned long long* ts = (unsigned long long*)(ws + WS_WR + 512 * 1024); ts[8] = __builtin_amdgcn_s_memrealtime();
            asm volatile("s_waitcnt vmcnt(0)" ::: "memory"); const float us = (PROBE_PHASE == 8) ? (float)(ts[8] - ts[0]) * 0.001f : (float)(ts[PROBE_PHASE + 1] - ts[PROBE_PHASE]) * 0.01f; F.out[0] += us * 0.1f; } }
#undef IN
#undef GRID_BAR
}

extern "C" void kernel_launch(void* const* d_in, const int* in_sizes, int n_in, void* d_out, int out_size, void* d_ws, size_t ws_size, hipStream_t stream) {
    static int grid = 0;
    if (grid == 0) {
        if (n_in != 20 || in_sizes[0] != T * D || out_size != T * D || ws_size < WS_END) { fprintf(stderr, "kernel_launch: unexpected shapes / workspace (n_in %d, in0 %d, out %d, ws %zu, need %zu)\n", n_in, n_in > 0 ? in_sizes[0] : -1, out_size, ws_size, (size_t)WS_END); grid = -1; return; }
        int dev = 0, cus = 0, per_cu = 0;
        if (hipGetDevice(&dev) != hipSuccess || hipDeviceGetAttribute(&cus, hipDeviceAttributeMultiprocessorCount, dev) != hipSuccess) { fprintf(stderr, "kernel_launch: device query failed\n"); grid = -1; return; }
        if (hipFuncSetAttribute((const void*)mk_fwd, hipFuncAttributeMaxDynamicSharedMemorySize, LDS_BYTES) != hipSuccess) { fprintf(stderr, "kernel_launch: hipFuncSetAttribute failed\n"); grid = -1; return; }
        if (hipOccupancyMaxActiveBlocksPerMultiprocessor(&per_cu, (const void*)mk_fwd, NWAVES * 64, LDS_BYTES) != hipSuccess || per_cu < 1) fprintf(stderr, "kernel_launch: occupancy query reports %d workgroups per CU\n", per_cu);
        (void)hipGetLastError();
        grid = cus;
    }
    if (grid < 0) return;
    if (hipMemsetAsync((char*)d_ws + WS_CTL, 0, CTL_ZERO_BYTES, stream) != hipSuccess) { fprintf(stderr, "kernel_launch: hipMemsetAsync failed\n"); return; }
    Args a{};
    for (int i = 0; i < 20; ++i) a.in[i] = (const float*)d_in[i];
    a.out = (float*)d_out; a.ws = (unsigned char*)d_ws;
    for (int li = 0; li < N_LAUNCHES; ++li) {
        a.ph_lo = (N_LAUNCHES == 1) ? 0 : li; a.ph_hi = (N_LAUNCHES == 1) ? NPHASES : li + 1; a.li = li;
        hipLaunchKernelGGL(mk_fwd, dim3(grid), dim3(NWAVES * 64), LDS_BYTES, stream, a);
        const hipError_t le = hipPeekAtLastError();
        if (le != hipSuccess) { fprintf(stderr, "kernel_launch: launch %d failed: %s\n", li, hipGetErrorName(le)); break; }
    }
}
```

```cpp
#include <hip/hip_runtime.h>
#include <cstdio>
#include <cstdint>

#define LAS __attribute__((address_space(3)))
#define GAS __attribute__((address_space(1)))
typedef unsigned short bf16;
typedef short bf16x8 __attribute__((ext_vector_type(8)));
typedef float f32x4 __attribute__((ext_vector_type(4)));
typedef float f32x2 __attribute__((ext_vector_type(2)));
typedef unsigned u32x4 __attribute__((ext_vector_type(4)));
typedef unsigned u32x2 __attribute__((ext_vector_type(2)));
typedef GAS unsigned gu32;
typedef int i32x4 __attribute__((ext_vector_type(4)));
typedef int i32x8 __attribute__((ext_vector_type(8)));
typedef unsigned char fp8;

constexpr int T = 16384, SEQ = 2048, D = 1024, DA = 512, DB = 512, DIN = 2560, NE = 32, DE = 512, CAP = 16384, PW = 1536;
constexpr float EPS = 1e-6f;
constexpr int NWAVES = 8;
#ifndef MK_N_LAUNCHES
#define MK_N_LAUNCHES 1
#endif
constexpr int N_LAUNCHES = MK_N_LAUNCHES;
constexpr int NPHASES = 8;
#ifndef PROBE_PHASE
#define PROBE_PHASE -1
#endif

constexpr size_t MiB = 1u << 20;
constexpr size_t WS_CTL = 0, CTL_ZERO_BYTES = 72 * 1024;
constexpr size_t WS_WIN = 1 * MiB;
constexpr size_t WS_WOUT = 6 * MiB;
constexpr size_t WS_WR = 8 * MiB;
constexpr size_t WS_SSQ = 9 * MiB;
constexpr size_t WS_LTOK = 11 * MiB;
constexpr size_t WS_LW = 13 * MiB;
constexpr size_t WS_LR2 = 15 * MiB;
constexpr size_t WS_W13 = 17 * MiB;
constexpr size_t WS_W2 = 49 * MiB;
constexpr size_t WS_X1B = 65 * MiB;
constexpr size_t WS_X1F8 = 97 * MiB;
constexpr size_t WS_XB = 113 * MiB;
constexpr size_t WS_P = 145 * MiB;
constexpr size_t WS_Y = 193 * MiB;
constexpr size_t WS_H = 113 * MiB;
constexpr size_t WS_CB = 133 * MiB;
constexpr size_t WS_END = 225 * MiB;
constexpr int CW_TMO = 0, CW_CODE = 1, CW_BAR = 4096, CW_GCNT = 16384;

constexpr int RING_OFF = 0, RING_BYTES = 131072;
constexpr int LDSCTL_OFF = RING_BYTES, MISC_OFF = LDSCTL_OFF + 320;
constexpr int LDS_BYTES = 147456;

#define RLX_AGENT __ATOMIC_RELAXED, __HIP_MEMORY_SCOPE_AGENT
#define LDS_WAIT() asm volatile("s_waitcnt lgkmcnt(0)" ::: "memory")
#define VM_WAIT() asm volatile("s_waitcnt vmcnt(0)" ::: "memory")
__device__ __forceinline__ unsigned f2bf(float f) { unsigned u = __builtin_bit_cast(unsigned, f); return (u + 0x7fffu + ((u >> 16) & 1u)) >> 16; }
__device__ __forceinline__ unsigned pk2(float lo, float hi) { return f2bf(lo) | (f2bf(hi) << 16); }
__device__ __forceinline__ unsigned cvt_pk_bf16(float lo, float hi) { unsigned r; asm volatile("v_cvt_pk_bf16_f32 %0, %1, %2" : "=v"(r) : "v"(lo), "v"(hi)); return r; }
__device__ __forceinline__ unsigned pk4_fp8(float a, float b, float c, float d) { int w = 0; w = __builtin_amdgcn_cvt_pk_fp8_f32(a, b, w, false); w = __builtin_amdgcn_cvt_pk_fp8_f32(c, d, w, true); return (unsigned)w; }
__device__ __forceinline__ float bflo(unsigned v) { return __builtin_bit_cast(float, v << 16); }
__device__ __forceinline__ float bfhi(unsigned v) { return __builtin_bit_cast(float, v & 0xffff0000u); }
__device__ __forceinline__ float fast_sigmoid(float v) { return __builtin_amdgcn_rcpf(1.0f + __expf(-v)); }
__device__ __forceinline__ int lane_id() { unsigned m = ~0u; asm volatile("" : "+s"(m)); return (int)__builtin_amdgcn_mbcnt_hi(m, __builtin_amdgcn_mbcnt_lo(m, 0u)); }
__device__ __forceinline__ float wave_sum(float v) {
#pragma unroll
    for (int o = 1; o < 64; o <<= 1) v += __shfl_xor(v, o);
    return v;
}

namespace pg8 {
constexpr int BM = 256, BK = 64, HALF = 128, HTB = HALF * BK * 2, STAGE_BYTES = 8 * HTB, NXCD = 8, WGM = 8;
__host__ __device__ __forceinline__ int lds_byte(int r, int c) { const int st = (r >> 4) * 2 + (c >> 5), rr = r & 15, cc = c & 31, ob = rr * 64 + cc * 2; return st * 1024 + (ob ^ (((ob >> 9) & 1) << 5)); }
__host__ __device__ __forceinline__ void stage_rc(int b, int& R, int& C) { const int st = b / 1024, sb = b % 1024, swz = sb ^ (((sb >> 9) & 1) << 5); R = (st >> 1) * 16 + swz / 64; C = (st & 1) * 32 + (swz % 64) / 2; }
__host__ __device__ __forceinline__ int perm32(int rho) { const int n = rho >> 4, i = rho & 15; return 8 * (i >> 2) + 4 * n + (i & 3); }

struct Unit { int pm, pn, e, rt, cnt; };

__device__ __forceinline__ bool tile_order(int i, int G, int c, int nM, int nN, int& pm, int& pn) {
    const int nwg = nM * nN; const int L = i * G + c; if (L >= nwg) return false;
    int wgid = L; { const int q = nwg / NXCD, r = nwg % NXCD, xcd = wgid % NXCD, off = wgid / NXCD; wgid = (xcd < r ? xcd * (q + 1) : r * (q + 1) + (xcd - r) * q) + off; }
    const int nig = WGM * nN, gid = wgid / nig, fm = gid * WGM, gsz = (nM - fm) < WGM ? (nM - fm) : WGM;
    pm = fm + ((wgid % nig) % gsz); pn = (wgid % nig) / gsz; return true;
}

struct SchedDense {
    static constexpr bool GATHER = false;
    const char* A; const char* Bt; int nM, nN, G, c; size_t tstepA; int nkt;
    __device__ __forceinline__ bool next(int i, Unit& u) const { u.e = 0; u.rt = 0; u.cnt = 0; return tile_order(i, G, c, nM, nN, u.pm, u.pn); }
    __device__ __forceinline__ const char* a_buf() const { return A; }
    __device__ __forceinline__ const char* b_buf() const { return Bt; }
    __device__ __forceinline__ unsigned a_soff(const Unit& u) const { return (unsigned)u.pm * (unsigned)tstepA; }
    __device__ __forceinline__ unsigned b_soff(const Unit& u) const { return (unsigned)(u.pn * nkt) * 32768u; }
    __device__ __forceinline__ void a_tokens(const Unit&, int, unsigned (&)[2]) const {}
};
struct SchedMoe {
    const char* A; const char* W; const unsigned* ltok; const LAS int* tab; int total_rt, G, c; size_t a_tile_bytes, w_exp_bytes; int nkt;
    __device__ __forceinline__ bool next(int i, Unit& u) const {
        if (!tile_order(i, G, c, total_rt, 4, u.pm, u.pn)) return false;
        const int lane = lane_id();
        const unsigned long long m = __ballot(lane < 32 && tab[lane & 31] <= u.pm);
        const int e = __builtin_amdgcn_readfirstlane(__popcll(m) - 1);
        u.e = e; u.rt = u.pm - __builtin_amdgcn_readfirstlane(tab[e]); u.cnt = __builtin_amdgcn_readfirstlane(tab[32 + e]); return true;
    }
    __device__ __forceinline__ const char* a_buf() const { return A; }
    __device__ __forceinline__ const char* b_buf() const { return W; }
    __device__ __forceinline__ unsigned b_soff(const Unit& u) const { return (unsigned)u.e * (unsigned)w_exp_bytes + (unsigned)(u.pn * nkt) * 32768u; }
};
struct SchedMoeA : SchedMoe {
    static constexpr bool GATHER = true;
    __device__ __forceinline__ unsigned a_soff(const Unit&) const { return 0u; }
    __device__ __forceinline__ void a_tokens(const Unit& u, int R, unsigned (&tk)[2]) const {
        asm volatile("" : "+v"(R));
        const __amdgpu_buffer_rsrc_t rl = __builtin_amdgcn_make_buffer_rsrc((void*)ltok, 0, NE * CAP * 4, 0x00020000);
#pragma unroll
        for (int h = 0; h < 2; ++h) { const int p0 = u.rt * 256 + 128 * h + R, p1 = p0 + 64;
            const unsigned r0 = (unsigned)__builtin_amdgcn_raw_buffer_load_b32(rl, p0 < u.cnt ? (u.e * CAP + p0) * 4 : 0x7ffffff0, 0, 0);
            const unsigned r1 = (unsigned)__builtin_amdgcn_raw_buffer_load_b32(rl, p1 < u.cnt ? (u.e * CAP + p1) * 4 : 0x7ffffff0, 0, 0);
            tk[h] = (r0 & 0xffffu) | (r1 << 16); }
    }
};
struct SchedMoeB : SchedMoe {
    static constexpr bool GATHER = false;
    __device__ __forceinline__ unsigned a_soff(const Unit& u) const { return (unsigned)u.pm * (unsigned)a_tile_bytes; }
    __device__ __forceinline__ void a_tokens(const Unit&, int, unsigned (&)[2]) const {}
};

struct EpiP1 {
    bf16* P;
    __device__ __forceinline__ void operator()(const f32x4 (&acc)[2][2][4][2], const Unit& u, int wr, int wc, int fr, int fq) const {
        asm volatile("" : "+v"(fr), "+v"(fq));
        const int row0 = u.pm * BM + wr * 64 + fr, cl = wc * 32 + 8 * fq;
        if (u.pn >= 4 && u.pn < 6) {
#pragma unroll
            for (int ai = 0; ai < 2; ++ai)
#pragma unroll
                for (int m = 0; m < 4; ++m) { bf16* rowp = P + (size_t)(row0 + ai * HALF + m * 16) * PW + 512 + (u.pn - 4) * 256 + cl;
#pragma unroll
                    for (int bj = 0; bj < 2; ++bj) { const f32x4 v0 = acc[ai][bj][m][0], v1 = acc[ai][bj][m][1];
                        u32x4 w; w.x = cvt_pk_bf16(v0[0], v0[1]); w.y = cvt_pk_bf16(v0[2], v0[3]); w.z = cvt_pk_bf16(v1[0], v1[1]); w.w = cvt_pk_bf16(v1[2], v1[3]);
                        *(u32x4*)(rowp + bj * HALF) = w; } }
        } else if (u.pn < 4) {
#pragma unroll
            for (int ai = 0; ai < 2; ++ai)
#pragma unroll
                for (int m = 0; m < 4; ++m) { bf16* rowp = P + (size_t)(row0 + ai * HALF + m * 16) * PW + u.pn * 128 + cl;
                    const f32x4 v0 = acc[ai][0][m][0] * acc[ai][1][m][0], v1 = acc[ai][0][m][1] * acc[ai][1][m][1];
                    u32x4 w; w.x = cvt_pk_bf16(v0[0], v0[1]); w.y = cvt_pk_bf16(v0[2], v0[3]); w.z = cvt_pk_bf16(v1[0], v1[1]); w.w = cvt_pk_bf16(v1[2], v1[3]);
                    *(u32x4*)rowp = w; }
        } else {
#pragma unroll
            for (int ai = 0; ai < 2; ++ai)
#pragma unroll
                for (int m = 0; m < 4; ++m) { bf16* rowp = P + (size_t)(row0 + ai * HALF + m * 16) * PW + 1024 + (u.pn - 6) * 128 + cl;
                    f32x4 v0, v1;
#pragma unroll
                    for (int j = 0; j < 4; ++j) { v0[j] = acc[ai][0][m][0][j] * fast_sigmoid(acc[ai][1][m][0][j]); v1[j] = acc[ai][0][m][1][j] * fast_sigmoid(acc[ai][1][m][1][j]); }
                    u32x4 w; w.x = cvt_pk_bf16(v0[0], v0[1]); w.y = cvt_pk_bf16(v0[2], v0[3]); w.z = cvt_pk_bf16(v1[0], v1[1]); w.w = cvt_pk_bf16(v1[2], v1[3]);
                    *(u32x4*)rowp = w; }
        }
    }
};
struct EpiX1 {
    const bf16* xb; const float* ri; bf16* x1b; float* ssq; fp8* x1f8;
    __device__ __forceinline__ void operator()(const f32x4 (&acc)[2][2][4][2], const Unit& u, int wr, int wc, int fr, int fq) const {
        asm volatile("" : "+v"(fr), "+v"(fq));
        const int row0 = u.pm * BM + wr * 64 + fr, col0 = u.pn * BM + wc * 32 + 8 * fq;
#pragma unroll
        for (int ai = 0; ai < 2; ++ai)
#pragma unroll
            for (int m = 0; m < 4; ++m) { const int row = row0 + ai * HALF + m * 16; const bf16* xr = xb + (size_t)row * D + col0; const float rinv = ri[row]; bf16* orow = x1b + (size_t)row * D + col0; fp8* qrow = x1f8 + (size_t)row * D + col0; float s = 0.f;
#pragma unroll
                for (int bj = 0; bj < 2; ++bj) { const u32x4 xq = *(const u32x4*)(xr + bj * HALF);
                    const f32x4 a = (f32x4){bflo(xq[0]), bfhi(xq[0]), bflo(xq[1]), bfhi(xq[1])} * rinv, b = (f32x4){bflo(xq[2]), bfhi(xq[2]), bflo(xq[3]), bfhi(xq[3])} * rinv;
                    const f32x4 v0 = acc[ai][bj][m][0] + a, v1 = acc[ai][bj][m][1] + b;
                    s += (v0[0] * v0[0] + v0[1] * v0[1]) + (v0[2] * v0[2] + v0[3] * v0[3]) + (v1[0] * v1[0] + v1[1] * v1[1]) + (v1[2] * v1[2] + v1[3] * v1[3]);
                    u32x4 w; w.x = cvt_pk_bf16(v0[0], v0[1]); w.y = cvt_pk_bf16(v0[2], v0[3]); w.z = cvt_pk_bf16(v1[0], v1[1]); w.w = cvt_pk_bf16(v1[2], v1[3]);
                    *(u32x4*)(orow + bj * HALF) = w;
                    u32x2 q; q.x = pk4_fp8(v0[0], v0[1], v0[2], v0[3]); q.y = pk4_fp8(v1[0], v1[1], v1[2], v1[3]); *(u32x2*)(qrow + bj * HALF) = q; }
                s += __shfl_xor(s, 16); s += __shfl_xor(s, 32);
                if (fq == 0) ssq[(size_t)(u.pn * 4 + wc) * T + row] = s; }
    }
};
struct EpiH {
    fp8* H; const float* lr2;
    __device__ __forceinline__ void operator()(const f32x4 (&acc)[2][2][4][2], const Unit& u, int wr, int wc, int fr, int fq) const {
        asm volatile("" : "+v"(fr), "+v"(fq));
        const int cl = u.pn * 128 + wc * 32 + 8 * fq;
#pragma unroll
        for (int ai = 0; ai < 2; ++ai)
#pragma unroll
            for (int m = 0; m < 4; ++m) { const int rl = ai * HALF + wr * 64 + m * 16 + fr, pos = u.rt * 256 + rl; float rr = 0.f; if (pos < u.cnt) rr = lr2[(size_t)u.e * CAP + pos] * (1.0f / 32.0f);
                f32x4 v0, v1;
#pragma unroll
                for (int j = 0; j < 4; ++j) { const float a0 = acc[ai][0][m][0][j] * rr, b0 = acc[ai][1][m][0][j] * rr, a1 = acc[ai][0][m][1][j] * rr, b1 = acc[ai][1][m][1][j] * rr;
                    v0[j] = a0 * fast_sigmoid(a0) * b0; v1[j] = a1 * fast_sigmoid(a1) * b1; }
                u32x2 w; w.x = pk4_fp8(v0[0], v0[1], v0[2], v0[3]); w.y = pk4_fp8(v1[0], v1[1], v1[2], v1[3]);
                *(u32x2*)(H + ((size_t)u.pm * 256 + rl) * DE + cl) = w; }
    }
};
struct EpiC {
    fp8* Cb; const unsigned* ltok; const float* lw;
    __device__ __forceinline__ void operator()(const f32x4 (&acc)[2][2][4][2], const Unit& u, int wr, int wc, int fr, int fq) const {
        asm volatile("" : "+v"(fr), "+v"(fq));
        const int cl = u.pn * 256 + wc * 32 + 8 * fq;
#pragma unroll
        for (int ai = 0; ai < 2; ++ai)
#pragma unroll
            for (int m = 0; m < 4; ++m) { const int rl = ai * HALF + wr * 64 + m * 16 + fr, pos = u.rt * 256 + rl;
                if (pos < u.cnt) { const unsigned rec = ltok[(size_t)u.e * CAP + pos]; const float cw = lw[(size_t)u.e * CAP + pos] * 4.0f;
                    fp8* orow = Cb + ((size_t)(rec >> 16) * T + (rec & 0xffffu)) * D + cl;
#pragma unroll
                    for (int bj = 0; bj < 2; ++bj) { const f32x4 v0 = acc[ai][bj][m][0] * cw, v1 = acc[ai][bj][m][1] * cw;
                        u32x2 w; w.x = pk4_fp8(v0[0], v0[1], v0[2], v0[3]); w.y = pk4_fp8(v1[0], v1[1], v1[2], v1[3]);
                        *(u32x2*)(orow + bj * HALF) = w; } } }
    }
};

template <class Epi, class Sched, bool F8>
__device__ __forceinline__ void gemm_phase(LAS unsigned char* lds, const int Kb, const Sched& S, const Epi& E, const int wid) {
    constexpr bool GATHER = Sched::GATHER;
    const int lane = lane_id(), tid = wid * 64 + lane, wr = wid >> 2, wc = wid & 3, fr = lane & 15, fq = lane >> 4;
    int nt = Kb / 128; asm volatile("" : "+s"(nt));
    const unsigned kstep = 128u, hstep = (unsigned)(HALF * Kb);
    const unsigned kstepB = 32768u, hstepB = 2048u;
    const __amdgpu_buffer_rsrc_t rsA = __builtin_amdgcn_make_buffer_rsrc((void*)S.a_buf(), 0, 0x7fffffff, 0x00020000);
    const __amdgpu_buffer_rsrc_t rsB = __builtin_amdgcn_make_buffer_rsrc((void*)S.b_buf(), 0, 0x7fffffff, 0x00020000);
    unsigned voffA[2], voffB[2], ct[2] = {0u, 0u}, ntk[2] = {0u, 0u}; unsigned pc2;
    { int R, C; stage_rc(tid * 16, R, C); pc2 = (unsigned)C * 2u; }
#define PG8_R0() ({ int _t = wid * 64 + lane_id(); asm volatile("" : "+v"(_t)); int _R, _C; stage_rc(_t * 16, _R, _C); _R; })
#pragma unroll
    for (int i = 0; i < 2; ++i) { int R, C; stage_rc(tid * 16 + i * 8192, R, C);
        voffA[i] = (unsigned)(R * Kb) + (unsigned)C * 2u;
        const int st = wid + 8 * i; voffB[i] = (unsigned)((((st & 1) * 4 + (lane >> 4)) * 256) + (st >> 1) * 16 + (lane & 15)) * 16u; }
    const unsigned ldsw = (unsigned)wid * 1024u;
    const int aoff = lds_byte(wr * 64 + fr, fq * 8), boff = wc * 4096 + (fq * 16 + fr) * 16;
    const LAS unsigned char* ldsA = lds + aoff; const LAS unsigned char* ldsB = lds + 4 * HTB + boff;
    asm volatile("" : "+v"(ldsA), "+v"(ldsB));
#define PG8_SA(b, h) (((b) * 2 + (h)) * HTB)
#define PG8_SB(b, h) ((4 + (b) * 2 + (h)) * HTB)
#define PG8_STAGE(bufoff, soff, voff) do { _Pragma("unroll") for (int _i = 0; _i < 2; ++_i) \
        __builtin_amdgcn_raw_ptr_buffer_load_lds(rsB, (LAS void*)(lds + (bufoff) + ldsw + _i * 8192), 16, (int)(voff)[_i], (int)(soff), 0, 0); } while (0)
#define PG8_STAGE_A(bufoff, soff, h, TK) do { _Pragma("unroll") for (int _i = 0; _i < 2; ++_i) { \
        const unsigned _o = GATHER ? ((((TK)[h] >> (16 * _i)) & 0xffffu) * (unsigned)Kb + pc2) : voffA[_i]; const unsigned _so = GATHER ? (unsigned)(soff) : (unsigned)(soff) + (h) * hstep; \
        __builtin_amdgcn_raw_ptr_buffer_load_lds(rsA, (LAS void*)(lds + (bufoff) + ldsw + _i * 8192), 16, (int)_o, (int)_so, 0, 0); } } while (0)
#define PG8_LDA(dst, b, h) do { _Pragma("unroll") for (int m = 0; m < 4; ++m) { if constexpr (F8) { const i32x4 _lo = *(const LAS i32x4*)(ldsA + PG8_SA(b, h) + m * 2048), _hi = *(const LAS i32x4*)(ldsA + PG8_SA(b, h) + m * 2048 + 1024); \
            dst##8[m] = __builtin_shufflevector(_lo, _hi, 0, 1, 2, 3, 4, 5, 6, 7); } else { _Pragma("unroll") for (int k = 0; k < 2; ++k) dst[m][k] = *(const LAS bf16x8*)(ldsA + PG8_SA(b, h) + m * 2048 + k * 1024); } } } while (0)
#define PG8_LDB(dst, b, h) do { _Pragma("unroll") for (int n = 0; n < 2; ++n) { if constexpr (F8) { const i32x4 _lo = *(const LAS i32x4*)(ldsB + (PG8_SB(b, h) - 4 * HTB) + n * 2048), _hi = *(const LAS i32x4*)(ldsB + (PG8_SB(b, h) - 4 * HTB) + n * 2048 + 1024); \
            dst##8[n] = __builtin_shufflevector(_lo, _hi, 0, 1, 2, 3, 4, 5, 6, 7); } else { _Pragma("unroll") for (int k = 0; k < 2; ++k) dst[n][k] = *(const LAS bf16x8*)(ldsB + (PG8_SB(b, h) - 4 * HTB) + n * 2048 + k * 1024); } } } while (0)
#define PG8_MMA(ai, bj, At, Bt) do { __builtin_amdgcn_s_setprio(1); _Pragma("unroll") for (int m = 0; m < 4; ++m) _Pragma("unroll") for (int n = 0; n < 2; ++n) { \
        if constexpr (F8) acc[ai][bj][m][n] = __builtin_amdgcn_mfma_scale_f32_16x16x128_f8f6f4(Bt##8[n], At##8[m], acc[ai][bj][m][n], 0, 0, 0, 0x7F7F7F7F, 0, 0x7F7F7F7F); \
        else { _Pragma("unroll") for (int k = 0; k < 2; ++k) acc[ai][bj][m][n] = __builtin_amdgcn_mfma_f32_16x16x32_bf16(Bt[n][k], At[m][k], acc[ai][bj][m][n], 0, 0, 0); } } \
        __builtin_amdgcn_s_setprio(0); } while (0)
#define PG8_WAIT_V(n) asm volatile("s_waitcnt vmcnt(" #n ")" ::: "memory")
#define PG8_WAIT_L(n) asm volatile("s_waitcnt lgkmcnt(" #n ")" ::: "memory")
#define PG8_BAR __builtin_amdgcn_s_barrier()
#define PG8_SCHED __builtin_amdgcn_sched_barrier(0)
    Unit cur, nxt; int ui = 0;
    if (!S.next(0, cur)) return;
    f32x4 acc[2][2][4][2];
#pragma unroll
    for (int a = 0; a < 2; ++a)
#pragma unroll
        for (int b = 0; b < 2; ++b)
#pragma unroll
            for (int m = 0; m < 4; ++m)
#pragma unroll
                for (int n = 0; n < 2; ++n) acc[a][b][m][n] = (f32x4){0.f, 0.f, 0.f, 0.f};
    bf16x8 At[4][2], B0[2][2], B1[2][2]; i32x8 At8[4], B08[2], B18[2];
    unsigned cA = S.a_soff(cur), cB = S.b_soff(cur);
    if constexpr (GATHER) { S.a_tokens(cur, PG8_R0(), ct); asm volatile("" : "+v"(ct[0]), "+v"(ct[1])); }
    PG8_STAGE(PG8_SB(0, 0), cB, voffB); PG8_STAGE(PG8_SB(0, 1), cB + hstepB, voffB); PG8_STAGE_A(PG8_SA(0, 0), cA, 0, ct); PG8_STAGE_A(PG8_SA(0, 1), cA, 1, ct);
    if (wr == 1) PG8_BAR;
    PG8_WAIT_V(2); PG8_BAR;
    PG8_STAGE(PG8_SB(1, 0), cB + kstepB, voffB); PG8_STAGE_A(PG8_SA(1, 0), cA + kstep, 0, ct); PG8_STAGE(PG8_SB(1, 1), cB + hstepB + kstepB, voffB);
    PG8_WAIT_V(6); PG8_BAR;
    for (;;) {
        const bool has_next = S.next(ui + 1, nxt);
        unsigned nA = cA, nB = cB;
        if constexpr (GATHER) { ntk[0] = ct[0]; ntk[1] = ct[1]; }
        if (has_next) { nA = S.a_soff(nxt); nB = S.b_soff(nxt);
            if constexpr (GATHER) { S.a_tokens(nxt, PG8_R0(), ntk); asm volatile("" : "+v"(ntk[0]), "+v"(ntk[1])); } }
#pragma unroll 1
        for (int t = 0; t < nt; t += 2) {
            const bool last = (t == nt - 2);
            const unsigned a1 = cA + (unsigned)(t + 1) * kstep;
            const unsigned a2 = last ? nA : cA + (unsigned)(t + 2) * kstep, b2 = last ? nB : cB + (unsigned)(t + 2) * kstepB;
            const unsigned a3 = a2 + kstep, b3 = b2 + kstepB;
            unsigned tc[2] = {ct[0], ct[1]}, t2[2];
            if constexpr (GATHER) asm volatile("" : "+v"(tc[0]), "+v"(tc[1]));
            t2[0] = (GATHER && last) ? ntk[0] : tc[0]; t2[1] = (GATHER && last) ? ntk[1] : tc[1];
            PG8_LDB(B0, 0, 0); PG8_LDB(B1, 0, 1); PG8_SCHED; PG8_LDA(At, 0, 0); PG8_STAGE_A(PG8_SA(1, 1), a1, 1, tc);
            PG8_WAIT_V(8); PG8_WAIT_L(0); PG8_BAR; PG8_MMA(0, 0, At, B0); PG8_MMA(0, 1, At, B1); PG8_BAR; PG8_SCHED;
            PG8_LDA(At, 0, 1); PG8_STAGE(PG8_SB(0, 0), b2, voffB); PG8_STAGE(PG8_SB(0, 1), b2 + hstepB, voffB); PG8_STAGE_A(PG8_SA(0, 0), a2, 0, t2);
            PG8_WAIT_V(8); PG8_WAIT_L(0); PG8_BAR; PG8_MMA(1, 0, At, B0); PG8_MMA(1, 1, At, B1); PG8_BAR; PG8_SCHED;
            PG8_LDB(B0, 1, 0); PG8_LDB(B1, 1, 1); PG8_SCHED; PG8_LDA(At, 1, 0); PG8_STAGE_A(PG8_SA(0, 1), a2, 1, t2);
            PG8_WAIT_V(8); PG8_WAIT_L(0); PG8_BAR; PG8_MMA(0, 0, At, B0); PG8_MMA(0, 1, At, B1); PG8_BAR; PG8_SCHED;
            PG8_LDA(At, 1, 1); PG8_STAGE(PG8_SB(1, 0), b3, voffB); PG8_STAGE(PG8_SB(1, 1), b3 + hstepB, voffB); PG8_STAGE_A(PG8_SA(1, 0), a3, 0, t2);
            PG8_WAIT_V(8); PG8_WAIT_L(0); PG8_BAR; PG8_MMA(1, 0, At, B0); PG8_MMA(1, 1, At, B1); PG8_BAR; PG8_SCHED;
        }
        if (wr == 0) PG8_BAR;
        { int _l = lane_id(); asm volatile("" : "+v"(_l)); E(acc, cur, wr, wc, _l & 15, (_l >> 4) & 3); }
        if (!has_next) break;
#pragma unroll
        for (int a = 0; a < 2; ++a)
#pragma unroll
            for (int b = 0; b < 2; ++b)
#pragma unroll
                for (int m = 0; m < 4; ++m)
#pragma unroll
                    for (int n = 0; n < 2; ++n) acc[a][b][m][n] = (f32x4){0.f, 0.f, 0.f, 0.f};
        cur = nxt; cA = nA; cB = nB; ++ui;
        if constexpr (GATHER) { ct[0] = ntk[0]; ct[1] = ntk[1]; }
        if (wr == 1) PG8_BAR;
    }
    PG8_WAIT_V(0);
    PG8_BAR;
#undef PG8_SA
#undef PG8_SB
#undef PG8_STAGE
#undef PG8_STAGE_A
#undef PG8_R0
#undef PG8_LDA
#undef PG8_LDB
#undef PG8_MMA
#undef PG8_WAIT_V
#undef PG8_WAIT_L
#undef PG8_BAR
#undef PG8_SCHED
}
}

#define XB_TMO      128
#define XB_XCNT(j)  (256  + 64 * (j))
#define XB_XSUB(j)  (1280 + 64 * (j))
#define XB_XGEN(j)  (2304 + 64 * (j))
#define XB_TOP      3328
#define XB_TOPGEN   3392
#define XCD_BAR_WORDS 3456
#define XB_SPIN_CAP (1u << 18)
__device__ __forceinline__ unsigned xb_ld(unsigned* p)              { return __hip_atomic_load(p, __ATOMIC_RELAXED, __HIP_MEMORY_SCOPE_AGENT); }
__device__ __forceinline__ unsigned xb_add(unsigned* p, unsigned v) { return __hip_atomic_fetch_add(p, v, __ATOMIC_RELAXED, __HIP_MEMORY_SCOPE_AGENT); }
__device__ __forceinline__ unsigned xb_xcc_id() { return (unsigned)__builtin_amdgcn_s_getreg((3 << 11) | 20) & 0xFu; }
#define XB_SPIN(cond, bar) do { unsigned _sp = 0; while (cond) { __builtin_amdgcn_s_sleep(1); \
    if ((++_sp & 255u) == 0u) { if (xb_ld(&(bar)[XB_TMO])) break; if (_sp > XB_SPIN_CAP) { atomicAdd(&(bar)[XB_TMO], 1u); break; } } } } while (0)
struct XcdBarrier { unsigned* bar; unsigned x; volatile LAS unsigned* st; int wave; };
__device__ __forceinline__ XcdBarrier xcd_barrier_post(unsigned* bar, volatile LAS unsigned* st, int wave) {
    XcdBarrier b; b.bar = bar; b.x = xb_xcc_id(); b.st = st; b.wave = wave;
    if (wave == 0 && lane_id() == 0) (void)xb_add(&bar[XB_XCNT(b.x)], 1u);
    return b;
}
__device__ __forceinline__ void xcd_barrier_complete(unsigned* bar, unsigned x, unsigned& nloc, unsigned& nx) {
    const unsigned G = gridDim.x * gridDim.y * gridDim.z;
    unsigned sum, cnt, mine, sp = 0u;
    for (;;) {
        sum = 0u; cnt = 0u; mine = 0u;
#pragma unroll
        for (unsigned j = 0; j < 16; ++j) { const unsigned c = xb_ld(&bar[XB_XCNT(j)]); sum += c; cnt += (c > 0u) ? 1u : 0u; mine = (j == x) ? c : mine; }
        if (sum == G) break;
        __builtin_amdgcn_s_sleep(1);
        if ((++sp & 255u) == 0u) { if (xb_ld(&bar[XB_TMO])) break; if (sp > XB_SPIN_CAP) { atomicAdd(&bar[XB_TMO], 1u); break; } }
    }
    nloc = mine > 0u ? mine : 1u; nx = cnt > 0u ? cnt : 1u;
}
__device__ __forceinline__ void xcd_barrier(const XcdBarrier& b) {
    asm volatile("s_waitcnt vmcnt(0)" ::: "memory");
    __syncthreads();
    if (b.wave == 0 && lane_id() == 0) {
        unsigned* bar = b.bar;
        __builtin_amdgcn_s_waitcnt(0);
        unsigned nloc = b.st[0], nx = b.st[1];
        if (nloc == 0u) { xcd_barrier_complete(bar, b.x, nloc, nx); b.st[0] = nloc; b.st[1] = nx; }
        const unsigned old = xb_add(&bar[XB_XSUB(b.x)], 1u);
        const unsigned gen = old / nloc;
        if (old + 1u == (gen + 1u) * nloc) {
            __builtin_amdgcn_fence(__ATOMIC_RELEASE, "agent");
            asm volatile("s_waitcnt vmcnt(0)" ::: "memory");
            const unsigned og = xb_add(&bar[XB_TOP], 1u);
            const unsigned tg = og / nx;
            if (og + 1u == (tg + 1u) * nx) xb_add(&bar[XB_TOPGEN], 1u);
            else XB_SPIN(xb_ld(&bar[XB_TOPGEN]) == tg, bar);
            __builtin_amdgcn_fence(__ATOMIC_ACQUIRE, "agent");
            xb_add(&bar[XB_XGEN(b.x)], 1u);
            asm volatile("s_waitcnt vmcnt(0)" ::: "memory");
        } else {
            XB_SPIN(xb_ld(&bar[XB_XGEN(b.x)]) == gen, bar);
            __builtin_amdgcn_fence(__ATOMIC_ACQUIRE, "agent");
            asm volatile("s_waitcnt vmcnt(0)" ::: "memory");
        }
    }
    __syncthreads();
}

struct Frame {
    LAS unsigned char* lds;
    volatile LAS unsigned* MISC;
    gu32* ctl;
    int vcu, G, wave;
    const float *x, *norm_mix_g, *w_in, *conv_a_w, *conv_b_w, *conv_b_bias, *ln_b_g, *ln_b_b, *beta_a, *beta_b, *w_out, *norm_ffn_g, *wrg, *brg, *wre, *bre, *w1, *w3, *w2, *gfin;
    float* out;
    bf16 *Win_t, *Wout_t, *Wr_t, *XB, *P, *Y, *X1B; fp8 *W13_t, *W2_t, *H, *X1F8, *CB; float* RI;
    float *SSQ, *LW, *LR2; unsigned* LTOK; unsigned* gcnt;
};

struct CvtItem { const float* src; const float* ks; bf16* dst; int N; bool valid; };
__device__ __forceinline__ void cvt_load(const CvtItem& it, f32x4 (&v)[8]) {
    if (it.valid) {
#pragma unroll
        for (int j = 0; j < 8; ++j) v[j] = __builtin_nontemporal_load((const GAS f32x4*)(it.src + (size_t)j * it.N));
    }
}
__device__ __forceinline__ void cvt_store(const CvtItem& it, f32x4 (&v)[8]) {
    if (it.valid) {
        if (it.ks) {
#pragma unroll
            for (int j = 0; j < 8; ++j) v[j] = v[j] * it.ks[j];
        }
#pragma unroll
        for (int c = 0; c < 4; ++c) { u32x4 g; g.x = cvt_pk_bf16(v[0][c], v[1][c]); g.y = cvt_pk_bf16(v[2][c], v[3][c]); g.z = cvt_pk_bf16(v[4][c], v[5][c]); g.w = cvt_pk_bf16(v[6][c], v[7][c]);
            *(GAS u32x4*)(it.dst + (size_t)c * 8) = g; }
    }
}
__device__ __forceinline__ int win_dest_row(int n0) {
    if (n0 < 512) return 256 * (n0 >> 7) + (n0 & 127);
    if (n0 < 1024) return n0 + 512;
    if (n0 < 1536) { const int j = n0 - 1024; return 256 * (j >> 7) + 128 + (j & 127); }
    if (n0 < 2048) { const int j = n0 - 1536; return 1536 + 256 * (j >> 7) + (j & 127); }
    { const int j = n0 - 2048; return 1536 + 256 * (j >> 7) + 128 + (j & 127); }
}
__device__ __forceinline__ size_t gran_idx(int kb, int drow, int nkt) { const int w = drow & 31, slot = (drow & 224) + 16 * ((w >> 2) & 1) + 4 * (w >> 3) + (w & 3);
    return ((size_t)(((drow >> 8) * nkt + (kb >> 3)) * 8 + (kb & 7)) * 256 + slot); }
constexpr int I_IN = 128 * 10, I_OUT = 128 * 4, NITEMS = I_IN + I_OUT;
constexpr int J_13 = NE * 2 * 64 * 2, J_2 = NE * 32 * 4, NITEMS8 = J_13 + J_2;
__device__ __forceinline__ CvtItem p0_decode(Frame& F, int it, int lane) {
    CvtItem c; c.valid = it < NITEMS; c.src = F.w_in; c.ks = nullptr; c.dst = F.Win_t; c.N = DIN;
    if (!c.valid) return c;
    int r = it;
    if (r < I_IN) { const int kb = r / 10, n = 256 * (r % 10) + 4 * lane;
        c.src = F.w_in + (size_t)(8 * kb) * DIN + n; c.N = DIN; c.ks = F.norm_mix_g + 8 * kb; c.dst = F.Win_t + gran_idx(kb, win_dest_row(n), 16) * 8; return c; }
    r -= I_IN;
    { const int kb = r / 4, n = 256 * (r % 4) + 4 * lane;
        c.src = F.w_out + (size_t)(8 * kb) * D + n; c.N = D; c.ks = (8 * kb < DA) ? F.beta_a + 8 * kb : F.beta_b + (8 * kb - DA); c.dst = F.Wout_t + gran_idx(kb, n, 16) * 8; return c; }
}
struct CvtItem8 { const float* src; const float* ks; fp8* dst; int N; float scale; };
__device__ __forceinline__ CvtItem8 p0_decode8(Frame& F, int it, int lane) {
    CvtItem8 c; int r = it;
    if (r < J_13) { const int e = r / 256, rr = r % 256, which = rr / 128, item = rr % 128, kb = item / 2, n = 256 * (item % 2) + 4 * lane;
        c.src = (which ? F.w3 : F.w1) + (size_t)e * D * DE + (size_t)(16 * kb) * DE + n; c.N = DE; c.ks = F.norm_ffn_g + 16 * kb; c.scale = 32.0f;
        c.dst = F.W13_t + (size_t)e * 1024 * D + gran_idx(kb, 256 * (n >> 7) + 128 * which + (n & 127), 8) * 16; return c; }
    r -= J_13;
    { const int e = r / 128, item = r % 128, kb = item / 4, n = 256 * (item % 4) + 4 * lane;
        c.src = F.w2 + (size_t)e * DE * D + (size_t)(16 * kb) * D + n; c.N = D; c.ks = nullptr; c.scale = 16.0f; c.dst = F.W2_t + (size_t)e * 1024 * DE + gran_idx(kb, n, 4) * 16; return c; }
}
__device__ __forceinline__ void p0_cvt8_item(Frame& F, int it, int lane) {
    const CvtItem8 c = p0_decode8(F, it, lane);
    f32x4 v[16];
#pragma unroll
    for (int j = 0; j < 16; ++j) v[j] = __builtin_nontemporal_load((const GAS f32x4*)(c.src + (size_t)j * c.N));
#pragma unroll
    for (int j = 0; j < 16; ++j) v[j] = v[j] * (c.ks ? c.ks[j] * c.scale : c.scale);
#pragma unroll
    for (int q = 0; q < 4; ++q) { u32x4 g;
#pragma unroll
        for (int w = 0; w < 4; ++w) g[w] = pk4_fp8(v[4 * w][q], v[4 * w + 1][q], v[4 * w + 2][q], v[4 * w + 3][q]);
        *(GAS u32x4*)(c.dst + (size_t)q * 16) = g; }
}
constexpr int NITEMS8_LATE = 4096;
__device__ __forceinline__ void p1_late_convert(Frame& F) {
    if (F.G != 256 || blockIdx.x < 128) return;
    int lane = lane_id(); asm volatile("" : "+v"(lane));
    const int w0 = ((int)blockIdx.x - 128) * NWAVES + F.wave;
    for (int it = NITEMS8 - NITEMS8_LATE + w0; it < NITEMS8; it += 128 * NWAVES) p0_cvt8_item(F, it, lane);
}
__device__ __forceinline__ void p0_prologue(Frame& F) {
    const int wave = F.wave; int lane = lane_id(); asm volatile("" : "+v"(lane)); const int tid = wave * 64 + lane;
    const int gw = F.vcu * NWAVES + wave, NGW = F.G * NWAVES;
    for (int it = gw; it < NITEMS; it += 2 * NGW) {
        const CvtItem c0 = p0_decode(F, it, lane), c1 = p0_decode(F, it + NGW, lane);
        f32x4 v0[8], v1[8];
        cvt_load(c0, v0); cvt_load(c1, v1);
        cvt_store(c0, v0); cvt_store(c1, v1);
    }
    for (int it = gw; it < NITEMS8 - (F.G == 256 ? NITEMS8_LATE : 0); it += NGW) p0_cvt8_item(F, it, lane);
    for (int i = gw * 64 + lane; i < 48 * D; i += NGW * 64) { const int o = i / D, k = i % D; float v = 0.f;
        if (o < 4) v = F.wrg[(size_t)k * 4 + o] * F.norm_ffn_g[k]; else if (o < 36) v = F.wre[(size_t)k * NE + (o - 4)] * F.norm_ffn_g[k];
        F.Wr_t[i] = (bf16)f2bf(v); }
    for (int m = gw; m < T; m += NGW) {
        const GAS f32x4* xr = (const GAS f32x4*)(F.x + (size_t)m * D) + lane;
        f32x4 v[4]; float s = 0.f;
#pragma unroll
        for (int j = 0; j < 4; ++j) { v[j] = __builtin_nontemporal_load(xr + 64 * j); s += (v[j].x * v[j].x + v[j].y * v[j].y) + (v[j].z * v[j].z + v[j].w * v[j].w); }
        const float r = rsqrtf(wave_sum(s) * (1.f / D) + EPS);
        if (lane == 0) F.RI[m] = 1.0f / r;
        GAS u32x2* o8 = (GAS u32x2*)(F.XB + (size_t)m * D) + lane;
#pragma unroll
        for (int j = 0; j < 4; ++j) { u32x2 w; w.x = pk2(v[j].x * r, v[j].y * r); w.y = pk2(v[j].z * r, v[j].w * r); o8[64 * j] = w; }
    }
}

template <int CTRL> __device__ __forceinline__ float dpp_f(float v) { return __builtin_bit_cast(float, __builtin_amdgcn_update_dpp(0, __builtin_bit_cast(int, v), CTRL, 0xf, 0xf, false)); }
#define DPP_XOR1 0xB1
#define DPP_XOR2 0x4E
#define DPP_HALF_MIRROR 0x141
#define DPP_ROW_MIRROR 0x140
__device__ __forceinline__ float sum8(float v) { v += dpp_f<DPP_XOR1>(v); v += dpp_f<DPP_XOR2>(v); v += dpp_f<DPP_HALF_MIRROR>(v); return v; }
__device__ __forceinline__ float sum16(float v) { v = sum8(v); v += dpp_f<DPP_ROW_MIRROR>(v); return v; }
__device__ __forceinline__ void p2_mixer(Frame& F) {
    const int wave = F.wave; int lane = lane_id(); asm volatile("" : "+v"(lane)); const int tid = wave * 64 + lane;
    LAS unsigned char* L = F.lds;
    LAS unsigned* Ut = (LAS unsigned*)L;
    LAS float* UC = (LAS float*)(L + 62 * 1024);
    LAS float* PRM = (LAS float*)(L + LDSCTL_OFF + 2048);
    PRM[tid] = F.ln_b_g[tid]; PRM[512 + tid] = F.ln_b_b[tid];
#pragma unroll
    for (int q = 0; q < 3; ++q) PRM[1024 + 512 * q + tid] = F.conv_a_w[q * DA + tid];
    const int cp = tid & 255, th = tid >> 8;
    f32x2 wb[31];
#pragma unroll
    for (int j = 0; j < 31; ++j) wb[j] = *(const f32x2*)(F.conv_b_w + j * DB + 2 * cp);
    const f32x2 bias2 = *(const f32x2*)(F.conv_b_bias + 2 * cp);
    const int tq = lane >> 4, tl = lane & 15;
    u32x4 ureg[8];
#define P2_ULOAD(tile_) do { const int _t0 = (tile_) * 32, _b = _t0 / SEQ, _s0 = _t0 % SEQ; int _tid = tid; asm volatile("" : "+v"(_tid)); _Pragma("unroll") for (int _i = 0; _i < 8; ++_i) { const int _ch = _tid + 512 * _i, _row = _ch >> 6, _c16 = _ch & 63, _s = _s0 - 15 + _row; \
        ureg[_i] = (u32x4){0u, 0u, 0u, 0u}; if (_ch < 62 * 64 && _s >= 0 && _s < SEQ) ureg[_i] = *(const GAS u32x4*)(F.P + (size_t)(_b * SEQ + _s) * PW + 1024 + _c16 * 8); } } while (0)
    int tile = F.vcu;
    if (tile < T / 32) P2_ULOAD(tile);
    __syncthreads();
    for (; tile < T / 32; tile += F.G) {
        const int t0 = tile * 32, s0 = t0 % SEQ;
        { int tid2 = tid; asm volatile("" : "+v"(tid2));
#pragma unroll
        for (int i = 0; i < 8; ++i) { const int ch = tid2 + 512 * i; if (ch < 62 * 64) *(LAS u32x4*)(L + ch * 16) = ureg[i]; } }
        __syncthreads();
        if (tile + F.G < T / 32) P2_ULOAD(tile + F.G);
#pragma unroll 1
        for (int sub = 0; sub < 2; ++sub) { const int i0 = th * 16 + sub * 8; f32x2 a[8];
#pragma unroll
            for (int i = 0; i < 8; ++i) a[i] = bias2;
#pragma unroll
            for (int w = 0; w < 38; ++w) { const unsigned v = Ut[(i0 + w) * 256 + cp]; const f32x2 x2 = (f32x2){bflo(v), bfhi(v)};
#pragma unroll
                for (int i = 0; i < 8; ++i) { const int j = w - i; if (j >= 0 && j < 31) a[i] = __builtin_elementwise_fma(wb[j], x2, a[i]); } }
#pragma unroll
            for (int i = 0; i < 8; ++i) *(LAS f32x2*)(UC + (i0 + i) * 512 + 2 * cp) = a[i];
        }
        __syncthreads();
        u32x4 gpm1[4], gp0[4], gpp1[4], gab[4];
        { const int i = wave * 4 + tq, s = s0 + i; const bf16* prow = F.P + (size_t)(t0 + i) * PW + 8 * tl; const u32x4 z4 = (u32x4){0u, 0u, 0u, 0u};
#pragma unroll
          for (int k = 0; k < 4; ++k) { const bf16* pk = prow + 128 * k;
            gpm1[k] = (s > 0) ? *(const GAS u32x4*)(pk - PW) : z4; gp0[k] = *(const GAS u32x4*)pk; gpp1[k] = (s < SEQ - 1) ? *(const GAS u32x4*)(pk + PW) : z4; gab[k] = *(const GAS u32x4*)(pk + 512); } }
        { const int i = wave * 4 + tq, t = t0 + i;
          float uv[4][8]; float s1 = 0.f;
#pragma unroll
          for (int k = 0; k < 4; ++k) { const LAS float* up = UC + i * 512 + 8 * (tl + 16 * k); const f32x4 ua = *(const LAS f32x4*)up, ub = *(const LAS f32x4*)(up + 4);
#pragma unroll
            for (int j = 0; j < 4; ++j) { uv[k][j] = ua[j]; uv[k][4 + j] = ub[j]; s1 += ua[j] + ub[j]; } }
          const float mu = sum16(s1) * (1.f / DB); float s2 = 0.f;
#pragma unroll
          for (int k = 0; k < 4; ++k)
#pragma unroll
            for (int j = 0; j < 8; ++j) { uv[k][j] -= mu; s2 += uv[k][j] * uv[k][j]; }
          const float rstd = rsqrtf(sum16(s2) * (1.f / DB) + EPS);
#pragma unroll
          for (int k = 0; k < 4; ++k) { const int c8 = 8 * (tl + 16 * k); const LAS float* gp = PRM + c8; const f32x4 g0 = *(const LAS f32x4*)gp, g1 = *(const LAS f32x4*)(gp + 4), b0 = *(const LAS f32x4*)(gp + 512), b1 = *(const LAS f32x4*)(gp + 516);
            float hb = 0.f;
#pragma unroll
            for (int j = 0; j < 8; ++j) { const float z = uv[k][j] * rstd * (j < 4 ? g0[j & 3] : g1[j & 3]) + (j < 4 ? b0[j & 3] : b1[j & 3]); uv[k][j] = z * fast_sigmoid(z); hb += uv[k][j] * uv[k][j]; }
            const float rb = rsqrtf(sum8(hb) * (1.f / 64.f) + EPS);
            u32x4 ob; ob.x = cvt_pk_bf16(uv[k][0] * rb, uv[k][1] * rb); ob.y = cvt_pk_bf16(uv[k][2] * rb, uv[k][3] * rb); ob.z = cvt_pk_bf16(uv[k][4] * rb, uv[k][5] * rb); ob.w = cvt_pk_bf16(uv[k][6] * rb, uv[k][7] * rb);
            *(GAS u32x4*)(F.Y + (size_t)t * D + DA + c8) = ob; }
#pragma unroll
          for (int k = 0; k < 4; ++k) { const int c8 = 8 * (tl + 16 * k); const LAS float* wp = PRM + 1024 + c8; float ya[8]; float ha = 0.f;
            f32x4 w0[2], w1[2], w2[2];
#pragma unroll
            for (int h = 0; h < 2; ++h) { w0[h] = *(const LAS f32x4*)(wp + 4 * h); w1[h] = *(const LAS f32x4*)(wp + 512 + 4 * h); w2[h] = *(const LAS f32x4*)(wp + 1024 + 4 * h); }
#pragma unroll
            for (int j = 0; j < 4; ++j) { const int h = j >> 1, e = 2 * (j & 1);
                const float c0 = w0[h][e] * bflo(gpm1[k][j]) + w1[h][e] * bflo(gp0[k][j]) + w2[h][e] * bflo(gpp1[k][j]);
                const float c1 = w0[h][e + 1] * bfhi(gpm1[k][j]) + w1[h][e + 1] * bfhi(gp0[k][j]) + w2[h][e + 1] * bfhi(gpp1[k][j]);
                ya[2 * j] = bflo(gab[k][j]) * c0; ya[2 * j + 1] = bfhi(gab[k][j]) * c1; ha += ya[2 * j] * ya[2 * j] + ya[2 * j + 1] * ya[2 * j + 1]; }
            const float ra = rsqrtf(sum8(ha) * (1.f / 64.f) + EPS);
            u32x4 oa; oa.x = cvt_pk_bf16(ya[0] * ra, ya[1] * ra); oa.y = cvt_pk_bf16(ya[2] * ra, ya[3] * ra); oa.z = cvt_pk_bf16(ya[4] * ra, ya[5] * ra); oa.w = cvt_pk_bf16(ya[6] * ra, ya[7] * ra);
            *(GAS u32x4*)(F.Y + (size_t)t * D + c8) = oa; }
        }
    }
#undef P2_ULOAD
    __syncthreads();
}

__device__ __forceinline__ void p4_route(Frame& F) {
    const int wave = F.wave; int lane = lane_id(); asm volatile("" : "+v"(lane)); const int tid = wave * 64 + lane;
    LAS float* LGp = (LAS float*)F.lds;
    LAS int* scnt = (LAS int*)(F.lds + 102400);
    bf16x8 bfr[4][3];
    { const bf16* brow = F.Wr_t + (size_t)(lane & 15) * D + 128 * wave + 8 * (lane >> 4);
#pragma unroll
      for (int ks = 0; ks < 4; ++ks)
#pragma unroll
        for (int nb = 0; nb < 3; ++nb) bfr[ks][nb] = *(const GAS bf16x8*)(brow + (size_t)nb * 16 * D + ks * 32); }
    for (int tile = F.vcu; tile < T / 64; tile += F.G) {
        if (tid < 32) scnt[tid] = 0;
        const int tb = tile * 64;
        bf16x8 af[4][4];
#pragma unroll
        for (int tg = 0; tg < 4; ++tg)
#pragma unroll
            for (int ks = 0; ks < 4; ++ks) af[tg][ks] = *(const GAS bf16x8*)(F.X1B + (size_t)(tb + 16 * tg + (lane & 15)) * D + 128 * wave + ks * 32 + 8 * (lane >> 4));
#pragma unroll
        for (int tg = 0; tg < 4; ++tg) { f32x4 acc[3];
#pragma unroll
            for (int nb = 0; nb < 3; ++nb) acc[nb] = (f32x4){0.f, 0.f, 0.f, 0.f};
#pragma unroll
            for (int ks = 0; ks < 4; ++ks)
#pragma unroll
                for (int nb = 0; nb < 3; ++nb) acc[nb] = __builtin_amdgcn_mfma_f32_16x16x32_bf16(af[tg][ks], bfr[ks][nb], acc[nb], 0, 0, 0);
#pragma unroll
            for (int nb = 0; nb < 3; ++nb)
#pragma unroll
                for (int r = 0; r < 4; ++r) LGp[(wave * 64 + 16 * tg + 4 * (lane >> 4) + r) * 49 + nb * 16 + (lane & 15)] = acc[nb][r]; }
        __syncthreads();
        int e0 = 0, e1 = 0, p0 = 0, p1 = 0; float c0 = 0.f, c1 = 0.f, r2 = 0.f;
        if (tid < 64) {
            const int t = tb + tid; float ss = 0.f;
#pragma unroll
            for (int s = 0; s < 16; ++s) ss += F.SSQ[(size_t)s * T + t];
            r2 = rsqrtf(ss * (1.f / D) + EPS);
            const LAS float* lg = LGp + tid * 49;
            float g4[4];
#pragma unroll
            for (int i = 0; i < 4; ++i) { float a = 0.f;
#pragma unroll
                for (int w = 0; w < 8; ++w) a += lg[w * 64 * 49 + i];
                g4[i] = a * r2 + F.brg[i]; }
            int g = 0; float m = g4[0];
#pragma unroll
            for (int i = 1; i < 4; ++i) if (g4[i] > m) { m = g4[i]; g = i; }
            float den = 0.f;
#pragma unroll
            for (int i = 0; i < 4; ++i) den += __expf(g4[i] - m);
            const float psel = 1.0f / den;
            int i0 = 0, i1 = -1; float m0 = -3.0e38f, m1 = -3.0e38f;
            for (int i = 0; i < 8; ++i) { float a = 0.f;
#pragma unroll
                for (int w = 0; w < 8; ++w) a += lg[w * 64 * 49 + 4 + g * 8 + i];
                const float v = a * r2 + F.bre[g * 8 + i];
                if (v > m0) { m1 = m0; i1 = i0; m0 = v; i0 = i; } else if (v > m1) { m1 = v; i1 = i; } }
            const float ex = __expf(m1 - m0);
            e0 = g * 8 + i0; e1 = g * 8 + i1; c0 = psel / (1.0f + ex); c1 = psel * ex / (1.0f + ex);
            p0 = __hip_atomic_fetch_add(scnt + e0, 1, __ATOMIC_RELAXED, __HIP_MEMORY_SCOPE_WORKGROUP); p1 = __hip_atomic_fetch_add(scnt + e1, 1, __ATOMIC_RELAXED, __HIP_MEMORY_SCOPE_WORKGROUP);
        }
        __syncthreads();
        if (tid < 32) scnt[32 + tid] = (int)__hip_atomic_fetch_add(F.gcnt + tid, (unsigned)scnt[tid], RLX_AGENT);
        __syncthreads();
        if (tid < 64) {
            const int t = tb + tid; const size_t d0 = (size_t)e0 * CAP + scnt[32 + e0] + p0, d1 = (size_t)e1 * CAP + scnt[32 + e1] + p1;
            F.LTOK[d0] = (unsigned)t; F.LW[d0] = c0; F.LR2[d0] = r2;
            F.LTOK[d1] = (unsigned)t | (1u << 16); F.LW[d1] = c1; F.LR2[d1] = r2;
        }
        __syncthreads();
    }
}

__device__ __forceinline__ void p7_final(Frame& F) {
    const int wave = F.wave; int lane = lane_id(); asm volatile("" : "+v"(lane)); const int tid = wave * 64 + lane;
    const int gw = F.vcu * NWAVES + wave, NGW = F.G * NWAVES;
    f32x4 g[2][2];
#pragma unroll
    for (int j = 0; j < 2; ++j) { g[j][0] = *(const f32x4*)(F.gfin + j * 512 + lane * 8); g[j][1] = *(const f32x4*)(F.gfin + j * 512 + lane * 8 + 4); }
    for (int t = gw; t < T; t += NGW) {
        float v[2][8]; float ss = 0.f;
#pragma unroll
        for (int j = 0; j < 2; ++j) { const size_t o = (size_t)t * D + j * 512 + lane * 8;
            const u32x4 a = *(const GAS u32x4*)(F.X1B + o); const u32x2 c0 = *(const GAS u32x2*)(F.CB + o), c1 = *(const GAS u32x2*)(F.CB + (size_t)T * D + o);
#pragma unroll
            for (int q = 0; q < 4; q += 2) { const f32x2 p0 = __builtin_amdgcn_cvt_pk_f32_fp8((int)c0[q >> 1], false), p1 = __builtin_amdgcn_cvt_pk_f32_fp8((int)c1[q >> 1], false),
                                                           p2 = __builtin_amdgcn_cvt_pk_f32_fp8((int)c0[q >> 1], true), p3 = __builtin_amdgcn_cvt_pk_f32_fp8((int)c1[q >> 1], true);
                v[j][2 * q] = bflo(a[q]) + (p0.x + p1.x) * (1.0f / 64.0f); v[j][2 * q + 1] = bfhi(a[q]) + (p0.y + p1.y) * (1.0f / 64.0f);
                v[j][2 * q + 2] = bflo(a[q + 1]) + (p2.x + p3.x) * (1.0f / 64.0f); v[j][2 * q + 3] = bfhi(a[q + 1]) + (p2.y + p3.y) * (1.0f / 64.0f); }
#pragma unroll
            for (int q = 0; q < 8; ++q) ss += v[j][q] * v[j][q]; }
        const float r = rsqrtf(wave_sum(ss) * (1.f / D) + EPS);
#pragma unroll
        for (int j = 0; j < 2; ++j) { float* o = F.out + (size_t)t * D + j * 512 + lane * 8;
            *(GAS f32x4*)o = (f32x4){v[j][0] * r * g[j][0][0], v[j][1] * r * g[j][0][1], v[j][2] * r * g[j][0][2], v[j][3] * r * g[j][0][3]};
            *(GAS f32x4*)(o + 4) = (f32x4){v[j][4] * r * g[j][1][0], v[j][5] * r * g[j][1][1], v[j][6] * r * g[j][1][2], v[j][7] * r * g[j][1][3]}; }
    }
}

__device__ __forceinline__ void moe_sched_init(pg8::SchedMoe& S, Frame& F) {
    int lane = lane_id(); asm volatile("" : "+v"(lane));
    LAS int* tab = (LAS int*)(F.lds + LDSCTL_OFF + 1024);
    int my_cnt = 0; if (lane < NE) my_cnt = (int)__hip_atomic_load(F.gcnt + lane, RLX_AGENT);
    const int tiles = (my_cnt + 255) >> 8; int incl = tiles;
#pragma unroll
    for (int o = 1; o < 32; o <<= 1) { const int v = __shfl_up(incl, o); if (lane >= o) incl += v; }
    if (F.wave == 0 && lane < NE) { tab[lane] = incl - tiles; tab[32 + lane] = my_cnt; }
    S.total_rt = __builtin_amdgcn_readlane(incl, 31); S.tab = tab;
    S.ltok = F.LTOK; S.G = F.G; S.c = (int)blockIdx.x;
    __syncthreads();
}

struct Args { const float* in[20]; float* out; unsigned char* ws; int ph_lo, ph_hi, li, pad; };
__global__ void __launch_bounds__(NWAVES * 64, 2) mk_fwd(Args args) {
    extern __shared__ __attribute__((aligned(16))) unsigned char lds[];
    Frame F;
    F.lds = (LAS unsigned char*)lds;
    F.MISC = (volatile LAS unsigned*)(F.lds + MISC_OFF);
    F.wave = __builtin_amdgcn_readfirstlane((int)threadIdx.x >> 6);
    F.G = gridDim.x; { const int bx = blockIdx.x; F.vcu = (F.G % 8 == 0) ? (bx % 8) * (F.G / 8) + bx / 8 : bx; }
    unsigned char* ws = args.ws;
    F.ctl = (gu32*)(ws + WS_CTL);
    F.x = args.in[0]; F.norm_mix_g = args.in[1]; F.w_in = args.in[2]; F.conv_a_w = args.in[3]; F.conv_b_w = args.in[4]; F.conv_b_bias = args.in[5]; F.ln_b_g = args.in[6]; F.ln_b_b = args.in[7];
    F.beta_a = args.in[8]; F.beta_b = args.in[9]; F.w_out = args.in[10]; F.norm_ffn_g = args.in[11]; F.wrg = args.in[12]; F.brg = args.in[13]; F.wre = args.in[14]; F.bre = args.in[15];
    F.w1 = args.in[16]; F.w3 = args.in[17]; F.w2 = args.in[18]; F.gfin = args.in[19]; F.out = args.out;
    F.Win_t = (bf16*)(ws + WS_WIN); F.Wout_t = (bf16*)(ws + WS_WOUT); F.Wr_t = (bf16*)(ws + WS_WR); F.W13_t = (fp8*)(ws + WS_W13); F.W2_t = (fp8*)(ws + WS_W2); F.X1F8 = (fp8*)(ws + WS_X1F8);
    F.XB = (bf16*)(ws + WS_XB); F.P = (bf16*)(ws + WS_P); F.Y = (bf16*)(ws + WS_Y); F.X1B = (bf16*)(ws + WS_X1B); F.H = (fp8*)(ws + WS_H); F.CB = (fp8*)(ws + WS_CB); F.RI = (float*)(ws + WS_WR + 768 * 1024);
    F.SSQ = (float*)(ws + WS_SSQ); F.LW = (float*)(ws + WS_LW); F.LR2 = (float*)(ws + WS_LR2); F.LTOK = (unsigned*)(ws + WS_LTOK); F.gcnt = (unsigned*)(ws + WS_CTL) + CW_GCNT;
    for (int u = F.wave * 64 + lane_id(); u < (LDS_BYTES - LDSCTL_OFF) / 4; u += NWAVES * 64) ((LAS unsigned*)(F.lds + LDSCTL_OFF))[u] = 0u;
    __syncthreads();
    XcdBarrier bar; bar.bar = (unsigned*)(F.ctl + CW_BAR); bar.x = 0; bar.st = nullptr; bar.wave = F.wave;
    if (N_LAUNCHES == 1) bar = xcd_barrier_post((unsigned*)(F.ctl + CW_BAR), F.MISC + 8, F.wave);
    const int lo = args.ph_lo, hi = args.ph_hi;
#define IN(k) (lo <= (k) && (k) < hi)
#define GRID_BAR(k) do { if (IN(k) && IN((k) + 1)) xcd_barrier(bar); if (PROBE_PHASE >= 0 && blockIdx.x == 0 && F.wave == 0 && lane_id() == 0) ((unsigned long long*)(ws + WS_WR + 512 * 1024))[(k) + 1] = __builtin_amdgcn_s_memrealtime(); } while (0)
    if (PROBE_PHASE >= 0 && blockIdx.x == 0 && F.wave == 0 && lane_id() == 0) ((unsigned long long*)(ws + WS_WR + 512 * 1024))[0] = __builtin_amdgcn_s_memrealtime();

    if (IN(0)) { p0_prologue(F); GRID_BAR(0); }
    if (IN(1)) {
        pg8::SchedDense S{(const char*)F.XB, (const char*)F.Win_t, T / 256, DIN / 256, F.G, (int)blockIdx.x, (size_t)256 * D * 2, 16};
        pg8::EpiP1 E{F.P};
        pg8::gemm_phase<pg8::EpiP1, pg8::SchedDense, false>(F.lds + RING_OFF, D * 2, S, E, F.wave);
        p1_late_convert(F);
        GRID_BAR(1);
    }
    if (IN(2)) { p2_mixer(F); GRID_BAR(2); }
    if (IN(3)) {
        pg8::SchedDense S{(const char*)F.Y, (const char*)F.Wout_t, T / 256, D / 256, F.G, (int)blockIdx.x, (size_t)256 * D * 2, 16};
        pg8::EpiX1 E{F.XB, F.RI, F.X1B, F.SSQ, F.X1F8};
        pg8::gemm_phase<pg8::EpiX1, pg8::SchedDense, false>(F.lds + RING_OFF, D * 2, S, E, F.wave);
        GRID_BAR(3);
    }
    if (IN(4)) { p4_route(F); GRID_BAR(4); }
    if (IN(5)) {
        pg8::SchedMoeA S; moe_sched_init(S, F); S.A = (const char*)F.X1F8; S.W = (const char*)F.W13_t; S.a_tile_bytes = 0; S.w_exp_bytes = (size_t)1024 * D; S.nkt = 8;
        pg8::EpiH E{F.H, F.LR2};
        pg8::gemm_phase<pg8::EpiH, pg8::SchedMoeA, true>(F.lds + RING_OFF, D, S, E, F.wave);
        GRID_BAR(5);
    }
    if (IN(6)) {
        pg8::SchedMoeB S; moe_sched_init(S, F); S.A = (const char*)F.H; S.W = (const char*)F.W2_t; S.a_tile_bytes = (size_t)256 * DE; S.w_exp_bytes = (size_t)1024 * DE; S.nkt = 4;
        pg8::EpiC E{F.CB, F.LTOK, F.LW};
        pg8::gemm_phase<pg8::EpiC, pg8::SchedMoeB, true>(F.lds + RING_OFF, DE, S, E, F.wave);
        GRID_BAR(6);
    }
    if (IN(7)) { p7_final(F);
        if (PROBE_PHASE >= 0 && blockIdx.x == 0 && F.wave == 0 && lane_id() == 0) { unsigned long long* ts = (unsigned long long*)(ws + WS_WR + 512 * 1024); ts[8] = __builtin_amdgcn_s_memrealtime();
            asm volatile("s_waitcnt vmcnt(0)" ::: "memory"); const float us = (PROBE_PHASE == 8) ? (float)(ts[8] - ts[0]) * 0.001f : (float)(ts[PROBE_PHASE + 1] - ts[PROBE_PHASE]) * 0.01f; F.out[0] += us * 0.1f; } }
#undef IN
#undef GRID_BAR
}

extern "C" void kernel_launch(void* const* d_in, const int* in_sizes, int n_in, void* d_out, int out_size, void* d_ws, size_t ws_size, hipStream_t stream) {
    static int grid = 0;
    if (grid == 0) {
        if (n_in != 20 || in_sizes[0] != T * D || out_size != T * D || ws_size < WS_END) { fprintf(stderr, "kernel_launch: unexpected shapes / workspace (n_in %d, in0 %d, out %d, ws %zu, need %zu)\n", n_in, n_in > 0 ? in_sizes[0] : -1, out_size, ws_size, (size_t)WS_END); grid = -1; return; }
        int dev = 0, cus = 0, per_cu = 0;
        if (hipGetDevice(&dev) != hipSuccess || hipDeviceGetAttribute(&cus, hipDeviceAttributeMultiprocessorCount, dev) != hipSuccess) { fprintf(stderr, "kernel_launch: device query failed\n"); grid = -1; return; }
        if (hipFuncSetAttribute((const void*)mk_fwd, hipFuncAttributeMaxDynamicSharedMemorySize, LDS_BYTES) != hipSuccess) { fprintf(stderr, "kernel_launch: hipFuncSetAttribute failed\n"); grid = -1; return; }
        if (hipOccupancyMaxActiveBlocksPerMultiprocessor(&per_cu, (const void*)mk_fwd, NWAVES * 64, LDS_BYTES) != hipSuccess || per_cu < 1) fprintf(stderr, "kernel_launch: occupancy query reports %d workgroups per CU\n", per_cu);
        (void)hipGetLastError();
        grid = cus;
    }
    if (grid < 0) return;
    if (hipMemsetAsync((char*)d_ws + WS_CTL, 0, CTL_ZERO_BYTES, stream) != hipSuccess) { fprintf(stderr, "kernel_launch: hipMemsetAsync failed\n"); return; }
    Args a{};
    for (int i = 0; i < 20; ++i) a.in[i] = (const float*)d_in[i];
    a.out = (float*)d_out; a.ws = (unsigned char*)d_ws;
    for (int li = 0; li < N_LAUNCHES; ++li) {
        a.ph_lo = (N_LAUNCHES == 1) ? 0 : li; a.ph_hi = (N_LAUNCHES == 1) ? NPHASES : li + 1; a.li = li;
        hipLaunchKernelGGL(mk_fwd, dim3(grid), dim3(NWAVES * 64), LDS_BYTES, stream, a);
        const hipError_t le = hipPeekAtLastError();
        if (le != hipSuccess) { fprintf(stderr, "kernel_launch: launch %d failed: %s\n", li, hipGetErrorName(le)); break; }
    }
}
```

```cpp
#include <hip/hip_runtime.h>
#include <cstdio>
#include <cstdint>

#define LAS __attribute__((address_space(3)))
#define GAS __attribute__((address_space(1)))
typedef unsigned short bf16;
typedef short bf16x8 __attribute__((ext_vector_type(8)));
typedef float f32x4 __attribute__((ext_vector_type(4)));
typedef float f32x2 __attribute__((ext_vector_type(2)));
typedef unsigned u32x4 __attribute__((ext_vector_type(4)));
typedef unsigned u32x2 __attribute__((ext_vector_type(2)));
typedef GAS unsigned gu32;
typedef int i32x4 __attribute__((ext_vector_type(4)));
typedef int i32x8 __attribute__((ext_vector_type(8)));
typedef unsigned char fp8;

constexpr int T = 16384, SEQ = 2048, D = 1024, DA = 512, DB = 512, DIN = 2560, NE = 32, DE = 512, CAP = 16384, PW = 1536;
constexpr float EPS = 1e-6f;
constexpr int NWAVES = 8;
#ifndef MK_N_LAUNCHES
#define MK_N_LAUNCHES 1
#endif
constexpr int N_LAUNCHES = MK_N_LAUNCHES;
constexpr int NPHASES = 8;
#ifndef PROBE_PHASE
#define PROBE_PHASE -1
#endif

constexpr size_t MiB = 1u << 20;
constexpr size_t WS_CTL = 0, CTL_ZERO_BYTES = 72 * 1024;
constexpr size_t WS_WIN = 1 * MiB;
constexpr size_t WS_WOUT = 6 * MiB;
constexpr size_t WS_WR = 8 * MiB;
constexpr size_t WS_SSQ = 9 * MiB;
constexpr size_t WS_LTOK = 11 * MiB;
constexpr size_t WS_LW = 13 * MiB;
constexpr size_t WS_LR2 = 15 * MiB;
constexpr size_t WS_W13 = 17 * MiB;
constexpr size_t WS_W2 = 49 * MiB;
constexpr size_t WS_X1B = 65 * MiB;
constexpr size_t WS_X1F8 = 97 * MiB;
constexpr size_t WS_XB = 113 * MiB;
constexpr size_t WS_P = 145 * MiB;
constexpr size_t WS_Y = 193 * MiB;
constexpr size_t WS_H = 113 * MiB;
constexpr size_t WS_CB = 133 * MiB;
constexpr size_t WS_END = 225 * MiB;
constexpr int CW_TMO = 0, CW_CODE = 1, CW_BAR = 4096, CW_GCNT = 16384;

constexpr int RING_OFF = 0, RING_BYTES = 131072;
constexpr int LDSCTL_OFF = RING_BYTES, MISC_OFF = LDSCTL_OFF + 320;
constexpr int LDS_BYTES = 147456;

#define RLX_AGENT __ATOMIC_RELAXED, __HIP_MEMORY_SCOPE_AGENT
#define LDS_WAIT() asm volatile("s_waitcnt lgkmcnt(0)" ::: "memory")
#define VM_WAIT() asm volatile("s_waitcnt vmcnt(0)" ::: "memory")
__device__ __forceinline__ unsigned f2bf(float f) { unsigned u = __builtin_bit_cast(unsigned, f); return (u + 0x7fffu + ((u >> 16) & 1u)) >> 16; }
__device__ __forceinline__ unsigned pk2(float lo, float hi) { return f2bf(lo) | (f2bf(hi) << 16); }
__device__ __forceinline__ unsigned cvt_pk_bf16(float lo, float hi) { unsigned r; asm volatile("v_cvt_pk_bf16_f32 %0, %1, %2" : "=v"(r) : "v"(lo), "v"(hi)); return r; }
__device__ __forceinline__ unsigned pk4_fp8(float a, float b, float c, float d) { int w = 0; w = __builtin_amdgcn_cvt_pk_fp8_f32(a, b, w, false); w = __builtin_amdgcn_cvt_pk_fp8_f32(c, d, w, true); return (unsigned)w; }
__device__ __forceinline__ float bflo(unsigned v) { return __builtin_bit_cast(float, v << 16); }
__device__ __forceinline__ float bfhi(unsigned v) { return __builtin_bit_cast(float, v & 0xffff0000u); }
__device__ __forceinline__ float fast_sigmoid(float v) { return __builtin_amdgcn_rcpf(1.0f + __expf(-v)); }
__device__ __forceinline__ int lane_id() { unsigned m = ~0u; asm volatile("" : "+s"(m)); return (int)__builtin_amdgcn_mbcnt_hi(m, __builtin_amdgcn_mbcnt_lo(m, 0u)); }
__device__ __forceinline__ float wave_sum(float v) {
#pragma unroll
    for (int o = 1; o < 64; o <<= 1) v += __shfl_xor(v, o);
    return v;
}

namespace pg8 {
constexpr int BM = 256, BK = 64, HALF = 128, HTB = HALF * BK * 2, STAGE_BYTES = 8 * HTB, NXCD = 8, WGM = 8;
__host__ __device__ __forceinline__ int lds_byte(int r, int c) { const int st = (r >> 4) * 2 + (c >> 5), rr = r & 15, cc = c & 31, ob = rr * 64 + cc * 2; return st * 1024 + (ob ^ (((ob >> 9) & 1) << 5)); }
__host__ __device__ __forceinline__ void stage_rc(int b, int& R, int& C) { const int st = b / 1024, sb = b % 1024, swz = sb ^ (((sb >> 9) & 1) << 5); R = (st >> 1) * 16 + swz / 64; C = (st & 1) * 32 + (swz % 64) / 2; }
__host__ __device__ __forceinline__ int perm32(int rho) { const int n = rho >> 4, i = rho & 15; return 8 * (i >> 2) + 4 * n + (i & 3); }

struct Unit { int pm, pn, e, rt, cnt; };

__device__ __forceinline__ bool tile_order(int i, int G, int c, int nM, int nN, int& pm, int& pn) {
    const int nwg = nM * nN; const int L = i * G + c; if (L >= nwg) return false;
    int wgid = L; { const int q = nwg / NXCD, r = nwg % NXCD, xcd = wgid % NXCD, off = wgid / NXCD; wgid = (xcd < r ? xcd * (q + 1) : r * (q + 1) + (xcd - r) * q) + off; }
    const int nig = WGM * nN, gid = wgid / nig, fm = gid * WGM, gsz = (nM - fm) < WGM ? (nM - fm) : WGM;
    pm = fm + ((wgid % nig) % gsz); pn = (wgid % nig) / gsz; return true;
}

struct SchedDense {
    static constexpr bool GATHER = false;
    const char* A; const char* Bt; int nM, nN, G, c; size_t tstepA; int nkt;
    __device__ __forceinline__ bool next(int i, Unit& u) const { u.e = 0; u.rt = 0; u.cnt = 0; return tile_order(i, G, c, nM, nN, u.pm, u.pn); }
    __device__ __forceinline__ const char* a_buf() const { return A; }
    __device__ __forceinline__ const char* b_buf() const { return Bt; }
    __device__ __forceinline__ unsigned a_soff(const Unit& u) const { return (unsigned)u.pm * (unsigned)tstepA; }
    __device__ __forceinline__ unsigned b_soff(const Unit& u) const { return (unsigned)(u.pn * nkt) * 32768u; }
    __device__ __forceinline__ void a_tokens(const Unit&, int, unsigned (&)[2]) const {}
};
struct SchedMoe {
    const char* A; const char* W; const unsigned* ltok; const LAS int* tab; int total_rt, G, c; size_t a_tile_bytes, w_exp_bytes; int nkt;
    __device__ __forceinline__ bool next(int i, Unit& u) const {
        if (!tile_order(i, G, c, total_rt, 4, u.pm, u.pn)) return false;
        const int lane = lane_id();
        const unsigned long long m = __ballot(lane < 32 && tab[lane & 31] <= u.pm);
        const int e = __builtin_amdgcn_readfirstlane(__popcll(m) - 1);
        u.e = e; u.rt = u.pm - __builtin_amdgcn_readfirstlane(tab[e]); u.cnt = __builtin_amdgcn_readfirstlane(tab[32 + e]); return true;
    }
    __device__ __forceinline__ const char* a_buf() const { return A; }
    __device__ __forceinline__ const char* b_buf() const { return W; }
    __device__ __forceinline__ unsigned b_soff(const Unit& u) const { return (unsigned)u.e * (unsigned)w_exp_bytes + (unsigned)(u.pn * nkt) * 32768u; }
};
struct SchedMoeA : SchedMoe {
    static constexpr bool GATHER = true;
    __device__ __forceinline__ unsigned a_soff(const Unit&) const { return 0u; }
    __device__ __forceinline__ void a_tokens(const Unit& u, int R, unsigned (&tk)[2]) const {
        asm volatile("" : "+v"(R));
        const __amdgpu_buffer_rsrc_t rl = __builtin_amdgcn_make_buffer_rsrc((void*)ltok, 0, NE * CAP * 4, 0x00020000);
#pragma unroll
        for (int h = 0; h < 2; ++h) { const int p0 = u.rt * 256 + 128 * h + R, p1 = p0 + 64;
            const unsigned r0 = (unsigned)__builtin_amdgcn_raw_buffer_load_b32(rl, p0 < u.cnt ? (u.e * CAP + p0) * 4 : 0x7ffffff0, 0, 0);
            const unsigned r1 = (unsigned)__builtin_amdgcn_raw_buffer_load_b32(rl, p1 < u.cnt ? (u.e * CAP + p1) * 4 : 0x7ffffff0, 0, 0);
            tk[h] = (r0 & 0x3fffu) | ((r1 & 0x3fffu) << 16); }
    }
};
struct SchedMoeB : SchedMoe {
    static constexpr bool GATHER = false;
    __device__ __forceinline__ unsigned a_soff(const Unit& u) const { return (unsigned)u.pm * (unsigned)a_tile_bytes; }
    __device__ __forceinline__ void a_tokens(const Unit&, int, unsigned (&)[2]) const {}
};

struct EpiP1 {
    bf16* P;
    __device__ __forceinline__ void operator()(const f32x4 (&acc)[2][2][4][2], const Unit& u, int wr, int wc, int fr, int fq) const {
        asm volatile("" : "+v"(fr), "+v"(fq));
        const int row0 = u.pm * BM + wr * 64 + fr, cl = wc * 32 + 8 * fq;
        if (u.pn >= 4 && u.pn < 6) {
#pragma unroll
            for (int ai = 0; ai < 2; ++ai)
#pragma unroll
                for (int m = 0; m < 4; ++m) { bf16* rowp = P + (size_t)(row0 + ai * HALF + m * 16) * PW + 512 + (u.pn - 4) * 256 + cl;
#pragma unroll
                    for (int bj = 0; bj < 2; ++bj) { const f32x4 v0 = acc[ai][bj][m][0], v1 = acc[ai][bj][m][1];
                        u32x4 w; w.x = cvt_pk_bf16(v0[0], v0[1]); w.y = cvt_pk_bf16(v0[2], v0[3]); w.z = cvt_pk_bf16(v1[0], v1[1]); w.w = cvt_pk_bf16(v1[2], v1[3]);
                        *(u32x4*)(rowp + bj * HALF) = w; } }
        } else if (u.pn < 4) {
#pragma unroll
            for (int ai = 0; ai < 2; ++ai)
#pragma unroll
                for (int m = 0; m < 4; ++m) { bf16* rowp = P + (size_t)(row0 + ai * HALF + m * 16) * PW + u.pn * 128 + cl;
                    const f32x4 v0 = acc[ai][0][m][0] * acc[ai][1][m][0], v1 = acc[ai][0][m][1] * acc[ai][1][m][1];
                    u32x4 w; w.x = cvt_pk_bf16(v0[0], v0[1]); w.y = cvt_pk_bf16(v0[2], v0[3]); w.z = cvt_pk_bf16(v1[0], v1[1]); w.w = cvt_pk_bf16(v1[2], v1[3]);
                    *(u32x4*)rowp = w; }
        } else {
#pragma unroll
            for (int ai = 0; ai < 2; ++ai)
#pragma unroll
                for (int m = 0; m < 4; ++m) { bf16* rowp = P + (size_t)(row0 + ai * HALF + m * 16) * PW + 1024 + (u.pn - 6) * 128 + cl;
                    f32x4 v0, v1;
#pragma unroll
                    for (int j = 0; j < 4; ++j) { v0[j] = acc[ai][0][m][0][j] * fast_sigmoid(acc[ai][1][m][0][j]); v1[j] = acc[ai][0][m][1][j] * fast_sigmoid(acc[ai][1][m][1][j]); }
                    u32x4 w; w.x = cvt_pk_bf16(v0[0], v0[1]); w.y = cvt_pk_bf16(v0[2], v0[3]); w.z = cvt_pk_bf16(v1[0], v1[1]); w.w = cvt_pk_bf16(v1[2], v1[3]);
                    *(u32x4*)rowp = w; }
        }
    }
};
struct EpiX1 {
    const bf16* xb; const float* ri; bf16* x1b; float* ssq;
    __device__ __forceinline__ void operator()(const f32x4 (&acc)[2][2][4][2], const Unit& u, int wr, int wc, int fr, int fq) const {
        asm volatile("" : "+v"(fr), "+v"(fq));
        const int row0 = u.pm * BM + wr * 64 + fr, col0 = u.pn * BM + wc * 32 + 8 * fq;
#pragma unroll
        for (int ai = 0; ai < 2; ++ai)
#pragma unroll
            for (int m = 0; m < 4; ++m) { const int row = row0 + ai * HALF + m * 16; const bf16* xr = xb + (size_t)row * D + col0; const float rinv = ri[row]; bf16* orow = x1b + (size_t)row * D + col0; float s = 0.f;
#pragma unroll
                for (int bj = 0; bj < 2; ++bj) { const u32x4 xq = *(const u32x4*)(xr + bj * HALF);
                    const f32x4 a = (f32x4){bflo(xq[0]), bfhi(xq[0]), bflo(xq[1]), bfhi(xq[1])} * rinv, b = (f32x4){bflo(xq[2]), bfhi(xq[2]), bflo(xq[3]), bfhi(xq[3])} * rinv;
                    const f32x4 v0 = acc[ai][bj][m][0] + a, v1 = acc[ai][bj][m][1] + b;
                    s += (v0[0] * v0[0] + v0[1] * v0[1]) + (v0[2] * v0[2] + v0[3] * v0[3]) + (v1[0] * v1[0] + v1[1] * v1[1]) + (v1[2] * v1[2] + v1[3] * v1[3]);
                    u32x4 w; w.x = cvt_pk_bf16(v0[0], v0[1]); w.y = cvt_pk_bf16(v0[2], v0[3]); w.z = cvt_pk_bf16(v1[0], v1[1]); w.w = cvt_pk_bf16(v1[2], v1[3]);
                    *(u32x4*)(orow + bj * HALF) = w; }
                s += __shfl_xor(s, 16); s += __shfl_xor(s, 32);
                if (fq == 0) ssq[(size_t)(u.pn * 4 + wc) * T + row] = s; }
    }
};
struct EpiH {
    fp8* H;
    __device__ __forceinline__ void operator()(const f32x4 (&acc)[2][2][4][2], const Unit& u, int wr, int wc, int fr, int fq) const {
        asm volatile("" : "+v"(fr), "+v"(fq));
        const int cl = u.pn * 128 + wc * 32 + 8 * fq;
#pragma unroll
        for (int ai = 0; ai < 2; ++ai)
#pragma unroll
            for (int m = 0; m < 4; ++m) { const int rl = ai * HALF + wr * 64 + m * 16 + fr; const float rr = 1.0f / 32.0f;
                f32x4 v0, v1;
#pragma unroll
                for (int j = 0; j < 4; ++j) { const float a0 = acc[ai][0][m][0][j] * rr, b0 = acc[ai][1][m][0][j] * rr, a1 = acc[ai][0][m][1][j] * rr, b1 = acc[ai][1][m][1][j] * rr;
                    v0[j] = a0 * fast_sigmoid(a0) * b0; v1[j] = a1 * fast_sigmoid(a1) * b1; }
                u32x2 w; w.x = pk4_fp8(v0[0], v0[1], v0[2], v0[3]); w.y = pk4_fp8(v1[0], v1[1], v1[2], v1[3]);
                *(u32x2*)(H + ((size_t)u.pm * 256 + rl) * DE + cl) = w; }
    }
};
struct EpiC {
    fp8* Cb; const unsigned* ltok;
    __device__ __forceinline__ void operator()(const f32x4 (&acc)[2][2][4][2], const Unit& u, int wr, int wc, int fr, int fq) const {
        asm volatile("" : "+v"(fr), "+v"(fq));
        const int cl = u.pn * 256 + wc * 32 + 8 * fq;
#pragma unroll
        for (int ai = 0; ai < 2; ++ai)
#pragma unroll
            for (int m = 0; m < 4; ++m) { const int rl = ai * HALF + wr * 64 + m * 16 + fr, pos = u.rt * 256 + rl;
                if (pos < u.cnt) { const unsigned rec = ltok[(size_t)u.e * CAP + pos]; const float cw = bfhi(rec) * 4.0f;
                    fp8* orow = Cb + ((size_t)((rec >> 14) & 1u) * T + (rec & 0x3fffu)) * D + cl;
#pragma unroll
                    for (int bj = 0; bj < 2; ++bj) { const f32x4 v0 = acc[ai][bj][m][0] * cw, v1 = acc[ai][bj][m][1] * cw;
                        u32x2 w; w.x = pk4_fp8(v0[0], v0[1], v0[2], v0[3]); w.y = pk4_fp8(v1[0], v1[1], v1[2], v1[3]);
                        *(u32x2*)(orow + bj * HALF) = w; } } }
    }
};

template <class Epi, class Sched, bool F8>
__device__ __forceinline__ void gemm_phase(LAS unsigned char* lds, const int Kb, const Sched& S, const Epi& E, const int wid) {
    constexpr bool GATHER = Sched::GATHER;
    const int lane = lane_id(), tid = wid * 64 + lane, wr = wid >> 2, wc = wid & 3, fr = lane & 15, fq = lane >> 4;
    int nt = Kb / 128; asm volatile("" : "+s"(nt));
    const unsigned kstep = 128u, hstep = (unsigned)(HALF * Kb);
    const unsigned kstepB = 32768u, hstepB = 2048u;
    const __amdgpu_buffer_rsrc_t rsA = __builtin_amdgcn_make_buffer_rsrc((void*)S.a_buf(), 0, 0x7fffffff, 0x00020000);
    const __amdgpu_buffer_rsrc_t rsB = __builtin_amdgcn_make_buffer_rsrc((void*)S.b_buf(), 0, 0x7fffffff, 0x00020000);
    unsigned voffA[2], voffB[2], ct[2] = {0u, 0u}, ntk[2] = {0u, 0u}; unsigned pc2;
    { int R, C; stage_rc(tid * 16, R, C); pc2 = (unsigned)C * 2u; }
#define PG8_R0() ({ int _t = wid * 64 + lane_id(); asm volatile("" : "+v"(_t)); int _R, _C; stage_rc(_t * 16, _R, _C); _R; })
#pragma unroll
    for (int i = 0; i < 2; ++i) { int R, C; stage_rc(tid * 16 + i * 8192, R, C);
        voffA[i] = (unsigned)(R * Kb) + (unsigned)C * 2u;
        const int st = wid + 8 * i; voffB[i] = (unsigned)((((st & 1) * 4 + (lane >> 4)) * 256) + (st >> 1) * 16 + (lane & 15)) * 16u; }
    const unsigned ldsw = (unsigned)wid * 1024u;
    const int aoff = lds_byte(wr * 64 + fr, fq * 8), boff = wc * 4096 + (fq * 16 + fr) * 16;
    const LAS unsigned char* ldsA = lds + aoff; const LAS unsigned char* ldsB = lds + 4 * HTB + boff;
    asm volatile("" : "+v"(ldsA), "+v"(ldsB));
#define PG8_SA(b, h) (((b) * 2 + (h)) * HTB)
#define PG8_SB(b, h) ((4 + (b) * 2 + (h)) * HTB)
#define PG8_STAGE(bufoff, soff, voff) do { _Pragma("unroll") for (int _i = 0; _i < 2; ++_i) \
        __builtin_amdgcn_raw_ptr_buffer_load_lds(rsB, (LAS void*)(lds + (bufoff) + ldsw + _i * 8192), 16, (int)(voff)[_i], (int)(soff), 0, 0); } while (0)
#define PG8_STAGE_A(bufoff, soff, h, TK) do { _Pragma("unroll") for (int _i = 0; _i < 2; ++_i) { \
        const unsigned _o = GATHER ? ((((TK)[h] >> (16 * _i)) & 0xffffu) * (unsigned)Kb + pc2) : voffA[_i]; const unsigned _so = GATHER ? (unsigned)(soff) : (unsigned)(soff) + (h) * hstep; \
        __builtin_amdgcn_raw_ptr_buffer_load_lds(rsA, (LAS void*)(lds + (bufoff) + ldsw + _i * 8192), 16, (int)_o, (int)_so, 0, 0); } } while (0)
#define PG8_LDA(dst, b, h) do { _Pragma("unroll") for (int m = 0; m < 4; ++m) { if constexpr (F8) { const i32x4 _lo = *(const LAS i32x4*)(ldsA + PG8_SA(b, h) + m * 2048), _hi = *(const LAS i32x4*)(ldsA + PG8_SA(b, h) + m * 2048 + 1024); \
            dst##8[m] = __builtin_shufflevector(_lo, _hi, 0, 1, 2, 3, 4, 5, 6, 7); } else { _Pragma("unroll") for (int k = 0; k < 2; ++k) dst[m][k] = *(const LAS bf16x8*)(ldsA + PG8_SA(b, h) + m * 2048 + k * 1024); } } } while (0)
#define PG8_LDB(dst, b, h) do { _Pragma("unroll") for (int n = 0; n < 2; ++n) { if constexpr (F8) { const i32x4 _lo = *(const LAS i32x4*)(ldsB + (PG8_SB(b, h) - 4 * HTB) + n * 2048), _hi = *(const LAS i32x4*)(ldsB + (PG8_SB(b, h) - 4 * HTB) + n * 2048 + 1024); \
            dst##8[n] = __builtin_shufflevector(_lo, _hi, 0, 1, 2, 3, 4, 5, 6, 7); } else { _Pragma("unroll") for (int k = 0; k < 2; ++k) dst[n][k] = *(const LAS bf16x8*)(ldsB + (PG8_SB(b, h) - 4 * HTB) + n * 2048 + k * 1024); } } } while (0)
#define PG8_MMA(ai, bj, At, Bt) do { __builtin_amdgcn_s_setprio(1); _Pragma("unroll") for (int m = 0; m < 4; ++m) _Pragma("unroll") for (int n = 0; n < 2; ++n) { \
        if constexpr (F8) acc[ai][bj][m][n] = __builtin_amdgcn_mfma_scale_f32_16x16x128_f8f6f4(Bt##8[n], At##8[m], acc[ai][bj][m][n], 0, 0, 0, 0x7F7F7F7F, 0, 0x7F7F7F7F); \
        else { _Pragma("unroll") for (int k = 0; k < 2; ++k) acc[ai][bj][m][n] = __builtin_amdgcn_mfma_f32_16x16x32_bf16(Bt[n][k], At[m][k], acc[ai][bj][m][n], 0, 0, 0); } } \
        __builtin_amdgcn_s_setprio(0); } while (0)
#define PG8_WAIT_V(n) asm volatile("s_waitcnt vmcnt(" #n ")" ::: "memory")
#define PG8_WAIT_L(n) asm volatile("s_waitcnt lgkmcnt(" #n ")" ::: "memory")
#define PG8_BAR __builtin_amdgcn_s_barrier()
#define PG8_SCHED __builtin_amdgcn_sched_barrier(0)
    Unit cur, nxt; int ui = 0;
    if (!S.next(0, cur)) return;
    f32x4 acc[2][2][4][2];
#pragma unroll
    for (int a = 0; a < 2; ++a)
#pragma unroll
        for (int b = 0; b < 2; ++b)
#pragma unroll
            for (int m = 0; m < 4; ++m)
#pragma unroll
                for (int n = 0; n < 2; ++n) acc[a][b][m][n] = (f32x4){0.f, 0.f, 0.f, 0.f};
    bf16x8 At[4][2], B0[2][2], B1[2][2]; i32x8 At8[4], B08[2], B18[2];
    unsigned cA = S.a_soff(cur), cB = S.b_soff(cur);
    if constexpr (GATHER) { S.a_tokens(cur, PG8_R0(), ct); asm volatile("" : "+v"(ct[0]), "+v"(ct[1])); }
    PG8_STAGE(PG8_SB(0, 0), cB, voffB); PG8_STAGE(PG8_SB(0, 1), cB + hstepB, voffB); PG8_STAGE_A(PG8_SA(0, 0), cA, 0, ct); PG8_STAGE_A(PG8_SA(0, 1), cA, 1, ct);
    if (wr == 1) PG8_BAR;
    PG8_WAIT_V(2); PG8_BAR;
    PG8_STAGE(PG8_SB(1, 0), cB + kstepB, voffB); PG8_STAGE_A(PG8_SA(1, 0), cA + kstep, 0, ct); PG8_STAGE(PG8_SB(1, 1), cB + hstepB + kstepB, voffB);
    PG8_WAIT_V(6); PG8_BAR;
    for (;;) {
        const bool has_next = S.next(ui + 1, nxt);
        unsigned nA = cA, nB = cB;
        if constexpr (GATHER) { ntk[0] = ct[0]; ntk[1] = ct[1]; }
        if (has_next) { nA = S.a_soff(nxt); nB = S.b_soff(nxt);
            if constexpr (GATHER) { S.a_tokens(nxt, PG8_R0(), ntk); asm volatile("" : "+v"(ntk[0]), "+v"(ntk[1])); } }
#pragma unroll 1
        for (int t = 0; t < nt; t += 2) {
            const bool last = (t == nt - 2);
            const unsigned a1 = cA + (unsigned)(t + 1) * kstep;
            const unsigned a2 = last ? nA : cA + (unsigned)(t + 2) * kstep, b2 = last ? nB : cB + (unsigned)(t + 2) * kstepB;
            const unsigned a3 = a2 + kstep, b3 = b2 + kstepB;
            unsigned tc[2] = {ct[0], ct[1]}, t2[2];
            if constexpr (GATHER) asm volatile("" : "+v"(tc[0]), "+v"(tc[1]));
            t2[0] = (GATHER && last) ? ntk[0] : tc[0]; t2[1] = (GATHER && last) ? ntk[1] : tc[1];
            PG8_LDB(B0, 0, 0); PG8_LDB(B1, 0, 1); PG8_SCHED; PG8_LDA(At, 0, 0); PG8_STAGE_A(PG8_SA(1, 1), a1, 1, tc);
            PG8_WAIT_V(8); PG8_WAIT_L(0); PG8_BAR; PG8_MMA(0, 0, At, B0); PG8_MMA(0, 1, At, B1); PG8_BAR; PG8_SCHED;
            PG8_LDA(At, 0, 1); PG8_STAGE(PG8_SB(0, 0), b2, voffB); PG8_STAGE(PG8_SB(0, 1), b2 + hstepB, voffB); PG8_STAGE_A(PG8_SA(0, 0), a2, 0, t2);
            PG8_WAIT_V(8); PG8_WAIT_L(0); PG8_BAR; PG8_MMA(1, 0, At, B0); PG8_MMA(1, 1, At, B1); PG8_BAR; PG8_SCHED;
            PG8_LDB(B0, 1, 0); PG8_LDB(B1, 1, 1); PG8_SCHED; PG8_LDA(At, 1, 0); PG8_STAGE_A(PG8_SA(0, 1), a2, 1, t2);
            PG8_WAIT_V(8); PG8_WAIT_L(0); PG8_BAR; PG8_MMA(0, 0, At, B0); PG8_MMA(0, 1, At, B1); PG8_BAR; PG8_SCHED;
            PG8_LDA(At, 1, 1); PG8_STAGE(PG8_SB(1, 0), b3, voffB); PG8_STAGE(PG8_SB(1, 1), b3 + hstepB, voffB); PG8_STAGE_A(PG8_SA(1, 0), a3, 0, t2);
            PG8_WAIT_V(8); PG8_WAIT_L(0); PG8_BAR; PG8_MMA(1, 0, At, B0); PG8_MMA(1, 1, At, B1); PG8_BAR; PG8_SCHED;
        }
        if (wr == 0) PG8_BAR;
        { int _l = lane_id(); asm volatile("" : "+v"(_l)); E(acc, cur, wr, wc, _l & 15, (_l >> 4) & 3); }
        if (!has_next) break;
#pragma unroll
        for (int a = 0; a < 2; ++a)
#pragma unroll
            for (int b = 0; b < 2; ++b)
#pragma unroll
                for (int m = 0; m < 4; ++m)
#pragma unroll
                    for (int n = 0; n < 2; ++n) acc[a][b][m][n] = (f32x4){0.f, 0.f, 0.f, 0.f};
        cur = nxt; cA = nA; cB = nB; ++ui;
        if constexpr (GATHER) { ct[0] = ntk[0]; ct[1] = ntk[1]; }
        if (wr == 1) PG8_BAR;
    }
    PG8_WAIT_V(0);
    PG8_BAR;
#undef PG8_SA
#undef PG8_SB
#undef PG8_STAGE
#undef PG8_STAGE_A
#undef PG8_R0
#undef PG8_LDA
#undef PG8_LDB
#undef PG8_MMA
#undef PG8_WAIT_V
#undef PG8_WAIT_L
#undef PG8_BAR
#undef PG8_SCHED
}
}

#define XB_TMO      128
#define XB_XCNT(j)  (256  + 64 * (j))
#define XB_XSUB(j)  (1280 + 64 * (j))
#define XB_XGEN(j)  (2304 + 64 * (j))
#define XB_TOP      3328
#define XB_TOPGEN   3392
#define XCD_BAR_WORDS 3456
#define XB_SPIN_CAP (1u << 18)
__device__ __forceinline__ unsigned xb_ld(unsigned* p)              { return __hip_atomic_load(p, __ATOMIC_RELAXED, __HIP_MEMORY_SCOPE_AGENT); }
__device__ __forceinline__ unsigned xb_add(unsigned* p, unsigned v) { return __hip_atomic_fetch_add(p, v, __ATOMIC_RELAXED, __HIP_MEMORY_SCOPE_AGENT); }
__device__ __forceinline__ unsigned xb_xcc_id() { return (unsigned)__builtin_amdgcn_s_getreg((3 << 11) | 20) & 0xFu; }
#define XB_SPIN(cond, bar) do { unsigned _sp = 0; while (cond) { __builtin_amdgcn_s_sleep(1); \
    if ((++_sp & 255u) == 0u) { if (xb_ld(&(bar)[XB_TMO])) break; if (_sp > XB_SPIN_CAP) { atomicAdd(&(bar)[XB_TMO], 1u); break; } } } } while (0)
struct XcdBarrier { unsigned* bar; unsigned x; volatile LAS unsigned* st; int wave; };
__device__ __forceinline__ XcdBarrier xcd_barrier_post(unsigned* bar, volatile LAS unsigned* st, int wave) {
    XcdBarrier b; b.bar = bar; b.x = xb_xcc_id(); b.st = st; b.wave = wave;
    if (wave == 0 && lane_id() == 0) (void)xb_add(&bar[XB_XCNT(b.x)], 1u);
    return b;
}
__device__ __forceinline__ void xcd_barrier_complete(unsigned* bar, unsigned x, unsigned& nloc, unsigned& nx) {
    const unsigned G = gridDim.x * gridDim.y * gridDim.z;
    unsigned sum, cnt, mine, sp = 0u;
    for (;;) {
        sum = 0u; cnt = 0u; mine = 0u;
#pragma unroll
        for (unsigned j = 0; j < 16; ++j) { const unsigned c = xb_ld(&bar[XB_XCNT(j)]); sum += c; cnt += (c > 0u) ? 1u : 0u; mine = (j == x) ? c : mine; }
        if (sum == G) break;
        __builtin_amdgcn_s_sleep(1);
        if ((++sp & 255u) == 0u) { if (xb_ld(&bar[XB_TMO])) break; if (sp > XB_SPIN_CAP) { atomicAdd(&bar[XB_TMO], 1u); break; } }
    }
    nloc = mine > 0u ? mine : 1u; nx = cnt > 0u ? cnt : 1u;
}
__device__ __forceinline__ void xcd_barrier(const XcdBarrier& b) {
    asm volatile("s_waitcnt vmcnt(0)" ::: "memory");
    __syncthreads();
    if (b.wave == 0 && lane_id() == 0) {
        unsigned* bar = b.bar;
        __builtin_amdgcn_s_waitcnt(0);
        unsigned nloc = b.st[0], nx = b.st[1];
        if (nloc == 0u) { xcd_barrier_complete(bar, b.x, nloc, nx); b.st[0] = nloc; b.st[1] = nx; }
        const unsigned old = xb_add(&bar[XB_XSUB(b.x)], 1u);
        const unsigned gen = old / nloc;
        if (old + 1u == (gen + 1u) * nloc) {
            __builtin_amdgcn_fence(__ATOMIC_RELEASE, "agent");
            asm volatile("s_waitcnt vmcnt(0)" ::: "memory");
            const unsigned og = xb_add(&bar[XB_TOP], 1u);
            const unsigned tg = og / nx;
            if (og + 1u == (tg + 1u) * nx) xb_add(&bar[XB_TOPGEN], 1u);
            else XB_SPIN(xb_ld(&bar[XB_TOPGEN]) == tg, bar);
            __builtin_amdgcn_fence(__ATOMIC_ACQUIRE, "agent");
            xb_add(&bar[XB_XGEN(b.x)], 1u);
            asm volatile("s_waitcnt vmcnt(0)" ::: "memory");
        } else {
            XB_SPIN(xb_ld(&bar[XB_XGEN(b.x)]) == gen, bar);
            __builtin_amdgcn_fence(__ATOMIC_ACQUIRE, "agent");
            asm volatile("s_waitcnt vmcnt(0)" ::: "memory");
        }
    }
    __syncthreads();
}

struct Frame {
    LAS unsigned char* lds;
    volatile LAS unsigned* MISC;
    gu32* ctl;
    int vcu, G, wave;
    const float *x, *norm_mix_g, *w_in, *conv_a_w, *conv_b_w, *conv_b_bias, *ln_b_g, *ln_b_b, *beta_a, *beta_b, *w_out, *norm_ffn_g, *wrg, *brg, *wre, *bre, *w1, *w3, *w2, *gfin;
    float* out;
    bf16 *Win_t, *Wout_t, *Wr_t, *XB, *P, *Y, *X1B; fp8 *W13_t, *W2_t, *H, *X1F8, *CB; float* RI;
    float *SSQ, *LW, *LR2; unsigned* LTOK; unsigned* gcnt;
};

struct CvtItem { const float* src; const float* ks; bf16* dst; int N; bool valid; };
__device__ __forceinline__ void cvt_load(const CvtItem& it, f32x4 (&v)[8]) {
    if (it.valid) {
#pragma unroll
        for (int j = 0; j < 8; ++j) v[j] = __builtin_nontemporal_load((const GAS f32x4*)(it.src + (size_t)j * it.N));
    }
}
__device__ __forceinline__ void cvt_store(const CvtItem& it, f32x4 (&v)[8]) {
    if (it.valid) {
        if (it.ks) {
#pragma unroll
            for (int j = 0; j < 8; ++j) v[j] = v[j] * it.ks[j];
        }
#pragma unroll
        for (int c = 0; c < 4; ++c) { u32x4 g; g.x = cvt_pk_bf16(v[0][c], v[1][c]); g.y = cvt_pk_bf16(v[2][c], v[3][c]); g.z = cvt_pk_bf16(v[4][c], v[5][c]); g.w = cvt_pk_bf16(v[6][c], v[7][c]);
            *(GAS u32x4*)(it.dst + (size_t)c * 8) = g; }
    }
}
__device__ __forceinline__ int win_dest_row(int n0) {
    if (n0 < 512) return 256 * (n0 >> 7) + (n0 & 127);
    if (n0 < 1024) return n0 + 512;
    if (n0 < 1536) { const int j = n0 - 1024; return 256 * (j >> 7) + 128 + (j & 127); }
    if (n0 < 2048) { const int j = n0 - 1536; return 1536 + 256 * (j >> 7) + (j & 127); }
    { const int j = n0 - 2048; return 1536 + 256 * (j >> 7) + 128 + (j & 127); }
}
__device__ __forceinline__ size_t gran_idx(int kb, int drow, int nkt) { const int w = drow & 31, slot = (drow & 224) + 16 * ((w >> 2) & 1) + 4 * (w >> 3) + (w & 3);
    return ((size_t)(((drow >> 8) * nkt + (kb >> 3)) * 8 + (kb & 7)) * 256 + slot); }
constexpr int I_IN = 128 * 10, I_OUT = 128 * 4, NITEMS = I_IN + I_OUT;
constexpr int J_13 = NE * 2 * 64 * 2, J_2 = NE * 32 * 4, NITEMS8 = J_13 + J_2;
__device__ __forceinline__ CvtItem p0_decode(Frame& F, int it, int lane) {
    CvtItem c; c.valid = it < NITEMS; c.src = F.w_in; c.ks = nullptr; c.dst = F.Win_t; c.N = DIN;
    if (!c.valid) return c;
    int r = it;
    if (r < I_IN) { const int kb = r / 10, n = 256 * (r % 10) + 4 * lane;
        c.src = F.w_in + (size_t)(8 * kb) * DIN + n; c.N = DIN; c.ks = F.norm_mix_g + 8 * kb; c.dst = F.Win_t + gran_idx(kb, win_dest_row(n), 16) * 8; return c; }
    r -= I_IN;
    { const int kb = r / 4, n = 256 * (r % 4) + 4 * lane;
        c.src = F.w_out + (size_t)(8 * kb) * D + n; c.N = D; c.ks = (8 * kb < DA) ? F.beta_a + 8 * kb : F.beta_b + (8 * kb - DA); c.dst = F.Wout_t + gran_idx(kb, n, 16) * 8; return c; }
}
struct CvtItem8 { const float* src; const float* ks; fp8* dst; int N; float scale; };
__device__ __forceinline__ CvtItem8 p0_decode8(Frame& F, int it, int lane) {
    CvtItem8 c; int r = it;
    if (r < J_13) { const int e = r / 256, rr = r % 256, which = rr / 128, item = rr % 128, kb = item / 2, n = 256 * (item % 2) + 4 * lane;
        c.src = (which ? F.w3 : F.w1) + (size_t)e * D * DE + (size_t)(16 * kb) * DE + n; c.N = DE; c.ks = F.norm_ffn_g + 16 * kb; c.scale = 32.0f;
        c.dst = F.W13_t + (size_t)e * 1024 * D + gran_idx(kb, 256 * (n >> 7) + 128 * which + (n & 127), 8) * 16; return c; }
    r -= J_13;
    { const int e = r / 128, item = r % 128, kb = item / 4, n = 256 * (item % 4) + 4 * lane;
        c.src = F.w2 + (size_t)e * DE * D + (size_t)(16 * kb) * D + n; c.N = D; c.ks = nullptr; c.scale = 16.0f; c.dst = F.W2_t + (size_t)e * 1024 * DE + gran_idx(kb, n, 4) * 16; return c; }
}
__device__ __forceinline__ void p0_cvt8_item(Frame& F, int it, int lane) {
    const CvtItem8 c = p0_decode8(F, it, lane);
    f32x4 v[16];
#pragma unroll
    for (int j = 0; j < 16; ++j) v[j] = __builtin_nontemporal_load((const GAS f32x4*)(c.src + (size_t)j * c.N));
#pragma unroll
    for (int j = 0; j < 16; ++j) v[j] = v[j] * (c.ks ? c.ks[j] * c.scale : c.scale);
#pragma unroll
    for (int q = 0; q < 4; ++q) { u32x4 g;
#pragma unroll
        for (int w = 0; w < 4; ++w) g[w] = pk4_fp8(v[4 * w][q], v[4 * w + 1][q], v[4 * w + 2][q], v[4 * w + 3][q]);
        *(GAS u32x4*)(c.dst + (size_t)q * 16) = g; }
}
constexpr int NITEMS8_LATE = 4096;
__device__ __forceinline__ void p1_late_convert(Frame& F) {
    if (F.G != 256 || blockIdx.x < 128) return;
    int lane = lane_id(); asm volatile("" : "+v"(lane));
    const int w0 = ((int)blockIdx.x - 128) * NWAVES + F.wave;
    for (int it = NITEMS8 - NITEMS8_LATE + w0; it < NITEMS8; it += 128 * NWAVES) p0_cvt8_item(F, it, lane);
}
__device__ __forceinline__ void p0_prologue(Frame& F) {
    const int wave = F.wave; int lane = lane_id(); asm volatile("" : "+v"(lane)); const int tid = wave * 64 + lane;
    const int gw = F.vcu * NWAVES + wave, NGW = F.G * NWAVES;
    for (int it = gw; it < NITEMS; it += 2 * NGW) {
        const CvtItem c0 = p0_decode(F, it, lane), c1 = p0_decode(F, it + NGW, lane);
        f32x4 v0[8], v1[8];
        cvt_load(c0, v0); cvt_load(c1, v1);
        cvt_store(c0, v0); cvt_store(c1, v1);
    }
    for (int it = gw; it < NITEMS8 - (F.G == 256 ? NITEMS8_LATE : 0); it += NGW) p0_cvt8_item(F, it, lane);
    for (int i = gw * 64 + lane; i < 48 * D; i += NGW * 64) { const int o = i / D, k = i % D; float v = 0.f;
        if (o < 4) v = F.wrg[(size_t)k * 4 + o] * F.norm_ffn_g[k]; else if (o < 36) v = F.wre[(size_t)k * NE + (o - 4)] * F.norm_ffn_g[k];
        F.Wr_t[i] = (bf16)f2bf(v); }
    for (int m = gw; m < T; m += NGW) {
        const GAS f32x4* xr = (const GAS f32x4*)(F.x + (size_t)m * D) + lane;
        f32x4 v[4]; float s = 0.f;
#pragma unroll
        for (int j = 0; j < 4; ++j) { v[j] = __builtin_nontemporal_load(xr + 64 * j); s += (v[j].x * v[j].x + v[j].y * v[j].y) + (v[j].z * v[j].z + v[j].w * v[j].w); }
        const float r = rsqrtf(wave_sum(s) * (1.f / D) + EPS);
        if (lane == 0) F.RI[m] = 1.0f / r;
        GAS u32x2* o8 = (GAS u32x2*)(F.XB + (size_t)m * D) + lane;
#pragma unroll
        for (int j = 0; j < 4; ++j) { u32x2 w; w.x = pk2(v[j].x * r, v[j].y * r); w.y = pk2(v[j].z * r, v[j].w * r); o8[64 * j] = w; }
    }
}

template <int CTRL> __device__ __forceinline__ float dpp_f(float v) { return __builtin_bit_cast(float, __builtin_amdgcn_update_dpp(0, __builtin_bit_cast(int, v), CTRL, 0xf, 0xf, false)); }
#define DPP_XOR1 0xB1
#define DPP_XOR2 0x4E
#define DPP_HALF_MIRROR 0x141
#define DPP_ROW_MIRROR 0x140
__device__ __forceinline__ float sum8(float v) { v += dpp_f<DPP_XOR1>(v); v += dpp_f<DPP_XOR2>(v); v += dpp_f<DPP_HALF_MIRROR>(v); return v; }
__device__ __forceinline__ float sum16(float v) { v = sum8(v); v += dpp_f<DPP_ROW_MIRROR>(v); return v; }
__device__ __forceinline__ void p2_mixer(Frame& F) {
    const int wave = F.wave; int lane = lane_id(); asm volatile("" : "+v"(lane)); const int tid = wave * 64 + lane;
    LAS unsigned char* L = F.lds;
    LAS unsigned* Ut = (LAS unsigned*)L;
    LAS float* UC = (LAS float*)(L + 62 * 1024);
    LAS float* PRM = (LAS float*)(L + LDSCTL_OFF + 2048);
    PRM[tid] = F.ln_b_g[tid]; PRM[512 + tid] = F.ln_b_b[tid];
#pragma unroll
    for (int q = 0; q < 3; ++q) PRM[1024 + 512 * q + tid] = F.conv_a_w[q * DA + tid];
    const int cp = tid & 255, th = tid >> 8;
    f32x2 wb[31];
#pragma unroll
    for (int j = 0; j < 31; ++j) wb[j] = *(const f32x2*)(F.conv_b_w + j * DB + 2 * cp);
    const f32x2 bias2 = *(const f32x2*)(F.conv_b_bias + 2 * cp);
    const int tq = lane >> 4, tl = lane & 15;
    u32x4 ureg[8];
#define P2_ULOAD(tile_) do { const int _t0 = (tile_) * 32, _b = _t0 / SEQ, _s0 = _t0 % SEQ; int _tid = tid; asm volatile("" : "+v"(_tid)); _Pragma("unroll") for (int _i = 0; _i < 8; ++_i) { const int _ch = _tid + 512 * _i, _row = _ch >> 6, _c16 = _ch & 63, _s = _s0 - 15 + _row; \
        ureg[_i] = (u32x4){0u, 0u, 0u, 0u}; if (_ch < 62 * 64 && _s >= 0 && _s < SEQ) ureg[_i] = *(const GAS u32x4*)(F.P + (size_t)(_b * SEQ + _s) * PW + 1024 + _c16 * 8); } } while (0)
    int tile = F.vcu;
    if (tile < T / 32) P2_ULOAD(tile);
    __syncthreads();
    for (; tile < T / 32; tile += F.G) {
        const int t0 = tile * 32, s0 = t0 % SEQ;
        { int tid2 = tid; asm volatile("" : "+v"(tid2));
#pragma unroll
        for (int i = 0; i < 8; ++i) { const int ch = tid2 + 512 * i; if (ch < 62 * 64) *(LAS u32x4*)(L + ch * 16) = ureg[i]; } }
        __syncthreads();
        if (tile + F.G < T / 32) P2_ULOAD(tile + F.G);
#pragma unroll 1
        for (int sub = 0; sub < 2; ++sub) { const int i0 = th * 16 + sub * 8; f32x2 a[8];
#pragma unroll
            for (int i = 0; i < 8; ++i) a[i] = bias2;
#pragma unroll
            for (int w = 0; w < 38; ++w) { const unsigned v = Ut[(i0 + w) * 256 + cp]; const f32x2 x2 = (f32x2){bflo(v), bfhi(v)};
#pragma unroll
                for (int i = 0; i < 8; ++i) { const int j = w - i; if (j >= 0 && j < 31) a[i] = __builtin_elementwise_fma(wb[j], x2, a[i]); } }
#pragma unroll
            for (int i = 0; i < 8; ++i) *(LAS f32x2*)(UC + (i0 + i) * 512 + 2 * cp) = a[i];
        }
        __syncthreads();
        u32x4 gpm1[4], gp0[4], gpp1[4], gab[4];
        { const int i = wave * 4 + tq, s = s0 + i; const bf16* prow = F.P + (size_t)(t0 + i) * PW + 8 * tl; const u32x4 z4 = (u32x4){0u, 0u, 0u, 0u};
#pragma unroll
          for (int k = 0; k < 4; ++k) { const bf16* pk = prow + 128 * k;
            gpm1[k] = (s > 0) ? *(const GAS u32x4*)(pk - PW) : z4; gp0[k] = *(const GAS u32x4*)pk; gpp1[k] = (s < SEQ - 1) ? *(const GAS u32x4*)(pk + PW) : z4; gab[k] = *(const GAS u32x4*)(pk + 512); } }
        { const int i = wave * 4 + tq, t = t0 + i;
          float uv[4][8]; float s1 = 0.f;
#pragma unroll
          for (int k = 0; k < 4; ++k) { const LAS float* up = UC + i * 512 + 8 * (tl + 16 * k); const f32x4 ua = *(const LAS f32x4*)up, ub = *(const LAS f32x4*)(up + 4);
#pragma unroll
            for (int j = 0; j < 4; ++j) { uv[k][j] = ua[j]; uv[k][4 + j] = ub[j]; s1 += ua[j] + ub[j]; } }
          const float mu = sum16(s1) * (1.f / DB); float s2 = 0.f;
#pragma unroll
          for (int k = 0; k < 4; ++k)
#pragma unroll
            for (int j = 0; j < 8; ++j) { uv[k][j] -= mu; s2 += uv[k][j] * uv[k][j]; }
          const float rstd = rsqrtf(sum16(s2) * (1.f / DB) + EPS);
#pragma unroll
          for (int k = 0; k < 4; ++k) { const int c8 = 8 * (tl + 16 * k); const LAS float* gp = PRM + c8; const f32x4 g0 = *(const LAS f32x4*)gp, g1 = *(const LAS f32x4*)(gp + 4), b0 = *(const LAS f32x4*)(gp + 512), b1 = *(const LAS f32x4*)(gp + 516);
            float hb = 0.f;
#pragma unroll
            for (int j = 0; j < 8; ++j) { const float z = uv[k][j] * rstd * (j < 4 ? g0[j & 3] : g1[j & 3]) + (j < 4 ? b0[j & 3] : b1[j & 3]); uv[k][j] = z * fast_sigmoid(z); hb += uv[k][j] * uv[k][j]; }
            const float rb = rsqrtf(sum8(hb) * (1.f / 64.f) + EPS);
            u32x4 ob; ob.x = cvt_pk_bf16(uv[k][0] * rb, uv[k][1] * rb); ob.y = cvt_pk_bf16(uv[k][2] * rb, uv[k][3] * rb); ob.z = cvt_pk_bf16(uv[k][4] * rb, uv[k][5] * rb); ob.w = cvt_pk_bf16(uv[k][6] * rb, uv[k][7] * rb);
            *(GAS u32x4*)(F.Y + (size_t)t * D + DA + c8) = ob; }
#pragma unroll
          for (int k = 0; k < 4; ++k) { const int c8 = 8 * (tl + 16 * k); const LAS float* wp = PRM + 1024 + c8; float ya[8]; float ha = 0.f;
            f32x4 w0[2], w1[2], w2[2];
#pragma unroll
            for (int h = 0; h < 2; ++h) { w0[h] = *(const LAS f32x4*)(wp + 4 * h); w1[h] = *(const LAS f32x4*)(wp + 512 + 4 * h); w2[h] = *(const LAS f32x4*)(wp + 1024 + 4 * h); }
#pragma unroll
            for (int j = 0; j < 4; ++j) { const int h = j >> 1, e = 2 * (j & 1);
                const float c0 = w0[h][e] * bflo(gpm1[k][j]) + w1[h][e] * bflo(gp0[k][j]) + w2[h][e] * bflo(gpp1[k][j]);
                const float c1 = w0[h][e + 1] * bfhi(gpm1[k][j]) + w1[h][e + 1] * bfhi(gp0[k][j]) + w2[h][e + 1] * bfhi(gpp1[k][j]);
                ya[2 * j] = bflo(gab[k][j]) * c0; ya[2 * j + 1] = bfhi(gab[k][j]) * c1; ha += ya[2 * j] * ya[2 * j] + ya[2 * j + 1] * ya[2 * j + 1]; }
            const float ra = rsqrtf(sum8(ha) * (1.f / 64.f) + EPS);
            u32x4 oa; oa.x = cvt_pk_bf16(ya[0] * ra, ya[1] * ra); oa.y = cvt_pk_bf16(ya[2] * ra, ya[3] * ra); oa.z = cvt_pk_bf16(ya[4] * ra, ya[5] * ra); oa.w = cvt_pk_bf16(ya[6] * ra, ya[7] * ra);
            *(GAS u32x4*)(F.Y + (size_t)t * D + c8) = oa; }
        }
    }
#undef P2_ULOAD
    __syncthreads();
}

__device__ __forceinline__ void p4_route(Frame& F) {
    const int wave = F.wave; int lane = lane_id(); asm volatile("" : "+v"(lane)); const int tid = wave * 64 + lane;
    LAS float* LGp = (LAS float*)F.lds;
    LAS int* scnt = (LAS int*)(F.lds + 102400);
    bf16x8 bfr[4][3];
    { const bf16* brow = F.Wr_t + (size_t)(lane & 15) * D + 128 * wave + 8 * (lane >> 4);
#pragma unroll
      for (int ks = 0; ks < 4; ++ks)
#pragma unroll
        for (int nb = 0; nb < 3; ++nb) bfr[ks][nb] = *(const GAS bf16x8*)(brow + (size_t)nb * 16 * D + ks * 32); }
    LAS float* r2s = (LAS float*)(F.lds + 102400 + 512);
    for (int tile = F.vcu; tile < T / 64; tile += F.G) {
        if (tid < 32) scnt[tid] = 0;
        const int tb = tile * 64;
        if (tid < 64) { float ss = 0.f;
#pragma unroll
            for (int s = 0; s < 16; ++s) ss += F.SSQ[(size_t)s * T + tb + tid];
            r2s[tid] = rsqrtf(ss * (1.f / D) + EPS); }
        bf16x8 af[4][4];
#pragma unroll
        for (int tg = 0; tg < 4; ++tg)
#pragma unroll
            for (int ks = 0; ks < 4; ++ks) af[tg][ks] = *(const GAS bf16x8*)(F.X1B + (size_t)(tb + 16 * tg + (lane & 15)) * D + 128 * wave + ks * 32 + 8 * (lane >> 4));
        __syncthreads();
#pragma unroll
        for (int tg = 0; tg < 4; ++tg) { f32x4 acc[3];
#pragma unroll
            for (int nb = 0; nb < 3; ++nb) acc[nb] = (f32x4){0.f, 0.f, 0.f, 0.f};
#pragma unroll
            for (int ks = 0; ks < 4; ++ks)
#pragma unroll
                for (int nb = 0; nb < 3; ++nb) acc[nb] = __builtin_amdgcn_mfma_f32_16x16x32_bf16(af[tg][ks], bfr[ks][nb], acc[nb], 0, 0, 0);
#pragma unroll
            for (int nb = 0; nb < 3; ++nb)
#pragma unroll
                for (int r = 0; r < 4; ++r) LGp[(wave * 64 + 16 * tg + 4 * (lane >> 4) + r) * 49 + nb * 16 + (lane & 15)] = acc[nb][r];
            const float rs = r2s[16 * tg + (lane & 15)];
#pragma unroll
            for (int ks = 0; ks < 4; ++ks) { const u32x4 q = __builtin_bit_cast(u32x4, af[tg][ks]); u32x2 o;
                o.x = pk4_fp8(bflo(q[0]) * rs, bfhi(q[0]) * rs, bflo(q[1]) * rs, bfhi(q[1]) * rs); o.y = pk4_fp8(bflo(q[2]) * rs, bfhi(q[2]) * rs, bflo(q[3]) * rs, bfhi(q[3]) * rs);
                *(GAS u32x2*)(F.X1F8 + (size_t)(tb + 16 * tg + (lane & 15)) * D + 128 * wave + ks * 32 + 8 * (lane >> 4)) = o; } }
        __syncthreads();
        int e0 = 0, e1 = 0, p0 = 0, p1 = 0; float c0 = 0.f, c1 = 0.f;
        if (tid < 64) {
            const float r2 = r2s[tid];
            const LAS float* lg = LGp + tid * 49;
            float g4[4];
#pragma unroll
            for (int i = 0; i < 4; ++i) { float a = 0.f;
#pragma unroll
                for (int w = 0; w < 8; ++w) a += lg[w * 64 * 49 + i];
                g4[i] = a * r2 + F.brg[i]; }
            int g = 0; float m = g4[0];
#pragma unroll
            for (int i = 1; i < 4; ++i) if (g4[i] > m) { m = g4[i]; g = i; }
            float den = 0.f;
#pragma unroll
            for (int i = 0; i < 4; ++i) den += __expf(g4[i] - m);
            const float psel = 1.0f / den;
            int i0 = 0, i1 = -1; float m0 = -3.0e38f, m1 = -3.0e38f;
            for (int i = 0; i < 8; ++i) { float a = 0.f;
#pragma unroll
                for (int w = 0; w < 8; ++w) a += lg[w * 64 * 49 + 4 + g * 8 + i];
                const float v = a * r2 + F.bre[g * 8 + i];
                if (v > m0) { m1 = m0; i1 = i0; m0 = v; i0 = i; } else if (v > m1) { m1 = v; i1 = i; } }
            const float ex = __expf(m1 - m0);
            e0 = g * 8 + i0; e1 = g * 8 + i1; c0 = psel / (1.0f + ex); c1 = psel * ex / (1.0f + ex);
            p0 = __hip_atomic_fetch_add(scnt + e0, 1, __ATOMIC_RELAXED, __HIP_MEMORY_SCOPE_WORKGROUP); p1 = __hip_atomic_fetch_add(scnt + e1, 1, __ATOMIC_RELAXED, __HIP_MEMORY_SCOPE_WORKGROUP);
        }
        __syncthreads();
        if (tid < 32) scnt[32 + tid] = (int)__hip_atomic_fetch_add(F.gcnt + tid, (unsigned)scnt[tid], RLX_AGENT);
        __syncthreads();
        if (tid < 64) {
            const int t = tb + tid; const size_t d0 = (size_t)e0 * CAP + scnt[32 + e0] + p0, d1 = (size_t)e1 * CAP + scnt[32 + e1] + p1;
            F.LTOK[d0] = (unsigned)t | (f2bf(c0) << 16);
            F.LTOK[d1] = (unsigned)t | (1u << 14) | (f2bf(c1) << 16);
        }
        __syncthreads();
    }
}

__device__ __forceinline__ void p7_final(Frame& F) {
    const int wave = F.wave; int lane = lane_id(); asm volatile("" : "+v"(lane)); const int tid = wave * 64 + lane;
    const int gw = F.vcu * NWAVES + wave, NGW = F.G * NWAVES;
    f32x4 g[2][2];
#pragma unroll
    for (int j = 0; j < 2; ++j) { g[j][0] = *(const f32x4*)(F.gfin + j * 512 + lane * 8); g[j][1] = *(const f32x4*)(F.gfin + j * 512 + lane * 8 + 4); }
    for (int t = gw; t < T; t += NGW) {
        float v[2][8]; float ss = 0.f;
#pragma unroll
        for (int j = 0; j < 2; ++j) { const size_t o = (size_t)t * D + j * 512 + lane * 8;
            const u32x4 a = *(const GAS u32x4*)(F.X1B + o); const u32x2 c0 = *(const GAS u32x2*)(F.CB + o), c1 = *(const GAS u32x2*)(F.CB + (size_t)T * D + o);
#pragma unroll
            for (int q = 0; q < 4; q += 2) { const f32x2 p0 = __builtin_amdgcn_cvt_pk_f32_fp8((int)c0[q >> 1], false), p1 = __builtin_amdgcn_cvt_pk_f32_fp8((int)c1[q >> 1], false),
                                                           p2 = __builtin_amdgcn_cvt_pk_f32_fp8((int)c0[q >> 1], true), p3 = __builtin_amdgcn_cvt_pk_f32_fp8((int)c1[q >> 1], true);
                v[j][2 * q] = bflo(a[q]) + (p0.x + p1.x) * (1.0f / 64.0f); v[j][2 * q + 1] = bfhi(a[q]) + (p0.y + p1.y) * (1.0f / 64.0f);
                v[j][2 * q + 2] = bflo(a[q + 1]) + (p2.x + p3.x) * (1.0f / 64.0f); v[j][2 * q + 3] = bfhi(a[q + 1]) + (p2.y + p3.y) * (1.0f / 64.0f); }
#pragma unroll
            for (int q = 0; q < 8; ++q) ss += v[j][q] * v[j][q]; }
        const float r = rsqrtf(wave_sum(ss) * (1.f / D) + EPS);
#pragma unroll
        for (int j = 0; j < 2; ++j) { float* o = F.out + (size_t)t * D + j * 512 + lane * 8;
            *(GAS f32x4*)o = (f32x4){v[j][0] * r * g[j][0][0], v[j][1] * r * g[j][0][1], v[j][2] * r * g[j][0][2], v[j][3] * r * g[j][0][3]};
            *(GAS f32x4*)(o + 4) = (f32x4){v[j][4] * r * g[j][1][0], v[j][5] * r * g[j][1][1], v[j][6] * r * g[j][1][2], v[j][7] * r * g[j][1][3]}; }
    }
}

__device__ __forceinline__ void moe_sched_init(pg8::SchedMoe& S, Frame& F) {
    int lane = lane_id(); asm volatile("" : "+v"(lane));
    LAS int* tab = (LAS int*)(F.lds + LDSCTL_OFF + 1024);
    int my_cnt = 0; if (lane < NE) my_cnt = (int)__hip_atomic_load(F.gcnt + lane, RLX_AGENT);
    const int tiles = (my_cnt + 255) >> 8; int incl = tiles;
#pragma unroll
    for (int o = 1; o < 32; o <<= 1) { const int v = __shfl_up(incl, o); if (lane >= o) incl += v; }
    if (F.wave == 0 && lane < NE) { tab[lane] = incl - tiles; tab[32 + lane] = my_cnt; }
    S.total_rt = __builtin_amdgcn_readlane(incl, 31); S.tab = tab;
    S.ltok = F.LTOK; S.G = F.G; S.c = (int)blockIdx.x;
    __syncthreads();
}

struct Args { const float* in[20]; float* out; unsigned char* ws; int ph_lo, ph_hi, li, pad; };
__global__ void __launch_bounds__(NWAVES * 64, 2) mk_fwd(Args args) {
    extern __shared__ __attribute__((aligned(16))) unsigned char lds[];
    Frame F;
    F.lds = (LAS unsigned char*)lds;
    F.MISC = (volatile LAS unsigned*)(F.lds + MISC_OFF);
    F.wave = __builtin_amdgcn_readfirstlane((int)threadIdx.x >> 6);
    F.G = gridDim.x; { const int bx = blockIdx.x; F.vcu = (F.G % 8 == 0) ? (bx % 8) * (F.G / 8) + bx / 8 : bx; }
    unsigned char* ws = args.ws;
    F.ctl = (gu32*)(ws + WS_CTL);
    F.x = args.in[0]; F.norm_mix_g = args.in[1]; F.w_in = args.in[2]; F.conv_a_w = args.in[3]; F.conv_b_w = args.in[4]; F.conv_b_bias = args.in[5]; F.ln_b_g = args.in[6]; F.ln_b_b = args.in[7];
    F.beta_a = args.in[8]; F.beta_b = args.in[9]; F.w_out = args.in[10]; F.norm_ffn_g = args.in[11]; F.wrg = args.in[12]; F.brg = args.in[13]; F.wre = args.in[14]; F.bre = args.in[15];
    F.w1 = args.in[16]; F.w3 = args.in[17]; F.w2 = args.in[18]; F.gfin = args.in[19]; F.out = args.out;
    F.Win_t = (bf16*)(ws + WS_WIN); F.Wout_t = (bf16*)(ws + WS_WOUT); F.Wr_t = (bf16*)(ws + WS_WR); F.W13_t = (fp8*)(ws + WS_W13); F.W2_t = (fp8*)(ws + WS_W2); F.X1F8 = (fp8*)(ws + WS_X1F8);
    F.XB = (bf16*)(ws + WS_XB); F.P = (bf16*)(ws + WS_P); F.Y = (bf16*)(ws + WS_Y); F.X1B = (bf16*)(ws + WS_X1B); F.H = (fp8*)(ws + WS_H); F.CB = (fp8*)(ws + WS_CB); F.RI = (float*)(ws + WS_WR + 768 * 1024);
    F.SSQ = (float*)(ws + WS_SSQ); F.LW = (float*)(ws + WS_LW); F.LR2 = (float*)(ws + WS_LR2); F.LTOK = (unsigned*)(ws + WS_LTOK); F.gcnt = (unsigned*)(ws + WS_CTL) + CW_GCNT;
    for (int u = F.wave * 64 + lane_id(); u < (LDS_BYTES - LDSCTL_OFF) / 4; u += NWAVES * 64) ((LAS unsigned*)(F.lds + LDSCTL_OFF))[u] = 0u;
    __syncthreads();
    XcdBarrier bar; bar.bar = (unsigned*)(F.ctl + CW_BAR); bar.x = 0; bar.st = nullptr; bar.wave = F.wave;
    if (N_LAUNCHES == 1) bar = xcd_barrier_post((unsigned*)(F.ctl + CW_BAR), F.MISC + 8, F.wave);
    const int lo = args.ph_lo, hi = args.ph_hi;
#define IN(k) (lo <= (k) && (k) < hi)
#define GRID_BAR(k) do { if (IN(k) && IN((k) + 1)) xcd_barrier(bar); if (PROBE_PHASE >= 0 && blockIdx.x == 0 && F.wave == 0 && lane_id() == 0) ((unsigned long long*)(ws + WS_WR + 512 * 1024))[(k) + 1] = __builtin_amdgcn_s_memrealtime(); } while (0)
    if (PROBE_PHASE >= 0 && blockIdx.x == 0 && F.wave == 0 && lane_id() == 0) ((unsigned long long*)(ws + WS_WR + 512 * 1024))[0] = __builtin_amdgcn_s_memrealtime();

    if (IN(0)) { p0_prologue(F); GRID_BAR(0); }
    if (IN(1)) {
        pg8::SchedDense S{(const char*)F.XB, (const char*)F.Win_t, T / 256, DIN / 256, F.G, (int)blockIdx.x, (size_t)256 * D * 2, 16};
        pg8::EpiP1 E{F.P};
        pg8::gemm_phase<pg8::EpiP1, pg8::SchedDense, false>(F.lds + RING_OFF, D * 2, S, E, F.wave);
        p1_late_convert(F);
        GRID_BAR(1);
    }
    if (IN(2)) { p2_mixer(F); GRID_BAR(2); }
    if (IN(3)) {
        pg8::SchedDense S{(const char*)F.Y, (const char*)F.Wout_t, T / 256, D / 256, F.G, (int)blockIdx.x, (size_t)256 * D * 2, 16};
        pg8::EpiX1 E{F.XB, F.RI, F.X1B, F.SSQ};
        pg8::gemm_phase<pg8::EpiX1, pg8::SchedDense, false>(F.lds + RING_OFF, D * 2, S, E, F.wave);
        GRID_BAR(3);
    }
    if (IN(4)) { p4_route(F); GRID_BAR(4); }
    if (IN(5)) {
        pg8::SchedMoeA S; moe_sched_init(S, F); S.A = (const char*)F.X1F8; S.W = (const char*)F.W13_t; S.a_tile_bytes = 0; S.w_exp_bytes = (size_t)1024 * D; S.nkt = 8;
        pg8::EpiH E{F.H};
        pg8::gemm_phase<pg8::EpiH, pg8::SchedMoeA, true>(F.lds + RING_OFF, D, S, E, F.wave);
        GRID_BAR(5);
    }
    if (IN(6)) {
        pg8::SchedMoeB S; moe_sched_init(S, F); S.A = (const char*)F.H; S.W = (const char*)F.W2_t; S.a_tile_bytes = (size_t)256 * DE; S.w_exp_bytes = (size_t)1024 * DE; S.nkt = 4;
        pg8::EpiC E{F.CB, F.LTOK};
        pg8::gemm_phase<pg8::EpiC, pg8::SchedMoeB, true>(F.lds + RING_OFF, DE, S, E, F.wave);
        GRID_BAR(6);
    }
    if (IN(7)) { p7_final(F);
        if (PROBE_PHASE >= 0 && blockIdx.x == 0 && F.wave == 0 && lane_id() == 0) { unsigned long long* ts = (unsigned long long*)(ws + WS_WR + 512 * 1024); ts[8] = __builtin_amdgcn_s_memrealtime();
            asm volatile("s_waitcnt vmcnt(0)" ::: "memory"); const float us = (PROBE_PHASE == 8) ? (float)(ts[8] - ts[0]) * 0.001f : (float)(ts[PROBE_PHASE + 1] - ts[PROBE_PHASE]) * 0.01f; F.out[0] += us * 0.1f; } }
#undef IN
#undef GRID_BAR
}

extern "C" void kernel_launch(void* const* d_in, const int* in_sizes, int n_in, void* d_out, int out_size, void* d_ws, size_t ws_size, hipStream_t stream) {
    static int grid = 0;
    if (grid == 0) {
        if (n_in != 20 || in_sizes[0] != T * D || out_size != T * D || ws_size < WS_END) { fprintf(stderr, "kernel_launch: unexpected shapes / workspace (n_in %d, in0 %d, out %d, ws %zu, need %zu)\n", n_in, n_in > 0 ? in_sizes[0] : -1, out_size, ws_size, (size_t)WS_END); grid = -1; return; }
        int dev = 0, cus = 0, per_cu = 0;
        if (hipGetDevice(&dev) != hipSuccess || hipDeviceGetAttribute(&cus, hipDeviceAttributeMultiprocessorCount, dev) != hipSuccess) { fprintf(stderr, "kernel_launch: device query failed\n"); grid = -1; return; }
        if (hipFuncSetAttribute((const void*)mk_fwd, hipFuncAttributeMaxDynamicSharedMemorySize, LDS_BYTES) != hipSuccess) { fprintf(stderr, "kernel_launch: hipFuncSetAttribute failed\n"); grid = -1; return; }
        if (hipOccupancyMaxActiveBlocksPerMultiprocessor(&per_cu, (const void*)mk_fwd, NWAVES * 64, LDS_BYTES) != hipSuccess || per_cu < 1) fprintf(stderr, "kernel_launch: occupancy query reports %d workgroups per CU\n", per_cu);
        (void)hipGetLastError();
        grid = cus;
    }
    if (grid < 0) return;
    if (hipMemsetAsync((char*)d_ws + WS_CTL, 0, CTL_ZERO_BYTES, stream) != hipSuccess) { fprintf(stderr, "kernel_launch: hipMemsetAsync failed\n"); return; }
    Args a{};
    for (int i = 0; i < 20; ++i) a.in[i] = (const float*)d_in[i];
    a.out = (float*)d_out; a.ws = (unsigned char*)d_ws;
    for (int li = 0; li < N_LAUNCHES; ++li) {
        a.ph_lo = (N_LAUNCHES == 1) ? 0 : li; a.ph_hi = (N_LAUNCHES == 1) ? NPHASES : li + 1; a.li = li;
        hipLaunchKernelGGL(mk_fwd, dim3(grid), dim3(NWAVES * 64), LDS_BYTES, stream, a);
        const hipError_t le = hipPeekAtLastError();
        if (le != hipSuccess) { fprintf(stderr, "kernel_launch: launch %d failed: %s\n", li, hipGetErrorName(le)); break; }
    }
}
```

```cpp
#include <hip/hip_runtime.h>
#include <cstdio>
#include <cstdint>

#define LAS __attribute__((address_space(3)))
#define GAS __attribute__((address_space(1)))
typedef unsigned short bf16;
typedef short bf16x8 __attribute__((ext_vector_type(8)));
typedef float f32x4 __attribute__((ext_vector_type(4)));
typedef float f32x2 __attribute__((ext_vector_type(2)));
typedef unsigned u32x4 __attribute__((ext_vector_type(4)));
typedef unsigned u32x2 __attribute__((ext_vector_type(2)));
typedef GAS unsigned gu32;
typedef int i32x4 __attribute__((ext_vector_type(4)));
typedef int i32x8 __attribute__((ext_vector_type(8)));
typedef unsigned char fp8;

constexpr int T = 16384, SEQ = 2048, D = 1024, DA = 512, DB = 512, DIN = 2560, NE = 32, DE = 512, CAP = 16384, PW = 1536;
constexpr float EPS = 1e-6f;
constexpr int NWAVES = 8;
#ifndef MK_N_LAUNCHES
#define MK_N_LAUNCHES 1
#endif
constexpr int N_LAUNCHES = MK_N_LAUNCHES;
constexpr int NPHASES = 8;
#ifndef PROBE_PHASE
#define PROBE_PHASE -1
#endif

constexpr size_t MiB = 1u << 20;
constexpr size_t WS_CTL = 0, CTL_ZERO_BYTES = 72 * 1024;
constexpr size_t WS_WIN = 1 * MiB;
constexpr size_t WS_WOUT = 6 * MiB;
constexpr size_t WS_WR = 8 * MiB;
constexpr size_t WS_SSQ = 9 * MiB;
constexpr size_t WS_LTOK = 11 * MiB;
constexpr size_t WS_LW = 13 * MiB;
constexpr size_t WS_LR2 = 15 * MiB;
constexpr size_t WS_W13 = 17 * MiB;
constexpr size_t WS_W2 = 49 * MiB;
constexpr size_t WS_X1B = 65 * MiB;
constexpr size_t WS_X1F8 = 97 * MiB;
constexpr size_t WS_XB = 113 * MiB;
constexpr size_t WS_P = 145 * MiB;
constexpr size_t WS_Y = 193 * MiB;
constexpr size_t WS_H = 113 * MiB;
constexpr size_t WS_CB = 133 * MiB;
constexpr size_t WS_END = 225 * MiB;
constexpr int CW_TMO = 0, CW_CODE = 1, CW_BAR = 4096, CW_GCNT = 16384;

constexpr int RING_OFF = 0, RING_BYTES = 131072;
constexpr int LDSCTL_OFF = RING_BYTES, MISC_OFF = LDSCTL_OFF + 320;
constexpr int LDS_BYTES = 147456;

#define RLX_AGENT __ATOMIC_RELAXED, __HIP_MEMORY_SCOPE_AGENT
#define LDS_WAIT() asm volatile("s_waitcnt lgkmcnt(0)" ::: "memory")
#define VM_WAIT() asm volatile("s_waitcnt vmcnt(0)" ::: "memory")
__device__ __forceinline__ unsigned f2bf(float f) { unsigned u = __builtin_bit_cast(unsigned, f); return (u + 0x7fffu + ((u >> 16) & 1u)) >> 16; }
__device__ __forceinline__ unsigned pk2(float lo, float hi) { return f2bf(lo) | (f2bf(hi) << 16); }
__device__ __forceinline__ unsigned cvt_pk_bf16(float lo, float hi) { unsigned r; asm volatile("v_cvt_pk_bf16_f32 %0, %1, %2" : "=v"(r) : "v"(lo), "v"(hi)); return r; }
__device__ __forceinline__ unsigned pk4_fp8(float a, float b, float c, float d) { int w = 0; w = __builtin_amdgcn_cvt_pk_fp8_f32(a, b, w, false); w = __builtin_amdgcn_cvt_pk_fp8_f32(c, d, w, true); return (unsigned)w; }
__device__ __forceinline__ float bflo(unsigned v) { return __builtin_bit_cast(float, v << 16); }
__device__ __forceinline__ float bfhi(unsigned v) { return __builtin_bit_cast(float, v & 0xffff0000u); }
__device__ __forceinline__ float fast_sigmoid(float v) { return __builtin_amdgcn_rcpf(1.0f + __expf(-v)); }
__device__ __forceinline__ int lane_id() { unsigned m = ~0u; asm volatile("" : "+s"(m)); return (int)__builtin_amdgcn_mbcnt_hi(m, __builtin_amdgcn_mbcnt_lo(m, 0u)); }
__device__ __forceinline__ float wave_sum(float v) {
#pragma unroll
    for (int o = 1; o < 64; o <<= 1) v += __shfl_xor(v, o);
    return v;
}

namespace pg8 {
constexpr int BM = 256, BK = 64, HALF = 128, HTB = HALF * BK * 2, STAGE_BYTES = 8 * HTB, NXCD = 8, WGM = 8;
__host__ __device__ __forceinline__ int lds_byte(int r, int c) { const int st = (r >> 4) * 2 + (c >> 5), rr = r & 15, cc = c & 31, ob = rr * 64 + cc * 2; return st * 1024 + (ob ^ (((ob >> 9) & 1) << 5)); }
__host__ __device__ __forceinline__ void stage_rc(int b, int& R, int& C) { const int st = b / 1024, sb = b % 1024, swz = sb ^ (((sb >> 9) & 1) << 5); R = (st >> 1) * 16 + swz / 64; C = (st & 1) * 32 + (swz % 64) / 2; }
__host__ __device__ __forceinline__ int perm32(int rho) { const int n = rho >> 4, i = rho & 15; return 8 * (i >> 2) + 4 * n + (i & 3); }

struct Unit { int pm, pn, e, rt, cnt; };

__device__ __forceinline__ bool tile_order(int i, int G, int c, int nM, int nN, int& pm, int& pn) {
    const int nwg = nM * nN; const int L = i * G + c; if (L >= nwg) return false;
    int wgid = L; { const int q = nwg / NXCD, r = nwg % NXCD, xcd = wgid % NXCD, off = wgid / NXCD; wgid = (xcd < r ? xcd * (q + 1) : r * (q + 1) + (xcd - r) * q) + off; }
    const int nig = WGM * nN, gid = wgid / nig, fm = gid * WGM, gsz = (nM - fm) < WGM ? (nM - fm) : WGM;
    pm = fm + ((wgid % nig) % gsz); pn = (wgid % nig) / gsz; return true;
}

struct SchedDense {
    static constexpr bool GATHER = false;
    const char* A; const char* Bt; int nM, nN, G, c; size_t tstepA; int nkt;
    __device__ __forceinline__ bool next(int i, Unit& u) const { u.e = 0; u.rt = 0; u.cnt = 0; return tile_order(i, G, c, nM, nN, u.pm, u.pn); }
    __device__ __forceinline__ const char* a_buf() const { return A; }
    __device__ __forceinline__ const char* b_buf() const { return Bt; }
    __device__ __forceinline__ unsigned a_soff(const Unit& u) const { return (unsigned)u.pm * (unsigned)tstepA; }
    __device__ __forceinline__ unsigned b_soff(const Unit& u) const { return (unsigned)(u.pn * nkt) * 32768u; }
    __device__ __forceinline__ void a_tokens(const Unit&, int, unsigned (&)[2]) const {}
};
struct SchedMoe {
    const char* A; const char* W; const unsigned* ltok; const LAS int* tab; int total_rt, G, c; size_t a_tile_bytes, w_exp_bytes; int nkt;
    __device__ __forceinline__ bool next(int i, Unit& u) const {
        if (!tile_order(i, G, c, total_rt, 4, u.pm, u.pn)) return false;
        const int lane = lane_id();
        const unsigned long long m = __ballot(lane < 32 && tab[lane & 31] <= u.pm);
        const int e = __builtin_amdgcn_readfirstlane(__popcll(m) - 1);
        u.e = e; u.rt = u.pm - __builtin_amdgcn_readfirstlane(tab[e]); u.cnt = __builtin_amdgcn_readfirstlane(tab[32 + e]); return true;
    }
    __device__ __forceinline__ const char* a_buf() const { return A; }
    __device__ __forceinline__ const char* b_buf() const { return W; }
    __device__ __forceinline__ unsigned b_soff(const Unit& u) const { return (unsigned)u.e * (unsigned)w_exp_bytes + (unsigned)(u.pn * nkt) * 32768u; }
};
struct SchedMoeA : SchedMoe {
    static constexpr bool GATHER = true;
    __device__ __forceinline__ unsigned a_soff(const Unit&) const { return 0u; }
    __device__ __forceinline__ void a_tokens(const Unit& u, int R, unsigned (&tk)[2]) const {
        asm volatile("" : "+v"(R));
        const __amdgpu_buffer_rsrc_t rl = __builtin_amdgcn_make_buffer_rsrc((void*)ltok, 0, NE * CAP * 4, 0x00020000);
#pragma unroll
        for (int h = 0; h < 2; ++h) { const int p0 = u.rt * 256 + 128 * h + R, p1 = p0 + 64;
            const unsigned r0 = (unsigned)__builtin_amdgcn_raw_buffer_load_b32(rl, p0 < u.cnt ? (u.e * CAP + p0) * 4 : 0x7ffffff0, 0, 0);
            const unsigned r1 = (unsigned)__builtin_amdgcn_raw_buffer_load_b32(rl, p1 < u.cnt ? (u.e * CAP + p1) * 4 : 0x7ffffff0, 0, 0);
            tk[h] = (r0 & 0x3fffu) | ((r1 & 0x3fffu) << 16); }
    }
};
struct SchedMoeB : SchedMoe {
    static constexpr bool GATHER = false;
    __device__ __forceinline__ unsigned a_soff(const Unit& u) const { return (unsigned)u.pm * (unsigned)a_tile_bytes; }
    __device__ __forceinline__ void a_tokens(const Unit&, int, unsigned (&)[2]) const {}
};

struct EpiP1 {
    bf16* P;
    __device__ __forceinline__ void operator()(const f32x4 (&acc)[2][2][4][2], const Unit& u, int wr, int wc, int fr, int fq) const {
        asm volatile("" : "+v"(fr), "+v"(fq));
        const int row0 = u.pm * BM + wr * 64 + fr, cl = wc * 32 + 8 * fq;
        if (u.pn >= 4 && u.pn < 6) {
#pragma unroll
            for (int ai = 0; ai < 2; ++ai)
#pragma unroll
                for (int m = 0; m < 4; ++m) { bf16* rowp = P + (size_t)(row0 + ai * HALF + m * 16) * PW + 512 + (u.pn - 4) * 256 + cl;
#pragma unroll
                    for (int bj = 0; bj < 2; ++bj) { const f32x4 v0 = acc[ai][bj][m][0], v1 = acc[ai][bj][m][1];
                        u32x4 w; w.x = cvt_pk_bf16(v0[0], v0[1]); w.y = cvt_pk_bf16(v0[2], v0[3]); w.z = cvt_pk_bf16(v1[0], v1[1]); w.w = cvt_pk_bf16(v1[2], v1[3]);
                        *(u32x4*)(rowp + bj * HALF) = w; } }
        } else if (u.pn < 4) {
#pragma unroll
            for (int ai = 0; ai < 2; ++ai)
#pragma unroll
                for (int m = 0; m < 4; ++m) { bf16* rowp = P + (size_t)(row0 + ai * HALF + m * 16) * PW + u.pn * 128 + cl;
                    const f32x4 v0 = acc[ai][0][m][0] * acc[ai][1][m][0], v1 = acc[ai][0][m][1] * acc[ai][1][m][1];
                    u32x4 w; w.x = cvt_pk_bf16(v0[0], v0[1]); w.y = cvt_pk_bf16(v0[2], v0[3]); w.z = cvt_pk_bf16(v1[0], v1[1]); w.w = cvt_pk_bf16(v1[2], v1[3]);
                    *(u32x4*)rowp = w; }
        } else {
#pragma unroll
            for (int ai = 0; ai < 2; ++ai)
#pragma unroll
                for (int m = 0; m < 4; ++m) { bf16* rowp = P + (size_t)(row0 + ai * HALF + m * 16) * PW + 1024 + (u.pn - 6) * 128 + cl;
                    f32x4 v0, v1;
#pragma unroll
                    for (int j = 0; j < 4; ++j) { v0[j] = acc[ai][0][m][0][j] * fast_sigmoid(acc[ai][1][m][0][j]); v1[j] = acc[ai][0][m][1][j] * fast_sigmoid(acc[ai][1][m][1][j]); }
                    u32x4 w; w.x = cvt_pk_bf16(v0[0], v0[1]); w.y = cvt_pk_bf16(v0[2], v0[3]); w.z = cvt_pk_bf16(v1[0], v1[1]); w.w = cvt_pk_bf16(v1[2], v1[3]);
                    *(u32x4*)rowp = w; }
        }
    }
};
struct EpiX1 {
    const bf16* xb; const float* ri; bf16* x1b; float* ssq;
    __device__ __forceinline__ void operator()(const f32x4 (&acc)[2][2][4][2], const Unit& u, int wr, int wc, int fr, int fq) const {
        asm volatile("" : "+v"(fr), "+v"(fq));
        const int row0 = u.pm * BM + wr * 64 + fr, col0 = u.pn * BM + wc * 64 + 16 * fq;
#pragma unroll
        for (int ai = 0; ai < 2; ++ai)
#pragma unroll
            for (int m = 0; m < 4; ++m) { const int row = row0 + ai * HALF + m * 16; const bf16* xr = xb + (size_t)row * D + col0; const float rinv = ri[row]; bf16* orow = x1b + (size_t)row * D + col0; float s = 0.f;
#pragma unroll
                for (int bj = 0; bj < 2; ++bj) { const u32x4 xq = *(const u32x4*)(xr + bj * 8);
                    const f32x4 a = (f32x4){bflo(xq[0]), bfhi(xq[0]), bflo(xq[1]), bfhi(xq[1])} * rinv, b = (f32x4){bflo(xq[2]), bfhi(xq[2]), bflo(xq[3]), bfhi(xq[3])} * rinv;
                    const f32x4 v0 = acc[ai][bj][m][0] + a, v1 = acc[ai][bj][m][1] + b;
                    s += (v0[0] * v0[0] + v0[1] * v0[1]) + (v0[2] * v0[2] + v0[3] * v0[3]) + (v1[0] * v1[0] + v1[1] * v1[1]) + (v1[2] * v1[2] + v1[3] * v1[3]);
                    u32x4 w; w.x = cvt_pk_bf16(v0[0], v0[1]); w.y = cvt_pk_bf16(v0[2], v0[3]); w.z = cvt_pk_bf16(v1[0], v1[1]); w.w = cvt_pk_bf16(v1[2], v1[3]);
                    *(u32x4*)(orow + bj * 8) = w; }
                s += __shfl_xor(s, 16); s += __shfl_xor(s, 32);
                if (fq == 0) ssq[(size_t)(u.pn * 4 + wc) * T + row] = s; }
    }
};
struct EpiH {
    fp8* H;
    __device__ __forceinline__ void operator()(const f32x4 (&acc)[2][2][4][2], const Unit& u, int wr, int wc, int fr, int fq) const {
        asm volatile("" : "+v"(fr), "+v"(fq));
        const int cl = u.pn * 128 + wc * 32 + 8 * fq;
#pragma unroll
        for (int ai = 0; ai < 2; ++ai)
#pragma unroll
            for (int m = 0; m < 4; ++m) { const int rl = ai * HALF + wr * 64 + m * 16 + fr; const float rr = 1.0f / 32.0f;
                f32x4 v0, v1;
#pragma unroll
                for (int j = 0; j < 4; ++j) { const float a0 = acc[ai][0][m][0][j] * rr, b0 = acc[ai][1][m][0][j] * rr, a1 = acc[ai][0][m][1][j] * rr, b1 = acc[ai][1][m][1][j] * rr;
                    v0[j] = a0 * fast_sigmoid(a0) * b0; v1[j] = a1 * fast_sigmoid(a1) * b1; }
                u32x2 w; w.x = pk4_fp8(v0[0], v0[1], v0[2], v0[3]); w.y = pk4_fp8(v1[0], v1[1], v1[2], v1[3]);
                *(u32x2*)(H + ((size_t)u.pm * 256 + rl) * DE + cl) = w; }
    }
};
struct EpiC {
    fp8* Cb; const unsigned* ltok;
    __device__ __forceinline__ void operator()(const f32x4 (&acc)[2][2][4][2], const Unit& u, int wr, int wc, int fr, int fq) const {
        asm volatile("" : "+v"(fr), "+v"(fq));
        const int cl = u.pn * 256 + wc * 64 + 16 * fq;
#pragma unroll
        for (int ai = 0; ai < 2; ++ai)
#pragma unroll
            for (int m = 0; m < 4; ++m) { const int rl = ai * HALF + wr * 64 + m * 16 + fr, pos = u.rt * 256 + rl;
                if (pos < u.cnt) { const unsigned rec = ltok[(size_t)u.e * CAP + pos]; const float cw = bfhi(rec) * 4.0f;
                    fp8* orow = Cb + ((size_t)((rec >> 14) & 1u) * T + (rec & 0x3fffu)) * D + cl;
                    const f32x4 v0 = acc[ai][0][m][0] * cw, v1 = acc[ai][0][m][1] * cw, v2 = acc[ai][1][m][0] * cw, v3 = acc[ai][1][m][1] * cw;
                    u32x4 w; w.x = pk4_fp8(v0[0], v0[1], v0[2], v0[3]); w.y = pk4_fp8(v1[0], v1[1], v1[2], v1[3]); w.z = pk4_fp8(v2[0], v2[1], v2[2], v2[3]); w.w = pk4_fp8(v3[0], v3[1], v3[2], v3[3]);
                    *(u32x4*)orow = w; } }
    }
};

template <class Epi, class Sched, bool F8>
__device__ __forceinline__ void gemm_phase(LAS unsigned char* lds, const int Kb, const Sched& S, const Epi& E, const int wid) {
    constexpr bool GATHER = Sched::GATHER;
    const int lane = lane_id(), tid = wid * 64 + lane, wr = wid >> 2, wc = wid & 3, fr = lane & 15, fq = lane >> 4;
    int nt = Kb / 128; asm volatile("" : "+s"(nt));
    const unsigned kstep = 128u, hstep = (unsigned)(HALF * Kb);
    const unsigned kstepB = 32768u, hstepB = 2048u;
    const __amdgpu_buffer_rsrc_t rsA = __builtin_amdgcn_make_buffer_rsrc((void*)S.a_buf(), 0, 0x7fffffff, 0x00020000);
    const __amdgpu_buffer_rsrc_t rsB = __builtin_amdgcn_make_buffer_rsrc((void*)S.b_buf(), 0, 0x7fffffff, 0x00020000);
    unsigned voffA[2], voffB[2], ct[2] = {0u, 0u}, ntk[2] = {0u, 0u}; unsigned pc2;
    { int R, C; stage_rc(tid * 16, R, C); pc2 = (unsigned)C * 2u; }
#define PG8_R0() ({ int _t = wid * 64 + lane_id(); asm volatile("" : "+v"(_t)); int _R, _C; stage_rc(_t * 16, _R, _C); _R; })
#pragma unroll
    for (int i = 0; i < 2; ++i) { int R, C; stage_rc(tid * 16 + i * 8192, R, C);
        voffA[i] = (unsigned)(R * Kb) + (unsigned)C * 2u;
        const int st = wid + 8 * i; voffB[i] = (unsigned)((((st & 1) * 4 + (lane >> 4)) * 256) + (st >> 1) * 16 + (lane & 15)) * 16u; }
    const unsigned ldsw = (unsigned)wid * 1024u;
    const int aoff = lds_byte(wr * 64 + fr, fq * 8), boff = wc * 4096 + (fq * 16 + fr) * 16;
    const LAS unsigned char* ldsA = lds + aoff; const LAS unsigned char* ldsB = lds + 4 * HTB + boff;
    asm volatile("" : "+v"(ldsA), "+v"(ldsB));
#define PG8_SA(b, h) (((b) * 2 + (h)) * HTB)
#define PG8_SB(b, h) ((4 + (b) * 2 + (h)) * HTB)
#define PG8_STAGE(bufoff, soff, voff) do { _Pragma("unroll") for (int _i = 0; _i < 2; ++_i) \
        __builtin_amdgcn_raw_ptr_buffer_load_lds(rsB, (LAS void*)(lds + (bufoff) + ldsw + _i * 8192), 16, (int)(voff)[_i], (int)(soff), 0, 0); } while (0)
#define PG8_STAGE_A(bufoff, soff, h, TK) do { _Pragma("unroll") for (int _i = 0; _i < 2; ++_i) { \
        const unsigned _o = GATHER ? ((((TK)[h] >> (16 * _i)) & 0xffffu) * (unsigned)Kb + pc2) : voffA[_i]; const unsigned _so = GATHER ? (unsigned)(soff) : (unsigned)(soff) + (h) * hstep; \
        __builtin_amdgcn_raw_ptr_buffer_load_lds(rsA, (LAS void*)(lds + (bufoff) + ldsw + _i * 8192), 16, (int)_o, (int)_so, 0, 0); } } while (0)
#define PG8_LDA(dst, b, h) do { _Pragma("unroll") for (int m = 0; m < 4; ++m) { if constexpr (F8) { const i32x4 _lo = *(const LAS i32x4*)(ldsA + PG8_SA(b, h) + m * 2048), _hi = *(const LAS i32x4*)(ldsA + PG8_SA(b, h) + m * 2048 + 1024); \
            dst##8[m] = __builtin_shufflevector(_lo, _hi, 0, 1, 2, 3, 4, 5, 6, 7); } else { _Pragma("unroll") for (int k = 0; k < 2; ++k) dst[m][k] = *(const LAS bf16x8*)(ldsA + PG8_SA(b, h) + m * 2048 + k * 1024); } } } while (0)
#define PG8_LDB(dst, b, h) do { _Pragma("unroll") for (int n = 0; n < 2; ++n) { if constexpr (F8) { const i32x4 _lo = *(const LAS i32x4*)(ldsB + (PG8_SB(b, h) - 4 * HTB) + n * 2048), _hi = *(const LAS i32x4*)(ldsB + (PG8_SB(b, h) - 4 * HTB) + n * 2048 + 1024); \
            dst##8[n] = __builtin_shufflevector(_lo, _hi, 0, 1, 2, 3, 4, 5, 6, 7); } else { _Pragma("unroll") for (int k = 0; k < 2; ++k) dst[n][k] = *(const LAS bf16x8*)(ldsB + (PG8_SB(b, h) - 4 * HTB) + n * 2048 + k * 1024); } } } while (0)
#define PG8_MMA(ai, bj, At, Bt) do { __builtin_amdgcn_s_setprio(1); _Pragma("unroll") for (int m = 0; m < 4; ++m) _Pragma("unroll") for (int n = 0; n < 2; ++n) { \
        if constexpr (F8) acc[ai][bj][m][n] = __builtin_amdgcn_mfma_scale_f32_16x16x128_f8f6f4(Bt##8[n], At##8[m], acc[ai][bj][m][n], 0, 0, 0, 0x7F7F7F7F, 0, 0x7F7F7F7F); \
        else { _Pragma("unroll") for (int k = 0; k < 2; ++k) acc[ai][bj][m][n] = __builtin_amdgcn_mfma_f32_16x16x32_bf16(Bt[n][k], At[m][k], acc[ai][bj][m][n], 0, 0, 0); } } \
        __builtin_amdgcn_s_setprio(0); } while (0)
#define PG8_WAIT_V(n) asm volatile("s_waitcnt vmcnt(" #n ")" ::: "memory")
#define PG8_WAIT_L(n) asm volatile("s_waitcnt lgkmcnt(" #n ")" ::: "memory")
#define PG8_BAR __builtin_amdgcn_s_barrier()
#define PG8_SCHED __builtin_amdgcn_sched_barrier(0)
    Unit cur, nxt; int ui = 0;
    if (!S.next(0, cur)) return;
    f32x4 acc[2][2][4][2];
#pragma unroll
    for (int a = 0; a < 2; ++a)
#pragma unroll
        for (int b = 0; b < 2; ++b)
#pragma unroll
            for (int m = 0; m < 4; ++m)
#pragma unroll
                for (int n = 0; n < 2; ++n) acc[a][b][m][n] = (f32x4){0.f, 0.f, 0.f, 0.f};
    bf16x8 At[4][2], B0[2][2], B1[2][2]; i32x8 At8[4], B08[2], B18[2];
    unsigned cA = S.a_soff(cur), cB = S.b_soff(cur);
    if constexpr (GATHER) { S.a_tokens(cur, PG8_R0(), ct); asm volatile("" : "+v"(ct[0]), "+v"(ct[1])); }
    PG8_STAGE(PG8_SB(0, 0), cB, voffB); PG8_STAGE(PG8_SB(0, 1), cB + hstepB, voffB); PG8_STAGE_A(PG8_SA(0, 0), cA, 0, ct); PG8_STAGE_A(PG8_SA(0, 1), cA, 1, ct);
    if (wr == 1) PG8_BAR;
    PG8_WAIT_V(2); PG8_BAR;
    PG8_STAGE(PG8_SB(1, 0), cB + kstepB, voffB); PG8_STAGE_A(PG8_SA(1, 0), cA + kstep, 0, ct); PG8_STAGE(PG8_SB(1, 1), cB + hstepB + kstepB, voffB);
    PG8_WAIT_V(6); PG8_BAR;
    for (;;) {
        const bool has_next = S.next(ui + 1, nxt);
        unsigned nA = cA, nB = cB;
        if constexpr (GATHER) { ntk[0] = ct[0]; ntk[1] = ct[1]; }
        if (has_next) { nA = S.a_soff(nxt); nB = S.b_soff(nxt);
            if constexpr (GATHER) { S.a_tokens(nxt, PG8_R0(), ntk); asm volatile("" : "+v"(ntk[0]), "+v"(ntk[1])); } }
#pragma unroll 1
        for (int t = 0; t < nt; t += 2) {
            const bool last = (t == nt - 2);
            const unsigned a1 = cA + (unsigned)(t + 1) * kstep;
            const unsigned a2 = last ? nA : cA + (unsigned)(t + 2) * kstep, b2 = last ? nB : cB + (unsigned)(t + 2) * kstepB;
            const unsigned a3 = a2 + kstep, b3 = b2 + kstepB;
            unsigned tc[2] = {ct[0], ct[1]}, t2[2];
            if constexpr (GATHER) asm volatile("" : "+v"(tc[0]), "+v"(tc[1]));
            t2[0] = (GATHER && last) ? ntk[0] : tc[0]; t2[1] = (GATHER && last) ? ntk[1] : tc[1];
            PG8_LDB(B0, 0, 0); PG8_LDB(B1, 0, 1); PG8_SCHED; PG8_LDA(At, 0, 0); PG8_STAGE_A(PG8_SA(1, 1), a1, 1, tc);
            PG8_WAIT_V(8); PG8_WAIT_L(0); PG8_BAR; PG8_MMA(0, 0, At, B0); PG8_MMA(0, 1, At, B1); PG8_BAR; PG8_SCHED;
            PG8_LDA(At, 0, 1); PG8_STAGE(PG8_SB(0, 0), b2, voffB); PG8_STAGE(PG8_SB(0, 1), b2 + hstepB, voffB); PG8_STAGE_A(PG8_SA(0, 0), a2, 0, t2);
            PG8_WAIT_V(8); PG8_WAIT_L(0); PG8_BAR; PG8_MMA(1, 0, At, B0); PG8_MMA(1, 1, At, B1); PG8_BAR; PG8_SCHED;
            PG8_LDB(B0, 1, 0); PG8_LDB(B1, 1, 1); PG8_SCHED; PG8_LDA(At, 1, 0); PG8_STAGE_A(PG8_SA(0, 1), a2, 1, t2);
            PG8_WAIT_V(8); PG8_WAIT_L(0); PG8_BAR; PG8_MMA(0, 0, At, B0); PG8_MMA(0, 1, At, B1); PG8_BAR; PG8_SCHED;
            PG8_LDA(At, 1, 1); PG8_STAGE(PG8_SB(1, 0), b3, voffB); PG8_STAGE(PG8_SB(1, 1), b3 + hstepB, voffB); PG8_STAGE_A(PG8_SA(1, 0), a3, 0, t2);
            PG8_WAIT_V(8); PG8_WAIT_L(0); PG8_BAR; PG8_MMA(1, 0, At, B0); PG8_MMA(1, 1, At, B1); PG8_BAR; PG8_SCHED;
        }
        if (wr == 0) PG8_BAR;
        { int _l = lane_id(); asm volatile("" : "+v"(_l)); E(acc, cur, wr, wc, _l & 15, (_l >> 4) & 3); }
        if (!has_next) break;
#pragma unroll
        for (int a = 0; a < 2; ++a)
#pragma unroll
            for (int b = 0; b < 2; ++b)
#pragma unroll
                for (int m = 0; m < 4; ++m)
#pragma unroll
                    for (int n = 0; n < 2; ++n) acc[a][b][m][n] = (f32x4){0.f, 0.f, 0.f, 0.f};
        cur = nxt; cA = nA; cB = nB; ++ui;
        if constexpr (GATHER) { ct[0] = ntk[0]; ct[1] = ntk[1]; }
        if (wr == 1) PG8_BAR;
    }
    PG8_WAIT_V(0);
    PG8_BAR;
#undef PG8_SA
#undef PG8_SB
#undef PG8_STAGE
#undef PG8_STAGE_A
#undef PG8_R0
#undef PG8_LDA
#undef PG8_LDB
#undef PG8_MMA
#undef PG8_WAIT_V
#undef PG8_WAIT_L
#undef PG8_BAR
#undef PG8_SCHED
}
}

#define XB_TMO      128
#define XB_XCNT(j)  (256  + 64 * (j))
#define XB_XSUB(j)  (1280 + 64 * (j))
#define XB_XGEN(j)  (2304 + 64 * (j))
#define XB_TOP      3328
#define XB_TOPGEN   3392
#define XCD_BAR_WORDS 3456
#define XB_SPIN_CAP (1u << 18)
__device__ __forceinline__ unsigned xb_ld(unsigned* p)              { return __hip_atomic_load(p, __ATOMIC_RELAXED, __HIP_MEMORY_SCOPE_AGENT); }
__device__ __forceinline__ unsigned xb_add(unsigned* p, unsigned v) { return __hip_atomic_fetch_add(p, v, __ATOMIC_RELAXED, __HIP_MEMORY_SCOPE_AGENT); }
__device__ __forceinline__ unsigned xb_xcc_id() { return (unsigned)__builtin_amdgcn_s_getreg((3 << 11) | 20) & 0xFu; }
#define XB_SPIN(cond, bar) do { unsigned _sp = 0; while (cond) { __builtin_amdgcn_s_sleep(1); \
    if ((++_sp & 255u) == 0u) { if (xb_ld(&(bar)[XB_TMO])) break; if (_sp > XB_SPIN_CAP) { atomicAdd(&(bar)[XB_TMO], 1u); break; } } } } while (0)
struct XcdBarrier { unsigned* bar; unsigned x; volatile LAS unsigned* st; int wave; };
__device__ __forceinline__ XcdBarrier xcd_barrier_post(unsigned* bar, volatile LAS unsigned* st, int wave) {
    XcdBarrier b; b.bar = bar; b.x = xb_xcc_id(); b.st = st; b.wave = wave;
    if (wave == 0 && lane_id() == 0) (void)xb_add(&bar[XB_XCNT(b.x)], 1u);
    return b;
}
__device__ __forceinline__ void xcd_barrier_complete(unsigned* bar, unsigned x, unsigned& nloc, unsigned& nx) {
    const unsigned G = gridDim.x * gridDim.y * gridDim.z;
    unsigned sum, cnt, mine, sp = 0u;
    for (;;) {
        sum = 0u; cnt = 0u; mine = 0u;
#pragma unroll
        for (unsigned j = 0; j < 16; ++j) { const unsigned c = xb_ld(&bar[XB_XCNT(j)]); sum += c; cnt += (c > 0u) ? 1u : 0u; mine = (j == x) ? c : mine; }
        if (sum == G) break;
        __builtin_amdgcn_s_sleep(1);
        if ((++sp & 255u) == 0u) { if (xb_ld(&bar[XB_TMO])) break; if (sp > XB_SPIN_CAP) { atomicAdd(&bar[XB_TMO], 1u); break; } }
    }
    nloc = mine > 0u ? mine : 1u; nx = cnt > 0u ? cnt : 1u;
}
__device__ __forceinline__ void xcd_barrier(const XcdBarrier& b) {
    asm volatile("s_waitcnt vmcnt(0)" ::: "memory");
    __syncthreads();
    if (b.wave == 0 && lane_id() == 0) {
        unsigned* bar = b.bar;
        __builtin_amdgcn_s_waitcnt(0);
        unsigned nloc = b.st[0], nx = b.st[1];
        if (nloc == 0u) { xcd_barrier_complete(bar, b.x, nloc, nx); b.st[0] = nloc; b.st[1] = nx; }
        const unsigned old = xb_add(&bar[XB_XSUB(b.x)], 1u);
        const unsigned gen = old / nloc;
        if (old + 1u == (gen + 1u) * nloc) {
            __builtin_amdgcn_fence(__ATOMIC_RELEASE, "agent");
            asm volatile("s_waitcnt vmcnt(0)" ::: "memory");
            const unsigned og = xb_add(&bar[XB_TOP], 1u);
            const unsigned tg = og / nx;
            if (og + 1u == (tg + 1u) * nx) xb_add(&bar[XB_TOPGEN], 1u);
            else XB_SPIN(xb_ld(&bar[XB_TOPGEN]) == tg, bar);
            __builtin_amdgcn_fence(__ATOMIC_ACQUIRE, "agent");
            xb_add(&bar[XB_XGEN(b.x)], 1u);
            asm volatile("s_waitcnt vmcnt(0)" ::: "memory");
        } else {
            XB_SPIN(xb_ld(&bar[XB_XGEN(b.x)]) == gen, bar);
            __builtin_amdgcn_fence(__ATOMIC_ACQUIRE, "agent");
            asm volatile("s_waitcnt vmcnt(0)" ::: "memory");
        }
    }
    __syncthreads();
}

struct Frame {
    LAS unsigned char* lds;
    volatile LAS unsigned* MISC;
    gu32* ctl;
    int vcu, G, wave;
    const float *x, *norm_mix_g, *w_in, *conv_a_w, *conv_b_w, *conv_b_bias, *ln_b_g, *ln_b_b, *beta_a, *beta_b, *w_out, *norm_ffn_g, *wrg, *brg, *wre, *bre, *w1, *w3, *w2, *gfin;
    float* out;
    bf16 *Win_t, *Wout_t, *Wr_t, *XB, *P, *Y, *X1B; fp8 *W13_t, *W2_t, *H, *X1F8, *CB; float* RI;
    float *SSQ, *LW, *LR2; unsigned* LTOK; unsigned* gcnt;
};

struct CvtItem { const float* src; const float* ks; bf16* dst; int N; bool valid; };
__device__ __forceinline__ void cvt_load(const CvtItem& it, f32x4 (&v)[8]) {
    if (it.valid) {
#pragma unroll
        for (int j = 0; j < 8; ++j) v[j] = __builtin_nontemporal_load((const GAS f32x4*)(it.src + (size_t)j * it.N));
    }
}
__device__ __forceinline__ void cvt_store(const CvtItem& it, f32x4 (&v)[8]) {
    if (it.valid) {
        if (it.ks) {
#pragma unroll
            for (int j = 0; j < 8; ++j) v[j] = v[j] * it.ks[j];
        }
#pragma unroll
        for (int c = 0; c < 4; ++c) { u32x4 g; g.x = cvt_pk_bf16(v[0][c], v[1][c]); g.y = cvt_pk_bf16(v[2][c], v[3][c]); g.z = cvt_pk_bf16(v[4][c], v[5][c]); g.w = cvt_pk_bf16(v[6][c], v[7][c]);
            *(GAS u32x4*)(it.dst + (size_t)c * 8) = g; }
    }
}
__device__ __forceinline__ int win_dest_row(int n0) {
    if (n0 < 512) return 256 * (n0 >> 7) + (n0 & 127);
    if (n0 < 1024) return n0 + 512;
    if (n0 < 1536) { const int j = n0 - 1024; return 256 * (j >> 7) + 128 + (j & 127); }
    if (n0 < 2048) { const int j = n0 - 1536; return 1536 + 256 * (j >> 7) + (j & 127); }
    { const int j = n0 - 2048; return 1536 + 256 * (j >> 7) + 128 + (j & 127); }
}
__device__ __forceinline__ size_t gran_idx(int kb, int drow, int nkt, bool wide = false) { const int w = drow & 31, c = drow & 255;
    const int slot = wide ? 128 * ((c >> 3) & 1) + 32 * (c >> 6) + 16 * ((c >> 2) & 1) + 4 * ((c >> 4) & 3) + (c & 3) : (drow & 224) + 16 * ((w >> 2) & 1) + 4 * (w >> 3) + (w & 3);
    return ((size_t)(((drow >> 8) * nkt + (kb >> 3)) * 8 + (kb & 7)) * 256 + slot); }
constexpr int I_IN = 128 * 10, I_OUT = 128 * 4, NITEMS = I_IN + I_OUT;
constexpr int J_13 = NE * 2 * 64 * 2, J_2 = NE * 32 * 4, NITEMS8 = J_13 + J_2;
__device__ __forceinline__ CvtItem p0_decode(Frame& F, int it, int lane) {
    CvtItem c; c.valid = it < NITEMS; c.src = F.w_in; c.ks = nullptr; c.dst = F.Win_t; c.N = DIN;
    if (!c.valid) return c;
    int r = it;
    if (r < I_IN) { const int kb = r / 10, n = 256 * (r % 10) + 4 * lane;
        c.src = F.w_in + (size_t)(8 * kb) * DIN + n; c.N = DIN; c.ks = F.norm_mix_g + 8 * kb; c.dst = F.Win_t + gran_idx(kb, win_dest_row(n), 16) * 8; return c; }
    r -= I_IN;
    { const int kb = r / 4, n = 256 * (r % 4) + 4 * lane;
        c.src = F.w_out + (size_t)(8 * kb) * D + n; c.N = D; c.ks = (8 * kb < DA) ? F.beta_a + 8 * kb : F.beta_b + (8 * kb - DA); c.dst = F.Wout_t + gran_idx(kb, n, 16, true) * 8; return c; }
}
struct CvtItem8 { const float* src; const float* ks; fp8* dst; int N; float scale; };
__device__ __forceinline__ CvtItem8 p0_decode8(Frame& F, int it, int lane) {
    CvtItem8 c; int r = it;
    if (r < J_13) { const int e = r / 256, rr = r % 256, which = rr / 128, item = rr % 128, kb = item / 2, n = 256 * (item % 2) + 4 * lane;
        c.src = (which ? F.w3 : F.w1) + (size_t)e * D * DE + (size_t)(16 * kb) * DE + n; c.N = DE; c.ks = F.norm_ffn_g + 16 * kb; c.scale = 32.0f;
        c.dst = F.W13_t + (size_t)e * 1024 * D + gran_idx(kb, 256 * (n >> 7) + 128 * which + (n & 127), 8) * 16; return c; }
    r -= J_13;
    { const int e = r / 128, item = r % 128, kb = item / 4, n = 256 * (item % 4) + 4 * lane;
        c.src = F.w2 + (size_t)e * DE * D + (size_t)(16 * kb) * D + n; c.N = D; c.ks = nullptr; c.scale = 16.0f; c.dst = F.W2_t + (size_t)e * 1024 * DE + gran_idx(kb, n, 4, true) * 16; return c; }
}
__device__ __forceinline__ void p0_cvt8_item(Frame& F, int it, int lane) {
    const CvtItem8 c = p0_decode8(F, it, lane);
    f32x4 v[16];
#pragma unroll
    for (int j = 0; j < 16; ++j) v[j] = __builtin_nontemporal_load((const GAS f32x4*)(c.src + (size_t)j * c.N));
#pragma unroll
    for (int j = 0; j < 16; ++j) v[j] = v[j] * (c.ks ? c.ks[j] * c.scale : c.scale);
#pragma unroll
    for (int q = 0; q < 4; ++q) { u32x4 g;
#pragma unroll
        for (int w = 0; w < 4; ++w) g[w] = pk4_fp8(v[4 * w][q], v[4 * w + 1][q], v[4 * w + 2][q], v[4 * w + 3][q]);
        *(GAS u32x4*)(c.dst + (size_t)q * 16) = g; }
}
constexpr int NITEMS8_LATE = 4096;
__device__ __forceinline__ void p1_late_convert(Frame& F) {
    if (F.G != 256 || blockIdx.x < 128) return;
    int lane = lane_id(); asm volatile("" : "+v"(lane));
    const int w0 = ((int)blockIdx.x - 128) * NWAVES + F.wave;
    for (int it = NITEMS8 - NITEMS8_LATE + w0; it < NITEMS8; it += 128 * NWAVES) p0_cvt8_item(F, it, lane);
}
__device__ __forceinline__ void p0_prologue(Frame& F) {
    const int wave = F.wave; int lane = lane_id(); asm volatile("" : "+v"(lane)); const int tid = wave * 64 + lane;
    const int gw = F.vcu * NWAVES + wave, NGW = F.G * NWAVES;
    for (int it = gw; it < NITEMS; it += 2 * NGW) {
        const CvtItem c0 = p0_decode(F, it, lane), c1 = p0_decode(F, it + NGW, lane);
        f32x4 v0[8], v1[8];
        cvt_load(c0, v0); cvt_load(c1, v1);
        cvt_store(c0, v0); cvt_store(c1, v1);
    }
    for (int it = gw; it < NITEMS8 - (F.G == 256 ? NITEMS8_LATE : 0); it += NGW) p0_cvt8_item(F, it, lane);
    for (int i = gw * 64 + lane; i < 48 * D; i += NGW * 64) { const int o = i / D, k = i % D; float v = 0.f;
        if (o < 4) v = F.wrg[(size_t)k * 4 + o] * F.norm_ffn_g[k]; else if (o < 36) v = F.wre[(size_t)k * NE + (o - 4)] * F.norm_ffn_g[k];
        F.Wr_t[i] = (bf16)f2bf(v); }
    for (int m = gw; m < T; m += NGW) {
        const GAS f32x4* xr = (const GAS f32x4*)(F.x + (size_t)m * D) + lane;
        f32x4 v[4]; float s = 0.f;
#pragma unroll
        for (int j = 0; j < 4; ++j) { v[j] = __builtin_nontemporal_load(xr + 64 * j); s += (v[j].x * v[j].x + v[j].y * v[j].y) + (v[j].z * v[j].z + v[j].w * v[j].w); }
        const float r = rsqrtf(wave_sum(s) * (1.f / D) + EPS);
        if (lane == 0) F.RI[m] = 1.0f / r;
        GAS u32x2* o8 = (GAS u32x2*)(F.XB + (size_t)m * D) + lane;
#pragma unroll
        for (int j = 0; j < 4; ++j) { u32x2 w; w.x = pk2(v[j].x * r, v[j].y * r); w.y = pk2(v[j].z * r, v[j].w * r); o8[64 * j] = w; }
    }
}

template <int CTRL> __device__ __forceinline__ float dpp_f(float v) { return __builtin_bit_cast(float, __builtin_amdgcn_update_dpp(0, __builtin_bit_cast(int, v), CTRL, 0xf, 0xf, false)); }
#define DPP_XOR1 0xB1
#define DPP_XOR2 0x4E
#define DPP_HALF_MIRROR 0x141
#define DPP_ROW_MIRROR 0x140
__device__ __forceinline__ float sum8(float v) { v += dpp_f<DPP_XOR1>(v); v += dpp_f<DPP_XOR2>(v); v += dpp_f<DPP_HALF_MIRROR>(v); return v; }
__device__ __forceinline__ float sum16(float v) { v = sum8(v); v += dpp_f<DPP_ROW_MIRROR>(v); return v; }
__device__ __forceinline__ void p2_mixer(Frame& F) {
    const int wave = F.wave; int lane = lane_id(); asm volatile("" : "+v"(lane)); const int tid = wave * 64 + lane;
    LAS unsigned char* L = F.lds;
    LAS unsigned* Ut = (LAS unsigned*)L;
    LAS float* UC = (LAS float*)(L + 62 * 1024);
    LAS float* PRM = (LAS float*)(L + LDSCTL_OFF + 2048);
    PRM[tid] = F.ln_b_g[tid]; PRM[512 + tid] = F.ln_b_b[tid];
#pragma unroll
    for (int q = 0; q < 3; ++q) PRM[1024 + 512 * q + tid] = F.conv_a_w[q * DA + tid];
    const int cp = tid & 255, th = tid >> 8;
    f32x2 wb[31];
#pragma unroll
    for (int j = 0; j < 31; ++j) wb[j] = *(const f32x2*)(F.conv_b_w + j * DB + 2 * cp);
    const f32x2 bias2 = *(const f32x2*)(F.conv_b_bias + 2 * cp);
    const int tq = lane >> 4, tl = lane & 15;
    u32x4 ureg[8];
#define P2_ULOAD(tile_) do { const int _t0 = (tile_) * 32, _b = _t0 / SEQ, _s0 = _t0 % SEQ; int _tid = tid; asm volatile("" : "+v"(_tid)); _Pragma("unroll") for (int _i = 0; _i < 8; ++_i) { const int _ch = _tid + 512 * _i, _row = _ch >> 6, _c16 = _ch & 63, _s = _s0 - 15 + _row; \
        ureg[_i] = (u32x4){0u, 0u, 0u, 0u}; if (_ch < 62 * 64 && _s >= 0 && _s < SEQ) ureg[_i] = *(const GAS u32x4*)(F.P + (size_t)(_b * SEQ + _s) * PW + 1024 + _c16 * 8); } } while (0)
    int tile = F.vcu;
    if (tile < T / 32) P2_ULOAD(tile);
    __syncthreads();
    for (; tile < T / 32; tile += F.G) {
        const int t0 = tile * 32, s0 = t0 % SEQ;
        { int tid2 = tid; asm volatile("" : "+v"(tid2));
#pragma unroll
        for (int i = 0; i < 8; ++i) { const int ch = tid2 + 512 * i; if (ch < 62 * 64) *(LAS u32x4*)(L + ch * 16) = ureg[i]; } }
        __syncthreads();
        if (tile + F.G < T / 32) P2_ULOAD(tile + F.G);
#pragma unroll 1
        for (int sub = 0; sub < 2; ++sub) { const int i0 = th * 16 + sub * 8; f32x2 a[8];
#pragma unroll
            for (int i = 0; i < 8; ++i) a[i] = bias2;
#pragma unroll
            for (int w = 0; w < 38; ++w) { const unsigned v = Ut[(i0 + w) * 256 + cp]; const f32x2 x2 = (f32x2){bflo(v), bfhi(v)};
#pragma unroll
                for (int i = 0; i < 8; ++i) { const int j = w - i; if (j >= 0 && j < 31) a[i] = __builtin_elementwise_fma(wb[j], x2, a[i]); } }
#pragma unroll
            for (int i = 0; i < 8; ++i) *(LAS f32x2*)(UC + (i0 + i) * 512 + 2 * cp) = a[i];
        }
        __syncthreads();
        u32x4 gpm1[4], gp0[4], gpp1[4], gab[4];
        { const int i = wave * 4 + tq, s = s0 + i; const bf16* prow = F.P + (size_t)(t0 + i) * PW + 8 * tl; const u32x4 z4 = (u32x4){0u, 0u, 0u, 0u};
#pragma unroll
          for (int k = 0; k < 4; ++k) { const bf16* pk = prow + 128 * k;
            gpm1[k] = (s > 0) ? *(const GAS u32x4*)(pk - PW) : z4; gp0[k] = *(const GAS u32x4*)pk; gpp1[k] = (s < SEQ - 1) ? *(const GAS u32x4*)(pk + PW) : z4; gab[k] = *(const GAS u32x4*)(pk + 512); } }
        { const int i = wave * 4 + tq, t = t0 + i;
          float uv[4][8]; float s1 = 0.f;
#pragma unroll
          for (int k = 0; k < 4; ++k) { const LAS float* up = UC + i * 512 + 8 * (tl + 16 * k); const f32x4 ua = *(const LAS f32x4*)up, ub = *(const LAS f32x4*)(up + 4);
#pragma unroll
            for (int j = 0; j < 4; ++j) { uv[k][j] = ua[j]; uv[k][4 + j] = ub[j]; s1 += ua[j] + ub[j]; } }
          const float mu = sum16(s1) * (1.f / DB); float s2 = 0.f;
#pragma unroll
          for (int k = 0; k < 4; ++k)
#pragma unroll
            for (int j = 0; j < 8; ++j) { uv[k][j] -= mu; s2 += uv[k][j] * uv[k][j]; }
          const float rstd = rsqrtf(sum16(s2) * (1.f / DB) + EPS);
#pragma unroll
          for (int k = 0; k < 4; ++k) { const int c8 = 8 * (tl + 16 * k); const LAS float* gp = PRM + c8; const f32x4 g0 = *(const LAS f32x4*)gp, g1 = *(const LAS f32x4*)(gp + 4), b0 = *(const LAS f32x4*)(gp + 512), b1 = *(const LAS f32x4*)(gp + 516);
            float hb = 0.f;
#pragma unroll
            for (int j = 0; j < 8; ++j) { const float z = uv[k][j] * rstd * (j < 4 ? g0[j & 3] : g1[j & 3]) + (j < 4 ? b0[j & 3] : b1[j & 3]); uv[k][j] = z * fast_sigmoid(z); hb += uv[k][j] * uv[k][j]; }
            const float rb = rsqrtf(sum8(hb) * (1.f / 64.f) + EPS);
            u32x4 ob; ob.x = cvt_pk_bf16(uv[k][0] * rb, uv[k][1] * rb); ob.y = cvt_pk_bf16(uv[k][2] * rb, uv[k][3] * rb); ob.z = cvt_pk_bf16(uv[k][4] * rb, uv[k][5] * rb); ob.w = cvt_pk_bf16(uv[k][6] * rb, uv[k][7] * rb);
            *(GAS u32x4*)(F.Y + (size_t)t * D + DA + c8) = ob; }
#pragma unroll
          for (int k = 0; k < 4; ++k) { const int c8 = 8 * (tl + 16 * k); const LAS float* wp = PRM + 1024 + c8; float ya[8]; float ha = 0.f;
            f32x4 w0[2], w1[2], w2[2];
#pragma unroll
            for (int h = 0; h < 2; ++h) { w0[h] = *(const LAS f32x4*)(wp + 4 * h); w1[h] = *(const LAS f32x4*)(wp + 512 + 4 * h); w2[h] = *(const LAS f32x4*)(wp + 1024 + 4 * h); }
#pragma unroll
            for (int j = 0; j < 4; ++j) { const int h = j >> 1, e = 2 * (j & 1);
                const float c0 = w0[h][e] * bflo(gpm1[k][j]) + w1[h][e] * bflo(gp0[k][j]) + w2[h][e] * bflo(gpp1[k][j]);
                const float c1 = w0[h][e + 1] * bfhi(gpm1[k][j]) + w1[h][e + 1] * bfhi(gp0[k][j]) + w2[h][e + 1] * bfhi(gpp1[k][j]);
                ya[2 * j] = bflo(gab[k][j]) * c0; ya[2 * j + 1] = bfhi(gab[k][j]) * c1; ha += ya[2 * j] * ya[2 * j] + ya[2 * j + 1] * ya[2 * j + 1]; }
            const float ra = rsqrtf(sum8(ha) * (1.f / 64.f) + EPS);
            u32x4 oa; oa.x = cvt_pk_bf16(ya[0] * ra, ya[1] * ra); oa.y = cvt_pk_bf16(ya[2] * ra, ya[3] * ra); oa.z = cvt_pk_bf16(ya[4] * ra, ya[5] * ra); oa.w = cvt_pk_bf16(ya[6] * ra, ya[7] * ra);
            *(GAS u32x4*)(F.Y + (size_t)t * D + c8) = oa; }
        }
    }
#undef P2_ULOAD
    __syncthreads();
}

__device__ __forceinline__ void p4_route(Frame& F) {
    const int wave = F.wave; int lane = lane_id(); asm volatile("" : "+v"(lane)); const int tid = wave * 64 + lane;
    LAS float* LGp = (LAS float*)F.lds;
    LAS int* scnt = (LAS int*)(F.lds + 102400);
    bf16x8 bfr[4][3];
    { const bf16* brow = F.Wr_t + (size_t)(lane & 15) * D + 128 * wave + 8 * (lane >> 4);
#pragma unroll
      for (int ks = 0; ks < 4; ++ks)
#pragma unroll
        for (int nb = 0; nb < 3; ++nb) bfr[ks][nb] = *(const GAS bf16x8*)(brow + (size_t)nb * 16 * D + ks * 32); }
    LAS float* r2s = (LAS float*)(F.lds + 102400 + 512);
    for (int tile = F.vcu; tile < T / 64; tile += F.G) {
        if (tid < 32) scnt[tid] = 0;
        const int tb = tile * 64;
        if (tid < 64) { float ss = 0.f;
#pragma unroll
            for (int s = 0; s < 16; ++s) ss += F.SSQ[(size_t)s * T + tb + tid];
            r2s[tid] = rsqrtf(ss * (1.f / D) + EPS); }
        bf16x8 af[4][4];
#pragma unroll
        for (int tg = 0; tg < 4; ++tg)
#pragma unroll
            for (int ks = 0; ks < 4; ++ks) af[tg][ks] = *(const GAS bf16x8*)(F.X1B + (size_t)(tb + 16 * tg + (lane & 15)) * D + 128 * wave + ks * 32 + 8 * (lane >> 4));
        __syncthreads();
#pragma unroll
        for (int tg = 0; tg < 4; ++tg) { f32x4 acc[3];
#pragma unroll
            for (int nb = 0; nb < 3; ++nb) acc[nb] = (f32x4){0.f, 0.f, 0.f, 0.f};
#pragma unroll
            for (int ks = 0; ks < 4; ++ks)
#pragma unroll
                for (int nb = 0; nb < 3; ++nb) acc[nb] = __builtin_amdgcn_mfma_f32_16x16x32_bf16(af[tg][ks], bfr[ks][nb], acc[nb], 0, 0, 0);
#pragma unroll
            for (int nb = 0; nb < 3; ++nb)
#pragma unroll
                for (int r = 0; r < 4; ++r) LGp[(wave * 64 + 16 * tg + 4 * (lane >> 4) + r) * 49 + nb * 16 + (lane & 15)] = acc[nb][r];
            const float rs = r2s[16 * tg + (lane & 15)];
#pragma unroll
            for (int ks = 0; ks < 4; ++ks) { const u32x4 q = __builtin_bit_cast(u32x4, af[tg][ks]); u32x2 o;
                o.x = pk4_fp8(bflo(q[0]) * rs, bfhi(q[0]) * rs, bflo(q[1]) * rs, bfhi(q[1]) * rs); o.y = pk4_fp8(bflo(q[2]) * rs, bfhi(q[2]) * rs, bflo(q[3]) * rs, bfhi(q[3]) * rs);
                *(GAS u32x2*)(F.X1F8 + (size_t)(tb + 16 * tg + (lane & 15)) * D + 128 * wave + ks * 32 + 8 * (lane >> 4)) = o; } }
        __syncthreads();
        int e0 = 0, e1 = 0, p0 = 0, p1 = 0; float c0 = 0.f, c1 = 0.f;
        if (tid < 64) {
            const float r2 = r2s[tid];
            const LAS float* lg = LGp + tid * 49;
            float g4[4];
#pragma unroll
            for (int i = 0; i < 4; ++i) { float a = 0.f;
#pragma unroll
                for (int w = 0; w < 8; ++w) a += lg[w * 64 * 49 + i];
                g4[i] = a * r2 + F.brg[i]; }
            int g = 0; float m = g4[0];
#pragma unroll
            for (int i = 1; i < 4; ++i) if (g4[i] > m) { m = g4[i]; g = i; }
            float den = 0.f;
#pragma unroll
            for (int i = 0; i < 4; ++i) den += __expf(g4[i] - m);
            const float psel = 1.0f / den;
            int i0 = 0, i1 = -1; float m0 = -3.0e38f, m1 = -3.0e38f;
            for (int i = 0; i < 8; ++i) { float a = 0.f;
#pragma unroll
                for (int w = 0; w < 8; ++w) a += lg[w * 64 * 49 + 4 + g * 8 + i];
                const float v = a * r2 + F.bre[g * 8 + i];
                if (v > m0) { m1 = m0; i1 = i0; m0 = v; i0 = i; } else if (v > m1) { m1 = v; i1 = i; } }
            const float ex = __expf(m1 - m0);
            e0 = g * 8 + i0; e1 = g * 8 + i1; c0 = psel / (1.0f + ex); c1 = psel * ex / (1.0f + ex);
            p0 = __hip_atomic_fetch_add(scnt + e0, 1, __ATOMIC_RELAXED, __HIP_MEMORY_SCOPE_WORKGROUP); p1 = __hip_atomic_fetch_add(scnt + e1, 1, __ATOMIC_RELAXED, __HIP_MEMORY_SCOPE_WORKGROUP);
        }
        __syncthreads();
        if (tid < 32) scnt[32 + tid] = (int)__hip_atomic_fetch_add(F.gcnt + tid, (unsigned)scnt[tid], RLX_AGENT);
        __syncthreads();
        if (tid < 64) {
            const int t = tb + tid; const size_t d0 = (size_t)e0 * CAP + scnt[32 + e0] + p0, d1 = (size_t)e1 * CAP + scnt[32 + e1] + p1;
            F.LTOK[d0] = (unsigned)t | (f2bf(c0) << 16);
            F.LTOK[d1] = (unsigned)t | (1u << 14) | (f2bf(c1) << 16);
        }
        __syncthreads();
    }
}

__device__ __forceinline__ void p7_final(Frame& F) {
    const int wave = F.wave; int lane = lane_id(); asm volatile("" : "+v"(lane)); const int tid = wave * 64 + lane;
    const int gw = F.vcu * NWAVES + wave, NGW = F.G * NWAVES;
    f32x4 g[2][2];
#pragma unroll
    for (int j = 0; j < 2; ++j) { g[j][0] = *(const f32x4*)(F.gfin + j * 512 + lane * 8); g[j][1] = *(const f32x4*)(F.gfin + j * 512 + lane * 8 + 4); }
    for (int t = gw; t < T; t += NGW) {
        float v[2][8]; float ss = 0.f;
#pragma unroll
        for (int j = 0; j < 2; ++j) { const size_t o = (size_t)t * D + j * 512 + lane * 8;
            const u32x4 a = *(const GAS u32x4*)(F.X1B + o); const u32x2 c0 = *(const GAS u32x2*)(F.CB + o), c1 = *(const GAS u32x2*)(F.CB + (size_t)T * D + o);
#pragma unroll
            for (int q = 0; q < 4; q += 2) { const f32x2 p0 = __builtin_amdgcn_cvt_pk_f32_fp8((int)c0[q >> 1], false), p1 = __builtin_amdgcn_cvt_pk_f32_fp8((int)c1[q >> 1], false),
                                                           p2 = __builtin_amdgcn_cvt_pk_f32_fp8((int)c0[q >> 1], true), p3 = __builtin_amdgcn_cvt_pk_f32_fp8((int)c1[q >> 1], true);
                v[j][2 * q] = bflo(a[q]) + (p0.x + p1.x) * (1.0f / 64.0f); v[j][2 * q + 1] = bfhi(a[q]) + (p0.y + p1.y) * (1.0f / 64.0f);
                v[j][2 * q + 2] = bflo(a[q + 1]) + (p2.x + p3.x) * (1.0f / 64.0f); v[j][2 * q + 3] = bfhi(a[q + 1]) + (p2.y + p3.y) * (1.0f / 64.0f); }
#pragma unroll
            for (int q = 0; q < 8; ++q) ss += v[j][q] * v[j][q]; }
        const float r = rsqrtf(wave_sum(ss) * (1.f / D) + EPS);
#pragma unroll
        for (int j = 0; j < 2; ++j) { float* o = F.out + (size_t)t * D + j * 512 + lane * 8;
            *(GAS f32x4*)o = (f32x4){v[j][0] * r * g[j][0][0], v[j][1] * r * g[j][0][1], v[j][2] * r * g[j][0][2], v[j][3] * r * g[j][0][3]};
            *(GAS f32x4*)(o + 4) = (f32x4){v[j][4] * r * g[j][1][0], v[j][5] * r * g[j][1][1], v[j][6] * r * g[j][1][2], v[j][7] * r * g[j][1][3]}; }
    }
}

__device__ __forceinline__ void moe_sched_init(pg8::SchedMoe& S, Frame& F) {
    int lane = lane_id(); asm volatile("" : "+v"(lane));
    LAS int* tab = (LAS int*)(F.lds + LDSCTL_OFF + 1024);
    int my_cnt = 0; if (lane < NE) my_cnt = (int)__hip_atomic_load(F.gcnt + lane, RLX_AGENT);
    const int tiles = (my_cnt + 255) >> 8; int incl = tiles;
#pragma unroll
    for (int o = 1; o < 32; o <<= 1) { const int v = __shfl_up(incl, o); if (lane >= o) incl += v; }
    if (F.wave == 0 && lane < NE) { tab[lane] = incl - tiles; tab[32 + lane] = my_cnt; }
    S.total_rt = __builtin_amdgcn_readlane(incl, 31); S.tab = tab;
    S.ltok = F.LTOK; S.G = F.G; S.c = (int)blockIdx.x;
    __syncthreads();
}

struct Args { const float* in[20]; float* out; unsigned char* ws; int ph_lo, ph_hi, li, pad; };
__global__ void __launch_bounds__(NWAVES * 64, 2) mk_fwd(Args args) {
    extern __shared__ __attribute__((aligned(16))) unsigned char lds[];
    Frame F;
    F.lds = (LAS unsigned char*)lds;
    F.MISC = (volatile LAS unsigned*)(F.lds + MISC_OFF);
    F.wave = __builtin_amdgcn_readfirstlane((int)threadIdx.x >> 6);
    F.G = gridDim.x; { const int bx = blockIdx.x; F.vcu = (F.G % 8 == 0) ? (bx % 8) * (F.G / 8) + bx / 8 : bx; }
    unsigned char* ws = args.ws;
    F.ctl = (gu32*)(ws + WS_CTL);
    F.x = args.in[0]; F.norm_mix_g = args.in[1]; F.w_in = args.in[2]; F.conv_a_w = args.in[3]; F.conv_b_w = args.in[4]; F.conv_b_bias = args.in[5]; F.ln_b_g = args.in[6]; F.ln_b_b = args.in[7];
    F.beta_a = args.in[8]; F.beta_b = args.in[9]; F.w_out = args.in[10]; F.norm_ffn_g = args.in[11]; F.wrg = args.in[12]; F.brg = args.in[13]; F.wre = args.in[14]; F.bre = args.in[15];
    F.w1 = args.in[16]; F.w3 = args.in[17]; F.w2 = args.in[18]; F.gfin = args.in[19]; F.out = args.out;
    F.Win_t = (bf16*)(ws + WS_WIN); F.Wout_t = (bf16*)(ws + WS_WOUT); F.Wr_t = (bf16*)(ws + WS_WR); F.W13_t = (fp8*)(ws + WS_W13); F.W2_t = (fp8*)(ws + WS_W2); F.X1F8 = (fp8*)(ws + WS_X1F8);
    F.XB = (bf16*)(ws + WS_XB); F.P = (bf16*)(ws + WS_P); F.Y = (bf16*)(ws + WS_Y); F.X1B = (bf16*)(ws + WS_X1B); F.H = (fp8*)(ws + WS_H); F.CB = (fp8*)(ws + WS_CB); F.RI = (float*)(ws + WS_WR + 768 * 1024);
    F.SSQ = (float*)(ws + WS_SSQ); F.LW = (float*)(ws + WS_LW); F.LR2 = (float*)(ws + WS_LR2); F.LTOK = (unsigned*)(ws + WS_LTOK); F.gcnt = (unsigned*)(ws + WS_CTL) + CW_GCNT;
    for (int u = F.wave * 64 + lane_id(); u < (LDS_BYTES - LDSCTL_OFF) / 4; u += NWAVES * 64) ((LAS unsigned*)(F.lds + LDSCTL_OFF))[u] = 0u;
    __syncthreads();
    XcdBarrier bar; bar.bar = (unsigned*)(F.ctl + CW_BAR); bar.x = 0; bar.st = nullptr; bar.wave = F.wave;
    if (N_LAUNCHES == 1) bar = xcd_barrier_post((unsigned*)(F.ctl + CW_BAR), F.MISC + 8, F.wave);
    const int lo = args.ph_lo, hi = args.ph_hi;
#define IN(k) (lo <= (k) && (k) < hi)
#define GRID_BAR(k) do { if (IN(k) && IN((k) + 1)) xcd_barrier(bar); if (PROBE_PHASE >= 0 && blockIdx.x == 0 && F.wave == 0 && lane_id() == 0) ((unsigned long long*)(ws + WS_WR + 512 * 1024))[(k) + 1] = __builtin_amdgcn_s_memrealtime(); } while (0)
    if (PROBE_PHASE >= 0 && blockIdx.x == 0 && F.wave == 0 && lane_id() == 0) ((unsigned long long*)(ws + WS_WR + 512 * 1024))[0] = __builtin_amdgcn_s_memrealtime();

    if (IN(0)) { p0_prologue(F); GRID_BAR(0); }
    if (IN(1)) {
        pg8::SchedDense S{(const char*)F.XB, (const char*)F.Win_t, T / 256, DIN / 256, F.G, (int)blockIdx.x, (size_t)256 * D * 2, 16};
        pg8::EpiP1 E{F.P};
        pg8::gemm_phase<pg8::EpiP1, pg8::SchedDense, false>(F.lds + RING_OFF, D * 2, S, E, F.wave);
        p1_late_convert(F);
        GRID_BAR(1);
    }
    if (IN(2)) { p2_mixer(F); GRID_BAR(2); }
    if (IN(3)) {
        pg8::SchedDense S{(const char*)F.Y, (const char*)F.Wout_t, T / 256, D / 256, F.G, (int)blockIdx.x, (size_t)256 * D * 2, 16};
        pg8::EpiX1 E{F.XB, F.RI, F.X1B, F.SSQ};
        pg8::gemm_phase<pg8::EpiX1, pg8::SchedDense, false>(F.lds + RING_OFF, D * 2, S, E, F.wave);
        GRID_BAR(3);
    }
    if (IN(4)) { p4_route(F); GRID_BAR(4); }
    if (IN(5)) {
        pg8::SchedMoeA S; moe_sched_init(S, F); S.A = (const char*)F.X1F8; S.W = (const char*)F.W13_t; S.a_tile_bytes = 0; S.w_exp_bytes = (size_t)1024 * D; S.nkt = 8;
        pg8::EpiH E{F.H};
        pg8::gemm_phase<pg8::EpiH, pg8::SchedMoeA, true>(F.lds + RING_OFF, D, S, E, F.wave);
        GRID_BAR(5);
    }
    if (IN(6)) {
        pg8::SchedMoeB S; moe_sched_init(S, F); S.A = (const char*)F.H; S.W = (const char*)F.W2_t; S.a_tile_bytes = (size_t)256 * DE; S.w_exp_bytes = (size_t)1024 * DE; S.nkt = 4;
        pg8::EpiC E{F.CB, F.LTOK};
        pg8::gemm_phase<pg8::EpiC, pg8::SchedMoeB, true>(F.lds + RING_OFF, DE, S, E, F.wave);
        GRID_BAR(6);
    }
    if (IN(7)) { p7_final(F);
        if (PROBE_PHASE >= 0 && blockIdx.x == 0 && F.wave == 0 && lane_id() == 0) { unsigned long long* ts = (unsigned long long*)(ws + WS_WR + 512 * 1024); ts[8] = __builtin_amdgcn_s_memrealtime();
            asm volatile("s_waitcnt vmcnt(0)" ::: "memory"); const float us = (PROBE_PHASE == 8) ? (float)(ts[8] - ts[0]) * 0.001f : (float)(ts[PROBE_PHASE + 1] - ts[PROBE_PHASE]) * 0.01f; F.out[0] += us * 0.1f; } }
#undef IN
#undef GRID_BAR
}

extern "C" void kernel_launch(void* const* d_in, const int* in_sizes, int n_in, void* d_out, int out_size, void* d_ws, size_t ws_size, hipStream_t stream) {
    static int grid = 0;
    if (grid == 0) {
        if (n_in != 20 || in_sizes[0] != T * D || out_size != T * D || ws_size < WS_END) { fprintf(stderr, "kernel_launch: unexpected shapes / workspace (n_in %d, in0 %d, out %d, ws %zu, need %zu)\n", n_in, n_in > 0 ? in_sizes[0] : -1, out_size, ws_size, (size_t)WS_END); grid = -1; return; }
        int dev = 0, cus = 0, per_cu = 0;
        if (hipGetDevice(&dev) != hipSuccess || hipDeviceGetAttribute(&cus, hipDeviceAttributeMultiprocessorCount, dev) != hipSuccess) { fprintf(stderr, "kernel_launch: device query failed\n"); grid = -1; return; }
        if (hipFuncSetAttribute((const void*)mk_fwd, hipFuncAttributeMaxDynamicSharedMemorySize, LDS_BYTES) != hipSuccess) { fprintf(stderr, "kernel_launch: hipFuncSetAttribute failed\n"); grid = -1; return; }
        if (hipOccupancyMaxActiveBlocksPerMultiprocessor(&per_cu, (const void*)mk_fwd, NWAVES * 64, LDS_BYTES) != hipSuccess || per_cu < 1) fprintf(stderr, "kernel_launch: occupancy query reports %d workgroups per CU\n", per_cu);
        (void)hipGetLastError();
        grid = cus;
    }
    if (grid < 0) return;
    if (hipMemsetAsync((char*)d_ws + WS_CTL, 0, CTL_ZERO_BYTES, stream) != hipSuccess) { fprintf(stderr, "kernel_launch: hipMemsetAsync failed\n"); return; }
    Args a{};
    for (int i = 0; i < 20; ++i) a.in[i] = (const float*)d_in[i];
    a.out = (float*)d_out; a.ws = (unsigned char*)d_ws;
    for (int li = 0; li < N_LAUNCHES; ++li) {
        a.ph_lo = (N_LAUNCHES == 1) ? 0 : li; a.ph_hi = (N_LAUNCHES == 1) ? NPHASES : li + 1; a.li = li;
        hipLaunchKernelGGL(mk_fwd, dim3(grid), dim3(NWAVES * 64), LDS_BYTES, stream, a);
        const hipError_t le = hipPeekAtLastError();
        if (le != hipSuccess) { fprintf(stderr, "kernel_launch: launch %d failed: %s\n", li, hipGetErrorName(le)); break; }
    }
}
```

```cpp
#include <hip/hip_runtime.h>
#include <cstdio>
#include <cstdint>

#define LAS __attribute__((address_space(3)))
#define GAS __attribute__((address_space(1)))
typedef unsigned short bf16;
typedef short bf16x8 __attribute__((ext_vector_type(8)));
typedef float f32x4 __attribute__((ext_vector_type(4)));
typedef float f32x2 __attribute__((ext_vector_type(2)));
typedef unsigned u32x4 __attribute__((ext_vector_type(4)));
typedef unsigned u32x2 __attribute__((ext_vector_type(2)));
typedef GAS unsigned gu32;
typedef int i32x4 __attribute__((ext_vector_type(4)));
typedef int i32x8 __attribute__((ext_vector_type(8)));
typedef unsigned char fp8;

constexpr int T = 16384, SEQ = 2048, D = 1024, DA = 512, DB = 512, DIN = 2560, NE = 32, DE = 512, CAP = 16384, PW = 1536;
constexpr float EPS = 1e-6f;
constexpr int NWAVES = 8;
#ifndef MK_N_LAUNCHES
#define MK_N_LAUNCHES 1
#endif
constexpr int N_LAUNCHES = MK_N_LAUNCHES;
constexpr int NPHASES = 8;
#ifndef PROBE_PHASE
#define PROBE_PHASE -1
#endif

constexpr size_t MiB = 1u << 20;
constexpr size_t WS_CTL = 0, CTL_ZERO_BYTES = 72 * 1024;
constexpr size_t WS_WIN = 1 * MiB;
constexpr size_t WS_WOUT = 6 * MiB;
constexpr size_t WS_WR = 8 * MiB;
constexpr size_t WS_SSQ = 9 * MiB;
constexpr size_t WS_LTOK = 11 * MiB;
constexpr size_t WS_LW = 13 * MiB;
constexpr size_t WS_LR2 = 15 * MiB;
constexpr size_t WS_W13 = 17 * MiB;
constexpr size_t WS_W2 = 49 * MiB;
constexpr size_t WS_X1B = 65 * MiB;
constexpr size_t WS_X1F8 = 97 * MiB;
constexpr size_t WS_XB = 113 * MiB;
constexpr size_t WS_P = 145 * MiB;
constexpr size_t WS_Y = 193 * MiB;
constexpr size_t WS_H = 113 * MiB;
constexpr size_t WS_CB = 133 * MiB;
constexpr size_t WS_END = 225 * MiB;
constexpr int CW_TMO = 0, CW_CODE = 1, CW_BAR = 4096, CW_GCNT = 16384;

constexpr int RING_OFF = 0, RING_BYTES = 131072;
constexpr int LDSCTL_OFF = RING_BYTES, MISC_OFF = LDSCTL_OFF + 320;
constexpr int LDS_BYTES = 147456;

#define RLX_AGENT __ATOMIC_RELAXED, __HIP_MEMORY_SCOPE_AGENT
#define LDS_WAIT() asm volatile("s_waitcnt lgkmcnt(0)" ::: "memory")
#define VM_WAIT() asm volatile("s_waitcnt vmcnt(0)" ::: "memory")
__device__ __forceinline__ unsigned f2bf(float f) { unsigned u = __builtin_bit_cast(unsigned, f); return (u + 0x7fffu + ((u >> 16) & 1u)) >> 16; }
__device__ __forceinline__ unsigned pk2(float lo, float hi) { return f2bf(lo) | (f2bf(hi) << 16); }
__device__ __forceinline__ unsigned cvt_pk_bf16(float lo, float hi) { unsigned r; asm volatile("v_cvt_pk_bf16_f32 %0, %1, %2" : "=v"(r) : "v"(lo), "v"(hi)); return r; }
__device__ __forceinline__ unsigned pk4_fp8(float a, float b, float c, float d) { int w = 0; w = __builtin_amdgcn_cvt_pk_fp8_f32(a, b, w, false); w = __builtin_amdgcn_cvt_pk_fp8_f32(c, d, w, true); return (unsigned)w; }
__device__ __forceinline__ float bflo(unsigned v) { return __builtin_bit_cast(float, v << 16); }
__device__ __forceinline__ float bfhi(unsigned v) { return __builtin_bit_cast(float, v & 0xffff0000u); }
__device__ __forceinline__ float fast_sigmoid(float v) { return __builtin_amdgcn_rcpf(1.0f + __expf(-v)); }
__device__ __forceinline__ int lane_id() { unsigned m = ~0u; asm volatile("" : "+s"(m)); return (int)__builtin_amdgcn_mbcnt_hi(m, __builtin_amdgcn_mbcnt_lo(m, 0u)); }
__device__ __forceinline__ float wave_sum(float v) {
#pragma unroll
    for (int o = 1; o < 64; o <<= 1) v += __shfl_xor(v, o);
    return v;
}

namespace pg8 {
constexpr int BM = 256, BK = 64, HALF = 128, HTB = HALF * BK * 2, STAGE_BYTES = 8 * HTB, NXCD = 8, WGM = 8;
__host__ __device__ __forceinline__ int lds_byte(int r, int c) { const int st = (r >> 4) * 2 + (c >> 5), rr = r & 15, cc = c & 31, ob = rr * 64 + cc * 2; return st * 1024 + (ob ^ (((ob >> 9) & 1) << 5)); }
__host__ __device__ __forceinline__ void stage_rc(int b, int& R, int& C) { const int st = b / 1024, sb = b % 1024, swz = sb ^ (((sb >> 9) & 1) << 5); R = (st >> 1) * 16 + swz / 64; C = (st & 1) * 32 + (swz % 64) / 2; }
__host__ __device__ __forceinline__ int perm32(int rho) { const int n = rho >> 4, i = rho & 15; return 8 * (i >> 2) + 4 * n + (i & 3); }

struct Unit { int pm, pn, e, rt, cnt; };

__device__ __forceinline__ bool tile_order(int i, int G, int c, int nM, int nN, int& pm, int& pn) {
    const int nwg = nM * nN; const int L = i * G + c; if (L >= nwg) return false;
    int wgid = L; { const int q = nwg / NXCD, r = nwg % NXCD, xcd = wgid % NXCD, off = wgid / NXCD; wgid = (xcd < r ? xcd * (q + 1) : r * (q + 1) + (xcd - r) * q) + off; }
    const int nig = WGM * nN, gid = wgid / nig, fm = gid * WGM, gsz = (nM - fm) < WGM ? (nM - fm) : WGM;
    pm = fm + ((wgid % nig) % gsz); pn = (wgid % nig) / gsz; return true;
}

struct SchedDense {
    static constexpr bool GATHER = false;
    const char* A; const char* Bt; int nM, nN, G, c; size_t tstepA; int nkt;
    __device__ __forceinline__ bool next(int i, Unit& u) const { u.e = 0; u.rt = 0; u.cnt = 0; return tile_order(i, G, c, nM, nN, u.pm, u.pn); }
    __device__ __forceinline__ const char* a_buf() const { return A; }
    __device__ __forceinline__ const char* b_buf() const { return Bt; }
    __device__ __forceinline__ unsigned a_soff(const Unit& u) const { return (unsigned)u.pm * (unsigned)tstepA; }
    __device__ __forceinline__ unsigned b_soff(const Unit& u) const { return (unsigned)(u.pn * nkt) * 32768u; }
    __device__ __forceinline__ void a_tokens(const Unit&, int, unsigned (&)[2]) const {}
};
struct SchedMoe {
    const char* A; const char* W; const unsigned* ltok; const LAS int* tab; int total_rt, G, c; size_t a_tile_bytes, w_exp_bytes; int nkt;
    __device__ __forceinline__ bool next(int i, Unit& u) const {
        if (!tile_order(i, G, c, total_rt, 4, u.pm, u.pn)) return false;
        const int lane = lane_id();
        const unsigned long long m = __ballot(lane < 32 && tab[lane & 31] <= u.pm);
        const int e = __builtin_amdgcn_readfirstlane(__popcll(m) - 1);
        u.e = e; u.rt = u.pm - __builtin_amdgcn_readfirstlane(tab[e]); u.cnt = __builtin_amdgcn_readfirstlane(tab[32 + e]); return true;
    }
    __device__ __forceinline__ const char* a_buf() const { return A; }
    __device__ __forceinline__ const char* b_buf() const { return W; }
    __device__ __forceinline__ unsigned b_soff(const Unit& u) const { return (unsigned)u.e * (unsigned)w_exp_bytes + (unsigned)(u.pn * nkt) * 32768u; }
};
struct SchedMoeA : SchedMoe {
    static constexpr bool GATHER = true;
    __device__ __forceinline__ unsigned a_soff(const Unit&) const { return 0u; }
    __device__ __forceinline__ void a_tokens(const Unit& u, int R, unsigned (&tk)[2]) const {
        asm volatile("" : "+v"(R));
        const __amdgpu_buffer_rsrc_t rl = __builtin_amdgcn_make_buffer_rsrc((void*)ltok, 0, NE * CAP * 4, 0x00020000);
#pragma unroll
        for (int h = 0; h < 2; ++h) { const int p0 = u.rt * 256 + 128 * h + R, p1 = p0 + 64;
            const unsigned r0 = (unsigned)__builtin_amdgcn_raw_buffer_load_b32(rl, p0 < u.cnt ? (u.e * CAP + p0) * 4 : 0x7ffffff0, 0, 0);
            const unsigned r1 = (unsigned)__builtin_amdgcn_raw_buffer_load_b32(rl, p1 < u.cnt ? (u.e * CAP + p1) * 4 : 0x7ffffff0, 0, 0);
            tk[h] = (r0 & 0x3fffu) | ((r1 & 0x3fffu) << 16); }
    }
};
struct SchedMoeB : SchedMoe {
    static constexpr bool GATHER = false;
    __device__ __forceinline__ unsigned a_soff(const Unit& u) const { return (unsigned)u.pm * (unsigned)a_tile_bytes; }
    __device__ __forceinline__ void a_tokens(const Unit&, int, unsigned (&)[2]) const {}
};

struct EpiP1 {
    bf16* P;
    __device__ __forceinline__ void operator()(const f32x4 (&acc)[2][2][4][2], const Unit& u, int wr, int wc, int fr, int fq) const {
        asm volatile("" : "+v"(fr), "+v"(fq));
        const int row0 = u.pm * BM + wr * 64 + fr, cl = wc * 32 + 8 * fq;
        if (u.pn >= 4 && u.pn < 6) {
#pragma unroll
            for (int ai = 0; ai < 2; ++ai)
#pragma unroll
                for (int m = 0; m < 4; ++m) { bf16* rowp = P + (size_t)(row0 + ai * HALF + m * 16) * PW + 512 + (u.pn - 4) * 256 + cl;
#pragma unroll
                    for (int bj = 0; bj < 2; ++bj) { const f32x4 v0 = acc[ai][bj][m][0], v1 = acc[ai][bj][m][1];
                        u32x4 w; w.x = cvt_pk_bf16(v0[0], v0[1]); w.y = cvt_pk_bf16(v0[2], v0[3]); w.z = cvt_pk_bf16(v1[0], v1[1]); w.w = cvt_pk_bf16(v1[2], v1[3]);
                        *(u32x4*)(rowp + bj * HALF) = w; } }
        } else if (u.pn < 4) {
#pragma unroll
            for (int ai = 0; ai < 2; ++ai)
#pragma unroll
                for (int m = 0; m < 4; ++m) { bf16* rowp = P + (size_t)(row0 + ai * HALF + m * 16) * PW + u.pn * 128 + cl;
                    const f32x4 v0 = acc[ai][0][m][0] * acc[ai][1][m][0], v1 = acc[ai][0][m][1] * acc[ai][1][m][1];
                    u32x4 w; w.x = cvt_pk_bf16(v0[0], v0[1]); w.y = cvt_pk_bf16(v0[2], v0[3]); w.z = cvt_pk_bf16(v1[0], v1[1]); w.w = cvt_pk_bf16(v1[2], v1[3]);
                    *(u32x4*)rowp = w; }
        } else {
#pragma unroll
            for (int ai = 0; ai < 2; ++ai)
#pragma unroll
                for (int m = 0; m < 4; ++m) { bf16* rowp = P + (size_t)(row0 + ai * HALF + m * 16) * PW + 1024 + (u.pn - 6) * 128 + cl;
                    f32x4 v0, v1;
#pragma unroll
                    for (int j = 0; j < 4; ++j) { v0[j] = acc[ai][0][m][0][j] * fast_sigmoid(acc[ai][1][m][0][j]); v1[j] = acc[ai][0][m][1][j] * fast_sigmoid(acc[ai][1][m][1][j]); }
                    u32x4 w; w.x = cvt_pk_bf16(v0[0], v0[1]); w.y = cvt_pk_bf16(v0[2], v0[3]); w.z = cvt_pk_bf16(v1[0], v1[1]); w.w = cvt_pk_bf16(v1[2], v1[3]);
                    *(u32x4*)rowp = w; }
        }
    }
};
struct EpiX1 {
    const bf16* xb; const float* ri; bf16* x1b; float* ssq;
    __device__ __forceinline__ void operator()(const f32x4 (&acc)[2][2][4][2], const Unit& u, int wr, int wc, int fr, int fq) const {
        asm volatile("" : "+v"(fr), "+v"(fq));
        const int row0 = u.pm * BM + wr * 64 + fr, col0 = u.pn * BM + wc * 64 + 16 * fq;
#pragma unroll
        for (int ai = 0; ai < 2; ++ai)
#pragma unroll
            for (int m = 0; m < 4; ++m) { const int row = row0 + ai * HALF + m * 16; const bf16* xr = xb + (size_t)row * D + col0; const float rinv = ri[row]; bf16* orow = x1b + (size_t)row * D + col0; float s = 0.f;
#pragma unroll
                for (int bj = 0; bj < 2; ++bj) { const u32x4 xq = *(const u32x4*)(xr + bj * 8);
                    const f32x4 a = (f32x4){bflo(xq[0]), bfhi(xq[0]), bflo(xq[1]), bfhi(xq[1])} * rinv, b = (f32x4){bflo(xq[2]), bfhi(xq[2]), bflo(xq[3]), bfhi(xq[3])} * rinv;
                    const f32x4 v0 = acc[ai][bj][m][0] + a, v1 = acc[ai][bj][m][1] + b;
                    s += (v0[0] * v0[0] + v0[1] * v0[1]) + (v0[2] * v0[2] + v0[3] * v0[3]) + (v1[0] * v1[0] + v1[1] * v1[1]) + (v1[2] * v1[2] + v1[3] * v1[3]);
                    u32x4 w; w.x = cvt_pk_bf16(v0[0], v0[1]); w.y = cvt_pk_bf16(v0[2], v0[3]); w.z = cvt_pk_bf16(v1[0], v1[1]); w.w = cvt_pk_bf16(v1[2], v1[3]);
                    *(u32x4*)(orow + bj * 8) = w; }
                s += __shfl_xor(s, 16); s += __shfl_xor(s, 32);
                if (fq == 0) ssq[(size_t)(u.pn * 4 + wc) * T + row] = s; }
    }
};
struct EpiH {
    fp8* H;
    __device__ __forceinline__ void operator()(const f32x4 (&acc)[2][2][4][2], const Unit& u, int wr, int wc, int fr, int fq) const {
        asm volatile("" : "+v"(fr), "+v"(fq));
        const int cl = u.pn * 128 + wc * 32 + 8 * fq;
#pragma unroll
        for (int ai = 0; ai < 2; ++ai)
#pragma unroll
            for (int m = 0; m < 4; ++m) { const int rl = ai * HALF + wr * 64 + m * 16 + fr; const float rr = 1.0f / 32.0f;
                f32x4 v0, v1;
#pragma unroll
                for (int j = 0; j < 4; ++j) { const float a0 = acc[ai][0][m][0][j] * rr, b0 = acc[ai][1][m][0][j] * rr, a1 = acc[ai][0][m][1][j] * rr, b1 = acc[ai][1][m][1][j] * rr;
                    v0[j] = a0 * fast_sigmoid(a0) * b0; v1[j] = a1 * fast_sigmoid(a1) * b1; }
                u32x2 w; w.x = pk4_fp8(v0[0], v0[1], v0[2], v0[3]); w.y = pk4_fp8(v1[0], v1[1], v1[2], v1[3]);
                *(u32x2*)(H + ((size_t)u.pm * 256 + rl) * DE + cl) = w; }
    }
};
struct EpiC {
    fp8* Cb; const unsigned* ltok;
    __device__ __forceinline__ void operator()(const f32x4 (&acc)[2][2][4][2], const Unit& u, int wr, int wc, int fr, int fq) const {
        asm volatile("" : "+v"(fr), "+v"(fq));
        const int cl = u.pn * 256 + wc * 64 + 16 * fq;
#pragma unroll
        for (int ai = 0; ai < 2; ++ai)
#pragma unroll
            for (int m = 0; m < 4; ++m) { const int rl = ai * HALF + wr * 64 + m * 16 + fr, pos = u.rt * 256 + rl;
                if (pos < u.cnt) { const unsigned rec = ltok[(size_t)u.e * CAP + pos]; const float cw = bfhi(rec) * 4.0f;
                    fp8* orow = Cb + ((size_t)((rec >> 14) & 1u) * T + (rec & 0x3fffu)) * D + cl;
                    const f32x4 v0 = acc[ai][0][m][0] * cw, v1 = acc[ai][0][m][1] * cw, v2 = acc[ai][1][m][0] * cw, v3 = acc[ai][1][m][1] * cw;
                    u32x4 w; w.x = pk4_fp8(v0[0], v0[1], v0[2], v0[3]); w.y = pk4_fp8(v1[0], v1[1], v1[2], v1[3]); w.z = pk4_fp8(v2[0], v2[1], v2[2], v2[3]); w.w = pk4_fp8(v3[0], v3[1], v3[2], v3[3]);
                    *(u32x4*)orow = w; } }
    }
};

template <class Epi, class Sched, bool F8>
__device__ __forceinline__ void gemm_phase(LAS unsigned char* lds, const int Kb, const Sched& S, const Epi& E, const int wid) {
    constexpr bool GATHER = Sched::GATHER;
    const int lane = lane_id(), tid = wid * 64 + lane, wr = wid >> 2, wc = wid & 3, fr = lane & 15, fq = lane >> 4;
    int nt = Kb / 128; asm volatile("" : "+s"(nt));
    const unsigned kstep = 128u, hstep = (unsigned)(HALF * Kb);
    const unsigned kstepB = 32768u, hstepB = 2048u;
    const __amdgpu_buffer_rsrc_t rsA = __builtin_amdgcn_make_buffer_rsrc((void*)S.a_buf(), 0, 0x7fffffff, 0x00020000);
    const __amdgpu_buffer_rsrc_t rsB = __builtin_amdgcn_make_buffer_rsrc((void*)S.b_buf(), 0, 0x7fffffff, 0x00020000);
    unsigned voffA[2], voffB[2], ct[2] = {0u, 0u}, ntk[2] = {0u, 0u}; unsigned pc2;
    { int R, C; stage_rc(tid * 16, R, C); pc2 = (unsigned)C * 2u; }
#define PG8_R0() ({ int _t = wid * 64 + lane_id(); asm volatile("" : "+v"(_t)); int _R, _C; stage_rc(_t * 16, _R, _C); _R; })
#pragma unroll
    for (int i = 0; i < 2; ++i) { int R, C; stage_rc(tid * 16 + i * 8192, R, C);
        voffA[i] = (unsigned)(R * Kb) + (unsigned)C * 2u;
        const int st = wid + 8 * i; voffB[i] = (unsigned)((((st & 1) * 4 + (lane >> 4)) * 256) + (st >> 1) * 16 + (lane & 15)) * 16u; }
    const unsigned ldsw = (unsigned)wid * 1024u;
    const int aoff = lds_byte(wr * 64 + fr, fq * 8), boff = wc * 4096 + (fq * 16 + fr) * 16;
    const LAS unsigned char* ldsA = lds + aoff; const LAS unsigned char* ldsB = lds + 4 * HTB + boff;
    asm volatile("" : "+v"(ldsA), "+v"(ldsB));
#define PG8_SA(b, h) (((b) * 2 + (h)) * HTB)
#define PG8_SB(b, h) ((4 + (b) * 2 + (h)) * HTB)
#define PG8_STAGE(bufoff, soff, voff) do { _Pragma("unroll") for (int _i = 0; _i < 2; ++_i) \
        __builtin_amdgcn_raw_ptr_buffer_load_lds(rsB, (LAS void*)(lds + (bufoff) + ldsw + _i * 8192), 16, (int)(voff)[_i], (int)(soff), 0, 0); } while (0)
#define PG8_STAGE_A(bufoff, soff, h, TK) do { _Pragma("unroll") for (int _i = 0; _i < 2; ++_i) { \
        const unsigned _o = GATHER ? ((((TK)[h] >> (16 * _i)) & 0xffffu) * (unsigned)Kb + pc2) : voffA[_i]; const unsigned _so = GATHER ? (unsigned)(soff) : (unsigned)(soff) + (h) * hstep; \
        __builtin_amdgcn_raw_ptr_buffer_load_lds(rsA, (LAS void*)(lds + (bufoff) + ldsw + _i * 8192), 16, (int)_o, (int)_so, 0, 0); } } while (0)
#define PG8_LDA(dst, b, h) do { _Pragma("unroll") for (int m = 0; m < 4; ++m) { if constexpr (F8) { const i32x4 _lo = *(const LAS i32x4*)(ldsA + PG8_SA(b, h) + m * 2048), _hi = *(const LAS i32x4*)(ldsA + PG8_SA(b, h) + m * 2048 + 1024); \
            dst##8[m] = __builtin_shufflevector(_lo, _hi, 0, 1, 2, 3, 4, 5, 6, 7); } else { _Pragma("unroll") for (int k = 0; k < 2; ++k) dst[m][k] = *(const LAS bf16x8*)(ldsA + PG8_SA(b, h) + m * 2048 + k * 1024); } } } while (0)
#define PG8_LDB(dst, b, h) do { _Pragma("unroll") for (int n = 0; n < 2; ++n) { if constexpr (F8) { const i32x4 _lo = *(const LAS i32x4*)(ldsB + (PG8_SB(b, h) - 4 * HTB) + n * 2048), _hi = *(const LAS i32x4*)(ldsB + (PG8_SB(b, h) - 4 * HTB) + n * 2048 + 1024); \
            dst##8[n] = __builtin_shufflevector(_lo, _hi, 0, 1, 2, 3, 4, 5, 6, 7); } else { _Pragma("unroll") for (int k = 0; k < 2; ++k) dst[n][k] = *(const LAS bf16x8*)(ldsB + (PG8_SB(b, h) - 4 * HTB) + n * 2048 + k * 1024); } } } while (0)
#define PG8_MMA(ai, bj, At, Bt) do { __builtin_amdgcn_s_setprio(1); _Pragma("unroll") for (int m = 0; m < 4; ++m) _Pragma("unroll") for (int n = 0; n < 2; ++n) { \
        if constexpr (F8) acc[ai][bj][m][n] = __builtin_amdgcn_mfma_scale_f32_16x16x128_f8f6f4(Bt##8[n], At##8[m], acc[ai][bj][m][n], 0, 0, 0, 0x7F7F7F7F, 0, 0x7F7F7F7F); \
        else { _Pragma("unroll") for (int k = 0; k < 2; ++k) acc[ai][bj][m][n] = __builtin_amdgcn_mfma_f32_16x16x32_bf16(Bt[n][k], At[m][k], acc[ai][bj][m][n], 0, 0, 0); } } \
        __builtin_amdgcn_s_setprio(0); } while (0)
#define PG8_WAIT_V(n) asm volatile("s_waitcnt vmcnt(" #n ")" ::: "memory")
#define PG8_WAIT_L(n) asm volatile("s_waitcnt lgkmcnt(" #n ")" ::: "memory")
#define PG8_BAR __builtin_amdgcn_s_barrier()
#define PG8_SCHED __builtin_amdgcn_sched_barrier(0)
    Unit cur, nxt; int ui = 0;
    if (!S.next(0, cur)) return;
    f32x4 acc[2][2][4][2];
#pragma unroll
    for (int a = 0; a < 2; ++a)
#pragma unroll
        for (int b = 0; b < 2; ++b)
#pragma unroll
            for (int m = 0; m < 4; ++m)
#pragma unroll
                for (int n = 0; n < 2; ++n) acc[a][b][m][n] = (f32x4){0.f, 0.f, 0.f, 0.f};
    bf16x8 At[4][2], B0[2][2], B1[2][2]; i32x8 At8[4], B08[2], B18[2];
    unsigned cA = S.a_soff(cur), cB = S.b_soff(cur);
    if constexpr (GATHER) { S.a_tokens(cur, PG8_R0(), ct); asm volatile("" : "+v"(ct[0]), "+v"(ct[1])); }
    PG8_STAGE(PG8_SB(0, 0), cB, voffB); PG8_STAGE(PG8_SB(0, 1), cB + hstepB, voffB); PG8_STAGE_A(PG8_SA(0, 0), cA, 0, ct); PG8_STAGE_A(PG8_SA(0, 1), cA, 1, ct);
    if (wr == 1) PG8_BAR;
    PG8_WAIT_V(2); PG8_BAR;
    PG8_STAGE(PG8_SB(1, 0), cB + kstepB, voffB); PG8_STAGE_A(PG8_SA(1, 0), cA + kstep, 0, ct); PG8_STAGE(PG8_SB(1, 1), cB + hstepB + kstepB, voffB);
    PG8_WAIT_V(6); PG8_BAR;
    for (;;) {
        const bool has_next = S.next(ui + 1, nxt);
        unsigned nA = cA, nB = cB;
        if constexpr (GATHER) { ntk[0] = ct[0]; ntk[1] = ct[1]; }
        if (has_next) { nA = S.a_soff(nxt); nB = S.b_soff(nxt);
            if constexpr (GATHER) { S.a_tokens(nxt, PG8_R0(), ntk); asm volatile("" : "+v"(ntk[0]), "+v"(ntk[1])); } }
#pragma unroll 1
        for (int t = 0; t < nt; t += 2) {
            const bool last = (t == nt - 2);
            const unsigned a1 = cA + (unsigned)(t + 1) * kstep;
            const unsigned a2 = last ? nA : cA + (unsigned)(t + 2) * kstep, b2 = last ? nB : cB + (unsigned)(t + 2) * kstepB;
            const unsigned a3 = a2 + kstep, b3 = b2 + kstepB;
            unsigned tc[2] = {ct[0], ct[1]}, t2[2];
            if constexpr (GATHER) asm volatile("" : "+v"(tc[0]), "+v"(tc[1]));
            t2[0] = (GATHER && last) ? ntk[0] : tc[0]; t2[1] = (GATHER && last) ? ntk[1] : tc[1];
            PG8_LDB(B0, 0, 0); PG8_LDB(B1, 0, 1); PG8_SCHED; PG8_LDA(At, 0, 0); PG8_STAGE_A(PG8_SA(1, 1), a1, 1, tc);
            PG8_WAIT_V(8); PG8_WAIT_L(0); PG8_BAR; PG8_MMA(0, 0, At, B0); PG8_MMA(0, 1, At, B1); PG8_BAR; PG8_SCHED;
            PG8_LDA(At, 0, 1); PG8_STAGE(PG8_SB(0, 0), b2, voffB); PG8_STAGE(PG8_SB(0, 1), b2 + hstepB, voffB); PG8_STAGE_A(PG8_SA(0, 0), a2, 0, t2);
            PG8_WAIT_V(8); PG8_WAIT_L(0); PG8_BAR; PG8_MMA(1, 0, At, B0); PG8_MMA(1, 1, At, B1); PG8_BAR; PG8_SCHED;
            PG8_LDB(B0, 1, 0); PG8_LDB(B1, 1, 1); PG8_SCHED; PG8_LDA(At, 1, 0); PG8_STAGE_A(PG8_SA(0, 1), a2, 1, t2);
            PG8_WAIT_V(8); PG8_WAIT_L(0); PG8_BAR; PG8_MMA(0, 0, At, B0); PG8_MMA(0, 1, At, B1); PG8_BAR; PG8_SCHED;
            PG8_LDA(At, 1, 1); PG8_STAGE(PG8_SB(1, 0), b3, voffB); PG8_STAGE(PG8_SB(1, 1), b3 + hstepB, voffB); PG8_STAGE_A(PG8_SA(1, 0), a3, 0, t2);
            PG8_WAIT_V(8); PG8_WAIT_L(0); PG8_BAR; PG8_MMA(1, 0, At, B0); PG8_MMA(1, 1, At, B1); PG8_BAR; PG8_SCHED;
        }
        if (wr == 0) PG8_BAR;
        { int _l = lane_id(); asm volatile("" : "+v"(_l)); E(acc, cur, wr, wc, _l & 15, (_l >> 4) & 3); }
        if (!has_next) break;
#pragma unroll
        for (int a = 0; a < 2; ++a)
#pragma unroll
            for (int b = 0; b < 2; ++b)
#pragma unroll
                for (int m = 0; m < 4; ++m)
#pragma unroll
                    for (int n = 0; n < 2; ++n) acc[a][b][m][n] = (f32x4){0.f, 0.f, 0.f, 0.f};
        cur = nxt; cA = nA; cB = nB; ++ui;
        if constexpr (GATHER) { ct[0] = ntk[0]; ct[1] = ntk[1]; }
        if (wr == 1) PG8_BAR;
    }
    PG8_WAIT_V(0);
    PG8_BAR;
#undef PG8_SA
#undef PG8_SB
#undef PG8_STAGE
#undef PG8_STAGE_A
#undef PG8_R0
#undef PG8_LDA
#undef PG8_LDB
#undef PG8_MMA
#undef PG8_WAIT_V
#undef PG8_WAIT_L
#undef PG8_BAR
#undef PG8_SCHED
}
}

#define XB_TMO      128
#define XB_XCNT(j)  (256  + 64 * (j))
#define XB_XSUB(j)  (1280 + 64 * (j))
#define XB_XGEN(j)  (2304 + 64 * (j))
#define XB_TOP      3328
#define XB_TOPGEN   3392
#define XCD_BAR_WORDS 3456
#define XB_SPIN_CAP (1u << 18)
__device__ __forceinline__ unsigned xb_ld(unsigned* p)              { return __hip_atomic_load(p, __ATOMIC_RELAXED, __HIP_MEMORY_SCOPE_AGENT); }
__device__ __forceinline__ unsigned xb_add(unsigned* p, unsigned v) { return __hip_atomic_fetch_add(p, v, __ATOMIC_RELAXED, __HIP_MEMORY_SCOPE_AGENT); }
__device__ __forceinline__ unsigned xb_xcc_id() { return (unsigned)__builtin_amdgcn_s_getreg((3 << 11) | 20) & 0xFu; }
#define XB_SPIN(cond, bar) do { unsigned _sp = 0; while (cond) { __builtin_amdgcn_s_sleep(1); \
    if ((++_sp & 255u) == 0u) { if (xb_ld(&(bar)[XB_TMO])) break; if (_sp > XB_SPIN_CAP) { atomicAdd(&(bar)[XB_TMO], 1u); break; } } } } while (0)
struct XcdBarrier { unsigned* bar; unsigned x; volatile LAS unsigned* st; int wave; };
__device__ __forceinline__ XcdBarrier xcd_barrier_post(unsigned* bar, volatile LAS unsigned* st, int wave) {
    XcdBarrier b; b.bar = bar; b.x = xb_xcc_id(); b.st = st; b.wave = wave;
    if (wave == 0 && lane_id() == 0) (void)xb_add(&bar[XB_XCNT(b.x)], 1u);
    return b;
}
__device__ __forceinline__ void xcd_barrier_complete(unsigned* bar, unsigned x, unsigned& nloc, unsigned& nx) {
    const unsigned G = gridDim.x * gridDim.y * gridDim.z;
    unsigned sum, cnt, mine, sp = 0u;
    for (;;) {
        sum = 0u; cnt = 0u; mine = 0u;
#pragma unroll
        for (unsigned j = 0; j < 16; ++j) { const unsigned c = xb_ld(&bar[XB_XCNT(j)]); sum += c; cnt += (c > 0u) ? 1u : 0u; mine = (j == x) ? c : mine; }
        if (sum == G) break;
        __builtin_amdgcn_s_sleep(1);
        if ((++sp & 255u) == 0u) { if (xb_ld(&bar[XB_TMO])) break; if (sp > XB_SPIN_CAP) { atomicAdd(&bar[XB_TMO], 1u); break; } }
    }
    nloc = mine > 0u ? mine : 1u; nx = cnt > 0u ? cnt : 1u;
}
__device__ __forceinline__ void xcd_barrier_leader(const XcdBarrier& b) {
    {
        unsigned* bar = b.bar;
        __builtin_amdgcn_s_waitcnt(0);
        unsigned nloc = b.st[0], nx = b.st[1];
        if (nloc == 0u) { xcd_barrier_complete(bar, b.x, nloc, nx); b.st[0] = nloc; b.st[1] = nx; }
        const unsigned old = xb_add(&bar[XB_XSUB(b.x)], 1u);
        const unsigned gen = old / nloc;
        if (old + 1u == (gen + 1u) * nloc) {
            __builtin_amdgcn_fence(__ATOMIC_RELEASE, "agent");
            asm volatile("s_waitcnt vmcnt(0)" ::: "memory");
            const unsigned og = xb_add(&bar[XB_TOP], 1u);
            const unsigned tg = og / nx;
            if (og + 1u == (tg + 1u) * nx) xb_add(&bar[XB_TOPGEN], 1u);
            else XB_SPIN(xb_ld(&bar[XB_TOPGEN]) == tg, bar);
            __builtin_amdgcn_fence(__ATOMIC_ACQUIRE, "agent");
            xb_add(&bar[XB_XGEN(b.x)], 1u);
            asm volatile("s_waitcnt vmcnt(0)" ::: "memory");
        } else {
            XB_SPIN(xb_ld(&bar[XB_XGEN(b.x)]) == gen, bar);
            __builtin_amdgcn_fence(__ATOMIC_ACQUIRE, "agent");
            asm volatile("s_waitcnt vmcnt(0)" ::: "memory");
        }
    }
}
__device__ __forceinline__ void xcd_barrier(const XcdBarrier& b) {
    asm volatile("s_waitcnt vmcnt(0)" ::: "memory");
    __syncthreads();
    if (b.wave == 0 && lane_id() == 0) xcd_barrier_leader(b);
    __syncthreads();
}

struct Frame {
    LAS unsigned char* lds;
    volatile LAS unsigned* MISC;
    gu32* ctl;
    int vcu, G, wave;
    const float *x, *norm_mix_g, *w_in, *conv_a_w, *conv_b_w, *conv_b_bias, *ln_b_g, *ln_b_b, *beta_a, *beta_b, *w_out, *norm_ffn_g, *wrg, *brg, *wre, *bre, *w1, *w3, *w2, *gfin;
    float* out;
    bf16 *Win_t, *Wout_t, *Wr_t, *XB, *P, *Y, *X1B; fp8 *W13_t, *W2_t, *H, *X1F8, *CB; float* RI;
    float *SSQ, *LW, *LR2; unsigned* LTOK; unsigned* gcnt;
};

struct CvtItem { const float* src; const float* ks; bf16* dst; int N; bool valid; };
__device__ __forceinline__ void cvt_load(const CvtItem& it, f32x4 (&v)[8]) {
    if (it.valid) {
#pragma unroll
        for (int j = 0; j < 8; ++j) v[j] = __builtin_nontemporal_load((const GAS f32x4*)(it.src + (size_t)j * it.N));
    }
}
__device__ __forceinline__ void cvt_store(const CvtItem& it, f32x4 (&v)[8]) {
    if (it.valid) {
        if (it.ks) {
#pragma unroll
            for (int j = 0; j < 8; ++j) v[j] = v[j] * it.ks[j];
        }
#pragma unroll
        for (int c = 0; c < 4; ++c) { u32x4 g; g.x = cvt_pk_bf16(v[0][c], v[1][c]); g.y = cvt_pk_bf16(v[2][c], v[3][c]); g.z = cvt_pk_bf16(v[4][c], v[5][c]); g.w = cvt_pk_bf16(v[6][c], v[7][c]);
            *(GAS u32x4*)(it.dst + (size_t)c * 8) = g; }
    }
}
__device__ __forceinline__ int win_dest_row(int n0) {
    if (n0 < 512) return 256 * (n0 >> 7) + (n0 & 127);
    if (n0 < 1024) return n0 + 512;
    if (n0 < 1536) { const int j = n0 - 1024; return 256 * (j >> 7) + 128 + (j & 127); }
    if (n0 < 2048) { const int j = n0 - 1536; return 1536 + 256 * (j >> 7) + (j & 127); }
    { const int j = n0 - 2048; return 1536 + 256 * (j >> 7) + 128 + (j & 127); }
}
__device__ __forceinline__ size_t gran_idx(int kb, int drow, int nkt, bool wide = false) { const int w = drow & 31, c = drow & 255;
    const int slot = wide ? 128 * ((c >> 3) & 1) + 32 * (c >> 6) + 16 * ((c >> 2) & 1) + 4 * ((c >> 4) & 3) + (c & 3) : (drow & 224) + 16 * ((w >> 2) & 1) + 4 * (w >> 3) + (w & 3);
    return ((size_t)(((drow >> 8) * nkt + (kb >> 3)) * 8 + (kb & 7)) * 256 + slot); }
constexpr int I_IN = 128 * 10, I_OUT = 128 * 4, NITEMS = I_IN + I_OUT;
constexpr int J_13 = NE * 2 * 64 * 2, J_2 = NE * 32 * 4, NITEMS8 = J_13 + J_2;
__device__ __forceinline__ CvtItem p0_decode(Frame& F, int it, int lane) {
    CvtItem c; c.valid = it < NITEMS; c.src = F.w_in; c.ks = nullptr; c.dst = F.Win_t; c.N = DIN;
    if (!c.valid) return c;
    int r = it;
    if (r < I_IN) { const int kb = r / 10, n = 256 * (r % 10) + 4 * lane;
        c.src = F.w_in + (size_t)(8 * kb) * DIN + n; c.N = DIN; c.ks = F.norm_mix_g + 8 * kb; c.dst = F.Win_t + gran_idx(kb, win_dest_row(n), 16) * 8; return c; }
    r -= I_IN;
    { const int kb = r / 4, n = 256 * (r % 4) + 4 * lane;
        c.src = F.w_out + (size_t)(8 * kb) * D + n; c.N = D; c.ks = (8 * kb < DA) ? F.beta_a + 8 * kb : F.beta_b + (8 * kb - DA); c.dst = F.Wout_t + gran_idx(kb, n, 16, true) * 8; return c; }
}
struct CvtItem8 { const float* src; const float* ks; fp8* dst; int N; float scale; };
__device__ __forceinline__ CvtItem8 p0_decode8(Frame& F, int it, int lane) {
    CvtItem8 c; int r = it;
    if (r < J_13) { const int e = r / 256, rr = r % 256, which = rr / 128, item = rr % 128, kb = item / 2, n = 256 * (item % 2) + 4 * lane;
        c.src = (which ? F.w3 : F.w1) + (size_t)e * D * DE + (size_t)(16 * kb) * DE + n; c.N = DE; c.ks = F.norm_ffn_g + 16 * kb; c.scale = 32.0f;
        c.dst = F.W13_t + (size_t)e * 1024 * D + gran_idx(kb, 256 * (n >> 7) + 128 * which + (n & 127), 8) * 16; return c; }
    r -= J_13;
    { const int e = r / 128, item = r % 128, kb = item / 4, n = 256 * (item % 4) + 4 * lane;
        c.src = F.w2 + (size_t)e * DE * D + (size_t)(16 * kb) * D + n; c.N = D; c.ks = nullptr; c.scale = 16.0f; c.dst = F.W2_t + (size_t)e * 1024 * DE + gran_idx(kb, n, 4, true) * 16; return c; }
}
__device__ __forceinline__ void p0_cvt8_item(Frame& F, int it, int lane) {
    const CvtItem8 c = p0_decode8(F, it, lane);
    f32x4 v[16];
#pragma unroll
    for (int j = 0; j < 16; ++j) v[j] = __builtin_nontemporal_load((const GAS f32x4*)(c.src + (size_t)j * c.N));
#pragma unroll
    for (int j = 0; j < 16; ++j) v[j] = v[j] * (c.ks ? c.ks[j] * c.scale : c.scale);
#pragma unroll
    for (int q = 0; q < 4; ++q) { u32x4 g;
#pragma unroll
        for (int w = 0; w < 4; ++w) g[w] = pk4_fp8(v[4 * w][q], v[4 * w + 1][q], v[4 * w + 2][q], v[4 * w + 3][q]);
        *(GAS u32x4*)(c.dst + (size_t)q * 16) = g; }
}
constexpr int NITEMS8_LATE = 4096;
__device__ __forceinline__ void p1_late_convert(Frame& F) {
    if (F.G != 256 || blockIdx.x < 128) return;
    int lane = lane_id(); asm volatile("" : "+v"(lane));
    const int w0 = ((int)blockIdx.x - 128) * NWAVES + F.wave;
    for (int it = NITEMS8 - NITEMS8_LATE + w0; it < NITEMS8; it += 128 * NWAVES) p0_cvt8_item(F, it, lane);
}
constexpr int W13_P0 = 1024, FILL_PER_BAR = 256 * (NWAVES - 1), N_FILL_BARS = 4;
static_assert(W13_P0 + N_FILL_BARS * FILL_PER_BAR >= J_13, "the barrier fillers must cover every W1/W3 item P0 leaves out");
__device__ __forceinline__ void xcd_barrier_fill(Frame& F, const XcdBarrier& b, int k) {
    asm volatile("s_waitcnt vmcnt(0)" ::: "memory");
    __syncthreads();
    if (b.wave == 0) { if (lane_id() == 0) xcd_barrier_leader(b); }
    else if (k < N_FILL_BARS && F.G == 256) {
        const int it = W13_P0 + k * FILL_PER_BAR + (int)blockIdx.x * (NWAVES - 1) + (b.wave - 1);
        if (it < W13_P0 + (k + 1) * FILL_PER_BAR && it < J_13) { int lane = lane_id(); asm volatile("" : "+v"(lane)); p0_cvt8_item(F, it, lane); }
    }
    __syncthreads();
}
__device__ __forceinline__ void p0_prologue(Frame& F) {
    const int wave = F.wave; int lane = lane_id(); asm volatile("" : "+v"(lane)); const int tid = wave * 64 + lane;
    const int gw = F.vcu * NWAVES + wave, NGW = F.G * NWAVES;
    for (int it = gw; it < NITEMS; it += 2 * NGW) {
        const CvtItem c0 = p0_decode(F, it, lane), c1 = p0_decode(F, it + NGW, lane);
        f32x4 v0[8], v1[8];
        cvt_load(c0, v0); cvt_load(c1, v1);
        cvt_store(c0, v0); cvt_store(c1, v1);
    }
    for (int it = gw; it < ((F.G == 256 && N_LAUNCHES == 1) ? W13_P0 : (F.G == 256 ? J_13 : NITEMS8)); it += NGW) p0_cvt8_item(F, it, lane);
    for (int i = gw * 64 + lane; i < 48 * D; i += NGW * 64) { const int o = i / D, k = i % D; float v = 0.f;
        if (o < 4) v = F.wrg[(size_t)k * 4 + o] * F.norm_ffn_g[k]; else if (o < 36) v = F.wre[(size_t)k * NE + (o - 4)] * F.norm_ffn_g[k];
        F.Wr_t[i] = (bf16)f2bf(v); }
    for (int m = gw; m < T; m += NGW) {
        const GAS f32x4* xr = (const GAS f32x4*)(F.x + (size_t)m * D) + lane;
        f32x4 v[4]; float s = 0.f;
#pragma unroll
        for (int j = 0; j < 4; ++j) { v[j] = __builtin_nontemporal_load(xr + 64 * j); s += (v[j].x * v[j].x + v[j].y * v[j].y) + (v[j].z * v[j].z + v[j].w * v[j].w); }
        const float r = rsqrtf(wave_sum(s) * (1.f / D) + EPS);
        if (lane == 0) F.RI[m] = 1.0f / r;
        GAS u32x2* o8 = (GAS u32x2*)(F.XB + (size_t)m * D) + lane;
#pragma unroll
        for (int j = 0; j < 4; ++j) { u32x2 w; w.x = pk2(v[j].x * r, v[j].y * r); w.y = pk2(v[j].z * r, v[j].w * r); o8[64 * j] = w; }
    }
}

template <int CTRL> __device__ __forceinline__ float dpp_f(float v) { return __builtin_bit_cast(float, __builtin_amdgcn_update_dpp(0, __builtin_bit_cast(int, v), CTRL, 0xf, 0xf, false)); }
#define DPP_XOR1 0xB1
#define DPP_XOR2 0x4E
#define DPP_HALF_MIRROR 0x141
#define DPP_ROW_MIRROR 0x140
__device__ __forceinline__ float sum8(float v) { v += dpp_f<DPP_XOR1>(v); v += dpp_f<DPP_XOR2>(v); v += dpp_f<DPP_HALF_MIRROR>(v); return v; }
__device__ __forceinline__ float sum16(float v) { v = sum8(v); v += dpp_f<DPP_ROW_MIRROR>(v); return v; }
__device__ __forceinline__ void p2_mixer(Frame& F) {
    const int wave = F.wave; int lane = lane_id(); asm volatile("" : "+v"(lane)); const int tid = wave * 64 + lane;
    LAS unsigned char* L = F.lds;
    LAS unsigned* Ut = (LAS unsigned*)L;
    LAS float* UC = (LAS float*)(L + 62 * 1024);
    LAS float* PRM = (LAS float*)(L + LDSCTL_OFF + 2048);
    PRM[tid] = F.ln_b_g[tid]; PRM[512 + tid] = F.ln_b_b[tid];
#pragma unroll
    for (int q = 0; q < 3; ++q) PRM[1024 + 512 * q + tid] = F.conv_a_w[q * DA + tid];
    const int cp = tid & 255, th = tid >> 8;
    f32x2 wb[31];
#pragma unroll
    for (int j = 0; j < 31; ++j) wb[j] = *(const f32x2*)(F.conv_b_w + j * DB + 2 * cp);
    const f32x2 bias2 = *(const f32x2*)(F.conv_b_bias + 2 * cp);
    const int tq = lane >> 4, tl = lane & 15;
    u32x4 ureg[8];
#define P2_ULOAD(tile_) do { const int _t0 = (tile_) * 32, _b = _t0 / SEQ, _s0 = _t0 % SEQ; int _tid = tid; asm volatile("" : "+v"(_tid)); _Pragma("unroll") for (int _i = 0; _i < 8; ++_i) { const int _ch = _tid + 512 * _i, _row = _ch >> 6, _c16 = _ch & 63, _s = _s0 - 15 + _row; \
        ureg[_i] = (u32x4){0u, 0u, 0u, 0u}; if (_ch < 62 * 64 && _s >= 0 && _s < SEQ) ureg[_i] = *(const GAS u32x4*)(F.P + (size_t)(_b * SEQ + _s) * PW + 1024 + _c16 * 8); } } while (0)
    int tile = F.vcu;
    if (tile < T / 32) P2_ULOAD(tile);
    __syncthreads();
    for (; tile < T / 32; tile += F.G) {
        const int t0 = tile * 32, s0 = t0 % SEQ;
        { int tid2 = tid; asm volatile("" : "+v"(tid2));
#pragma unroll
        for (int i = 0; i < 8; ++i) { const int ch = tid2 + 512 * i; if (ch < 62 * 64) *(LAS u32x4*)(L + ch * 16) = ureg[i]; } }
        __syncthreads();
        if (tile + F.G < T / 32) P2_ULOAD(tile + F.G);
#pragma unroll 1
        for (int sub = 0; sub < 2; ++sub) { const int i0 = th * 16 + sub * 8; f32x2 a[8];
#pragma unroll
            for (int i = 0; i < 8; ++i) a[i] = bias2;
#pragma unroll
            for (int w = 0; w < 38; ++w) { const unsigned v = Ut[(i0 + w) * 256 + cp]; const f32x2 x2 = (f32x2){bflo(v), bfhi(v)};
#pragma unroll
                for (int i = 0; i < 8; ++i) { const int j = w - i; if (j >= 0 && j < 31) a[i] = __builtin_elementwise_fma(wb[j], x2, a[i]); } }
#pragma unroll
            for (int i = 0; i < 8; ++i) *(LAS f32x2*)(UC + (i0 + i) * 512 + 2 * cp) = a[i];
        }
        __syncthreads();
        u32x4 gpm1[4], gp0[4], gpp1[4], gab[4];
        { const int i = wave * 4 + tq, s = s0 + i; const bf16* prow = F.P + (size_t)(t0 + i) * PW + 8 * tl; const u32x4 z4 = (u32x4){0u, 0u, 0u, 0u};
#pragma unroll
          for (int k = 0; k < 4; ++k) { const bf16* pk = prow + 128 * k;
            gpm1[k] = (s > 0) ? *(const GAS u32x4*)(pk - PW) : z4; gp0[k] = *(const GAS u32x4*)pk; gpp1[k] = (s < SEQ - 1) ? *(const GAS u32x4*)(pk + PW) : z4; gab[k] = *(const GAS u32x4*)(pk + 512); } }
        { const int i = wave * 4 + tq, t = t0 + i;
          float uv[4][8]; float s1 = 0.f;
#pragma unroll
          for (int k = 0; k < 4; ++k) { const LAS float* up = UC + i * 512 + 8 * (tl + 16 * k); const f32x4 ua = *(const LAS f32x4*)up, ub = *(const LAS f32x4*)(up + 4);
#pragma unroll
            for (int j = 0; j < 4; ++j) { uv[k][j] = ua[j]; uv[k][4 + j] = ub[j]; s1 += ua[j] + ub[j]; } }
          const float mu = sum16(s1) * (1.f / DB); float s2 = 0.f;
#pragma unroll
          for (int k = 0; k < 4; ++k)
#pragma unroll
            for (int j = 0; j < 8; ++j) { uv[k][j] -= mu; s2 += uv[k][j] * uv[k][j]; }
          const float rstd = rsqrtf(sum16(s2) * (1.f / DB) + EPS);
#pragma unroll
          for (int k = 0; k < 4; ++k) { const int c8 = 8 * (tl + 16 * k); const LAS float* gp = PRM + c8; const f32x4 g0 = *(const LAS f32x4*)gp, g1 = *(const LAS f32x4*)(gp + 4), b0 = *(const LAS f32x4*)(gp + 512), b1 = *(const LAS f32x4*)(gp + 516);
            float hb = 0.f;
#pragma unroll
            for (int j = 0; j < 8; ++j) { const float z = uv[k][j] * rstd * (j < 4 ? g0[j & 3] : g1[j & 3]) + (j < 4 ? b0[j & 3] : b1[j & 3]); uv[k][j] = z * fast_sigmoid(z); hb += uv[k][j] * uv[k][j]; }
            const float rb = rsqrtf(sum8(hb) * (1.f / 64.f) + EPS);
            u32x4 ob; ob.x = cvt_pk_bf16(uv[k][0] * rb, uv[k][1] * rb); ob.y = cvt_pk_bf16(uv[k][2] * rb, uv[k][3] * rb); ob.z = cvt_pk_bf16(uv[k][4] * rb, uv[k][5] * rb); ob.w = cvt_pk_bf16(uv[k][6] * rb, uv[k][7] * rb);
            *(GAS u32x4*)(F.Y + (size_t)t * D + DA + c8) = ob; }
#pragma unroll
          for (int k = 0; k < 4; ++k) { const int c8 = 8 * (tl + 16 * k); const LAS float* wp = PRM + 1024 + c8; float ya[8]; float ha = 0.f;
            f32x4 w0[2], w1[2], w2[2];
#pragma unroll
            for (int h = 0; h < 2; ++h) { w0[h] = *(const LAS f32x4*)(wp + 4 * h); w1[h] = *(const LAS f32x4*)(wp + 512 + 4 * h); w2[h] = *(const LAS f32x4*)(wp + 1024 + 4 * h); }
#pragma unroll
            for (int j = 0; j < 4; ++j) { const int h = j >> 1, e = 2 * (j & 1);
                const float c0 = w0[h][e] * bflo(gpm1[k][j]) + w1[h][e] * bflo(gp0[k][j]) + w2[h][e] * bflo(gpp1[k][j]);
                const float c1 = w0[h][e + 1] * bfhi(gpm1[k][j]) + w1[h][e + 1] * bfhi(gp0[k][j]) + w2[h][e + 1] * bfhi(gpp1[k][j]);
                ya[2 * j] = bflo(gab[k][j]) * c0; ya[2 * j + 1] = bfhi(gab[k][j]) * c1; ha += ya[2 * j] * ya[2 * j] + ya[2 * j + 1] * ya[2 * j + 1]; }
            const float ra = rsqrtf(sum8(ha) * (1.f / 64.f) + EPS);
            u32x4 oa; oa.x = cvt_pk_bf16(ya[0] * ra, ya[1] * ra); oa.y = cvt_pk_bf16(ya[2] * ra, ya[3] * ra); oa.z = cvt_pk_bf16(ya[4] * ra, ya[5] * ra); oa.w = cvt_pk_bf16(ya[6] * ra, ya[7] * ra);
            *(GAS u32x4*)(F.Y + (size_t)t * D + c8) = oa; }
        }
    }
#undef P2_ULOAD
    __syncthreads();
}

__device__ __forceinline__ void p4_route(Frame& F) {
    const int wave = F.wave; int lane = lane_id(); asm volatile("" : "+v"(lane)); const int tid = wave * 64 + lane;
    LAS float* LGp = (LAS float*)F.lds;
    LAS int* scnt = (LAS int*)(F.lds + 102400);
    bf16x8 bfr[4][3];
    { const bf16* brow = F.Wr_t + (size_t)(lane & 15) * D + 128 * wave + 8 * (lane >> 4);
#pragma unroll
      for (int ks = 0; ks < 4; ++ks)
#pragma unroll
        for (int nb = 0; nb < 3; ++nb) bfr[ks][nb] = *(const GAS bf16x8*)(brow + (size_t)nb * 16 * D + ks * 32); }
    LAS float* r2s = (LAS float*)(F.lds + 102400 + 512);
    for (int tile = F.vcu; tile < T / 64; tile += F.G) {
        if (tid < 32) scnt[tid] = 0;
        const int tb = tile * 64;
        if (tid < 64) { float ss = 0.f;
#pragma unroll
            for (int s = 0; s < 16; ++s) ss += F.SSQ[(size_t)s * T + tb + tid];
            r2s[tid] = rsqrtf(ss * (1.f / D) + EPS); }
        bf16x8 af[4][4];
#pragma unroll
        for (int tg = 0; tg < 4; ++tg)
#pragma unroll
            for (int ks = 0; ks < 4; ++ks) af[tg][ks] = *(const GAS bf16x8*)(F.X1B + (size_t)(tb + 16 * tg + (lane & 15)) * D + 128 * wave + ks * 32 + 8 * (lane >> 4));
        __syncthreads();
#pragma unroll
        for (int tg = 0; tg < 4; ++tg) { f32x4 acc[3];
#pragma unroll
            for (int nb = 0; nb < 3; ++nb) acc[nb] = (f32x4){0.f, 0.f, 0.f, 0.f};
#pragma unroll
            for (int ks = 0; ks < 4; ++ks)
#pragma unroll
                for (int nb = 0; nb < 3; ++nb) acc[nb] = __builtin_amdgcn_mfma_f32_16x16x32_bf16(af[tg][ks], bfr[ks][nb], acc[nb], 0, 0, 0);
#pragma unroll
            for (int nb = 0; nb < 3; ++nb)
#pragma unroll
                for (int r = 0; r < 4; ++r) LGp[(wave * 64 + 16 * tg + 4 * (lane >> 4) + r) * 49 + nb * 16 + (lane & 15)] = acc[nb][r];
            const float rs = r2s[16 * tg + (lane & 15)];
#pragma unroll
            for (int ks = 0; ks < 4; ++ks) { const u32x4 q = __builtin_bit_cast(u32x4, af[tg][ks]); u32x2 o;
                o.x = pk4_fp8(bflo(q[0]) * rs, bfhi(q[0]) * rs, bflo(q[1]) * rs, bfhi(q[1]) * rs); o.y = pk4_fp8(bflo(q[2]) * rs, bfhi(q[2]) * rs, bflo(q[3]) * rs, bfhi(q[3]) * rs);
                *(GAS u32x2*)(F.X1F8 + (size_t)(tb + 16 * tg + (lane & 15)) * D + 128 * wave + ks * 32 + 8 * (lane >> 4)) = o; } }
        __syncthreads();
        int e0 = 0, e1 = 0, p0 = 0, p1 = 0; float c0 = 0.f, c1 = 0.f;
        if (tid < 64) {
            const float r2 = r2s[tid];
            const LAS float* lg = LGp + tid * 49;
            float g4[4];
#pragma unroll
            for (int i = 0; i < 4; ++i) { float a = 0.f;
#pragma unroll
                for (int w = 0; w < 8; ++w) a += lg[w * 64 * 49 + i];
                g4[i] = a * r2 + F.brg[i]; }
            int g = 0; float m = g4[0];
#pragma unroll
            for (int i = 1; i < 4; ++i) if (g4[i] > m) { m = g4[i]; g = i; }
            float den = 0.f;
#pragma unroll
            for (int i = 0; i < 4; ++i) den += __expf(g4[i] - m);
            const float psel = 1.0f / den;
            int i0 = 0, i1 = -1; float m0 = -3.0e38f, m1 = -3.0e38f;
            for (int i = 0; i < 8; ++i) { float a = 0.f;
#pragma unroll
                for (int w = 0; w < 8; ++w) a += lg[w * 64 * 49 + 4 + g * 8 + i];
                const float v = a * r2 + F.bre[g * 8 + i];
                if (v > m0) { m1 = m0; i1 = i0; m0 = v; i0 = i; } else if (v > m1) { m1 = v; i1 = i; } }
            const float ex = __expf(m1 - m0);
            e0 = g * 8 + i0; e1 = g * 8 + i1; c0 = psel / (1.0f + ex); c1 = psel * ex / (1.0f + ex);
            p0 = __hip_atomic_fetch_add(scnt + e0, 1, __ATOMIC_RELAXED, __HIP_MEMORY_SCOPE_WORKGROUP); p1 = __hip_atomic_fetch_add(scnt + e1, 1, __ATOMIC_RELAXED, __HIP_MEMORY_SCOPE_WORKGROUP);
        }
        __syncthreads();
        if (tid < 32) scnt[32 + tid] = (int)__hip_atomic_fetch_add(F.gcnt + tid, (unsigned)scnt[tid], RLX_AGENT);
        __syncthreads();
        if (tid < 64) {
            const int t = tb + tid; const size_t d0 = (size_t)e0 * CAP + scnt[32 + e0] + p0, d1 = (size_t)e1 * CAP + scnt[32 + e1] + p1;
            F.LTOK[d0] = (unsigned)t | (f2bf(c0) << 16);
            F.LTOK[d1] = (unsigned)t | (1u << 14) | (f2bf(c1) << 16);
        }
        __syncthreads();
    }
}

__device__ __forceinline__ void p7_final(Frame& F) {
    const int wave = F.wave; int lane = lane_id(); asm volatile("" : "+v"(lane)); const int tid = wave * 64 + lane;
    const int gw = F.vcu * NWAVES + wave, NGW = F.G * NWAVES;
    f32x4 g[2][2];
#pragma unroll
    for (int j = 0; j < 2; ++j) { g[j][0] = *(const f32x4*)(F.gfin + j * 512 + lane * 8); g[j][1] = *(const f32x4*)(F.gfin + j * 512 + lane * 8 + 4); }
    for (int t = gw; t < T; t += NGW) {
        float v[2][8]; float ss = 0.f;
#pragma unroll
        for (int j = 0; j < 2; ++j) { const size_t o = (size_t)t * D + j * 512 + lane * 8;
            const u32x4 a = *(const GAS u32x4*)(F.X1B + o); const u32x2 c0 = *(const GAS u32x2*)(F.CB + o), c1 = *(const GAS u32x2*)(F.CB + (size_t)T * D + o);
#pragma unroll
            for (int q = 0; q < 4; q += 2) { const f32x2 p0 = __builtin_amdgcn_cvt_pk_f32_fp8((int)c0[q >> 1], false), p1 = __builtin_amdgcn_cvt_pk_f32_fp8((int)c1[q >> 1], false),
                                                           p2 = __builtin_amdgcn_cvt_pk_f32_fp8((int)c0[q >> 1], true), p3 = __builtin_amdgcn_cvt_pk_f32_fp8((int)c1[q >> 1], true);
                v[j][2 * q] = bflo(a[q]) + (p0.x + p1.x) * (1.0f / 64.0f); v[j][2 * q + 1] = bfhi(a[q]) + (p0.y + p1.y) * (1.0f / 64.0f);
                v[j][2 * q + 2] = bflo(a[q + 1]) + (p2.x + p3.x) * (1.0f / 64.0f); v[j][2 * q + 3] = bfhi(a[q + 1]) + (p2.y + p3.y) * (1.0f / 64.0f); }
#pragma unroll
            for (int q = 0; q < 8; ++q) ss += v[j][q] * v[j][q]; }
        const float r = rsqrtf(wave_sum(ss) * (1.f / D) + EPS);
#pragma unroll
        for (int j = 0; j < 2; ++j) { float* o = F.out + (size_t)t * D + j * 512 + lane * 8;
            *(GAS f32x4*)o = (f32x4){v[j][0] * r * g[j][0][0], v[j][1] * r * g[j][0][1], v[j][2] * r * g[j][0][2], v[j][3] * r * g[j][0][3]};
            *(GAS f32x4*)(o + 4) = (f32x4){v[j][4] * r * g[j][1][0], v[j][5] * r * g[j][1][1], v[j][6] * r * g[j][1][2], v[j][7] * r * g[j][1][3]}; }
    }
}

__device__ __forceinline__ void moe_sched_init(pg8::SchedMoe& S, Frame& F) {
    int lane = lane_id(); asm volatile("" : "+v"(lane));
    LAS int* tab = (LAS int*)(F.lds + LDSCTL_OFF + 1024);
    int my_cnt = 0; if (lane < NE) my_cnt = (int)__hip_atomic_load(F.gcnt + lane, RLX_AGENT);
    const int tiles = (my_cnt + 255) >> 8; int incl = tiles;
#pragma unroll
    for (int o = 1; o < 32; o <<= 1) { const int v = __shfl_up(incl, o); if (lane >= o) incl += v; }
    if (F.wave == 0 && lane < NE) { tab[lane] = incl - tiles; tab[32 + lane] = my_cnt; }
    S.total_rt = __builtin_amdgcn_readlane(incl, 31); S.tab = tab;
    S.ltok = F.LTOK; S.G = F.G; S.c = (int)blockIdx.x;
    __syncthreads();
}

struct Args { const float* in[20]; float* out; unsigned char* ws; int ph_lo, ph_hi, li, pad; };
__global__ void __launch_bounds__(NWAVES * 64, 2) mk_fwd(Args args) {
    extern __shared__ __attribute__((aligned(16))) unsigned char lds[];
    Frame F;
    F.lds = (LAS unsigned char*)lds;
    F.MISC = (volatile LAS unsigned*)(F.lds + MISC_OFF);
    F.wave = __builtin_amdgcn_readfirstlane((int)threadIdx.x >> 6);
    F.G = gridDim.x; { const int bx = blockIdx.x; F.vcu = (F.G % 8 == 0) ? (bx % 8) * (F.G / 8) + bx / 8 : bx; }
    unsigned char* ws = args.ws;
    F.ctl = (gu32*)(ws + WS_CTL);
    F.x = args.in[0]; F.norm_mix_g = args.in[1]; F.w_in = args.in[2]; F.conv_a_w = args.in[3]; F.conv_b_w = args.in[4]; F.conv_b_bias = args.in[5]; F.ln_b_g = args.in[6]; F.ln_b_b = args.in[7];
    F.beta_a = args.in[8]; F.beta_b = args.in[9]; F.w_out = args.in[10]; F.norm_ffn_g = args.in[11]; F.wrg = args.in[12]; F.brg = args.in[13]; F.wre = args.in[14]; F.bre = args.in[15];
    F.w1 = args.in[16]; F.w3 = args.in[17]; F.w2 = args.in[18]; F.gfin = args.in[19]; F.out = args.out;
    F.Win_t = (bf16*)(ws + WS_WIN); F.Wout_t = (bf16*)(ws + WS_WOUT); F.Wr_t = (bf16*)(ws + WS_WR); F.W13_t = (fp8*)(ws + WS_W13); F.W2_t = (fp8*)(ws + WS_W2); F.X1F8 = (fp8*)(ws + WS_X1F8);
    F.XB = (bf16*)(ws + WS_XB); F.P = (bf16*)(ws + WS_P); F.Y = (bf16*)(ws + WS_Y); F.X1B = (bf16*)(ws + WS_X1B); F.H = (fp8*)(ws + WS_H); F.CB = (fp8*)(ws + WS_CB); F.RI = (float*)(ws + WS_WR + 768 * 1024);
    F.SSQ = (float*)(ws + WS_SSQ); F.LW = (float*)(ws + WS_LW); F.LR2 = (float*)(ws + WS_LR2); F.LTOK = (unsigned*)(ws + WS_LTOK); F.gcnt = (unsigned*)(ws + WS_CTL) + CW_GCNT;
    for (int u = F.wave * 64 + lane_id(); u < (LDS_BYTES - LDSCTL_OFF) / 4; u += NWAVES * 64) ((LAS unsigned*)(F.lds + LDSCTL_OFF))[u] = 0u;
    __syncthreads();
    XcdBarrier bar; bar.bar = (unsigned*)(F.ctl + CW_BAR); bar.x = 0; bar.st = nullptr; bar.wave = F.wave;
    if (N_LAUNCHES == 1) bar = xcd_barrier_post((unsigned*)(F.ctl + CW_BAR), F.MISC + 8, F.wave);
    const int lo = args.ph_lo, hi = args.ph_hi;
#define IN(k) (lo <= (k) && (k) < hi)
#define GRID_BAR(k) do { if (IN(k) && IN((k) + 1)) xcd_barrier_fill(F, bar, (k)); if (PROBE_PHASE >= 0 && blockIdx.x == 0 && F.wave == 0 && lane_id() == 0) ((unsigned long long*)(ws + WS_WR + 512 * 1024))[(k) + 1] = __builtin_amdgcn_s_memrealtime(); } while (0)
    if (PROBE_PHASE >= 0 && blockIdx.x == 0 && F.wave == 0 && lane_id() == 0) ((unsigned long long*)(ws + WS_WR + 512 * 1024))[0] = __builtin_amdgcn_s_memrealtime();

    if (IN(0)) { p0_prologue(F); GRID_BAR(0); }
    if (IN(1)) {
        pg8::SchedDense S{(const char*)F.XB, (const char*)F.Win_t, T / 256, DIN / 256, F.G, (int)blockIdx.x, (size_t)256 * D * 2, 16};
        pg8::EpiP1 E{F.P};
        pg8::gemm_phase<pg8::EpiP1, pg8::SchedDense, false>(F.lds + RING_OFF, D * 2, S, E, F.wave);
        p1_late_convert(F);
        GRID_BAR(1);
    }
    if (IN(2)) { p2_mixer(F); GRID_BAR(2); }
    if (IN(3)) {
        pg8::SchedDense S{(const char*)F.Y, (const char*)F.Wout_t, T / 256, D / 256, F.G, (int)blockIdx.x, (size_t)256 * D * 2, 16};
        pg8::EpiX1 E{F.XB, F.RI, F.X1B, F.SSQ};
        pg8::gemm_phase<pg8::EpiX1, pg8::SchedDense, false>(F.lds + RING_OFF, D * 2, S, E, F.wave);
        GRID_BAR(3);
    }
    if (IN(4)) { p4_route(F); GRID_BAR(4); }
    if (IN(5)) {
        pg8::SchedMoeA S; moe_sched_init(S, F); S.A = (const char*)F.X1F8; S.W = (const char*)F.W13_t; S.a_tile_bytes = 0; S.w_exp_bytes = (size_t)1024 * D; S.nkt = 8;
        pg8::EpiH E{F.H};
        pg8::gemm_phase<pg8::EpiH, pg8::SchedMoeA, true>(F.lds + RING_OFF, D, S, E, F.wave);
        GRID_BAR(5);
    }
    if (IN(6)) {
        pg8::SchedMoeB S; moe_sched_init(S, F); S.A = (const char*)F.H; S.W = (const char*)F.W2_t; S.a_tile_bytes = (size_t)256 * DE; S.w_exp_bytes = (size_t)1024 * DE; S.nkt = 4;
        pg8::EpiC E{F.CB, F.LTOK};
        pg8::gemm_phase<pg8::EpiC, pg8::SchedMoeB, true>(F.lds + RING_OFF, DE, S, E, F.wave);
        GRID_BAR(6);
    }
    if (IN(7)) { p7_final(F);
        if (PROBE_PHASE >= 0 && blockIdx.x == 0 && F.wave == 0 && lane_id() == 0) { unsigned long long* ts = (unsigned long long*)(ws + WS_WR + 512 * 1024); ts[8] = __builtin_amdgcn_s_memrealtime();
            asm volatile("s_waitcnt vmcnt(0)" ::: "memory"); const float us = (PROBE_PHASE == 8) ? (float)(ts[8] - ts[0]) * 0.001f : (float)(ts[PROBE_PHASE + 1] - ts[PROBE_PHASE]) * 0.01f; F.out[0] += us * 0.1f; } }
#undef IN
#undef GRID_BAR
}

extern "C" void kernel_launch(void* const* d_in, const int* in_sizes, int n_in, void* d_out, int out_size, void* d_ws, size_t ws_size, hipStream_t stream) {
    static int grid = 0;
    if (grid == 0) {
        if (n_in != 20 || in_sizes[0] != T * D || out_size != T * D || ws_size < WS_END) { fprintf(stderr, "kernel_launch: unexpected shapes / workspace (n_in %d, in0 %d, out %d, ws %zu, need %zu)\n", n_in, n_in > 0 ? in_sizes[0] : -1, out_size, ws_size, (size_t)WS_END); grid = -1; return; }
        int dev = 0, cus = 0, per_cu = 0;
        if (hipGetDevice(&dev) != hipSuccess || hipDeviceGetAttribute(&cus, hipDeviceAttributeMultiprocessorCount, dev) != hipSuccess) { fprintf(stderr, "kernel_launch: device query failed\n"); grid = -1; return; }
        if (hipFuncSetAttribute((const void*)mk_fwd, hipFuncAttributeMaxDynamicSharedMemorySize, LDS_BYTES) != hipSuccess) { fprintf(stderr, "kernel_launch: hipFuncSetAttribute failed\n"); grid = -1; return; }
        if (hipOccupancyMaxActiveBlocksPerMultiprocessor(&per_cu, (const void*)mk_fwd, NWAVES * 64, LDS_BYTES) != hipSuccess || per_cu < 1) fprintf(stderr, "kernel_launch: occupancy query reports %d workgroups per CU\n", per_cu);
        (void)hipGetLastError();
        grid = cus;
    }
    if (grid < 0) return;
    if (hipMemsetAsync((char*)d_ws + WS_CTL, 0, CTL_ZERO_BYTES, stream) != hipSuccess) { fprintf(stderr, "kernel_launch: hipMemsetAsync failed\n"); return; }
    Args a{};
    for (int i = 0; i < 20; ++i) a.in[i] = (const float*)d_in[i];
    a.out = (float*)d_out; a.ws = (unsigned char*)d_ws;
    for (int li = 0; li < N_LAUNCHES; ++li) {
        a.ph_lo = (N_LAUNCHES == 1) ? 0 : li; a.ph_hi = (N_LAUNCHES == 1) ? NPHASES : li + 1; a.li = li;
        hipLaunchKernelGGL(mk_fwd, dim3(grid), dim3(NWAVES * 64), LDS_BYTES, stream, a);
        const hipError_t le = hipPeekAtLastError();
        if (le != hipSuccess) { fprintf(stderr, "kernel_launch: launch %d failed: %s\n", li, hipGetErrorName(le)); break; }
    }
}
```

```cpp
#include <hip/hip_runtime.h>
#include <cstdio>
#include <cstdint>

#define LAS __attribute__((address_space(3)))
#define GAS __attribute__((address_space(1)))
typedef unsigned short bf16;
typedef short bf16x8 __attribute__((ext_vector_type(8)));
typedef float f32x4 __attribute__((ext_vector_type(4)));
typedef float f32x2 __attribute__((ext_vector_type(2)));
typedef unsigned u32x4 __attribute__((ext_vector_type(4)));
typedef unsigned u32x2 __attribute__((ext_vector_type(2)));
typedef GAS unsigned gu32;
typedef int i32x4 __attribute__((ext_vector_type(4)));
typedef int i32x8 __attribute__((ext_vector_type(8)));
typedef unsigned char fp8;

constexpr int T = 16384, SEQ = 2048, D = 1024, DA = 512, DB = 512, DIN = 2560, NE = 32, DE = 512, CAP = 16384, PW = 1536;
constexpr float EPS = 1e-6f;
constexpr int NWAVES = 8;
#ifndef MK_N_LAUNCHES
#define MK_N_LAUNCHES 1
#endif
constexpr int N_LAUNCHES = MK_N_LAUNCHES;
constexpr int NPHASES = 8;
#ifndef PROBE_PHASE
#define PROBE_PHASE -1
#endif

constexpr size_t MiB = 1u << 20;
constexpr size_t WS_CTL = 0, CTL_ZERO_BYTES = 72 * 1024;
constexpr size_t WS_WIN = 1 * MiB;
constexpr size_t WS_WOUT = 6 * MiB;
constexpr size_t WS_WR = 8 * MiB;
constexpr size_t WS_SSQ = 9 * MiB;
constexpr size_t WS_LTOK = 11 * MiB;
constexpr size_t WS_LW = 13 * MiB;
constexpr size_t WS_LR2 = 15 * MiB;
constexpr size_t WS_W13 = 17 * MiB;
constexpr size_t WS_W2 = 49 * MiB;
constexpr size_t WS_X1B = 65 * MiB;
constexpr size_t WS_X1F8 = 97 * MiB;
constexpr size_t WS_XB = 113 * MiB;
constexpr size_t WS_P = 145 * MiB;
constexpr size_t WS_Y = 193 * MiB;
constexpr size_t WS_H = 113 * MiB;
constexpr size_t WS_CB = 133 * MiB;
constexpr size_t WS_END = 225 * MiB;
constexpr int CW_TMO = 0, CW_CODE = 1, CW_BAR = 4096, CW_GCNT = 16384;

constexpr int RING_OFF = 0, RING_BYTES = 131072;
constexpr int LDSCTL_OFF = RING_BYTES, MISC_OFF = LDSCTL_OFF + 320;
constexpr int LDS_BYTES = 147456;

#define RLX_AGENT __ATOMIC_RELAXED, __HIP_MEMORY_SCOPE_AGENT
#define LDS_WAIT() asm volatile("s_waitcnt lgkmcnt(0)" ::: "memory")
#define VM_WAIT() asm volatile("s_waitcnt vmcnt(0)" ::: "memory")
__device__ __forceinline__ unsigned f2bf(float f) { unsigned u = __builtin_bit_cast(unsigned, f); return (u + 0x7fffu + ((u >> 16) & 1u)) >> 16; }
__device__ __forceinline__ unsigned pk2(float lo, float hi) { return f2bf(lo) | (f2bf(hi) << 16); }
__device__ __forceinline__ unsigned cvt_pk_bf16(float lo, float hi) { unsigned r; asm volatile("v_cvt_pk_bf16_f32 %0, %1, %2" : "=v"(r) : "v"(lo), "v"(hi)); return r; }
__device__ __forceinline__ unsigned pk4_fp8(float a, float b, float c, float d) { int w = 0; w = __builtin_amdgcn_cvt_pk_fp8_f32(a, b, w, false); w = __builtin_amdgcn_cvt_pk_fp8_f32(c, d, w, true); return (unsigned)w; }
__device__ __forceinline__ float bflo(unsigned v) { return __builtin_bit_cast(float, v << 16); }
__device__ __forceinline__ float bfhi(unsigned v) { return __builtin_bit_cast(float, v & 0xffff0000u); }
__device__ __forceinline__ float fast_sigmoid(float v) { return __builtin_amdgcn_rcpf(1.0f + __expf(-v)); }
__device__ __forceinline__ int lane_id() { unsigned m = ~0u; asm volatile("" : "+s"(m)); return (int)__builtin_amdgcn_mbcnt_hi(m, __builtin_amdgcn_mbcnt_lo(m, 0u)); }
__device__ __forceinline__ float wave_sum(float v) {
#pragma unroll
    for (int o = 1; o < 64; o <<= 1) v += __shfl_xor(v, o);
    return v;
}

namespace pg8 {
constexpr int BM = 256, BK = 64, HALF = 128, HTB = HALF * BK * 2, STAGE_BYTES = 8 * HTB, NXCD = 8, WGM = 8;
__host__ __device__ __forceinline__ int lds_byte(int r, int c) { const int st = (r >> 4) * 2 + (c >> 5), rr = r & 15, cc = c & 31, ob = rr * 64 + cc * 2; return st * 1024 + (ob ^ (((ob >> 9) & 1) << 5)); }
__host__ __device__ __forceinline__ void stage_rc(int b, int& R, int& C) { const int st = b / 1024, sb = b % 1024, swz = sb ^ (((sb >> 9) & 1) << 5); R = (st >> 1) * 16 + swz / 64; C = (st & 1) * 32 + (swz % 64) / 2; }
__host__ __device__ __forceinline__ int perm32(int rho) { const int n = rho >> 4, i = rho & 15; return 8 * (i >> 2) + 4 * n + (i & 3); }

struct Unit { int pm, pn, e, rt, cnt; };

__device__ __forceinline__ bool tile_order(int i, int G, int c, int nM, int nN, int& pm, int& pn) {
    const int nwg = nM * nN; const int L = i * G + c; if (L >= nwg) return false;
    int wgid = L; { const int q = nwg / NXCD, r = nwg % NXCD, xcd = wgid % NXCD, off = wgid / NXCD; wgid = (xcd < r ? xcd * (q + 1) : r * (q + 1) + (xcd - r) * q) + off; }
    const int nig = WGM * nN, gid = wgid / nig, fm = gid * WGM, gsz = (nM - fm) < WGM ? (nM - fm) : WGM;
    pm = fm + ((wgid % nig) % gsz); pn = (wgid % nig) / gsz; return true;
}

struct SchedDense {
    static constexpr bool GATHER = false;
    const char* A; const char* Bt; int nM, nN, G, c; size_t tstepA; int nkt;
    __device__ __forceinline__ bool next(int i, Unit& u) const { u.e = 0; u.rt = 0; u.cnt = 0; return tile_order(i, G, c, nM, nN, u.pm, u.pn); }
    __device__ __forceinline__ const char* a_buf() const { return A; }
    __device__ __forceinline__ const char* b_buf() const { return Bt; }
    __device__ __forceinline__ unsigned a_soff(const Unit& u) const { return (unsigned)u.pm * (unsigned)tstepA; }
    __device__ __forceinline__ unsigned b_soff(const Unit& u) const { return (unsigned)(u.pn * nkt) * 32768u; }
    __device__ __forceinline__ void a_tokens(const Unit&, int, unsigned (&)[2]) const {}
};
struct SchedMoe {
    const char* A; const char* W; const unsigned* ltok; const LAS int* tab; int total_rt, G, c; size_t a_tile_bytes, w_exp_bytes; int nkt;
    __device__ __forceinline__ bool next(int i, Unit& u) const {
        if (!tile_order(i, G, c, total_rt, 4, u.pm, u.pn)) return false;
        const int lane = lane_id();
        const unsigned long long m = __ballot(lane < 32 && tab[lane & 31] <= u.pm);
        const int e = __builtin_amdgcn_readfirstlane(__popcll(m) - 1);
        u.e = e; u.rt = u.pm - __builtin_amdgcn_readfirstlane(tab[e]); u.cnt = __builtin_amdgcn_readfirstlane(tab[32 + e]); return true;
    }
    __device__ __forceinline__ const char* a_buf() const { return A; }
    __device__ __forceinline__ const char* b_buf() const { return W; }
    __device__ __forceinline__ unsigned b_soff(const Unit& u) const { return (unsigned)u.e * (unsigned)w_exp_bytes + (unsigned)(u.pn * nkt) * 32768u; }
};
struct SchedMoeA : SchedMoe {
    static constexpr bool GATHER = true;
    __device__ __forceinline__ unsigned a_soff(const Unit&) const { return 0u; }
    __device__ __forceinline__ void a_tokens(const Unit& u, int R, unsigned (&tk)[2]) const {
        asm volatile("" : "+v"(R));
        const __amdgpu_buffer_rsrc_t rl = __builtin_amdgcn_make_buffer_rsrc((void*)ltok, 0, NE * CAP * 4, 0x00020000);
#pragma unroll
        for (int h = 0; h < 2; ++h) { const int p0 = u.rt * 256 + 128 * h + R, p1 = p0 + 64;
            const unsigned r0 = (unsigned)__builtin_amdgcn_raw_buffer_load_b32(rl, p0 < u.cnt ? (u.e * CAP + p0) * 4 : 0x7ffffff0, 0, 0);
            const unsigned r1 = (unsigned)__builtin_amdgcn_raw_buffer_load_b32(rl, p1 < u.cnt ? (u.e * CAP + p1) * 4 : 0x7ffffff0, 0, 0);
            tk[h] = (r0 & 0x3fffu) | ((r1 & 0x3fffu) << 16); }
    }
};
struct SchedMoeB : SchedMoe {
    static constexpr bool GATHER = false;
    __device__ __forceinline__ unsigned a_soff(const Unit& u) const { return (unsigned)u.pm * (unsigned)a_tile_bytes; }
    __device__ __forceinline__ void a_tokens(const Unit&, int, unsigned (&)[2]) const {}
};

struct EpiP1 {
    bf16* P;
    __device__ __forceinline__ void operator()(const f32x4 (&acc)[2][2][4][2], const Unit& u, int wr, int wc, int fr, int fq) const {
        asm volatile("" : "+v"(fr), "+v"(fq));
        const int row0 = u.pm * BM + wr * 64 + fr, cl = wc * 32 + 8 * fq;
        if (u.pn >= 4 && u.pn < 6) {
#pragma unroll
            for (int ai = 0; ai < 2; ++ai)
#pragma unroll
                for (int m = 0; m < 4; ++m) { bf16* rowp = P + (size_t)(row0 + ai * HALF + m * 16) * PW + 512 + (u.pn - 4) * 256 + cl;
#pragma unroll
                    for (int bj = 0; bj < 2; ++bj) { const f32x4 v0 = acc[ai][bj][m][0], v1 = acc[ai][bj][m][1];
                        u32x4 w; w.x = cvt_pk_bf16(v0[0], v0[1]); w.y = cvt_pk_bf16(v0[2], v0[3]); w.z = cvt_pk_bf16(v1[0], v1[1]); w.w = cvt_pk_bf16(v1[2], v1[3]);
                        *(u32x4*)(rowp + bj * HALF) = w; } }
        } else if (u.pn < 4) {
#pragma unroll
            for (int ai = 0; ai < 2; ++ai)
#pragma unroll
                for (int m = 0; m < 4; ++m) { bf16* rowp = P + (size_t)(row0 + ai * HALF + m * 16) * PW + u.pn * 128 + cl;
                    const f32x4 v0 = acc[ai][0][m][0] * acc[ai][1][m][0], v1 = acc[ai][0][m][1] * acc[ai][1][m][1];
                    u32x4 w; w.x = cvt_pk_bf16(v0[0], v0[1]); w.y = cvt_pk_bf16(v0[2], v0[3]); w.z = cvt_pk_bf16(v1[0], v1[1]); w.w = cvt_pk_bf16(v1[2], v1[3]);
                    *(u32x4*)rowp = w; }
        } else {
#pragma unroll
            for (int ai = 0; ai < 2; ++ai)
#pragma unroll
                for (int m = 0; m < 4; ++m) { bf16* rowp = P + (size_t)(row0 + ai * HALF + m * 16) * PW + 1024 + (u.pn - 6) * 128 + cl;
                    f32x4 v0, v1;
#pragma unroll
                    for (int j = 0; j < 4; ++j) { v0[j] = acc[ai][0][m][0][j] * fast_sigmoid(acc[ai][1][m][0][j]); v1[j] = acc[ai][0][m][1][j] * fast_sigmoid(acc[ai][1][m][1][j]); }
                    u32x4 w; w.x = cvt_pk_bf16(v0[0], v0[1]); w.y = cvt_pk_bf16(v0[2], v0[3]); w.z = cvt_pk_bf16(v1[0], v1[1]); w.w = cvt_pk_bf16(v1[2], v1[3]);
                    *(u32x4*)rowp = w; }
        }
    }
};
struct EpiX1 {
    const bf16* xb; const float* ri; bf16* x1b; float* ssq;
    __device__ __forceinline__ void operator()(const f32x4 (&acc)[2][2][4][2], const Unit& u, int wr, int wc, int fr, int fq) const {
        asm volatile("" : "+v"(fr), "+v"(fq));
        const int row0 = u.pm * BM + wr * 64 + fr, col0 = u.pn * BM + wc * 64 + 16 * fq;
#pragma unroll
        for (int ai = 0; ai < 2; ++ai)
#pragma unroll
            for (int m = 0; m < 4; ++m) { const int row = row0 + ai * HALF + m * 16; const bf16* xr = xb + (size_t)row * D + col0; const float rinv = ri[row]; bf16* orow = x1b + (size_t)row * D + col0; float s = 0.f;
#pragma unroll
                for (int bj = 0; bj < 2; ++bj) { const u32x4 xq = *(const u32x4*)(xr + bj * 8);
                    const f32x4 a = (f32x4){bflo(xq[0]), bfhi(xq[0]), bflo(xq[1]), bfhi(xq[1])} * rinv, b = (f32x4){bflo(xq[2]), bfhi(xq[2]), bflo(xq[3]), bfhi(xq[3])} * rinv;
                    const f32x4 v0 = acc[ai][bj][m][0] + a, v1 = acc[ai][bj][m][1] + b;
                    s += (v0[0] * v0[0] + v0[1] * v0[1]) + (v0[2] * v0[2] + v0[3] * v0[3]) + (v1[0] * v1[0] + v1[1] * v1[1]) + (v1[2] * v1[2] + v1[3] * v1[3]);
                    u32x4 w; w.x = cvt_pk_bf16(v0[0], v0[1]); w.y = cvt_pk_bf16(v0[2], v0[3]); w.z = cvt_pk_bf16(v1[0], v1[1]); w.w = cvt_pk_bf16(v1[2], v1[3]);
                    *(u32x4*)(orow + bj * 8) = w; }
                s += __shfl_xor(s, 16); s += __shfl_xor(s, 32);
                if (fq == 0) ssq[(size_t)(u.pn * 4 + wc) * T + row] = s; }
    }
};
struct EpiH {
    fp8* H;
    __device__ __forceinline__ void operator()(const f32x4 (&acc)[2][2][4][2], const Unit& u, int wr, int wc, int fr, int fq) const {
        asm volatile("" : "+v"(fr), "+v"(fq));
        const int cl = u.pn * 128 + wc * 32 + 8 * fq;
#pragma unroll
        for (int ai = 0; ai < 2; ++ai)
#pragma unroll
            for (int m = 0; m < 4; ++m) { const int rl = ai * HALF + wr * 64 + m * 16 + fr; const float rr = 1.0f / 32.0f;
                f32x4 v0, v1;
#pragma unroll
                for (int j = 0; j < 4; ++j) { const float a0 = acc[ai][0][m][0][j] * rr, b0 = acc[ai][1][m][0][j] * rr, a1 = acc[ai][0][m][1][j] * rr, b1 = acc[ai][1][m][1][j] * rr;
                    v0[j] = a0 * fast_sigmoid(a0) * b0; v1[j] = a1 * fast_sigmoid(a1) * b1; }
                u32x2 w; w.x = pk4_fp8(v0[0], v0[1], v0[2], v0[3]); w.y = pk4_fp8(v1[0], v1[1], v1[2], v1[3]);
                *(u32x2*)(H + ((size_t)u.pm * 256 + rl) * DE + cl) = w; }
    }
};
struct EpiC {
    fp8* Cb; const unsigned* ltok;
    __device__ __forceinline__ void operator()(const f32x4 (&acc)[2][2][4][2], const Unit& u, int wr, int wc, int fr, int fq) const {
        asm volatile("" : "+v"(fr), "+v"(fq));
        const int cl = u.pn * 256 + wc * 64 + 16 * fq;
#pragma unroll
        for (int ai = 0; ai < 2; ++ai)
#pragma unroll
            for (int m = 0; m < 4; ++m) { const int rl = ai * HALF + wr * 64 + m * 16 + fr, pos = u.rt * 256 + rl;
                if (pos < u.cnt) { const unsigned rec = ltok[(size_t)u.e * CAP + pos]; const float cw = bfhi(rec) * 4.0f;
                    fp8* orow = Cb + ((size_t)((rec >> 14) & 1u) * T + (rec & 0x3fffu)) * D + cl;
                    const f32x4 v0 = acc[ai][0][m][0] * cw, v1 = acc[ai][0][m][1] * cw, v2 = acc[ai][1][m][0] * cw, v3 = acc[ai][1][m][1] * cw;
                    u32x4 w; w.x = pk4_fp8(v0[0], v0[1], v0[2], v0[3]); w.y = pk4_fp8(v1[0], v1[1], v1[2], v1[3]); w.z = pk4_fp8(v2[0], v2[1], v2[2], v2[3]); w.w = pk4_fp8(v3[0], v3[1], v3[2], v3[3]);
                    *(u32x4*)orow = w; } }
    }
};

template <class Epi, class Sched, bool F8>
__device__ __forceinline__ void gemm_phase(LAS unsigned char* lds, const int Kb, const Sched& S, const Epi& E, const int wid) {
    constexpr bool GATHER = Sched::GATHER;
    const int lane = lane_id(), tid = wid * 64 + lane, wr = wid >> 2, wc = wid & 3, fr = lane & 15, fq = lane >> 4;
    int nt = Kb / 128; asm volatile("" : "+s"(nt));
    const unsigned kstep = 128u, hstep = (unsigned)(HALF * Kb);
    const unsigned kstepB = 32768u, hstepB = 2048u;
    const __amdgpu_buffer_rsrc_t rsA = __builtin_amdgcn_make_buffer_rsrc((void*)S.a_buf(), 0, 0x7fffffff, 0x00020000);
    const __amdgpu_buffer_rsrc_t rsB = __builtin_amdgcn_make_buffer_rsrc((void*)S.b_buf(), 0, 0x7fffffff, 0x00020000);
    unsigned voffA[2], voffB[2], ct[2] = {0u, 0u}, ntk[2] = {0u, 0u}; unsigned pc2;
    { int R, C; stage_rc(tid * 16, R, C); pc2 = (unsigned)C * 2u; }
#define PG8_R0() ({ int _t = wid * 64 + lane_id(); asm volatile("" : "+v"(_t)); int _R, _C; stage_rc(_t * 16, _R, _C); _R; })
#pragma unroll
    for (int i = 0; i < 2; ++i) { int R, C; stage_rc(tid * 16 + i * 8192, R, C);
        voffA[i] = (unsigned)(R * Kb) + (unsigned)C * 2u;
        const int st = wid + 8 * i; voffB[i] = (unsigned)((((st & 1) * 4 + (lane >> 4)) * 256) + (st >> 1) * 16 + (lane & 15)) * 16u; }
    const unsigned ldsw = (unsigned)wid * 1024u;
    const int aoff = lds_byte(wr * 64 + fr, fq * 8), boff = wc * 4096 + (fq * 16 + fr) * 16;
    const LAS unsigned char* ldsA = lds + aoff; const LAS unsigned char* ldsB = lds + 4 * HTB + boff;
    asm volatile("" : "+v"(ldsA), "+v"(ldsB));
#define PG8_SA(b, h) (((b) * 2 + (h)) * HTB)
#define PG8_SB(b, h) ((4 + (b) * 2 + (h)) * HTB)
#define PG8_STAGE(bufoff, soff, voff) do { _Pragma("unroll") for (int _i = 0; _i < 2; ++_i) \
        __builtin_amdgcn_raw_ptr_buffer_load_lds(rsB, (LAS void*)(lds + (bufoff) + ldsw + _i * 8192), 16, (int)(voff)[_i], (int)(soff), 0, 0); } while (0)
#define PG8_STAGE_A(bufoff, soff, h, TK) do { _Pragma("unroll") for (int _i = 0; _i < 2; ++_i) { \
        const unsigned _o = GATHER ? ((((TK)[h] >> (16 * _i)) & 0xffffu) * (unsigned)Kb + pc2) : voffA[_i]; const unsigned _so = GATHER ? (unsigned)(soff) : (unsigned)(soff) + (h) * hstep; \
        __builtin_amdgcn_raw_ptr_buffer_load_lds(rsA, (LAS void*)(lds + (bufoff) + ldsw + _i * 8192), 16, (int)_o, (int)_so, 0, 0); } } while (0)
#define PG8_LDA(dst, b, h) do { _Pragma("unroll") for (int m = 0; m < 4; ++m) { if constexpr (F8) { const i32x4 _lo = *(const LAS i32x4*)(ldsA + PG8_SA(b, h) + m * 2048), _hi = *(const LAS i32x4*)(ldsA + PG8_SA(b, h) + m * 2048 + 1024); \
            dst##8[m] = __builtin_shufflevector(_lo, _hi, 0, 1, 2, 3, 4, 5, 6, 7); } else { _Pragma("unroll") for (int k = 0; k < 2; ++k) dst[m][k] = *(const LAS bf16x8*)(ldsA + PG8_SA(b, h) + m * 2048 + k * 1024); } } } while (0)
#define PG8_LDB(dst, b, h) do { _Pragma("unroll") for (int n = 0; n < 2; ++n) { if constexpr (F8) { const i32x4 _lo = *(const LAS i32x4*)(ldsB + (PG8_SB(b, h) - 4 * HTB) + n * 2048), _hi = *(const LAS i32x4*)(ldsB + (PG8_SB(b, h) - 4 * HTB) + n * 2048 + 1024); \
            dst##8[n] = __builtin_shufflevector(_lo, _hi, 0, 1, 2, 3, 4, 5, 6, 7); } else { _Pragma("unroll") for (int k = 0; k < 2; ++k) dst[n][k] = *(const LAS bf16x8*)(ldsB + (PG8_SB(b, h) - 4 * HTB) + n * 2048 + k * 1024); } } } while (0)
#define PG8_MMA(ai, bj, At, Bt) do { __builtin_amdgcn_s_setprio(1); _Pragma("unroll") for (int m = 0; m < 4; ++m) _Pragma("unroll") for (int n = 0; n < 2; ++n) { \
        if constexpr (F8) acc[ai][bj][m][n] = __builtin_amdgcn_mfma_scale_f32_16x16x128_f8f6f4(Bt##8[n], At##8[m], acc[ai][bj][m][n], 0, 0, 0, 0x7F7F7F7F, 0, 0x7F7F7F7F); \
        else { _Pragma("unroll") for (int k = 0; k < 2; ++k) acc[ai][bj][m][n] = __builtin_amdgcn_mfma_f32_16x16x32_bf16(Bt[n][k], At[m][k], acc[ai][bj][m][n], 0, 0, 0); } } \
        __builtin_amdgcn_s_setprio(0); } while (0)
#define PG8_WAIT_V(n) asm volatile("s_waitcnt vmcnt(" #n ")" ::: "memory")
#define PG8_WAIT_L(n) asm volatile("s_waitcnt lgkmcnt(" #n ")" ::: "memory")
#define PG8_BAR __builtin_amdgcn_s_barrier()
#define PG8_SCHED __builtin_amdgcn_sched_barrier(0)
    Unit cur, nxt; int ui = 0;
    if (!S.next(0, cur)) return;
    f32x4 acc[2][2][4][2];
#pragma unroll
    for (int a = 0; a < 2; ++a)
#pragma unroll
        for (int b = 0; b < 2; ++b)
#pragma unroll
            for (int m = 0; m < 4; ++m)
#pragma unroll
                for (int n = 0; n < 2; ++n) acc[a][b][m][n] = (f32x4){0.f, 0.f, 0.f, 0.f};
    bf16x8 At[4][2], B0[2][2], B1[2][2]; i32x8 At8[4], B08[2], B18[2];
    unsigned cA = S.a_soff(cur), cB = S.b_soff(cur);
    if constexpr (GATHER) { S.a_tokens(cur, PG8_R0(), ct); asm volatile("" : "+v"(ct[0]), "+v"(ct[1])); }
    PG8_STAGE(PG8_SB(0, 0), cB, voffB); PG8_STAGE(PG8_SB(0, 1), cB + hstepB, voffB); PG8_STAGE_A(PG8_SA(0, 0), cA, 0, ct); PG8_STAGE_A(PG8_SA(0, 1), cA, 1, ct);
    if (wr == 1) PG8_BAR;
    PG8_WAIT_V(2); PG8_BAR;
    PG8_STAGE(PG8_SB(1, 0), cB + kstepB, voffB); PG8_STAGE_A(PG8_SA(1, 0), cA + kstep, 0, ct); PG8_STAGE(PG8_SB(1, 1), cB + hstepB + kstepB, voffB);
    PG8_WAIT_V(6); PG8_BAR;
    for (;;) {
        const bool has_next = S.next(ui + 1, nxt);
        unsigned nA = cA, nB = cB;
        if constexpr (GATHER) { ntk[0] = ct[0]; ntk[1] = ct[1]; }
        if (has_next) { nA = S.a_soff(nxt); nB = S.b_soff(nxt);
            if constexpr (GATHER) { S.a_tokens(nxt, PG8_R0(), ntk); asm volatile("" : "+v"(ntk[0]), "+v"(ntk[1])); } }
#pragma unroll 1
        for (int t = 0; t < nt; t += 2) {
            const bool last = (t == nt - 2);
            const unsigned a1 = cA + (unsigned)(t + 1) * kstep;
            const unsigned a2 = last ? nA : cA + (unsigned)(t + 2) * kstep, b2 = last ? nB : cB + (unsigned)(t + 2) * kstepB;
            const unsigned a3 = a2 + kstep, b3 = b2 + kstepB;
            unsigned tc[2] = {ct[0], ct[1]}, t2[2];
            if constexpr (GATHER) asm volatile("" : "+v"(tc[0]), "+v"(tc[1]));
            t2[0] = (GATHER && last) ? ntk[0] : tc[0]; t2[1] = (GATHER && last) ? ntk[1] : tc[1];
            PG8_LDB(B0, 0, 0); PG8_LDB(B1, 0, 1); PG8_SCHED; PG8_LDA(At, 0, 0); PG8_STAGE_A(PG8_SA(1, 1), a1, 1, tc);
            PG8_WAIT_V(8); PG8_WAIT_L(0); PG8_BAR; PG8_MMA(0, 0, At, B0); PG8_MMA(0, 1, At, B1); PG8_BAR; PG8_SCHED;
            PG8_LDA(At, 0, 1); PG8_STAGE(PG8_SB(0, 0), b2, voffB); PG8_STAGE(PG8_SB(0, 1), b2 + hstepB, voffB); PG8_STAGE_A(PG8_SA(0, 0), a2, 0, t2);
            PG8_WAIT_V(8); PG8_WAIT_L(0); PG8_BAR; PG8_MMA(1, 0, At, B0); PG8_MMA(1, 1, At, B1); PG8_BAR; PG8_SCHED;
            PG8_LDB(B0, 1, 0); PG8_LDB(B1, 1, 1); PG8_SCHED; PG8_LDA(At, 1, 0); PG8_STAGE_A(PG8_SA(0, 1), a2, 1, t2);
            PG8_WAIT_V(8); PG8_WAIT_L(0); PG8_BAR; PG8_MMA(0, 0, At, B0); PG8_MMA(0, 1, At, B1); PG8_BAR; PG8_SCHED;
            PG8_LDA(At, 1, 1); PG8_STAGE(PG8_SB(1, 0), b3, voffB); PG8_STAGE(PG8_SB(1, 1), b3 + hstepB, voffB); PG8_STAGE_A(PG8_SA(1, 0), a3, 0, t2);
            PG8_WAIT_V(8); PG8_WAIT_L(0); PG8_BAR; PG8_MMA(1, 0, At, B0); PG8_MMA(1, 1, At, B1); PG8_BAR; PG8_SCHED;
        }
        if (wr == 0) PG8_BAR;
        { int _l = lane_id(); asm volatile("" : "+v"(_l)); E(acc, cur, wr, wc, _l & 15, (_l >> 4) & 3); }
        if (!has_next) break;
#pragma unroll
        for (int a = 0; a < 2; ++a)
#pragma unroll
            for (int b = 0; b < 2; ++b)
#pragma unroll
                for (int m = 0; m < 4; ++m)
#pragma unroll
                    for (int n = 0; n < 2; ++n) acc[a][b][m][n] = (f32x4){0.f, 0.f, 0.f, 0.f};
        cur = nxt; cA = nA; cB = nB; ++ui;
        if constexpr (GATHER) { ct[0] = ntk[0]; ct[1] = ntk[1]; }
        if (wr == 1) PG8_BAR;
    }
    PG8_WAIT_V(0);
    PG8_BAR;
#undef PG8_SA
#undef PG8_SB
#undef PG8_STAGE
#undef PG8_STAGE_A
#undef PG8_R0
#undef PG8_LDA
#undef PG8_LDB
#undef PG8_MMA
#undef PG8_WAIT_V
#undef PG8_WAIT_L
#undef PG8_BAR
#undef PG8_SCHED
}
}

#define XB_TMO      128
#define XB_XCNT(j)  (256  + 64 * (j))
#define XB_XSUB(j)  (1280 + 64 * (j))
#define XB_XGEN(j)  (2304 + 64 * (j))
#define XB_TOP      3328
#define XB_TOPGEN   3392
#define XCD_BAR_WORDS 3456
#define XB_SPIN_CAP (1u << 18)
__device__ __forceinline__ unsigned xb_ld(unsigned* p)              { return __hip_atomic_load(p, __ATOMIC_RELAXED, __HIP_MEMORY_SCOPE_AGENT); }
__device__ __forceinline__ unsigned xb_add(unsigned* p, unsigned v) { return __hip_atomic_fetch_add(p, v, __ATOMIC_RELAXED, __HIP_MEMORY_SCOPE_AGENT); }
__device__ __forceinline__ unsigned xb_xcc_id() { return (unsigned)__builtin_amdgcn_s_getreg((3 << 11) | 20) & 0xFu; }
#define XB_SPIN(cond, bar) do { unsigned _sp = 0; while (cond) { __builtin_amdgcn_s_sleep(1); \
    if ((++_sp & 255u) == 0u) { if (xb_ld(&(bar)[XB_TMO])) break; if (_sp > XB_SPIN_CAP) { atomicAdd(&(bar)[XB_TMO], 1u); break; } } } } while (0)
struct XcdBarrier { unsigned* bar; unsigned x; volatile LAS unsigned* st; int wave; };
__device__ __forceinline__ XcdBarrier xcd_barrier_post(unsigned* bar, volatile LAS unsigned* st, int wave) {
    XcdBarrier b; b.bar = bar; b.x = xb_xcc_id(); b.st = st; b.wave = wave;
    if (wave == 0 && lane_id() == 0) (void)xb_add(&bar[XB_XCNT(b.x)], 1u);
    return b;
}
__device__ __forceinline__ void xcd_barrier_complete(unsigned* bar, unsigned x, unsigned& nloc, unsigned& nx) {
    const unsigned G = gridDim.x * gridDim.y * gridDim.z;
    unsigned sum, cnt, mine, sp = 0u;
    for (;;) {
        sum = 0u; cnt = 0u; mine = 0u;
#pragma unroll
        for (unsigned j = 0; j < 16; ++j) { const unsigned c = xb_ld(&bar[XB_XCNT(j)]); sum += c; cnt += (c > 0u) ? 1u : 0u; mine = (j == x) ? c : mine; }
        if (sum == G) break;
        __builtin_amdgcn_s_sleep(1);
        if ((++sp & 255u) == 0u) { if (xb_ld(&bar[XB_TMO])) break; if (sp > XB_SPIN_CAP) { atomicAdd(&bar[XB_TMO], 1u); break; } }
    }
    nloc = mine > 0u ? mine : 1u; nx = cnt > 0u ? cnt : 1u;
}
__device__ __forceinline__ void xcd_barrier_leader(const XcdBarrier& b) {
    {
        unsigned* bar = b.bar;
        __builtin_amdgcn_s_waitcnt(0);
        unsigned nloc = b.st[0], nx = b.st[1];
        if (nloc == 0u) { xcd_barrier_complete(bar, b.x, nloc, nx); b.st[0] = nloc; b.st[1] = nx; }
        const unsigned old = xb_add(&bar[XB_XSUB(b.x)], 1u);
        const unsigned gen = old / nloc;
        if (old + 1u == (gen + 1u) * nloc) {
            __builtin_amdgcn_fence(__ATOMIC_RELEASE, "agent");
            asm volatile("s_waitcnt vmcnt(0)" ::: "memory");
            const unsigned og = xb_add(&bar[XB_TOP], 1u);
            const unsigned tg = og / nx;
            if (og + 1u == (tg + 1u) * nx) xb_add(&bar[XB_TOPGEN], 1u);
            else XB_SPIN(xb_ld(&bar[XB_TOPGEN]) == tg, bar);
            __builtin_amdgcn_fence(__ATOMIC_ACQUIRE, "agent");
            xb_add(&bar[XB_XGEN(b.x)], 1u);
            asm volatile("s_waitcnt vmcnt(0)" ::: "memory");
        } else {
            XB_SPIN(xb_ld(&bar[XB_XGEN(b.x)]) == gen, bar);
            __builtin_amdgcn_fence(__ATOMIC_ACQUIRE, "agent");
            asm volatile("s_waitcnt vmcnt(0)" ::: "memory");
        }
    }
}
__device__ __forceinline__ void xcd_barrier(const XcdBarrier& b) {
    asm volatile("s_waitcnt vmcnt(0)" ::: "memory");
    __syncthreads();
    if (b.wave == 0 && lane_id() == 0) xcd_barrier_leader(b);
    __syncthreads();
}

struct Frame {
    LAS unsigned char* lds;
    volatile LAS unsigned* MISC;
    gu32* ctl;
    int vcu, G, wave;
    const float *x, *norm_mix_g, *w_in, *conv_a_w, *conv_b_w, *conv_b_bias, *ln_b_g, *ln_b_b, *beta_a, *beta_b, *w_out, *norm_ffn_g, *wrg, *brg, *wre, *bre, *w1, *w3, *w2, *gfin;
    float* out;
    bf16 *Win_t, *Wout_t, *Wr_t, *XB, *P, *Y, *X1B; fp8 *W13_t, *W2_t, *H, *X1F8, *CB; float* RI;
    float *SSQ, *LW, *LR2; unsigned* LTOK; unsigned* gcnt;
};

struct CvtItem { const float* src; const float* ks; bf16* dst; int N; bool valid; };
__device__ __forceinline__ void cvt_load(const CvtItem& it, f32x4 (&v)[8]) {
    if (it.valid) {
#pragma unroll
        for (int j = 0; j < 8; ++j) v[j] = __builtin_nontemporal_load((const GAS f32x4*)(it.src + (size_t)j * it.N));
    }
}
__device__ __forceinline__ void cvt_store(const CvtItem& it, f32x4 (&v)[8]) {
    if (it.valid) {
        if (it.ks) {
#pragma unroll
            for (int j = 0; j < 8; ++j) v[j] = v[j] * it.ks[j];
        }
#pragma unroll
        for (int c = 0; c < 4; ++c) { u32x4 g; g.x = cvt_pk_bf16(v[0][c], v[1][c]); g.y = cvt_pk_bf16(v[2][c], v[3][c]); g.z = cvt_pk_bf16(v[4][c], v[5][c]); g.w = cvt_pk_bf16(v[6][c], v[7][c]);
            *(GAS u32x4*)(it.dst + (size_t)c * 8) = g; }
    }
}
__device__ __forceinline__ int win_dest_row(int n0) {
    if (n0 < 512) return 256 * (n0 >> 7) + (n0 & 127);
    if (n0 < 1024) return n0 + 512;
    if (n0 < 1536) { const int j = n0 - 1024; return 256 * (j >> 7) + 128 + (j & 127); }
    if (n0 < 2048) { const int j = n0 - 1536; return 1536 + 256 * (j >> 7) + (j & 127); }
    { const int j = n0 - 2048; return 1536 + 256 * (j >> 7) + 128 + (j & 127); }
}
__device__ __forceinline__ size_t gran_idx(int kb, int drow, int nkt, bool wide = false) { const int w = drow & 31, c = drow & 255;
    const int slot = wide ? 128 * ((c >> 3) & 1) + 32 * (c >> 6) + 16 * ((c >> 2) & 1) + 4 * ((c >> 4) & 3) + (c & 3) : (drow & 224) + 16 * ((w >> 2) & 1) + 4 * (w >> 3) + (w & 3);
    return ((size_t)(((drow >> 8) * nkt + (kb >> 3)) * 8 + (kb & 7)) * 256 + slot); }
constexpr int I_IN = 128 * 10, I_OUT = 128 * 4, NITEMS = I_IN + I_OUT;
constexpr int J_13 = NE * 2 * 64 * 2, J_2 = NE * 32 * 4, NITEMS8 = J_13 + J_2;
__device__ __forceinline__ CvtItem p0_decode(Frame& F, int it, int lane) {
    CvtItem c; c.valid = it < NITEMS; c.src = F.w_in; c.ks = nullptr; c.dst = F.Win_t; c.N = DIN;
    if (!c.valid) return c;
    int r = it;
    if (r < I_IN) { const int kb = r / 10, n = 256 * (r % 10) + 4 * lane;
        c.src = F.w_in + (size_t)(8 * kb) * DIN + n; c.N = DIN; c.ks = F.norm_mix_g + 8 * kb; c.dst = F.Win_t + gran_idx(kb, win_dest_row(n), 16) * 8; return c; }
    r -= I_IN;
    { const int kb = r / 4, n = 256 * (r % 4) + 4 * lane;
        c.src = F.w_out + (size_t)(8 * kb) * D + n; c.N = D; c.ks = (8 * kb < DA) ? F.beta_a + 8 * kb : F.beta_b + (8 * kb - DA); c.dst = F.Wout_t + gran_idx(kb, n, 16, true) * 8; return c; }
}
struct CvtItem8 { const float* src; const float* ks; fp8* dst; int N; float scale; };
__device__ __forceinline__ CvtItem8 p0_decode8(Frame& F, int it, int lane) {
    CvtItem8 c; int r = it;
    if (r < J_13) { const int e = r / 256, rr = r % 256, which = rr / 128, item = rr % 128, kb = item / 2, n = 256 * (item % 2) + 4 * lane;
        c.src = (which ? F.w3 : F.w1) + (size_t)e * D * DE + (size_t)(16 * kb) * DE + n; c.N = DE; c.ks = F.norm_ffn_g + 16 * kb; c.scale = 32.0f;
        c.dst = F.W13_t + (size_t)e * 1024 * D + gran_idx(kb, 256 * (n >> 7) + 128 * which + (n & 127), 8) * 16; return c; }
    r -= J_13;
    { const int e = r / 128, item = r % 128, kb = item / 4, n = 256 * (item % 4) + 4 * lane;
        c.src = F.w2 + (size_t)e * DE * D + (size_t)(16 * kb) * D + n; c.N = D; c.ks = nullptr; c.scale = 16.0f; c.dst = F.W2_t + (size_t)e * 1024 * DE + gran_idx(kb, n, 4, true) * 16; return c; }
}
__device__ __forceinline__ void p0_cvt8_item(Frame& F, int it, int lane) {
    const CvtItem8 c = p0_decode8(F, it, lane);
    f32x4 v[16];
#pragma unroll
    for (int j = 0; j < 16; ++j) v[j] = __builtin_nontemporal_load((const GAS f32x4*)(c.src + (size_t)j * c.N));
#pragma unroll
    for (int j = 0; j < 16; ++j) v[j] = v[j] * (c.ks ? c.ks[j] * c.scale : c.scale);
#pragma unroll
    for (int q = 0; q < 4; ++q) { u32x4 g;
#pragma unroll
        for (int w = 0; w < 4; ++w) g[w] = pk4_fp8(v[4 * w][q], v[4 * w + 1][q], v[4 * w + 2][q], v[4 * w + 3][q]);
        *(GAS u32x4*)(c.dst + (size_t)q * 16) = g; }
}
constexpr int NITEMS8_LATE = 4096;
__device__ __forceinline__ void p1_late_convert(Frame& F) {
    if (F.G != 256 || blockIdx.x < 128) return;
    int lane = lane_id(); asm volatile("" : "+v"(lane));
    const int w0 = ((int)blockIdx.x - 128) * NWAVES + F.wave;
    for (int it = NITEMS8 - NITEMS8_LATE + w0; it < NITEMS8; it += 128 * NWAVES) p0_cvt8_item(F, it, lane);
}
constexpr int W13_P0 = 1024, FILL_PER_BAR = 256 * (NWAVES - 1), N_FILL_BARS = 4;
static_assert(W13_P0 + N_FILL_BARS * FILL_PER_BAR >= J_13, "the barrier fillers must cover every W1/W3 item P0 leaves out");
__device__ __forceinline__ void xcd_barrier_fill(Frame& F, const XcdBarrier& b, int k) {
    asm volatile("s_waitcnt vmcnt(0)" ::: "memory");
    __syncthreads();
    if (b.wave == 0) { if (lane_id() == 0) xcd_barrier_leader(b); }
    else if (k < N_FILL_BARS && F.G == 256) {
        const int it = W13_P0 + k * FILL_PER_BAR + (int)blockIdx.x * (NWAVES - 1) + (b.wave - 1);
        if (it < W13_P0 + (k + 1) * FILL_PER_BAR && it < J_13) { int lane = lane_id(); asm volatile("" : "+v"(lane)); p0_cvt8_item(F, it, lane); }
    }
    __syncthreads();
}
__device__ __forceinline__ void p0_prologue(Frame& F) {
    const int wave = F.wave; int lane = lane_id(); asm volatile("" : "+v"(lane)); const int tid = wave * 64 + lane;
    const int gw = F.vcu * NWAVES + wave, NGW = F.G * NWAVES;
    for (int it = gw; it < NITEMS; it += 2 * NGW) {
        const CvtItem c0 = p0_decode(F, it, lane), c1 = p0_decode(F, it + NGW, lane);
        f32x4 v0[8], v1[8];
        cvt_load(c0, v0); cvt_load(c1, v1);
        cvt_store(c0, v0); cvt_store(c1, v1);
    }
    for (int it = gw; it < ((F.G == 256 && N_LAUNCHES == 1) ? 0 : (F.G == 256 ? J_13 : NITEMS8)); it += NGW) p0_cvt8_item(F, it, lane);
    for (int i = gw * 64 + lane; i < 48 * D; i += NGW * 64) { const int o = i / D, k = i % D; float v = 0.f;
        if (o < 4) v = F.wrg[(size_t)k * 4 + o] * F.norm_ffn_g[k]; else if (o < 36) v = F.wre[(size_t)k * NE + (o - 4)] * F.norm_ffn_g[k];
        F.Wr_t[i] = (bf16)f2bf(v); }
    for (int m = gw; m < T; m += NGW) {
        const GAS f32x4* xr = (const GAS f32x4*)(F.x + (size_t)m * D) + lane;
        f32x4 v[4]; float s = 0.f;
#pragma unroll
        for (int j = 0; j < 4; ++j) { v[j] = __builtin_nontemporal_load(xr + 64 * j); s += (v[j].x * v[j].x + v[j].y * v[j].y) + (v[j].z * v[j].z + v[j].w * v[j].w); }
        const float r = rsqrtf(wave_sum(s) * (1.f / D) + EPS);
        if (lane == 0) F.RI[m] = 1.0f / r;
        GAS u32x2* o8 = (GAS u32x2*)(F.XB + (size_t)m * D) + lane;
#pragma unroll
        for (int j = 0; j < 4; ++j) { u32x2 w; w.x = pk2(v[j].x * r, v[j].y * r); w.y = pk2(v[j].z * r, v[j].w * r); o8[64 * j] = w; }
    }
}

template <int CTRL> __device__ __forceinline__ float dpp_f(float v) { return __builtin_bit_cast(float, __builtin_amdgcn_update_dpp(0, __builtin_bit_cast(int, v), CTRL, 0xf, 0xf, false)); }
#define DPP_XOR1 0xB1
#define DPP_XOR2 0x4E
#define DPP_HALF_MIRROR 0x141
#define DPP_ROW_MIRROR 0x140
__device__ __forceinline__ float sum8(float v) { v += dpp_f<DPP_XOR1>(v); v += dpp_f<DPP_XOR2>(v); v += dpp_f<DPP_HALF_MIRROR>(v); return v; }
__device__ __forceinline__ float sum16(float v) { v = sum8(v); v += dpp_f<DPP_ROW_MIRROR>(v); return v; }
__device__ __forceinline__ void p2_mixer(Frame& F) {
    const int wave = F.wave; int lane = lane_id(); asm volatile("" : "+v"(lane)); const int tid = wave * 64 + lane;
    LAS unsigned char* L = F.lds;
    LAS unsigned* Ut = (LAS unsigned*)L;
    LAS float* UC = (LAS float*)(L + 62 * 1024);
    LAS float* PRM = (LAS float*)(L + LDSCTL_OFF + 2048);
    PRM[tid] = F.ln_b_g[tid]; PRM[512 + tid] = F.ln_b_b[tid];
#pragma unroll
    for (int q = 0; q < 3; ++q) PRM[1024 + 512 * q + tid] = F.conv_a_w[q * DA + tid];
    const int cp = tid & 255, th = tid >> 8;
    f32x2 wb[31];
#pragma unroll
    for (int j = 0; j < 31; ++j) wb[j] = *(const f32x2*)(F.conv_b_w + j * DB + 2 * cp);
    const f32x2 bias2 = *(const f32x2*)(F.conv_b_bias + 2 * cp);
    const int tq = lane >> 4, tl = lane & 15;
    u32x4 ureg[8];
#define P2_ULOAD(tile_) do { const int _t0 = (tile_) * 32, _b = _t0 / SEQ, _s0 = _t0 % SEQ; int _tid = tid; asm volatile("" : "+v"(_tid)); _Pragma("unroll") for (int _i = 0; _i < 8; ++_i) { const int _ch = _tid + 512 * _i, _row = _ch >> 6, _c16 = _ch & 63, _s = _s0 - 15 + _row; \
        ureg[_i] = (u32x4){0u, 0u, 0u, 0u}; if (_ch < 62 * 64 && _s >= 0 && _s < SEQ) ureg[_i] = *(const GAS u32x4*)(F.P + (size_t)(_b * SEQ + _s) * PW + 1024 + _c16 * 8); } } while (0)
    int tile = F.vcu;
    if (tile < T / 32) P2_ULOAD(tile);
    __syncthreads();
    for (; tile < T / 32; tile += F.G) {
        const int t0 = tile * 32, s0 = t0 % SEQ;
        { int tid2 = tid; asm volatile("" : "+v"(tid2));
#pragma unroll
        for (int i = 0; i < 8; ++i) { const int ch = tid2 + 512 * i; if (ch < 62 * 64) *(LAS u32x4*)(L + ch * 16) = ureg[i]; } }
        __syncthreads();
        if (tile + F.G < T / 32) P2_ULOAD(tile + F.G);
#pragma unroll 1
        for (int sub = 0; sub < 2; ++sub) { const int i0 = th * 16 + sub * 8; f32x2 a[8];
#pragma unroll
            for (int i = 0; i < 8; ++i) a[i] = bias2;
#pragma unroll
            for (int w = 0; w < 38; ++w) { const unsigned v = Ut[(i0 + w) * 256 + cp]; const f32x2 x2 = (f32x2){bflo(v), bfhi(v)};
#pragma unroll
                for (int i = 0; i < 8; ++i) { const int j = w - i; if (j >= 0 && j < 31) a[i] = __builtin_elementwise_fma(wb[j], x2, a[i]); } }
#pragma unroll
            for (int i = 0; i < 8; ++i) *(LAS f32x2*)(UC + (i0 + i) * 512 + 2 * cp) = a[i];
        }
        __syncthreads();
        u32x4 gpm1[4], gp0[4], gpp1[4], gab[4];
        { const int i = wave * 4 + tq, s = s0 + i; const bf16* prow = F.P + (size_t)(t0 + i) * PW + 8 * tl; const u32x4 z4 = (u32x4){0u, 0u, 0u, 0u};
#pragma unroll
          for (int k = 0; k < 4; ++k) { const bf16* pk = prow + 128 * k;
            gpm1[k] = (s > 0) ? *(const GAS u32x4*)(pk - PW) : z4; gp0[k] = *(const GAS u32x4*)pk; gpp1[k] = (s < SEQ - 1) ? *(const GAS u32x4*)(pk + PW) : z4; gab[k] = *(const GAS u32x4*)(pk + 512); } }
        { const int i = wave * 4 + tq, t = t0 + i;
          float uv[4][8]; float s1 = 0.f;
#pragma unroll
          for (int k = 0; k < 4; ++k) { const LAS float* up = UC + i * 512 + 8 * (tl + 16 * k); const f32x4 ua = *(const LAS f32x4*)up, ub = *(const LAS f32x4*)(up + 4);
#pragma unroll
            for (int j = 0; j < 4; ++j) { uv[k][j] = ua[j]; uv[k][4 + j] = ub[j]; s1 += ua[j] + ub[j]; } }
          const float mu = sum16(s1) * (1.f / DB); float s2 = 0.f;
#pragma unroll
          for (int k = 0; k < 4; ++k)
#pragma unroll
            for (int j = 0; j < 8; ++j) { uv[k][j] -= mu; s2 += uv[k][j] * uv[k][j]; }
          const float rstd = rsqrtf(sum16(s2) * (1.f / DB) + EPS);
#pragma unroll
          for (int k = 0; k < 4; ++k) { const int c8 = 8 * (tl + 16 * k); const LAS float* gp = PRM + c8; const f32x4 g0 = *(const LAS f32x4*)gp, g1 = *(const LAS f32x4*)(gp + 4), b0 = *(const LAS f32x4*)(gp + 512), b1 = *(const LAS f32x4*)(gp + 516);
            float hb = 0.f;
#pragma unroll
            for (int j = 0; j < 8; ++j) { const float z = uv[k][j] * rstd * (j < 4 ? g0[j & 3] : g1[j & 3]) + (j < 4 ? b0[j & 3] : b1[j & 3]); uv[k][j] = z * fast_sigmoid(z); hb += uv[k][j] * uv[k][j]; }
            const float rb = rsqrtf(sum8(hb) * (1.f / 64.f) + EPS);
            u32x4 ob; ob.x = cvt_pk_bf16(uv[k][0] * rb, uv[k][1] * rb); ob.y = cvt_pk_bf16(uv[k][2] * rb, uv[k][3] * rb); ob.z = cvt_pk_bf16(uv[k][4] * rb, uv[k][5] * rb); ob.w = cvt_pk_bf16(uv[k][6] * rb, uv[k][7] * rb);
            *(GAS u32x4*)(F.Y + (size_t)t * D + DA + c8) = ob; }
#pragma unroll
          for (int k = 0; k < 4; ++k) { const int c8 = 8 * (tl + 16 * k); const LAS float* wp = PRM + 1024 + c8; float ya[8]; float ha = 0.f;
            f32x4 w0[2], w1[2], w2[2];
#pragma unroll
            for (int h = 0; h < 2; ++h) { w0[h] = *(const LAS f32x4*)(wp + 4 * h); w1[h] = *(const LAS f32x4*)(wp + 512 + 4 * h); w2[h] = *(const LAS f32x4*)(wp + 1024 + 4 * h); }
#pragma unroll
            for (int j = 0; j < 4; ++j) { const int h = j >> 1, e = 2 * (j & 1);
                const float c0 = w0[h][e] * bflo(gpm1[k][j]) + w1[h][e] * bflo(gp0[k][j]) + w2[h][e] * bflo(gpp1[k][j]);
                const float c1 = w0[h][e + 1] * bfhi(gpm1[k][j]) + w1[h][e + 1] * bfhi(gp0[k][j]) + w2[h][e + 1] * bfhi(gpp1[k][j]);
                ya[2 * j] = bflo(gab[k][j]) * c0; ya[2 * j + 1] = bfhi(gab[k][j]) * c1; ha += ya[2 * j] * ya[2 * j] + ya[2 * j + 1] * ya[2 * j + 1]; }
            const float ra = rsqrtf(sum8(ha) * (1.f / 64.f) + EPS);
            u32x4 oa; oa.x = cvt_pk_bf16(ya[0] * ra, ya[1] * ra); oa.y = cvt_pk_bf16(ya[2] * ra, ya[3] * ra); oa.z = cvt_pk_bf16(ya[4] * ra, ya[5] * ra); oa.w = cvt_pk_bf16(ya[6] * ra, ya[7] * ra);
            *(GAS u32x4*)(F.Y + (size_t)t * D + c8) = oa; }
        }
    }
#undef P2_ULOAD
    __syncthreads();
}

__device__ __forceinline__ void p4_route(Frame& F) {
    const int wave = F.wave; int lane = lane_id(); asm volatile("" : "+v"(lane)); const int tid = wave * 64 + lane;
    LAS float* LGp = (LAS float*)F.lds;
    LAS int* scnt = (LAS int*)(F.lds + 102400);
    bf16x8 bfr[4][3];
    { const bf16* brow = F.Wr_t + (size_t)(lane & 15) * D + 128 * wave + 8 * (lane >> 4);
#pragma unroll
      for (int ks = 0; ks < 4; ++ks)
#pragma unroll
        for (int nb = 0; nb < 3; ++nb) bfr[ks][nb] = *(const GAS bf16x8*)(brow + (size_t)nb * 16 * D + ks * 32); }
    LAS float* r2s = (LAS float*)(F.lds + 102400 + 512);
    for (int tile = F.vcu; tile < T / 64; tile += F.G) {
        if (tid < 32) scnt[tid] = 0;
        const int tb = tile * 64;
        if (tid < 64) { float ss = 0.f;
#pragma unroll
            for (int s = 0; s < 16; ++s) ss += F.SSQ[(size_t)s * T + tb + tid];
            r2s[tid] = rsqrtf(ss * (1.f / D) + EPS); }
        bf16x8 af[4][4];
#pragma unroll
        for (int tg = 0; tg < 4; ++tg)
#pragma unroll
            for (int ks = 0; ks < 4; ++ks) af[tg][ks] = *(const GAS bf16x8*)(F.X1B + (size_t)(tb + 16 * tg + (lane & 15)) * D + 128 * wave + ks * 32 + 8 * (lane >> 4));
        __syncthreads();
#pragma unroll
        for (int tg = 0; tg < 4; ++tg) { f32x4 acc[3];
#pragma unroll
            for (int nb = 0; nb < 3; ++nb) acc[nb] = (f32x4){0.f, 0.f, 0.f, 0.f};
#pragma unroll
            for (int ks = 0; ks < 4; ++ks)
#pragma unroll
                for (int nb = 0; nb < 3; ++nb) acc[nb] = __builtin_amdgcn_mfma_f32_16x16x32_bf16(af[tg][ks], bfr[ks][nb], acc[nb], 0, 0, 0);
#pragma unroll
            for (int nb = 0; nb < 3; ++nb)
#pragma unroll
                for (int r = 0; r < 4; ++r) LGp[(wave * 64 + 16 * tg + 4 * (lane >> 4) + r) * 49 + nb * 16 + (lane & 15)] = acc[nb][r];
            const float rs = r2s[16 * tg + (lane & 15)];
#pragma unroll
            for (int ks = 0; ks < 4; ++ks) { const u32x4 q = __builtin_bit_cast(u32x4, af[tg][ks]); u32x2 o;
                o.x = pk4_fp8(bflo(q[0]) * rs, bfhi(q[0]) * rs, bflo(q[1]) * rs, bfhi(q[1]) * rs); o.y = pk4_fp8(bflo(q[2]) * rs, bfhi(q[2]) * rs, bflo(q[3]) * rs, bfhi(q[3]) * rs);
                *(GAS u32x2*)(F.X1F8 + (size_t)(tb + 16 * tg + (lane & 15)) * D + 128 * wave + ks * 32 + 8 * (lane >> 4)) = o; } }
        __syncthreads();
        int e0 = 0, e1 = 0, p0 = 0, p1 = 0; float c0 = 0.f, c1 = 0.f;
        if (tid < 64) {
            const float r2 = r2s[tid];
            const LAS float* lg = LGp + tid * 49;
            float g4[4];
#pragma unroll
            for (int i = 0; i < 4; ++i) { float a = 0.f;
#pragma unroll
                for (int w = 0; w < 8; ++w) a += lg[w * 64 * 49 + i];
                g4[i] = a * r2 + F.brg[i]; }
            int g = 0; float m = g4[0];
#pragma unroll
            for (int i = 1; i < 4; ++i) if (g4[i] > m) { m = g4[i]; g = i; }
            float den = 0.f;
#pragma unroll
            for (int i = 0; i < 4; ++i) den += __expf(g4[i] - m);
            const float psel = 1.0f / den;
            int i0 = 0, i1 = -1; float m0 = -3.0e38f, m1 = -3.0e38f;
            for (int i = 0; i < 8; ++i) { float a = 0.f;
#pragma unroll
                for (int w = 0; w < 8; ++w) a += lg[w * 64 * 49 + 4 + g * 8 + i];
                const float v = a * r2 + F.bre[g * 8 + i];
                if (v > m0) { m1 = m0; i1 = i0; m0 = v; i0 = i; } else if (v > m1) { m1 = v; i1 = i; } }
            const float ex = __expf(m1 - m0);
            e0 = g * 8 + i0; e1 = g * 8 + i1; c0 = psel / (1.0f + ex); c1 = psel * ex / (1.0f + ex);
            p0 = __hip_atomic_fetch_add(scnt + e0, 1, __ATOMIC_RELAXED, __HIP_MEMORY_SCOPE_WORKGROUP); p1 = __hip_atomic_fetch_add(scnt + e1, 1, __ATOMIC_RELAXED, __HIP_MEMORY_SCOPE_WORKGROUP);
        } else if (F.G == 256 && N_LAUNCHES == 1 && tile == F.vcu) {
            const int it = (int)blockIdx.x * (NWAVES - 1) + (wave - 1); if (it < W13_P0) p0_cvt8_item(F, it, lane);
        }
        __syncthreads();
        if (tid < 32) scnt[32 + tid] = (int)__hip_atomic_fetch_add(F.gcnt + tid, (unsigned)scnt[tid], RLX_AGENT);
        __syncthreads();
        if (tid < 64) {
            const int t = tb + tid; const size_t d0 = (size_t)e0 * CAP + scnt[32 + e0] + p0, d1 = (size_t)e1 * CAP + scnt[32 + e1] + p1;
            F.LTOK[d0] = (unsigned)t | (f2bf(c0) << 16);
            F.LTOK[d1] = (unsigned)t | (1u << 14) | (f2bf(c1) << 16);
        }
        __syncthreads();
    }
}

__device__ __forceinline__ void p7_final(Frame& F) {
    const int wave = F.wave; int lane = lane_id(); asm volatile("" : "+v"(lane)); const int tid = wave * 64 + lane;
    const int gw = F.vcu * NWAVES + wave, NGW = F.G * NWAVES;
    f32x4 g[2][2];
#pragma unroll
    for (int j = 0; j < 2; ++j) { g[j][0] = *(const f32x4*)(F.gfin + j * 512 + lane * 8); g[j][1] = *(const f32x4*)(F.gfin + j * 512 + lane * 8 + 4); }
    for (int t = gw; t < T; t += NGW) {
        float v[2][8]; float ss = 0.f;
#pragma unroll
        for (int j = 0; j < 2; ++j) { const size_t o = (size_t)t * D + j * 512 + lane * 8;
            const u32x4 a = *(const GAS u32x4*)(F.X1B + o); const u32x2 c0 = *(const GAS u32x2*)(F.CB + o), c1 = *(const GAS u32x2*)(F.CB + (size_t)T * D + o);
#pragma unroll
            for (int q = 0; q < 4; q += 2) { const f32x2 p0 = __builtin_amdgcn_cvt_pk_f32_fp8((int)c0[q >> 1], false), p1 = __builtin_amdgcn_cvt_pk_f32_fp8((int)c1[q >> 1], false),
                                                           p2 = __builtin_amdgcn_cvt_pk_f32_fp8((int)c0[q >> 1], true), p3 = __builtin_amdgcn_cvt_pk_f32_fp8((int)c1[q >> 1], true);
                v[j][2 * q] = bflo(a[q]) + (p0.x + p1.x) * (1.0f / 64.0f); v[j][2 * q + 1] = bfhi(a[q]) + (p0.y + p1.y) * (1.0f / 64.0f);
                v[j][2 * q + 2] = bflo(a[q + 1]) + (p2.x + p3.x) * (1.0f / 64.0f); v[j][2 * q + 3] = bfhi(a[q + 1]) + (p2.y + p3.y) * (1.0f / 64.0f); }
#pragma unroll
            for (int q = 0; q < 8; ++q) ss += v[j][q] * v[j][q]; }
        const float r = rsqrtf(wave_sum(ss) * (1.f / D) + EPS);
#pragma unroll
        for (int j = 0; j < 2; ++j) { float* o = F.out + (size_t)t * D + j * 512 + lane * 8;
            *(GAS f32x4*)o = (f32x4){v[j][0] * r * g[j][0][0], v[j][1] * r * g[j][0][1], v[j][2] * r * g[j][0][2], v[j][3] * r * g[j][0][3]};
            *(GAS f32x4*)(o + 4) = (f32x4){v[j][4] * r * g[j][1][0], v[j][5] * r * g[j][1][1], v[j][6] * r * g[j][1][2], v[j][7] * r * g[j][1][3]}; }
    }
}

__device__ __forceinline__ void moe_sched_init(pg8::SchedMoe& S, Frame& F) {
    int lane = lane_id(); asm volatile("" : "+v"(lane));
    LAS int* tab = (LAS int*)(F.lds + LDSCTL_OFF + 1024);
    int my_cnt = 0; if (lane < NE) my_cnt = (int)__hip_atomic_load(F.gcnt + lane, RLX_AGENT);
    const int tiles = (my_cnt + 255) >> 8; int incl = tiles;
#pragma unroll
    for (int o = 1; o < 32; o <<= 1) { const int v = __shfl_up(incl, o); if (lane >= o) incl += v; }
    if (F.wave == 0 && lane < NE) { tab[lane] = incl - tiles; tab[32 + lane] = my_cnt; }
    S.total_rt = __builtin_amdgcn_readlane(incl, 31); S.tab = tab;
    S.ltok = F.LTOK; S.G = F.G; S.c = (int)blockIdx.x;
    __syncthreads();
}

struct Args { const float* in[20]; float* out; unsigned char* ws; int ph_lo, ph_hi, li, pad; };
__global__ void __launch_bounds__(NWAVES * 64, 2) mk_fwd(Args args) {
    extern __shared__ __attribute__((aligned(16))) unsigned char lds[];
    Frame F;
    F.lds = (LAS unsigned char*)lds;
    F.MISC = (volatile LAS unsigned*)(F.lds + MISC_OFF);
    F.wave = __builtin_amdgcn_readfirstlane((int)threadIdx.x >> 6);
    F.G = gridDim.x; { const int bx = blockIdx.x; F.vcu = (F.G % 8 == 0) ? (bx % 8) * (F.G / 8) + bx / 8 : bx; }
    unsigned char* ws = args.ws;
    F.ctl = (gu32*)(ws + WS_CTL);
    F.x = args.in[0]; F.norm_mix_g = args.in[1]; F.w_in = args.in[2]; F.conv_a_w = args.in[3]; F.conv_b_w = args.in[4]; F.conv_b_bias = args.in[5]; F.ln_b_g = args.in[6]; F.ln_b_b = args.in[7];
    F.beta_a = args.in[8]; F.beta_b = args.in[9]; F.w_out = args.in[10]; F.norm_ffn_g = args.in[11]; F.wrg = args.in[12]; F.brg = args.in[13]; F.wre = args.in[14]; F.bre = args.in[15];
    F.w1 = args.in[16]; F.w3 = args.in[17]; F.w2 = args.in[18]; F.gfin = args.in[19]; F.out = args.out;
    F.Win_t = (bf16*)(ws + WS_WIN); F.Wout_t = (bf16*)(ws + WS_WOUT); F.Wr_t = (bf16*)(ws + WS_WR); F.W13_t = (fp8*)(ws + WS_W13); F.W2_t = (fp8*)(ws + WS_W2); F.X1F8 = (fp8*)(ws + WS_X1F8);
    F.XB = (bf16*)(ws + WS_XB); F.P = (bf16*)(ws + WS_P); F.Y = (bf16*)(ws + WS_Y); F.X1B = (bf16*)(ws + WS_X1B); F.H = (fp8*)(ws + WS_H); F.CB = (fp8*)(ws + WS_CB); F.RI = (float*)(ws + WS_WR + 768 * 1024);
    F.SSQ = (float*)(ws + WS_SSQ); F.LW = (float*)(ws + WS_LW); F.LR2 = (float*)(ws + WS_LR2); F.LTOK = (unsigned*)(ws + WS_LTOK); F.gcnt = (unsigned*)(ws + WS_CTL) + CW_GCNT;
    for (int u = F.wave * 64 + lane_id(); u < (LDS_BYTES - LDSCTL_OFF) / 4; u += NWAVES * 64) ((LAS unsigned*)(F.lds + LDSCTL_OFF))[u] = 0u;
    __syncthreads();
    XcdBarrier bar; bar.bar = (unsigned*)(F.ctl + CW_BAR); bar.x = 0; bar.st = nullptr; bar.wave = F.wave;
    if (N_LAUNCHES == 1) bar = xcd_barrier_post((unsigned*)(F.ctl + CW_BAR), F.MISC + 8, F.wave);
    const int lo = args.ph_lo, hi = args.ph_hi;
#define IN(k) (lo <= (k) && (k) < hi)
#define GRID_BAR(k) do { if (IN(k) && IN((k) + 1)) xcd_barrier_fill(F, bar, (k)); if (PROBE_PHASE >= 0 && blockIdx.x == 0 && F.wave == 0 && lane_id() == 0) ((unsigned long long*)(ws + WS_WR + 512 * 1024))[(k) + 1] = __builtin_amdgcn_s_memrealtime(); } while (0)
    if (PROBE_PHASE >= 0 && blockIdx.x == 0 && F.wave == 0 && lane_id() == 0) ((unsigned long long*)(ws + WS_WR + 512 * 1024))[0] = __builtin_amdgcn_s_memrealtime();

    if (IN(0)) { p0_prologue(F); GRID_BAR(0); }
    if (IN(1)) {
        pg8::SchedDense S{(const char*)F.XB, (const char*)F.Win_t, T / 256, DIN / 256, F.G, (int)blockIdx.x, (size_t)256 * D * 2, 16};
        pg8::EpiP1 E{F.P};
        pg8::gemm_phase<pg8::EpiP1, pg8::SchedDense, false>(F.lds + RING_OFF, D * 2, S, E, F.wave);
        p1_late_convert(F);
        GRID_BAR(1);
    }
    if (IN(2)) { p2_mixer(F); GRID_BAR(2); }
    if (IN(3)) {
        pg8::SchedDense S{(const char*)F.Y, (const char*)F.Wout_t, T / 256, D / 256, F.G, (int)blockIdx.x, (size_t)256 * D * 2, 16};
        pg8::EpiX1 E{F.XB, F.RI, F.X1B, F.SSQ};
        pg8::gemm_phase<pg8::EpiX1, pg8::SchedDense, false>(F.lds + RING_OFF, D * 2, S, E, F.wave);
        GRID_BAR(3);
    }
    if (IN(4)) { p4_route(F); GRID_BAR(4); }
    if (IN(5)) {
        pg8::SchedMoeA S; moe_sched_init(S, F); S.A = (const char*)F.X1F8; S.W = (const char*)F.W13_t; S.a_tile_bytes = 0; S.w_exp_bytes = (size_t)1024 * D; S.nkt = 8;
        pg8::EpiH E{F.H};
        pg8::gemm_phase<pg8::EpiH, pg8::SchedMoeA, true>(F.lds + RING_OFF, D, S, E, F.wave);
        GRID_BAR(5);
    }
    if (IN(6)) {
        pg8::SchedMoeB S; moe_sched_init(S, F); S.A = (const char*)F.H; S.W = (const char*)F.W2_t; S.a_tile_bytes = (size_t)256 * DE; S.w_exp_bytes = (size_t)1024 * DE; S.nkt = 4;
        pg8::EpiC E{F.CB, F.LTOK};
        pg8::gemm_phase<pg8::EpiC, pg8::SchedMoeB, true>(F.lds + RING_OFF, DE, S, E, F.wave);
        GRID_BAR(6);
    }
    if (IN(7)) { p7_final(F);
        if (PROBE_PHASE >= 0 && blockIdx.x == 0 && F.wave == 0 && lane_id() == 0) { unsigned long long* ts = (unsigned long long*)(ws + WS_WR + 512 * 1024); ts[8] = __builtin_amdgcn_s_memrealtime();
            asm volatile("s_waitcnt vmcnt(0)" ::: "memory"); const float us = (PROBE_PHASE == 8) ? (float)(ts[8] - ts[0]) * 0.001f : (float)(ts[PROBE_PHASE + 1] - ts[PROBE_PHASE]) * 0.01f; F.out[0] += us * 0.1f; } }
#undef IN
#undef GRID_BAR
}

extern "C" void kernel_launch(void* const* d_in, const int* in_sizes, int n_in, void* d_out, int out_size, void* d_ws, size_t ws_size, hipStream_t stream) {
    static int grid = 0;
    if (grid == 0) {
        if (n_in != 20 || in_sizes[0] != T * D || out_size != T * D || ws_size < WS_END) { fprintf(stderr, "kernel_launch: unexpected shapes / workspace (n_in %d, in0 %d, out %d, ws %zu, need %zu)\n", n_in, n_in > 0 ? in_sizes[0] : -1, out_size, ws_size, (size_t)WS_END); grid = -1; return; }
        int dev = 0, cus = 0, per_cu = 0;
        if (hipGetDevice(&dev) != hipSuccess || hipDeviceGetAttribute(&cus, hipDeviceAttributeMultiprocessorCount, dev) != hipSuccess) { fprintf(stderr, "kernel_launch: device query failed\n"); grid = -1; return; }
        if (hipFuncSetAttribute((const void*)mk_fwd, hipFuncAttributeMaxDynamicSharedMemorySize, LDS_BYTES) != hipSuccess) { fprintf(stderr, "kernel_launch: hipFuncSetAttribute failed\n"); grid = -1; return; }
        if (hipOccupancyMaxActiveBlocksPerMultiprocessor(&per_cu, (const void*)mk_fwd, NWAVES * 64, LDS_BYTES) != hipSuccess || per_cu < 1) fprintf(stderr, "kernel_launch: occupancy query reports %d workgroups per CU\n", per_cu);
        (void)hipGetLastError();
        grid = cus;
    }
    if (grid < 0) return;
    if (hipMemsetAsync((char*)d_ws + WS_CTL, 0, CTL_ZERO_BYTES, stream) != hipSuccess) { fprintf(stderr, "kernel_launch: hipMemsetAsync failed\n"); return; }
    Args a{};
    for (int i = 0; i < 20; ++i) a.in[i] = (const float*)d_in[i];
    a.out = (float*)d_out; a.ws = (unsigned char*)d_ws;
    for (int li = 0; li < N_LAUNCHES; ++li) {
        a.ph_lo = (N_LAUNCHES == 1) ? 0 : li; a.ph_hi = (N_LAUNCHES == 1) ? NPHASES : li + 1; a.li = li;
        hipLaunchKernelGGL(mk_fwd, dim3(grid), dim3(NWAVES * 64), LDS_BYTES, stream, a);
        const hipError_t le = hipPeekAtLastError();
        if (le != hipSuccess) { fprintf(stderr, "kernel_launch: launch %d failed: %s\n", li, hipGetErrorName(le)); break; }
    }
}
```

```cpp
#include <hip/hip_runtime.h>
#include <cstdio>
#include <cstdint>

#define LAS __attribute__((address_space(3)))
#define GAS __attribute__((address_space(1)))
typedef unsigned short bf16;
typedef short bf16x8 __attribute__((ext_vector_type(8)));
typedef float f32x4 __attribute__((ext_vector_type(4)));
typedef float f32x2 __attribute__((ext_vector_type(2)));
typedef unsigned u32x4 __attribute__((ext_vector_type(4)));
typedef unsigned u32x2 __attribute__((ext_vector_type(2)));
typedef GAS unsigned gu32;
typedef int i32x4 __attribute__((ext_vector_type(4)));
typedef int i32x8 __attribute__((ext_vector_type(8)));
typedef unsigned char fp8;

constexpr int T = 16384, SEQ = 2048, D = 1024, DA = 512, DB = 512, DIN = 2560, NE = 32, DE = 512, CAP = 16384, PW = 1536;
constexpr float EPS = 1e-6f;
constexpr int NWAVES = 8;
#ifndef MK_N_LAUNCHES
#define MK_N_LAUNCHES 1
#endif
constexpr int N_LAUNCHES = MK_N_LAUNCHES;
constexpr int NPHASES = 8;
#ifndef PROBE_PHASE
#define PROBE_PHASE -1
#endif

constexpr size_t MiB = 1u << 20;
constexpr size_t WS_CTL = 0, CTL_ZERO_BYTES = 72 * 1024;
constexpr size_t WS_WIN = 1 * MiB;
constexpr size_t WS_WOUT = 6 * MiB;
constexpr size_t WS_WR = 8 * MiB;
constexpr size_t WS_SSQ = 9 * MiB;
constexpr size_t WS_LTOK = 11 * MiB;
constexpr size_t WS_LW = 13 * MiB;
constexpr size_t WS_LR2 = 15 * MiB;
constexpr size_t WS_W13 = 17 * MiB;
constexpr size_t WS_W2 = 49 * MiB;
constexpr size_t WS_X1B = 65 * MiB;
constexpr size_t WS_X1F8 = 97 * MiB;
constexpr size_t WS_XB = 113 * MiB;
constexpr size_t WS_P = 145 * MiB;
constexpr size_t WS_Y = 193 * MiB;
constexpr size_t WS_H = 113 * MiB;
constexpr size_t WS_CB = 133 * MiB;
constexpr size_t WS_END = 225 * MiB;
constexpr int CW_TMO = 0, CW_CODE = 1, CW_BAR = 4096, CW_GCNT = 16384;

constexpr int RING_OFF = 0, RING_BYTES = 131072;
constexpr int LDSCTL_OFF = RING_BYTES, MISC_OFF = LDSCTL_OFF + 320;
constexpr int LDS_BYTES = 147456;

#define RLX_AGENT __ATOMIC_RELAXED, __HIP_MEMORY_SCOPE_AGENT
#define LDS_WAIT() asm volatile("s_waitcnt lgkmcnt(0)" ::: "memory")
#define VM_WAIT() asm volatile("s_waitcnt vmcnt(0)" ::: "memory")
__device__ __forceinline__ unsigned f2bf(float f) { unsigned u = __builtin_bit_cast(unsigned, f); return (u + 0x7fffu + ((u >> 16) & 1u)) >> 16; }
__device__ __forceinline__ unsigned pk2(float lo, float hi) { return f2bf(lo) | (f2bf(hi) << 16); }
__device__ __forceinline__ unsigned cvt_pk_bf16(float lo, float hi) { unsigned r; asm volatile("v_cvt_pk_bf16_f32 %0, %1, %2" : "=v"(r) : "v"(lo), "v"(hi)); return r; }
__device__ __forceinline__ unsigned pk4_fp8(float a, float b, float c, float d) { int w = 0; w = __builtin_amdgcn_cvt_pk_fp8_f32(a, b, w, false); w = __builtin_amdgcn_cvt_pk_fp8_f32(c, d, w, true); return (unsigned)w; }
__device__ __forceinline__ float bflo(unsigned v) { return __builtin_bit_cast(float, v << 16); }
__device__ __forceinline__ float bfhi(unsigned v) { return __builtin_bit_cast(float, v & 0xffff0000u); }
__device__ __forceinline__ float fast_sigmoid(float v) { return __builtin_amdgcn_rcpf(1.0f + __expf(-v)); }
__device__ __forceinline__ int lane_id() { unsigned m = ~0u; asm volatile("" : "+s"(m)); return (int)__builtin_amdgcn_mbcnt_hi(m, __builtin_amdgcn_mbcnt_lo(m, 0u)); }
__device__ __forceinline__ float wave_sum(float v) {
#pragma unroll
    for (int o = 1; o < 64; o <<= 1) v += __shfl_xor(v, o);
    return v;
}

namespace pg8 {
constexpr int BM = 256, BK = 64, HALF = 128, HTB = HALF * BK * 2, STAGE_BYTES = 8 * HTB, NXCD = 8, WGM = 8;
__host__ __device__ __forceinline__ int lds_byte(int r, int c) { const int st = (r >> 4) * 2 + (c >> 5), rr = r & 15, cc = c & 31, ob = rr * 64 + cc * 2; return st * 1024 + (ob ^ (((ob >> 9) & 1) << 5)); }
__host__ __device__ __forceinline__ void stage_rc(int b, int& R, int& C) { const int st = b / 1024, sb = b % 1024, swz = sb ^ (((sb >> 9) & 1) << 5); R = (st >> 1) * 16 + swz / 64; C = (st & 1) * 32 + (swz % 64) / 2; }
__host__ __device__ __forceinline__ int perm32(int rho) { const int n = rho >> 4, i = rho & 15; return 8 * (i >> 2) + 4 * n + (i & 3); }

struct Unit { int pm, pn, e, rt, cnt; };

__device__ __forceinline__ bool tile_order(int i, int G, int c, int nM, int nN, int& pm, int& pn) {
    const int nwg = nM * nN; const int L = i * G + c; if (L >= nwg) return false;
    int wgid = L; { const int q = nwg / NXCD, r = nwg % NXCD, xcd = wgid % NXCD, off = wgid / NXCD; wgid = (xcd < r ? xcd * (q + 1) : r * (q + 1) + (xcd - r) * q) + off; }
    const int nig = WGM * nN, gid = wgid / nig, fm = gid * WGM, gsz = (nM - fm) < WGM ? (nM - fm) : WGM;
    pm = fm + ((wgid % nig) % gsz); pn = (wgid % nig) / gsz; return true;
}

struct SchedDense {
    static constexpr bool GATHER = false;
    const char* A; const char* Bt; int nM, nN, G, c; size_t tstepA; int nkt;
    __device__ __forceinline__ bool next(int i, Unit& u) const { u.e = 0; u.rt = 0; u.cnt = 0; return tile_order(i, G, c, nM, nN, u.pm, u.pn); }
    __device__ __forceinline__ const char* a_buf() const { return A; }
    __device__ __forceinline__ const char* b_buf() const { return Bt; }
    __device__ __forceinline__ unsigned a_soff(const Unit& u) const { return (unsigned)u.pm * (unsigned)tstepA; }
    __device__ __forceinline__ unsigned b_soff(const Unit& u) const { return (unsigned)(u.pn * nkt) * 32768u; }
    __device__ __forceinline__ void a_tokens(const Unit&, int, unsigned (&)[2]) const {}
};
struct SchedMoe {
    const char* A; const char* W; const unsigned* ltok; const LAS int* tab; int total_rt, G, c; size_t a_tile_bytes, w_exp_bytes; int nkt;
    __device__ __forceinline__ bool next(int i, Unit& u) const {
        if (!tile_order(i, G, c, total_rt, 4, u.pm, u.pn)) return false;
        const int lane = lane_id();
        const unsigned long long m = __ballot(lane < 32 && tab[lane & 31] <= u.pm);
        const int e = __builtin_amdgcn_readfirstlane(__popcll(m) - 1);
        u.e = e; u.rt = u.pm - __builtin_amdgcn_readfirstlane(tab[e]); u.cnt = __builtin_amdgcn_readfirstlane(tab[32 + e]); return true;
    }
    __device__ __forceinline__ const char* a_buf() const { return A; }
    __device__ __forceinline__ const char* b_buf() const { return W; }
    __device__ __forceinline__ unsigned b_soff(const Unit& u) const { return (unsigned)u.e * (unsigned)w_exp_bytes + (unsigned)(u.pn * nkt) * 32768u; }
};
struct SchedMoeA : SchedMoe {
    static constexpr bool GATHER = true;
    __device__ __forceinline__ unsigned a_soff(const Unit&) const { return 0u; }
    __device__ __forceinline__ void a_tokens(const Unit& u, int R, unsigned (&tk)[2]) const {
        asm volatile("" : "+v"(R));
        const __amdgpu_buffer_rsrc_t rl = __builtin_amdgcn_make_buffer_rsrc((void*)ltok, 0, NE * CAP * 4, 0x00020000);
#pragma unroll
        for (int h = 0; h < 2; ++h) { const int p0 = u.rt * 256 + 128 * h + R, p1 = p0 + 64;
            const unsigned r0 = (unsigned)__builtin_amdgcn_raw_buffer_load_b32(rl, p0 < u.cnt ? (u.e * CAP + p0) * 4 : 0x7ffffff0, 0, 0);
            const unsigned r1 = (unsigned)__builtin_amdgcn_raw_buffer_load_b32(rl, p1 < u.cnt ? (u.e * CAP + p1) * 4 : 0x7ffffff0, 0, 0);
            tk[h] = (r0 & 0x3fffu) | ((r1 & 0x3fffu) << 16); }
    }
};
struct SchedMoeB : SchedMoe {
    static constexpr bool GATHER = false;
    __device__ __forceinline__ unsigned a_soff(const Unit& u) const { return (unsigned)u.pm * (unsigned)a_tile_bytes; }
    __device__ __forceinline__ void a_tokens(const Unit&, int, unsigned (&)[2]) const {}
};

struct EpiP1 {
    bf16* P;
    __device__ __forceinline__ void operator()(const f32x4 (&acc)[2][2][4][2], const Unit& u, int wr, int wc, int fr, int fq) const {
        asm volatile("" : "+v"(fr), "+v"(fq));
        const int row0 = u.pm * BM + wr * 64 + fr, cl = wc * 32 + 8 * fq;
        if (u.pn >= 4 && u.pn < 6) {
#pragma unroll
            for (int ai = 0; ai < 2; ++ai)
#pragma unroll
                for (int m = 0; m < 4; ++m) { bf16* rowp = P + (size_t)(row0 + ai * HALF + m * 16) * PW + 512 + (u.pn - 4) * 256 + cl;
#pragma unroll
                    for (int bj = 0; bj < 2; ++bj) { const f32x4 v0 = acc[ai][bj][m][0], v1 = acc[ai][bj][m][1];
                        u32x4 w; w.x = cvt_pk_bf16(v0[0], v0[1]); w.y = cvt_pk_bf16(v0[2], v0[3]); w.z = cvt_pk_bf16(v1[0], v1[1]); w.w = cvt_pk_bf16(v1[2], v1[3]);
                        *(u32x4*)(rowp + bj * HALF) = w; } }
        } else if (u.pn < 4) {
#pragma unroll
            for (int ai = 0; ai < 2; ++ai)
#pragma unroll
                for (int m = 0; m < 4; ++m) { bf16* rowp = P + (size_t)(row0 + ai * HALF + m * 16) * PW + u.pn * 128 + cl;
                    const f32x4 v0 = acc[ai][0][m][0] * acc[ai][1][m][0], v1 = acc[ai][0][m][1] * acc[ai][1][m][1];
                    u32x4 w; w.x = cvt_pk_bf16(v0[0], v0[1]); w.y = cvt_pk_bf16(v0[2], v0[3]); w.z = cvt_pk_bf16(v1[0], v1[1]); w.w = cvt_pk_bf16(v1[2], v1[3]);
                    *(u32x4*)rowp = w; }
        } else {
#pragma unroll
            for (int ai = 0; ai < 2; ++ai)
#pragma unroll
                for (int m = 0; m < 4; ++m) { bf16* rowp = P + (size_t)(row0 + ai * HALF + m * 16) * PW + 1024 + (u.pn - 6) * 128 + cl;
                    f32x4 v0, v1;
#pragma unroll
                    for (int j = 0; j < 4; ++j) { v0[j] = acc[ai][0][m][0][j] * fast_sigmoid(acc[ai][1][m][0][j]); v1[j] = acc[ai][0][m][1][j] * fast_sigmoid(acc[ai][1][m][1][j]); }
                    u32x4 w; w.x = cvt_pk_bf16(v0[0], v0[1]); w.y = cvt_pk_bf16(v0[2], v0[3]); w.z = cvt_pk_bf16(v1[0], v1[1]); w.w = cvt_pk_bf16(v1[2], v1[3]);
                    *(u32x4*)rowp = w; }
        }
    }
};
struct EpiX1 {
    const bf16* xb; const float* ri; bf16* x1b; float* ssq;
    __device__ __forceinline__ void operator()(const f32x4 (&acc)[2][2][4][2], const Unit& u, int wr, int wc, int fr, int fq) const {
        asm volatile("" : "+v"(fr), "+v"(fq));
        const int row0 = u.pm * BM + wr * 64 + fr, col0 = u.pn * BM + wc * 64 + 16 * fq;
        u32x4 xq2[2][4][2]; float rv[2][4];
#pragma unroll
        for (int ai = 0; ai < 2; ++ai)
#pragma unroll
            for (int m = 0; m < 4; ++m) { const int row = row0 + ai * HALF + m * 16; const bf16* xr = xb + (size_t)row * D + col0; rv[ai][m] = ri[row];
#pragma unroll
                for (int bj = 0; bj < 2; ++bj) xq2[ai][m][bj] = *(const u32x4*)(xr + bj * 8); }
#pragma unroll
        for (int ai = 0; ai < 2; ++ai)
#pragma unroll
            for (int m = 0; m < 4; ++m) { const int row = row0 + ai * HALF + m * 16; const float rinv = rv[ai][m]; bf16* orow = x1b + (size_t)row * D + col0; float s = 0.f;
#pragma unroll
                for (int bj = 0; bj < 2; ++bj) { const u32x4 xq = xq2[ai][m][bj];
                    const f32x4 a = (f32x4){bflo(xq[0]), bfhi(xq[0]), bflo(xq[1]), bfhi(xq[1])} * rinv, b = (f32x4){bflo(xq[2]), bfhi(xq[2]), bflo(xq[3]), bfhi(xq[3])} * rinv;
                    const f32x4 v0 = acc[ai][bj][m][0] + a, v1 = acc[ai][bj][m][1] + b;
                    s += (v0[0] * v0[0] + v0[1] * v0[1]) + (v0[2] * v0[2] + v0[3] * v0[3]) + (v1[0] * v1[0] + v1[1] * v1[1]) + (v1[2] * v1[2] + v1[3] * v1[3]);
                    u32x4 w; w.x = cvt_pk_bf16(v0[0], v0[1]); w.y = cvt_pk_bf16(v0[2], v0[3]); w.z = cvt_pk_bf16(v1[0], v1[1]); w.w = cvt_pk_bf16(v1[2], v1[3]);
                    *(u32x4*)(orow + bj * 8) = w; }
                s += __shfl_xor(s, 16); s += __shfl_xor(s, 32);
                if (fq == 0) ssq[(size_t)(u.pn * 4 + wc) * T + row] = s; }
    }
};
struct EpiH {
    fp8* H;
    __device__ __forceinline__ void operator()(const f32x4 (&acc)[2][2][4][2], const Unit& u, int wr, int wc, int fr, int fq) const {
        asm volatile("" : "+v"(fr), "+v"(fq));
        const int cl = u.pn * 128 + wc * 32 + 8 * fq;
#pragma unroll
        for (int ai = 0; ai < 2; ++ai)
#pragma unroll
            for (int m = 0; m < 4; ++m) { const int rl = ai * HALF + wr * 64 + m * 16 + fr; const float rr = 1.0f / 32.0f;
                f32x4 v0, v1;
#pragma unroll
                for (int j = 0; j < 4; ++j) { const float a0 = acc[ai][0][m][0][j] * rr, b0 = acc[ai][1][m][0][j] * rr, a1 = acc[ai][0][m][1][j] * rr, b1 = acc[ai][1][m][1][j] * rr;
                    v0[j] = a0 * fast_sigmoid(a0) * b0; v1[j] = a1 * fast_sigmoid(a1) * b1; }
                u32x2 w; w.x = pk4_fp8(v0[0], v0[1], v0[2], v0[3]); w.y = pk4_fp8(v1[0], v1[1], v1[2], v1[3]);
                *(u32x2*)(H + ((size_t)u.pm * 256 + rl) * DE + cl) = w; }
    }
};
struct EpiC {
    fp8* Cb; const unsigned* ltok;
    __device__ __forceinline__ void operator()(const f32x4 (&acc)[2][2][4][2], const Unit& u, int wr, int wc, int fr, int fq) const {
        asm volatile("" : "+v"(fr), "+v"(fq));
        const int cl = u.pn * 256 + wc * 64 + 16 * fq;
        unsigned recs[2][4];
#pragma unroll
        for (int ai = 0; ai < 2; ++ai)
#pragma unroll
            for (int m = 0; m < 4; ++m) { const int pos = u.rt * 256 + ai * HALF + wr * 64 + m * 16 + fr; recs[ai][m] = ltok[(size_t)u.e * CAP + (pos < u.cnt ? pos : 0)]; }
#pragma unroll
        for (int ai = 0; ai < 2; ++ai)
#pragma unroll
            for (int m = 0; m < 4; ++m) { const int rl = ai * HALF + wr * 64 + m * 16 + fr, pos = u.rt * 256 + rl;
                if (pos < u.cnt) { const unsigned rec = recs[ai][m]; const float cw = bfhi(rec) * 4.0f;
                    fp8* orow = Cb + ((size_t)((rec >> 14) & 1u) * T + (rec & 0x3fffu)) * D + cl;
                    const f32x4 v0 = acc[ai][0][m][0] * cw, v1 = acc[ai][0][m][1] * cw, v2 = acc[ai][1][m][0] * cw, v3 = acc[ai][1][m][1] * cw;
                    u32x4 w; w.x = pk4_fp8(v0[0], v0[1], v0[2], v0[3]); w.y = pk4_fp8(v1[0], v1[1], v1[2], v1[3]); w.z = pk4_fp8(v2[0], v2[1], v2[2], v2[3]); w.w = pk4_fp8(v3[0], v3[1], v3[2], v3[3]);
                    *(u32x4*)orow = w; } }
    }
};

template <class Epi, class Sched, bool F8>
__device__ __forceinline__ void gemm_phase(LAS unsigned char* lds, const int Kb, const Sched& S, const Epi& E, const int wid) {
    constexpr bool GATHER = Sched::GATHER;
    const int lane = lane_id(), tid = wid * 64 + lane, wr = wid >> 2, wc = wid & 3, fr = lane & 15, fq = lane >> 4;
    int nt = Kb / 128; asm volatile("" : "+s"(nt));
    const unsigned kstep = 128u, hstep = (unsigned)(HALF * Kb);
    const unsigned kstepB = 32768u, hstepB = 2048u;
    const __amdgpu_buffer_rsrc_t rsA = __builtin_amdgcn_make_buffer_rsrc((void*)S.a_buf(), 0, 0x7fffffff, 0x00020000);
    const __amdgpu_buffer_rsrc_t rsB = __builtin_amdgcn_make_buffer_rsrc((void*)S.b_buf(), 0, 0x7fffffff, 0x00020000);
    unsigned voffA[2], voffB[2], ct[2] = {0u, 0u}, ntk[2] = {0u, 0u}; unsigned pc2;
    { int R, C; stage_rc(tid * 16, R, C); pc2 = (unsigned)C * 2u; }
#define PG8_R0() ({ int _t = wid * 64 + lane_id(); asm volatile("" : "+v"(_t)); int _R, _C; stage_rc(_t * 16, _R, _C); _R; })
#pragma unroll
    for (int i = 0; i < 2; ++i) { int R, C; stage_rc(tid * 16 + i * 8192, R, C);
        voffA[i] = (unsigned)(R * Kb) + (unsigned)C * 2u;
        const int st = wid + 8 * i; voffB[i] = (unsigned)((((st & 1) * 4 + (lane >> 4)) * 256) + (st >> 1) * 16 + (lane & 15)) * 16u; }
    const unsigned ldsw = (unsigned)wid * 1024u;
    const int aoff = lds_byte(wr * 64 + fr, fq * 8), boff = wc * 4096 + (fq * 16 + fr) * 16;
    const LAS unsigned char* ldsA = lds + aoff; const LAS unsigned char* ldsB = lds + 4 * HTB + boff;
    asm volatile("" : "+v"(ldsA), "+v"(ldsB));
#define PG8_SA(b, h) (((b) * 2 + (h)) * HTB)
#define PG8_SB(b, h) ((4 + (b) * 2 + (h)) * HTB)
#define PG8_STAGE(bufoff, soff, voff) do { _Pragma("unroll") for (int _i = 0; _i < 2; ++_i) \
        __builtin_amdgcn_raw_ptr_buffer_load_lds(rsB, (LAS void*)(lds + (bufoff) + ldsw + _i * 8192), 16, (int)(voff)[_i], (int)(soff), 0, 0); } while (0)
#define PG8_STAGE_A(bufoff, soff, h, TK) do { _Pragma("unroll") for (int _i = 0; _i < 2; ++_i) { \
        const unsigned _o = GATHER ? ((((TK)[h] >> (16 * _i)) & 0xffffu) * (unsigned)Kb + pc2) : voffA[_i]; const unsigned _so = GATHER ? (unsigned)(soff) : (unsigned)(soff) + (h) * hstep; \
        __builtin_amdgcn_raw_ptr_buffer_load_lds(rsA, (LAS void*)(lds + (bufoff) + ldsw + _i * 8192), 16, (int)_o, (int)_so, 0, 0); } } while (0)
#define PG8_LDA(dst, b, h) do { _Pragma("unroll") for (int m = 0; m < 4; ++m) { if constexpr (F8) { const i32x4 _lo = *(const LAS i32x4*)(ldsA + PG8_SA(b, h) + m * 2048), _hi = *(const LAS i32x4*)(ldsA + PG8_SA(b, h) + m * 2048 + 1024); \
            dst##8[m] = __builtin_shufflevector(_lo, _hi, 0, 1, 2, 3, 4, 5, 6, 7); } else { _Pragma("unroll") for (int k = 0; k < 2; ++k) dst[m][k] = *(const LAS bf16x8*)(ldsA + PG8_SA(b, h) + m * 2048 + k * 1024); } } } while (0)
#define PG8_LDB(dst, b, h) do { _Pragma("unroll") for (int n = 0; n < 2; ++n) { if constexpr (F8) { const i32x4 _lo = *(const LAS i32x4*)(ldsB + (PG8_SB(b, h) - 4 * HTB) + n * 2048), _hi = *(const LAS i32x4*)(ldsB + (PG8_SB(b, h) - 4 * HTB) + n * 2048 + 1024); \
            dst##8[n] = __builtin_shufflevector(_lo, _hi, 0, 1, 2, 3, 4, 5, 6, 7); } else { _Pragma("unroll") for (int k = 0; k < 2; ++k) dst[n][k] = *(const LAS bf16x8*)(ldsB + (PG8_SB(b, h) - 4 * HTB) + n * 2048 + k * 1024); } } } while (0)
#define PG8_MMA(ai, bj, At, Bt) do { __builtin_amdgcn_s_setprio(1); _Pragma("unroll") for (int m = 0; m < 4; ++m) _Pragma("unroll") for (int n = 0; n < 2; ++n) { \
        if constexpr (F8) acc[ai][bj][m][n] = __builtin_amdgcn_mfma_scale_f32_16x16x128_f8f6f4(Bt##8[n], At##8[m], acc[ai][bj][m][n], 0, 0, 0, 0x7F7F7F7F, 0, 0x7F7F7F7F); \
        else { _Pragma("unroll") for (int k = 0; k < 2; ++k) acc[ai][bj][m][n] = __builtin_amdgcn_mfma_f32_16x16x32_bf16(Bt[n][k], At[m][k], acc[ai][bj][m][n], 0, 0, 0); } } \
        __builtin_amdgcn_s_setprio(0); } while (0)
#define PG8_WAIT_V(n) asm volatile("s_waitcnt vmcnt(" #n ")" ::: "memory")
#define PG8_WAIT_L(n) asm volatile("s_waitcnt lgkmcnt(" #n ")" ::: "memory")
#define PG8_BAR __builtin_amdgcn_s_barrier()
#define PG8_SCHED __builtin_amdgcn_sched_barrier(0)
    Unit cur, nxt; int ui = 0;
    if (!S.next(0, cur)) return;
    f32x4 acc[2][2][4][2];
#pragma unroll
    for (int a = 0; a < 2; ++a)
#pragma unroll
        for (int b = 0; b < 2; ++b)
#pragma unroll
            for (int m = 0; m < 4; ++m)
#pragma unroll
                for (int n = 0; n < 2; ++n) acc[a][b][m][n] = (f32x4){0.f, 0.f, 0.f, 0.f};
    bf16x8 At[4][2], B0[2][2], B1[2][2]; i32x8 At8[4], B08[2], B18[2];
    unsigned cA = S.a_soff(cur), cB = S.b_soff(cur);
    if constexpr (GATHER) { S.a_tokens(cur, PG8_R0(), ct); asm volatile("" : "+v"(ct[0]), "+v"(ct[1])); }
    PG8_STAGE(PG8_SB(0, 0), cB, voffB); PG8_STAGE(PG8_SB(0, 1), cB + hstepB, voffB); PG8_STAGE_A(PG8_SA(0, 0), cA, 0, ct); PG8_STAGE_A(PG8_SA(0, 1), cA, 1, ct);
    if (wr == 1) PG8_BAR;
    PG8_WAIT_V(2); PG8_BAR;
    PG8_STAGE(PG8_SB(1, 0), cB + kstepB, voffB); PG8_STAGE_A(PG8_SA(1, 0), cA + kstep, 0, ct); PG8_STAGE(PG8_SB(1, 1), cB + hstepB + kstepB, voffB);
    PG8_WAIT_V(6); PG8_BAR;
    for (;;) {
        const bool has_next = S.next(ui + 1, nxt);
        unsigned nA = cA, nB = cB;
        if constexpr (GATHER) { ntk[0] = ct[0]; ntk[1] = ct[1]; }
        if (has_next) { nA = S.a_soff(nxt); nB = S.b_soff(nxt);
            if constexpr (GATHER) { S.a_tokens(nxt, PG8_R0(), ntk); asm volatile("" : "+v"(ntk[0]), "+v"(ntk[1])); } }
#pragma unroll 1
        for (int t = 0; t < nt; t += 2) {
            const bool last = (t == nt - 2);
            const unsigned a1 = cA + (unsigned)(t + 1) * kstep;
            const unsigned a2 = last ? nA : cA + (unsigned)(t + 2) * kstep, b2 = last ? nB : cB + (unsigned)(t + 2) * kstepB;
            const unsigned a3 = a2 + kstep, b3 = b2 + kstepB;
            unsigned tc[2] = {ct[0], ct[1]}, t2[2];
            if constexpr (GATHER) asm volatile("" : "+v"(tc[0]), "+v"(tc[1]));
            t2[0] = (GATHER && last) ? ntk[0] : tc[0]; t2[1] = (GATHER && last) ? ntk[1] : tc[1];
            PG8_LDB(B0, 0, 0); PG8_LDB(B1, 0, 1); PG8_SCHED; PG8_LDA(At, 0, 0); PG8_STAGE_A(PG8_SA(1, 1), a1, 1, tc);
            PG8_WAIT_V(8); PG8_WAIT_L(0); PG8_BAR; PG8_MMA(0, 0, At, B0); PG8_MMA(0, 1, At, B1); PG8_BAR; PG8_SCHED;
            PG8_LDA(At, 0, 1); PG8_STAGE(PG8_SB(0, 0), b2, voffB); PG8_STAGE(PG8_SB(0, 1), b2 + hstepB, voffB); PG8_STAGE_A(PG8_SA(0, 0), a2, 0, t2);
            PG8_WAIT_V(8); PG8_WAIT_L(0); PG8_BAR; PG8_MMA(1, 0, At, B0); PG8_MMA(1, 1, At, B1); PG8_BAR; PG8_SCHED;
            PG8_LDB(B0, 1, 0); PG8_LDB(B1, 1, 1); PG8_SCHED; PG8_LDA(At, 1, 0); PG8_STAGE_A(PG8_SA(0, 1), a2, 1, t2);
            PG8_WAIT_V(8); PG8_WAIT_L(0); PG8_BAR; PG8_MMA(0, 0, At, B0); PG8_MMA(0, 1, At, B1); PG8_BAR; PG8_SCHED;
            PG8_LDA(At, 1, 1); PG8_STAGE(PG8_SB(1, 0), b3, voffB); PG8_STAGE(PG8_SB(1, 1), b3 + hstepB, voffB); PG8_STAGE_A(PG8_SA(1, 0), a3, 0, t2);
            PG8_WAIT_V(8); PG8_WAIT_L(0); PG8_BAR; PG8_MMA(1, 0, At, B0); PG8_MMA(1, 1, At, B1); PG8_BAR; PG8_SCHED;
        }
        if (wr == 0) PG8_BAR;
        { int _l = lane_id(); asm volatile("" : "+v"(_l)); E(acc, cur, wr, wc, _l & 15, (_l >> 4) & 3); }
        if (!has_next) break;
#pragma unroll
        for (int a = 0; a < 2; ++a)
#pragma unroll
            for (int b = 0; b < 2; ++b)
#pragma unroll
                for (int m = 0; m < 4; ++m)
#pragma unroll
                    for (int n = 0; n < 2; ++n) acc[a][b][m][n] = (f32x4){0.f, 0.f, 0.f, 0.f};
        cur = nxt; cA = nA; cB = nB; ++ui;
        if constexpr (GATHER) { ct[0] = ntk[0]; ct[1] = ntk[1]; }
        if (wr == 1) PG8_BAR;
    }
    PG8_WAIT_V(0);
    PG8_BAR;
#undef PG8_SA
#undef PG8_SB
#undef PG8_STAGE
#undef PG8_STAGE_A
#undef PG8_R0
#undef PG8_LDA
#undef PG8_LDB
#undef PG8_MMA
#undef PG8_WAIT_V
#undef PG8_WAIT_L
#undef PG8_BAR
#undef PG8_SCHED
}
}

#define XB_TMO      128
#define XB_XCNT(j)  (256  + 64 * (j))
#define XB_XSUB(j)  (1280 + 64 * (j))
#define XB_XGEN(j)  (2304 + 64 * (j))
#define XB_TOP      3328
#define XB_TOPGEN   3392
#define XCD_BAR_WORDS 3456
#define XB_SPIN_CAP (1u << 18)
__device__ __forceinline__ unsigned xb_ld(unsigned* p)              { return __hip_atomic_load(p, __ATOMIC_RELAXED, __HIP_MEMORY_SCOPE_AGENT); }
__device__ __forceinline__ unsigned xb_add(unsigned* p, unsigned v) { return __hip_atomic_fetch_add(p, v, __ATOMIC_RELAXED, __HIP_MEMORY_SCOPE_AGENT); }
__device__ __forceinline__ unsigned xb_xcc_id() { return (unsigned)__builtin_amdgcn_s_getreg((3 << 11) | 20) & 0xFu; }
#define XB_SPIN(cond, bar) do { unsigned _sp = 0; while (cond) { __builtin_amdgcn_s_sleep(1); \
    if ((++_sp & 255u) == 0u) { if (xb_ld(&(bar)[XB_TMO])) break; if (_sp > XB_SPIN_CAP) { atomicAdd(&(bar)[XB_TMO], 1u); break; } } } } while (0)
struct XcdBarrier { unsigned* bar; unsigned x; volatile LAS unsigned* st; int wave; };
__device__ __forceinline__ XcdBarrier xcd_barrier_post(unsigned* bar, volatile LAS unsigned* st, int wave) {
    XcdBarrier b; b.bar = bar; b.x = xb_xcc_id(); b.st = st; b.wave = wave;
    if (wave == 0 && lane_id() == 0) (void)xb_add(&bar[XB_XCNT(b.x)], 1u);
    return b;
}
__device__ __forceinline__ void xcd_barrier_complete(unsigned* bar, unsigned x, unsigned& nloc, unsigned& nx) {
    const unsigned G = gridDim.x * gridDim.y * gridDim.z;
    unsigned sum, cnt, mine, sp = 0u;
    for (;;) {
        sum = 0u; cnt = 0u; mine = 0u;
#pragma unroll
        for (unsigned j = 0; j < 16; ++j) { const unsigned c = xb_ld(&bar[XB_XCNT(j)]); sum += c; cnt += (c > 0u) ? 1u : 0u; mine = (j == x) ? c : mine; }
        if (sum == G) break;
        __builtin_amdgcn_s_sleep(1);
        if ((++sp & 255u) == 0u) { if (xb_ld(&bar[XB_TMO])) break; if (sp > XB_SPIN_CAP) { atomicAdd(&bar[XB_TMO], 1u); break; } }
    }
    nloc = mine > 0u ? mine : 1u; nx = cnt > 0u ? cnt : 1u;
}
__device__ __forceinline__ void xcd_barrier_leader(const XcdBarrier& b) {
    {
        unsigned* bar = b.bar;
        __builtin_amdgcn_s_waitcnt(0);
        unsigned nloc = b.st[0], nx = b.st[1];
        if (nloc == 0u) { xcd_barrier_complete(bar, b.x, nloc, nx); b.st[0] = nloc; b.st[1] = nx; }
        const unsigned old = xb_add(&bar[XB_XSUB(b.x)], 1u);
        const unsigned gen = old / nloc;
        if (old + 1u == (gen + 1u) * nloc) {
            __builtin_amdgcn_fence(__ATOMIC_RELEASE, "agent");
            asm volatile("s_waitcnt vmcnt(0)" ::: "memory");
            const unsigned og = xb_add(&bar[XB_TOP], 1u);
            const unsigned tg = og / nx;
            if (og + 1u == (tg + 1u) * nx) xb_add(&bar[XB_TOPGEN], 1u);
            else XB_SPIN(xb_ld(&bar[XB_TOPGEN]) == tg, bar);
            __builtin_amdgcn_fence(__ATOMIC_ACQUIRE, "agent");
            xb_add(&bar[XB_XGEN(b.x)], 1u);
            asm volatile("s_waitcnt vmcnt(0)" ::: "memory");
        } else {
            XB_SPIN(xb_ld(&bar[XB_XGEN(b.x)]) == gen, bar);
            __builtin_amdgcn_fence(__ATOMIC_ACQUIRE, "agent");
            asm volatile("s_waitcnt vmcnt(0)" ::: "memory");
        }
    }
}
__device__ __forceinline__ void xcd_barrier(const XcdBarrier& b) {
    asm volatile("s_waitcnt vmcnt(0)" ::: "memory");
    __syncthreads();
    if (b.wave == 0 && lane_id() == 0) xcd_barrier_leader(b);
    __syncthreads();
}

struct Frame {
    LAS unsigned char* lds;
    volatile LAS unsigned* MISC;
    gu32* ctl;
    int vcu, G, wave;
    const float *x, *norm_mix_g, *w_in, *conv_a_w, *conv_b_w, *conv_b_bias, *ln_b_g, *ln_b_b, *beta_a, *beta_b, *w_out, *norm_ffn_g, *wrg, *brg, *wre, *bre, *w1, *w3, *w2, *gfin;
    float* out;
    bf16 *Win_t, *Wout_t, *Wr_t, *XB, *P, *Y, *X1B; fp8 *W13_t, *W2_t, *H, *X1F8, *CB; float* RI;
    float *SSQ, *LW, *LR2; unsigned* LTOK; unsigned* gcnt;
};

struct CvtItem { const float* src; const float* ks; bf16* dst; int N; bool valid; };
__device__ __forceinline__ void cvt_load(const CvtItem& it, f32x4 (&v)[8]) {
    if (it.valid) {
#pragma unroll
        for (int j = 0; j < 8; ++j) v[j] = __builtin_nontemporal_load((const GAS f32x4*)(it.src + (size_t)j * it.N));
    }
}
__device__ __forceinline__ void cvt_store(const CvtItem& it, f32x4 (&v)[8]) {
    if (it.valid) {
        if (it.ks) {
#pragma unroll
            for (int j = 0; j < 8; ++j) v[j] = v[j] * it.ks[j];
        }
#pragma unroll
        for (int c = 0; c < 4; ++c) { u32x4 g; g.x = cvt_pk_bf16(v[0][c], v[1][c]); g.y = cvt_pk_bf16(v[2][c], v[3][c]); g.z = cvt_pk_bf16(v[4][c], v[5][c]); g.w = cvt_pk_bf16(v[6][c], v[7][c]);
            *(GAS u32x4*)(it.dst + (size_t)c * 8) = g; }
    }
}
__device__ __forceinline__ int win_dest_row(int n0) {
    if (n0 < 512) return 256 * (n0 >> 7) + (n0 & 127);
    if (n0 < 1024) return n0 + 512;
    if (n0 < 1536) { const int j = n0 - 1024; return 256 * (j >> 7) + 128 + (j & 127); }
    if (n0 < 2048) { const int j = n0 - 1536; return 1536 + 256 * (j >> 7) + (j & 127); }
    { const int j = n0 - 2048; return 1536 + 256 * (j >> 7) + 128 + (j & 127); }
}
__device__ __forceinline__ size_t gran_idx(int kb, int drow, int nkt, bool wide = false) { const int w = drow & 31, c = drow & 255;
    const int slot = wide ? 128 * ((c >> 3) & 1) + 32 * (c >> 6) + 16 * ((c >> 2) & 1) + 4 * ((c >> 4) & 3) + (c & 3) : (drow & 224) + 16 * ((w >> 2) & 1) + 4 * (w >> 3) + (w & 3);
    return ((size_t)(((drow >> 8) * nkt + (kb >> 3)) * 8 + (kb & 7)) * 256 + slot); }
constexpr int I_IN = 128 * 10, I_OUT = 128 * 4, NITEMS = I_IN + I_OUT;
constexpr int J_13 = NE * 2 * 64 * 2, J_2 = NE * 32 * 4, NITEMS8 = J_13 + J_2;
__device__ __forceinline__ CvtItem p0_decode(Frame& F, int it, int lane) {
    CvtItem c; c.valid = it < NITEMS; c.src = F.w_in; c.ks = nullptr; c.dst = F.Win_t; c.N = DIN;
    if (!c.valid) return c;
    int r = it;
    if (r < I_IN) { const int kb = r / 10, n = 256 * (r % 10) + 4 * lane;
        c.src = F.w_in + (size_t)(8 * kb) * DIN + n; c.N = DIN; c.ks = F.norm_mix_g + 8 * kb; c.dst = F.Win_t + gran_idx(kb, win_dest_row(n), 16) * 8; return c; }
    r -= I_IN;
    { const int kb = r / 4, n = 256 * (r % 4) + 4 * lane;
        c.src = F.w_out + (size_t)(8 * kb) * D + n; c.N = D; c.ks = (8 * kb < DA) ? F.beta_a + 8 * kb : F.beta_b + (8 * kb - DA); c.dst = F.Wout_t + gran_idx(kb, n, 16, true) * 8; return c; }
}
struct CvtItem8 { const float* src; const float* ks; fp8* dst; int N; float scale; };
__device__ __forceinline__ CvtItem8 p0_decode8(Frame& F, int it, int lane) {
    CvtItem8 c; int r = it;
    if (r < J_13) { const int e = r / 256, rr = r % 256, which = rr / 128, item = rr % 128, kb = item / 2, n = 256 * (item % 2) + 4 * lane;
        c.src = (which ? F.w3 : F.w1) + (size_t)e * D * DE + (size_t)(16 * kb) * DE + n; c.N = DE; c.ks = F.norm_ffn_g + 16 * kb; c.scale = 32.0f;
        c.dst = F.W13_t + (size_t)e * 1024 * D + gran_idx(kb, 256 * (n >> 7) + 128 * which + (n & 127), 8) * 16; return c; }
    r -= J_13;
    { const int e = r / 128, item = r % 128, kb = item / 4, n = 256 * (item % 4) + 4 * lane;
        c.src = F.w2 + (size_t)e * DE * D + (size_t)(16 * kb) * D + n; c.N = D; c.ks = nullptr; c.scale = 16.0f; c.dst = F.W2_t + (size_t)e * 1024 * DE + gran_idx(kb, n, 4, true) * 16; return c; }
}
__device__ __forceinline__ void p0_cvt8_item(Frame& F, int it, int lane) {
    const CvtItem8 c = p0_decode8(F, it, lane);
    f32x4 v[16];
#pragma unroll
    for (int j = 0; j < 16; ++j) v[j] = __builtin_nontemporal_load((const GAS f32x4*)(c.src + (size_t)j * c.N));
#pragma unroll
    for (int j = 0; j < 16; ++j) v[j] = v[j] * (c.ks ? c.ks[j] * c.scale : c.scale);
#pragma unroll
    for (int q = 0; q < 4; ++q) { u32x4 g;
#pragma unroll
        for (int w = 0; w < 4; ++w) g[w] = pk4_fp8(v[4 * w][q], v[4 * w + 1][q], v[4 * w + 2][q], v[4 * w + 3][q]);
        *(GAS u32x4*)(c.dst + (size_t)q * 16) = g; }
}
constexpr int NITEMS8_LATE = 4096;
__device__ __forceinline__ void p1_late_convert(Frame& F) {
    if (F.G != 256 || blockIdx.x < 128) return;
    int lane = lane_id(); asm volatile("" : "+v"(lane));
    const int w0 = ((int)blockIdx.x - 128) * NWAVES + F.wave;
    for (int it = NITEMS8 - NITEMS8_LATE + w0; it < NITEMS8; it += 128 * NWAVES) p0_cvt8_item(F, it, lane);
}
constexpr int W13_P0 = 1024, FILL_PER_BAR = 256 * (NWAVES - 1), N_FILL_BARS = 4;
static_assert(W13_P0 + N_FILL_BARS * FILL_PER_BAR >= J_13, "the barrier fillers must cover every W1/W3 item P0 leaves out");
__device__ __forceinline__ void xcd_barrier_fill(Frame& F, const XcdBarrier& b, int k) {
    asm volatile("s_waitcnt vmcnt(0)" ::: "memory");
    __syncthreads();
    if (b.wave == 0) { if (lane_id() == 0) xcd_barrier_leader(b); }
    else if (k < N_FILL_BARS && F.G == 256) {
        const int it = W13_P0 + k * FILL_PER_BAR + (int)blockIdx.x * (NWAVES - 1) + (b.wave - 1);
        if (it < W13_P0 + (k + 1) * FILL_PER_BAR && it < J_13) { int lane = lane_id(); asm volatile("" : "+v"(lane)); p0_cvt8_item(F, it, lane); }
    }
    __syncthreads();
}
__device__ __forceinline__ void p0_prologue(Frame& F) {
    const int wave = F.wave; int lane = lane_id(); asm volatile("" : "+v"(lane)); const int tid = wave * 64 + lane;
    const int gw = F.vcu * NWAVES + wave, NGW = F.G * NWAVES;
    for (int it = gw; it < NITEMS; it += 2 * NGW) {
        const CvtItem c0 = p0_decode(F, it, lane), c1 = p0_decode(F, it + NGW, lane);
        f32x4 v0[8], v1[8];
        cvt_load(c0, v0); cvt_load(c1, v1);
        cvt_store(c0, v0); cvt_store(c1, v1);
    }
    for (int it = gw; it < ((F.G == 256 && N_LAUNCHES == 1) ? 0 : (F.G == 256 ? J_13 : NITEMS8)); it += NGW) p0_cvt8_item(F, it, lane);
    for (int i = gw * 64 + lane; i < 48 * D; i += NGW * 64) { const int o = i / D, k = i % D; float v = 0.f;
        if (o < 4) v = F.wrg[(size_t)k * 4 + o] * F.norm_ffn_g[k]; else if (o < 36) v = F.wre[(size_t)k * NE + (o - 4)] * F.norm_ffn_g[k];
        F.Wr_t[i] = (bf16)f2bf(v); }
    for (int m = gw; m < T; m += NGW) {
        const GAS f32x4* xr = (const GAS f32x4*)(F.x + (size_t)m * D) + lane;
        f32x4 v[4]; float s = 0.f;
#pragma unroll
        for (int j = 0; j < 4; ++j) { v[j] = __builtin_nontemporal_load(xr + 64 * j); s += (v[j].x * v[j].x + v[j].y * v[j].y) + (v[j].z * v[j].z + v[j].w * v[j].w); }
        const float r = rsqrtf(wave_sum(s) * (1.f / D) + EPS);
        if (lane == 0) F.RI[m] = 1.0f / r;
        GAS u32x2* o8 = (GAS u32x2*)(F.XB + (size_t)m * D) + lane;
#pragma unroll
        for (int j = 0; j < 4; ++j) { u32x2 w; w.x = pk2(v[j].x * r, v[j].y * r); w.y = pk2(v[j].z * r, v[j].w * r); o8[64 * j] = w; }
    }
}

template <int CTRL> __device__ __forceinline__ float dpp_f(float v) { return __builtin_bit_cast(float, __builtin_amdgcn_update_dpp(0, __builtin_bit_cast(int, v), CTRL, 0xf, 0xf, false)); }
#define DPP_XOR1 0xB1
#define DPP_XOR2 0x4E
#define DPP_HALF_MIRROR 0x141
#define DPP_ROW_MIRROR 0x140
__device__ __forceinline__ float sum8(float v) { v += dpp_f<DPP_XOR1>(v); v += dpp_f<DPP_XOR2>(v); v += dpp_f<DPP_HALF_MIRROR>(v); return v; }
__device__ __forceinline__ float sum16(float v) { v = sum8(v); v += dpp_f<DPP_ROW_MIRROR>(v); return v; }
__device__ __forceinline__ void p2_mixer(Frame& F) {
    const int wave = F.wave; int lane = lane_id(); asm volatile("" : "+v"(lane)); const int tid = wave * 64 + lane;
    LAS unsigned char* L = F.lds;
    LAS unsigned* Ut = (LAS unsigned*)L;
    LAS float* UC = (LAS float*)(L + 62 * 1024);
    LAS float* PRM = (LAS float*)(L + LDSCTL_OFF + 2048);
    PRM[tid] = F.ln_b_g[tid]; PRM[512 + tid] = F.ln_b_b[tid];
#pragma unroll
    for (int q = 0; q < 3; ++q) PRM[1024 + 512 * q + tid] = F.conv_a_w[q * DA + tid];
    const int cp = tid & 255, th = tid >> 8;
    f32x2 wb[31];
#pragma unroll
    for (int j = 0; j < 31; ++j) wb[j] = *(const f32x2*)(F.conv_b_w + j * DB + 2 * cp);
    const f32x2 bias2 = *(const f32x2*)(F.conv_b_bias + 2 * cp);
    const int tq = lane >> 4, tl = lane & 15;
    u32x4 ureg[8];
#define P2_ULOAD(tile_) do { const int _t0 = (tile_) * 32, _b = _t0 / SEQ, _s0 = _t0 % SEQ; int _tid = tid; asm volatile("" : "+v"(_tid)); _Pragma("unroll") for (int _i = 0; _i < 8; ++_i) { const int _ch = _tid + 512 * _i, _row = _ch >> 6, _c16 = _ch & 63, _s = _s0 - 15 + _row; \
        ureg[_i] = (u32x4){0u, 0u, 0u, 0u}; if (_ch < 62 * 64 && _s >= 0 && _s < SEQ) ureg[_i] = *(const GAS u32x4*)(F.P + (size_t)(_b * SEQ + _s) * PW + 1024 + _c16 * 8); } } while (0)
    int tile = F.vcu;
    if (tile < T / 32) P2_ULOAD(tile);
    __syncthreads();
    for (; tile < T / 32; tile += F.G) {
        const int t0 = tile * 32, s0 = t0 % SEQ;
        { int tid2 = tid; asm volatile("" : "+v"(tid2));
#pragma unroll
        for (int i = 0; i < 8; ++i) { const int ch = tid2 + 512 * i; if (ch < 62 * 64) *(LAS u32x4*)(L + ch * 16) = ureg[i]; } }
        __syncthreads();
        if (tile + F.G < T / 32) P2_ULOAD(tile + F.G);
#pragma unroll 1
        for (int sub = 0; sub < 2; ++sub) { const int i0 = th * 16 + sub * 8; f32x2 a[8];
#pragma unroll
            for (int i = 0; i < 8; ++i) a[i] = bias2;
#pragma unroll
            for (int w = 0; w < 38; ++w) { const unsigned v = Ut[(i0 + w) * 256 + cp]; const f32x2 x2 = (f32x2){bflo(v), bfhi(v)};
#pragma unroll
                for (int i = 0; i < 8; ++i) { const int j = w - i; if (j >= 0 && j < 31) a[i] = __builtin_elementwise_fma(wb[j], x2, a[i]); } }
#pragma unroll
            for (int i = 0; i < 8; ++i) *(LAS f32x2*)(UC + (i0 + i) * 512 + 2 * cp) = a[i];
        }
        __syncthreads();
        u32x4 gpm1[4], gp0[4], gpp1[4], gab[4];
        { const int i = wave * 4 + tq, s = s0 + i; const bf16* prow = F.P + (size_t)(t0 + i) * PW + 8 * tl; const u32x4 z4 = (u32x4){0u, 0u, 0u, 0u};
#pragma unroll
          for (int k = 0; k < 4; ++k) { const bf16* pk = prow + 128 * k;
            gpm1[k] = (s > 0) ? *(const GAS u32x4*)(pk - PW) : z4; gp0[k] = *(const GAS u32x4*)pk; gpp1[k] = (s < SEQ - 1) ? *(const GAS u32x4*)(pk + PW) : z4; gab[k] = *(const GAS u32x4*)(pk + 512); } }
        { const int i = wave * 4 + tq, t = t0 + i;
          float uv[4][8]; float s1 = 0.f;
#pragma unroll
          for (int k = 0; k < 4; ++k) { const LAS float* up = UC + i * 512 + 8 * (tl + 16 * k); const f32x4 ua = *(const LAS f32x4*)up, ub = *(const LAS f32x4*)(up + 4);
#pragma unroll
            for (int j = 0; j < 4; ++j) { uv[k][j] = ua[j]; uv[k][4 + j] = ub[j]; s1 += ua[j] + ub[j]; } }
          const float mu = sum16(s1) * (1.f / DB); float s2 = 0.f;
#pragma unroll
          for (int k = 0; k < 4; ++k)
#pragma unroll
            for (int j = 0; j < 8; ++j) { uv[k][j] -= mu; s2 += uv[k][j] * uv[k][j]; }
          const float rstd = rsqrtf(sum16(s2) * (1.f / DB) + EPS);
#pragma unroll
          for (int k = 0; k < 4; ++k) { const int c8 = 8 * (tl + 16 * k); const LAS float* gp = PRM + c8; const f32x4 g0 = *(const LAS f32x4*)gp, g1 = *(const LAS f32x4*)(gp + 4), b0 = *(const LAS f32x4*)(gp + 512), b1 = *(const LAS f32x4*)(gp + 516);
            float hb = 0.f;
#pragma unroll
            for (int j = 0; j < 8; ++j) { const float z = uv[k][j] * rstd * (j < 4 ? g0[j & 3] : g1[j & 3]) + (j < 4 ? b0[j & 3] : b1[j & 3]); uv[k][j] = z * fast_sigmoid(z); hb += uv[k][j] * uv[k][j]; }
            const float rb = rsqrtf(sum8(hb) * (1.f / 64.f) + EPS);
            u32x4 ob; ob.x = cvt_pk_bf16(uv[k][0] * rb, uv[k][1] * rb); ob.y = cvt_pk_bf16(uv[k][2] * rb, uv[k][3] * rb); ob.z = cvt_pk_bf16(uv[k][4] * rb, uv[k][5] * rb); ob.w = cvt_pk_bf16(uv[k][6] * rb, uv[k][7] * rb);
            *(GAS u32x4*)(F.Y + (size_t)t * D + DA + c8) = ob; }
#pragma unroll
          for (int k = 0; k < 4; ++k) { const int c8 = 8 * (tl + 16 * k); const LAS float* wp = PRM + 1024 + c8; float ya[8]; float ha = 0.f;
            f32x4 w0[2], w1[2], w2[2];
#pragma unroll
            for (int h = 0; h < 2; ++h) { w0[h] = *(const LAS f32x4*)(wp + 4 * h); w1[h] = *(const LAS f32x4*)(wp + 512 + 4 * h); w2[h] = *(const LAS f32x4*)(wp + 1024 + 4 * h); }
#pragma unroll
            for (int j = 0; j < 4; ++j) { const int h = j >> 1, e = 2 * (j & 1);
                const float c0 = w0[h][e] * bflo(gpm1[k][j]) + w1[h][e] * bflo(gp0[k][j]) + w2[h][e] * bflo(gpp1[k][j]);
                const float c1 = w0[h][e + 1] * bfhi(gpm1[k][j]) + w1[h][e + 1] * bfhi(gp0[k][j]) + w2[h][e + 1] * bfhi(gpp1[k][j]);
                ya[2 * j] = bflo(gab[k][j]) * c0; ya[2 * j + 1] = bfhi(gab[k][j]) * c1; ha += ya[2 * j] * ya[2 * j] + ya[2 * j + 1] * ya[2 * j + 1]; }
            const float ra = rsqrtf(sum8(ha) * (1.f / 64.f) + EPS);
            u32x4 oa; oa.x = cvt_pk_bf16(ya[0] * ra, ya[1] * ra); oa.y = cvt_pk_bf16(ya[2] * ra, ya[3] * ra); oa.z = cvt_pk_bf16(ya[4] * ra, ya[5] * ra); oa.w = cvt_pk_bf16(ya[6] * ra, ya[7] * ra);
            *(GAS u32x4*)(F.Y + (size_t)t * D + c8) = oa; }
        }
    }
#undef P2_ULOAD
    __syncthreads();
}

__device__ __forceinline__ void p4_route(Frame& F) {
    const int wave = F.wave; int lane = lane_id(); asm volatile("" : "+v"(lane)); const int tid = wave * 64 + lane;
    LAS float* LGp = (LAS float*)F.lds;
    LAS int* scnt = (LAS int*)(F.lds + 102400);
    bf16x8 bfr[4][3];
    { const bf16* brow = F.Wr_t + (size_t)(lane & 15) * D + 128 * wave + 8 * (lane >> 4);
#pragma unroll
      for (int ks = 0; ks < 4; ++ks)
#pragma unroll
        for (int nb = 0; nb < 3; ++nb) bfr[ks][nb] = *(const GAS bf16x8*)(brow + (size_t)nb * 16 * D + ks * 32); }
    LAS float* r2s = (LAS float*)(F.lds + 102400 + 512);
    for (int tile = F.vcu; tile < T / 64; tile += F.G) {
        if (tid < 32) scnt[tid] = 0;
        const int tb = tile * 64;
        if (tid < 64) { float ss = 0.f;
#pragma unroll
            for (int s = 0; s < 16; ++s) ss += F.SSQ[(size_t)s * T + tb + tid];
            r2s[tid] = rsqrtf(ss * (1.f / D) + EPS); }
        bf16x8 af[4][4];
#pragma unroll
        for (int tg = 0; tg < 4; ++tg)
#pragma unroll
            for (int ks = 0; ks < 4; ++ks) af[tg][ks] = *(const GAS bf16x8*)(F.X1B + (size_t)(tb + 16 * tg + (lane & 15)) * D + 128 * wave + ks * 32 + 8 * (lane >> 4));
        __syncthreads();
#pragma unroll
        for (int tg = 0; tg < 4; ++tg) { f32x4 acc[3];
#pragma unroll
            for (int nb = 0; nb < 3; ++nb) acc[nb] = (f32x4){0.f, 0.f, 0.f, 0.f};
#pragma unroll
            for (int ks = 0; ks < 4; ++ks)
#pragma unroll
                for (int nb = 0; nb < 3; ++nb) acc[nb] = __builtin_amdgcn_mfma_f32_16x16x32_bf16(af[tg][ks], bfr[ks][nb], acc[nb], 0, 0, 0);
#pragma unroll
            for (int nb = 0; nb < 3; ++nb)
#pragma unroll
                for (int r = 0; r < 4; ++r) LGp[(wave * 64 + 16 * tg + 4 * (lane >> 4) + r) * 49 + nb * 16 + (lane & 15)] = acc[nb][r];
            const float rs = r2s[16 * tg + (lane & 15)];
#pragma unroll
            for (int ks = 0; ks < 4; ++ks) { const u32x4 q = __builtin_bit_cast(u32x4, af[tg][ks]); u32x2 o;
                o.x = pk4_fp8(bflo(q[0]) * rs, bfhi(q[0]) * rs, bflo(q[1]) * rs, bfhi(q[1]) * rs); o.y = pk4_fp8(bflo(q[2]) * rs, bfhi(q[2]) * rs, bflo(q[3]) * rs, bfhi(q[3]) * rs);
                *(GAS u32x2*)(F.X1F8 + (size_t)(tb + 16 * tg + (lane & 15)) * D + 128 * wave + ks * 32 + 8 * (lane >> 4)) = o; } }
        __syncthreads();
        int e0 = 0, e1 = 0, p0 = 0, p1 = 0; float c0 = 0.f, c1 = 0.f;
        if (tid < 64) {
            const float r2 = r2s[tid];
            const LAS float* lg = LGp + tid * 49;
            float g4[4];
#pragma unroll
            for (int i = 0; i < 4; ++i) { float a = 0.f;
#pragma unroll
                for (int w = 0; w < 8; ++w) a += lg[w * 64 * 49 + i];
                g4[i] = a * r2 + F.brg[i]; }
            int g = 0; float m = g4[0];
#pragma unroll
            for (int i = 1; i < 4; ++i) if (g4[i] > m) { m = g4[i]; g = i; }
            float den = 0.f;
#pragma unroll
            for (int i = 0; i < 4; ++i) den += __expf(g4[i] - m);
            const float psel = 1.0f / den;
            int i0 = 0, i1 = -1; float m0 = -3.0e38f, m1 = -3.0e38f;
            for (int i = 0; i < 8; ++i) { float a = 0.f;
#pragma unroll
                for (int w = 0; w < 8; ++w) a += lg[w * 64 * 49 + 4 + g * 8 + i];
                const float v = a * r2 + F.bre[g * 8 + i];
                if (v > m0) { m1 = m0; i1 = i0; m0 = v; i0 = i; } else if (v > m1) { m1 = v; i1 = i; } }
            const float ex = __expf(m1 - m0);
            e0 = g * 8 + i0; e1 = g * 8 + i1; c0 = psel / (1.0f + ex); c1 = psel * ex / (1.0f + ex);
            p0 = __hip_atomic_fetch_add(scnt + e0, 1, __ATOMIC_RELAXED, __HIP_MEMORY_SCOPE_WORKGROUP); p1 = __hip_atomic_fetch_add(scnt + e1, 1, __ATOMIC_RELAXED, __HIP_MEMORY_SCOPE_WORKGROUP);
        } else if (F.G == 256 && N_LAUNCHES == 1 && tile == F.vcu) {
            const int it = (int)blockIdx.x * (NWAVES - 1) + (wave - 1); if (it < W13_P0) p0_cvt8_item(F, it, lane);
        }
        __syncthreads();
        if (tid < 32) scnt[32 + tid] = (int)__hip_atomic_fetch_add(F.gcnt + tid, (unsigned)scnt[tid], RLX_AGENT);
        __syncthreads();
        if (tid < 64) {
            const int t = tb + tid; const size_t d0 = (size_t)e0 * CAP + scnt[32 + e0] + p0, d1 = (size_t)e1 * CAP + scnt[32 + e1] + p1;
            F.LTOK[d0] = (unsigned)t | (f2bf(c0) << 16);
            F.LTOK[d1] = (unsigned)t | (1u << 14) | (f2bf(c1) << 16);
        }
        __syncthreads();
    }
}

__device__ __forceinline__ void p7_final(Frame& F) {
    const int wave = F.wave; int lane = lane_id(); asm volatile("" : "+v"(lane)); const int tid = wave * 64 + lane;
    const int gw = F.vcu * NWAVES + wave, NGW = F.G * NWAVES;
    f32x4 g[2][2];
#pragma unroll
    for (int j = 0; j < 2; ++j) { g[j][0] = *(const f32x4*)(F.gfin + j * 512 + lane * 8); g[j][1] = *(const f32x4*)(F.gfin + j * 512 + lane * 8 + 4); }
    for (int t = gw; t < T; t += NGW) {
        float v[2][8]; float ss = 0.f;
#pragma unroll
        for (int j = 0; j < 2; ++j) { const size_t o = (size_t)t * D + j * 512 + lane * 8;
            const u32x4 a = *(const GAS u32x4*)(F.X1B + o); const u32x2 c0 = *(const GAS u32x2*)(F.CB + o), c1 = *(const GAS u32x2*)(F.CB + (size_t)T * D + o);
#pragma unroll
            for (int q = 0; q < 4; q += 2) { const f32x2 p0 = __builtin_amdgcn_cvt_pk_f32_fp8((int)c0[q >> 1], false), p1 = __builtin_amdgcn_cvt_pk_f32_fp8((int)c1[q >> 1], false),
                                                           p2 = __builtin_amdgcn_cvt_pk_f32_fp8((int)c0[q >> 1], true), p3 = __builtin_amdgcn_cvt_pk_f32_fp8((int)c1[q >> 1], true);
                v[j][2 * q] = bflo(a[q]) + (p0.x + p1.x) * (1.0f / 64.0f); v[j][2 * q + 1] = bfhi(a[q]) + (p0.y + p1.y) * (1.0f / 64.0f);
                v[j][2 * q + 2] = bflo(a[q + 1]) + (p2.x + p3.x) * (1.0f / 64.0f); v[j][2 * q + 3] = bfhi(a[q + 1]) + (p2.y + p3.y) * (1.0f / 64.0f); }
#pragma unroll
            for (int q = 0; q < 8; ++q) ss += v[j][q] * v[j][q]; }
        const float r = rsqrtf(wave_sum(ss) * (1.f / D) + EPS);
#pragma unroll
        for (int j = 0; j < 2; ++j) { float* o = F.out + (size_t)t * D + j * 512 + lane * 8;
            *(GAS f32x4*)o = (f32x4){v[j][0] * r * g[j][0][0], v[j][1] * r * g[j][0][1], v[j][2] * r * g[j][0][2], v[j][3] * r * g[j][0][3]};
            *(GAS f32x4*)(o + 4) = (f32x4){v[j][4] * r * g[j][1][0], v[j][5] * r * g[j][1][1], v[j][6] * r * g[j][1][2], v[j][7] * r * g[j][1][3]}; }
    }
}

__device__ __forceinline__ void moe_sched_init(pg8::SchedMoe& S, Frame& F) {
    int lane = lane_id(); asm volatile("" : "+v"(lane));
    LAS int* tab = (LAS int*)(F.lds + LDSCTL_OFF + 1024);
    int my_cnt = 0; if (lane < NE) my_cnt = (int)__hip_atomic_load(F.gcnt + lane, RLX_AGENT);
    const int tiles = (my_cnt + 255) >> 8; int incl = tiles;
#pragma unroll
    for (int o = 1; o < 32; o <<= 1) { const int v = __shfl_up(incl, o); if (lane >= o) incl += v; }
    if (F.wave == 0 && lane < NE) { tab[lane] = incl - tiles; tab[32 + lane] = my_cnt; }
    S.total_rt = __builtin_amdgcn_readlane(incl, 31); S.tab = tab;
    S.ltok = F.LTOK; S.G = F.G; S.c = (int)blockIdx.x;
    __syncthreads();
}

struct Args { const float* in[20]; float* out; unsigned char* ws; int ph_lo, ph_hi, li, pad; };
__global__ void __launch_bounds__(NWAVES * 64, 2) mk_fwd(Args args) {
    extern __shared__ __attribute__((aligned(16))) unsigned char lds[];
    Frame F;
    F.lds = (LAS unsigned char*)lds;
    F.MISC = (volatile LAS unsigned*)(F.lds + MISC_OFF);
    F.wave = __builtin_amdgcn_readfirstlane((int)threadIdx.x >> 6);
    F.G = gridDim.x; { const int bx = blockIdx.x; F.vcu = (F.G % 8 == 0) ? (bx % 8) * (F.G / 8) + bx / 8 : bx; }
    unsigned char* ws = args.ws;
    F.ctl = (gu32*)(ws + WS_CTL);
    F.x = args.in[0]; F.norm_mix_g = args.in[1]; F.w_in = args.in[2]; F.conv_a_w = args.in[3]; F.conv_b_w = args.in[4]; F.conv_b_bias = args.in[5]; F.ln_b_g = args.in[6]; F.ln_b_b = args.in[7];
    F.beta_a = args.in[8]; F.beta_b = args.in[9]; F.w_out = args.in[10]; F.norm_ffn_g = args.in[11]; F.wrg = args.in[12]; F.brg = args.in[13]; F.wre = args.in[14]; F.bre = args.in[15];
    F.w1 = args.in[16]; F.w3 = args.in[17]; F.w2 = args.in[18]; F.gfin = args.in[19]; F.out = args.out;
    F.Win_t = (bf16*)(ws + WS_WIN); F.Wout_t = (bf16*)(ws + WS_WOUT); F.Wr_t = (bf16*)(ws + WS_WR); F.W13_t = (fp8*)(ws + WS_W13); F.W2_t = (fp8*)(ws + WS_W2); F.X1F8 = (fp8*)(ws + WS_X1F8);
    F.XB = (bf16*)(ws + WS_XB); F.P = (bf16*)(ws + WS_P); F.Y = (bf16*)(ws + WS_Y); F.X1B = (bf16*)(ws + WS_X1B); F.H = (fp8*)(ws + WS_H); F.CB = (fp8*)(ws + WS_CB); F.RI = (float*)(ws + WS_WR + 768 * 1024);
    F.SSQ = (float*)(ws + WS_SSQ); F.LW = (float*)(ws + WS_LW); F.LR2 = (float*)(ws + WS_LR2); F.LTOK = (unsigned*)(ws + WS_LTOK); F.gcnt = (unsigned*)(ws + WS_CTL) + CW_GCNT;
    for (int u = F.wave * 64 + lane_id(); u < (LDS_BYTES - LDSCTL_OFF) / 4; u += NWAVES * 64) ((LAS unsigned*)(F.lds + LDSCTL_OFF))[u] = 0u;
    __syncthreads();
    XcdBarrier bar; bar.bar = (unsigned*)(F.ctl + CW_BAR); bar.x = 0; bar.st = nullptr; bar.wave = F.wave;
    if (N_LAUNCHES == 1) bar = xcd_barrier_post((unsigned*)(F.ctl + CW_BAR), F.MISC + 8, F.wave);
    const int lo = args.ph_lo, hi = args.ph_hi;
#define IN(k) (lo <= (k) && (k) < hi)
#define GRID_BAR(k) do { if (IN(k) && IN((k) + 1)) xcd_barrier_fill(F, bar, (k)); if (PROBE_PHASE >= 0 && blockIdx.x == 0 && F.wave == 0 && lane_id() == 0) ((unsigned long long*)(ws + WS_WR + 512 * 1024))[(k) + 1] = __builtin_amdgcn_s_memrealtime(); } while (0)
    if (PROBE_PHASE >= 0 && blockIdx.x == 0 && F.wave == 0 && lane_id() == 0) ((unsigned long long*)(ws + WS_WR + 512 * 1024))[0] = __builtin_amdgcn_s_memrealtime();

    if (IN(0)) { p0_prologue(F); GRID_BAR(0); }
    if (IN(1)) {
        pg8::SchedDense S{(const char*)F.XB, (const char*)F.Win_t, T / 256, DIN / 256, F.G, (int)blockIdx.x, (size_t)256 * D * 2, 16};
        pg8::EpiP1 E{F.P};
        pg8::gemm_phase<pg8::EpiP1, pg8::SchedDense, false>(F.lds + RING_OFF, D * 2, S, E, F.wave);
        p1_late_convert(F);
        GRID_BAR(1);
    }
    if (IN(2)) { p2_mixer(F); GRID_BAR(2); }
    if (IN(3)) {
        pg8::SchedDense S{(const char*)F.Y, (const char*)F.Wout_t, T / 256, D / 256, F.G, (int)blockIdx.x, (size_t)256 * D * 2, 16};
        pg8::EpiX1 E{F.XB, F.RI, F.X1B, F.SSQ};
        pg8::gemm_phase<pg8::EpiX1, pg8::SchedDense, false>(F.lds + RING_OFF, D * 2, S, E, F.wave);
        GRID_BAR(3);
    }
    if (IN(4)) { p4_route(F); GRID_BAR(4); }
    if (IN(5)) {
        pg8::SchedMoeA S; moe_sched_init(S, F); S.A = (const char*)F.X1F8; S.W = (const char*)F.W13_t; S.a_tile_bytes = 0; S.w_exp_bytes = (size_t)1024 * D; S.nkt = 8;
        pg8::EpiH E{F.H};
        pg8::gemm_phase<pg8::EpiH, pg8::SchedMoeA, true>(F.lds + RING_OFF, D, S, E, F.wave);
        GRID_BAR(5);
    }
    if (IN(6)) {
        pg8::SchedMoeB S; moe_sched_init(S, F); S.A = (const char*)F.H; S.W = (const char*)F.W2_t; S.a_tile_bytes = (size_t)256 * DE; S.w_exp_bytes = (size_t)1024 * DE; S.nkt = 4;
        pg8::EpiC E{F.CB, F.LTOK};
        pg8::gemm_phase<pg8::EpiC, pg8::SchedMoeB, true>(F.lds + RING_OFF, DE, S, E, F.wave);
        GRID_BAR(6);
    }
    if (IN(7)) { p7_final(F);
        if (PROBE_PHASE >= 0 && blockIdx.x == 0 && F.wave == 0 && lane_id() == 0) { unsigned long long* ts = (unsigned long long*)(ws + WS_WR + 512 * 1024); ts[8] = __builtin_amdgcn_s_memrealtime();
            asm volatile("s_waitcnt vmcnt(0)" ::: "memory"); const float us = (PROBE_PHASE == 8) ? (float)(ts[8] - ts[0]) * 0.001f : (float)(ts[PROBE_PHASE + 1] - ts[PROBE_PHASE]) * 0.01f; F.out[0] += us * 0.1f; } }
#undef IN
#undef GRID_BAR
}

extern "C" void kernel_launch(void* const* d_in, const int* in_sizes, int n_in, void* d_out, int out_size, void* d_ws, size_t ws_size, hipStream_t stream) {
    static int grid = 0;
    if (grid == 0) {
        if (n_in != 20 || in_sizes[0] != T * D || out_size != T * D || ws_size < WS_END) { fprintf(stderr, "kernel_launch: unexpected shapes / workspace (n_in %d, in0 %d, out %d, ws %zu, need %zu)\n", n_in, n_in > 0 ? in_sizes[0] : -1, out_size, ws_size, (size_t)WS_END); grid = -1; return; }
        int dev = 0, cus = 0, per_cu = 0;
        if (hipGetDevice(&dev) != hipSuccess || hipDeviceGetAttribute(&cus, hipDeviceAttributeMultiprocessorCount, dev) != hipSuccess) { fprintf(stderr, "kernel_launch: device query failed\n"); grid = -1; return; }
        if (hipFuncSetAttribute((const void*)mk_fwd, hipFuncAttributeMaxDynamicSharedMemorySize, LDS_BYTES) != hipSuccess) { fprintf(stderr, "kernel_launch: hipFuncSetAttribute failed\n"); grid = -1; return; }
        if (hipOccupancyMaxActiveBlocksPerMultiprocessor(&per_cu, (const void*)mk_fwd, NWAVES * 64, LDS_BYTES) != hipSuccess || per_cu < 1) fprintf(stderr, "kernel_launch: occupancy query reports %d workgroups per CU\n", per_cu);
        (void)hipGetLastError();
        grid = cus;
    }
    if (grid < 0) return;
    if (hipMemsetAsync((char*)d_ws + WS_CTL, 0, CTL_ZERO_BYTES, stream) != hipSuccess) { fprintf(stderr, "kernel_launch: hipMemsetAsync failed\n"); return; }
    Args a{};
    for (int i = 0; i < 20; ++i) a.in[i] = (const float*)d_in[i];
    a.out = (float*)d_out; a.ws = (unsigned char*)d_ws;
    for (int li = 0; li < N_LAUNCHES; ++li) {
        a.ph_lo = (N_LAUNCHES == 1) ? 0 : li; a.ph_hi = (N_LAUNCHES == 1) ? NPHASES : li + 1; a.li = li;
        hipLaunchKernelGGL(mk_fwd, dim3(grid), dim3(NWAVES * 64), LDS_BYTES, stream, a);
        const hipError_t le = hipPeekAtLastError();
        if (le != hipSuccess) { fprintf(stderr, "kernel_launch: launch %d failed: %s\n", li, hipGetErrorName(le)); break; }
    }
}
```
